# Optimizing an MI355X kernel written in HIP

```python
import math
import jax, jax.numpy as jnp
from jax import lax
import numpy as np

D_MODEL = 2048
BATCH = 2
SEQ = 4096
DEPTH = 4

CHUNK = 64
PE_DIM = 256
EPS = 1e-6
RNN_WIDTH = 2048
RNN_BLOCKS = 16
RNN_BLOCK = 128
CONV_WIDTH = 4
LRU_C = 8.0
ATT_HEADS = 16
HEAD_DIM = 128
KV_HEADS = 4
ATT_WIDTH = 2048
KV_WIDTH = 512
IDX_HEADS = 16
IDX_DIM = 64
TOPK_MAX = 256
Q_BLOCK = 128
N_BUCKETS = 32
MAX_DISTANCE = 128
SG_CHUNK = 128
SG_GROUPS = 16
SG_GROUP = 128
SG_WIDTH = 2048
EVEN_SPLITS = (RNN_WIDTH, RNN_WIDTH, ATT_WIDTH, KV_WIDTH, KV_WIDTH, ATT_WIDTH, IDX_HEADS * IDX_DIM, IDX_DIM, IDX_HEADS)
EVEN_IN = 2 * RNN_WIDTH + 2 * ATT_WIDTH + 2 * KV_WIDTH + IDX_HEADS * IDX_DIM + IDX_DIM + IDX_HEADS
ODD_IN = 3 * SG_WIDTH
N_EVEN = (DEPTH + 1) // 2
N_ODD = DEPTH // 2

kernel_name = 'hybrid_rglru_dsa_sgu_trunk'


def rms_norm(x, gain):
    xf = x.astype(jnp.float32)
    y = xf * lax.rsqrt(jnp.mean(xf * xf, axis=-1, keepdims=True) + EPS)
    return (y * gain.astype(jnp.float32)).astype(x.dtype)


def layer_norm(x, gain, bias):
    xf = x.astype(jnp.float32)
    mu = jnp.mean(xf, axis=-1, keepdims=True)
    xc = xf - mu
    y = xc * lax.rsqrt(jnp.mean(xc * xc, axis=-1, keepdims=True) + EPS)
    return (y * gain.astype(jnp.float32) + bias.astype(jnp.float32)).astype(x.dtype)


def t5_bucket(rel):
    half = N_BUCKETS // 2
    max_exact = half // 2
    ret = jnp.where(rel > 0, half, 0)
    n = jnp.abs(rel)
    nf = jnp.maximum(n, 1).astype(jnp.float32)
    large = max_exact + (jnp.log(nf / max_exact) / math.log(MAX_DISTANCE / max_exact) * (half - max_exact)).astype(jnp.int32)
    large = jnp.minimum(large, half - 1)
    return ret + jnp.where(n < max_exact, n, large)


def causal_dwconv(x, w, b):
    c = x.shape[-1]
    xp = jnp.pad(x, ((0, 0), (CONV_WIDTH - 1, 0), (0, 0)))
    y = lax.conv_general_dilated(xp, w.astype(x.dtype)[:, None, :], window_strides=(1,), padding='VALID',
                                 dimension_numbers=('NWC', 'WIO', 'NWC'), feature_group_count=c)
    return y + b.astype(x.dtype)


def rg_lru(x, w_r, b_r, w_i, b_i, lam):
    bsz, t = x.shape[:2]
    xb = x.reshape(bsz, t, RNN_BLOCKS, RNN_BLOCK)
    r = jax.nn.sigmoid((jnp.einsum('btgi,gij->btgj', xb, w_r) + b_r).astype(jnp.float32)).reshape(bsz, t, RNN_WIDTH)
    i = jax.nn.sigmoid((jnp.einsum('btgi,gij->btgj', xb, w_i) + b_i).astype(jnp.float32)).reshape(bsz, t, RNN_WIDTH)
    log_a = -LRU_C * r * jax.nn.softplus(-lam.astype(jnp.float32))
    a = jnp.exp(log_a)
    mult = jnp.sqrt(jnp.maximum(-jnp.expm1(2.0 * log_a), 0.0))
    bx = mult * i * x.astype(jnp.float32)

    def combine(left, right):
        a1, b1 = left
        a2, b2 = right
        return a1 * a2, a2 * b1 + b2

    _, h = lax.associative_scan(combine, (a, bx), axis=1)
    return h.astype(x.dtype)


def dsa_attention(q, k, v, iq, ik, iw, rel_table, topk):
    bsz, t = q.shape[:2]
    n_blocks = t // Q_BLOCK
    rep = ATT_HEADS // KV_HEADS
    key_pos = jnp.arange(t)
    idx_scale = (IDX_DIM ** -0.5) * (IDX_HEADS ** -0.5)
    att_scale = HEAD_DIM ** -0.5

    def block(bi):
        t0 = bi * Q_BLOCK
        qb = lax.dynamic_slice_in_dim(q, t0, Q_BLOCK, axis=1)
        iqb = lax.dynamic_slice_in_dim(iq, t0, Q_BLOCK, axis=1)
        iwb = lax.dynamic_slice_in_dim(iw, t0, Q_BLOCK, axis=1)
        q_pos = t0 + jnp.arange(Q_BLOCK)
        limit = (q_pos // CHUNK + 1) * CHUNK
        s_h = jax.nn.relu(jnp.einsum('bqhd,bsd->bqhs', iqb, ik).astype(jnp.float32))
        score = jnp.einsum('bqhs,bqh->bqs', s_h, iwb.astype(jnp.float32)) * idx_scale
        admissible = key_pos[None, :] < limit[:, None]
        score = jnp.where(admissible[None], score, -jnp.inf)
        _, sel = lax.top_k(score, topk)
        valid = sel < limit[None, :, None]
        kg = jax.vmap(lambda kb, ib: kb[ib])(k, sel)
        vg = jax.vmap(lambda vb, ib: vb[ib])(v, sel)
        qg = qb.reshape(bsz, Q_BLOCK, KV_HEADS, rep, HEAD_DIM)
        logits = jnp.einsum('bqgrd,bqkgd->bqgrk', qg, kg).astype(jnp.float32) * att_scale
        bias = rel_table[t5_bucket(sel - q_pos[None, :, None])].astype(jnp.float32)
        bias = bias.reshape(bsz, Q_BLOCK, topk, KV_HEADS, rep).transpose(0, 1, 3, 4, 2)
        logits = jnp.where(valid[:, :, None, None, :], logits + bias, -jnp.inf)
        probs = jax.nn.softmax(logits, axis=-1).astype(v.dtype)
        o = jnp.einsum('bqgrk,bqkgd->bqgrd', probs, vg)
        return o.reshape(bsz, Q_BLOCK, ATT_WIDTH)

    out = lax.map(block, jnp.arange(n_blocks))
    return out.transpose(1, 0, 2, 3).reshape(bsz, t, ATT_WIDTH)


def even_mixer(hn, w_in, conv_w, conv_b, w_r, b_r, w_i, b_i, lam, q_gain, k_gain, rel_table, w_out, topk):
    bsz, t, _ = hn.shape
    offsets = [int(o) for o in np.cumsum(EVEN_SPLITS)[:-1]]
    xa, ga, q, k, v, gb, iq, ik, iw = jnp.split(hn @ w_in, offsets, axis=-1)
    ya = rg_lru(causal_dwconv(xa, conv_w, conv_b), w_r, b_r, w_i, b_i, lam) * jax.nn.silu(ga)
    q = rms_norm(q.reshape(bsz, t, ATT_HEADS, HEAD_DIM), q_gain)
    k = rms_norm(k.reshape(bsz, t, KV_HEADS, HEAD_DIM), k_gain)
    v = v.reshape(bsz, t, KV_HEADS, HEAD_DIM)
    iq = iq.reshape(bsz, t, IDX_HEADS, IDX_DIM)
    yb = dsa_attention(q, k, v, iq, ik, iw, rel_table, topk) * jax.nn.silu(gb)
    return jnp.concatenate([ya, yb], axis=-1) @ w_out


def odd_mixer(hn, w_in, ln_g, ln_b, w_s, b_s, w_out):
    bsz, t, _ = hn.shape
    u, v, g = jnp.split(hn @ w_in, 3, axis=-1)
    u = jax.nn.gelu(u)
    v = layer_norm(jax.nn.gelu(v), ln_g, ln_b)
    n_chunks = t // SG_CHUNK
    vc = v.reshape(bsz, n_chunks, SG_CHUNK, SG_GROUPS, SG_GROUP)
    cpos = jnp.arange(SG_CHUNK) // CHUNK
    mask = cpos[:, None] >= cpos[None, :]
    ws = jnp.where(mask[None], w_s, 0.0).astype(v.dtype)
    mixed = jnp.einsum('gts,bcsgd->bctgd', ws, vc) + b_s.T[:, :, None].astype(v.dtype)
    y = u * mixed.reshape(bsz, t, SG_WIDTH) * jax.nn.silu(g)
    return y @ w_out


def per_layer_embedding(h, p_i, w_pe, gate_norm, w_gate):
    e = p_i.astype(h.dtype) @ w_pe
    gate = jax.nn.sigmoid((rms_norm(h, gate_norm) @ w_gate).astype(jnp.float32)).astype(h.dtype)
    return gate * e


def setup_inputs(seed: int = 0) -> dict:
    key = jax.random.key(seed)
    ks = jax.random.split(key, 26)
    f32 = jnp.float32

    def nrm(k, shape, scale):
        return jax.random.normal(k, shape, f32) * scale

    u = jax.random.uniform(ks[11], (N_EVEN, RNN_WIDTH), f32, 0.9, 0.999)
    a = u ** (1.0 / LRU_C)
    return {
        'x': nrm(ks[0], (BATCH, SEQ, D_MODEL), 1.0),
        'p': nrm(ks[1], (DEPTH, BATCH, SEQ, PE_DIM), 1.0),
        'norm_gain': 1.0 + nrm(ks[2], (DEPTH, D_MODEL), 0.02),
        'rel_bias': nrm(ks[3], (N_BUCKETS, ATT_HEADS), 0.5),
        'even_w_in': nrm(ks[4], (N_EVEN, D_MODEL, EVEN_IN), D_MODEL ** -0.5),
        'conv_w': nrm(ks[5], (N_EVEN, CONV_WIDTH, RNN_WIDTH), CONV_WIDTH ** -0.5),
        'conv_b': nrm(ks[6], (N_EVEN, RNN_WIDTH), 0.01),
        'lru_w_r': nrm(ks[7], (N_EVEN, RNN_BLOCKS, RNN_BLOCK, RNN_BLOCK), RNN_BLOCK ** -0.5),
        'lru_b_r': nrm(ks[8], (N_EVEN, RNN_BLOCKS, RNN_BLOCK), 0.01),
        'lru_w_i': nrm(ks[9], (N_EVEN, RNN_BLOCKS, RNN_BLOCK, RNN_BLOCK), RNN_BLOCK ** -0.5),
        'lru_b_i': nrm(ks[10], (N_EVEN, RNN_BLOCKS, RNN_BLOCK), 0.01),
        'lru_lambda': jnp.log(a) - jnp.log1p(-a),
        'q_norm': 1.0 + nrm(ks[12], (N_EVEN, HEAD_DIM), 0.02),
        'k_norm': 1.0 + nrm(ks[13], (N_EVEN, HEAD_DIM), 0.02),
        'even_w_out': nrm(ks[14], (N_EVEN, RNN_WIDTH + ATT_WIDTH, D_MODEL), (RNN_WIDTH + ATT_WIDTH) ** -0.5),
        'odd_w_in': nrm(ks[15], (N_ODD, D_MODEL, ODD_IN), D_MODEL ** -0.5),
        'sg_ln_g': 1.0 + nrm(ks[16], (N_ODD, SG_WIDTH), 0.02),
        'sg_ln_b': nrm(ks[17], (N_ODD, SG_WIDTH), 0.01),
        'sg_w_s': nrm(ks[18], (N_ODD, SG_GROUPS, SG_CHUNK, SG_CHUNK), SG_CHUNK ** -0.5),
        'sg_b_s': 1.0 + nrm(ks[19], (N_ODD, SG_GROUPS, SG_CHUNK), 0.1),
        'odd_w_out': nrm(ks[20], (N_ODD, SG_WIDTH, D_MODEL), SG_WIDTH ** -0.5),
        'pe_w': nrm(ks[21], (DEPTH, PE_DIM, D_MODEL), PE_DIM ** -0.5),
        'pe_gate_norm': 1.0 + nrm(ks[22], (DEPTH, D_MODEL), 0.02),
        'pe_w_gate': nrm(ks[23], (DEPTH, D_MODEL, D_MODEL), D_MODEL ** -0.5),
    }


def reference(x, p, norm_gain, rel_bias, even_w_in, conv_w, conv_b, lru_w_r, lru_b_r, lru_w_i, lru_b_i,
              lru_lambda, q_norm, k_norm, even_w_out, odd_w_in, sg_ln_g, sg_ln_b, sg_w_s, sg_b_s, odd_w_out,
              pe_w, pe_gate_norm, pe_w_gate):
    topk = min(TOPK_MAX, x.shape[1] // 4)
    h = x
    for layer in range(DEPTH):
        hn = rms_norm(h, norm_gain[layer])
        j = layer // 2
        if layer % 2 == 0:
            mix = even_mixer(hn, even_w_in[j], conv_w[j], conv_b[j], lru_w_r[j], lru_b_r[j], lru_w_i[j],
                             lru_b_i[j], lru_lambda[j], q_norm[j], k_norm[j], rel_bias, even_w_out[j], topk)
        else:
            mix = odd_mixer(hn, odd_w_in[j], sg_ln_g[j], sg_ln_b[j], sg_w_s[j], sg_b_s[j], odd_w_out[j])
        h = h + mix
        h = h + per_layer_embedding(h, p[layer], pe_w[layer], pe_gate_norm[layer], pe_w_gate[layer])
    return h
```

```cpp
#include <hip/hip_runtime.h>
#include <cstdio>
#include <cstdint>
#include <cmath>
namespace pg8 {
#define PG8_LAS __attribute__((address_space(3)))
typedef unsigned short bf16_t;
typedef short bf16x8 __attribute__((ext_vector_type(8)));
typedef float f32x4 __attribute__((ext_vector_type(4)));
typedef unsigned u32x4 __attribute__((ext_vector_type(4)));
constexpr int BM = 256, BK = 64, HALF = 128, HTB = HALF * BK * 2  , STAGE_BYTES = 8 * HTB, NXCD = 8, WGM = 8;

__host__ __device__ __forceinline__ int lds_byte(int r, int c) { const int st = (r >> 4) * 2 + (c >> 5), rr = r & 15, cc = c & 31, ob = rr * 64 + cc * 2; return st * 1024 + (ob ^ (((ob >> 9) & 1) << 5)); }
__host__ __device__ __forceinline__ void stage_rc(int b, int& R, int& C) { const int st = b / 1024, sb = b % 1024, swz = sb ^ (((sb >> 9) & 1) << 5); R = (st >> 1) * 16 + swz / 64; C = (st & 1) * 32 + (swz % 64) / 2; }
__host__ __device__ __forceinline__ int perm32(int rho) { const int n = rho >> 4, i = rho & 15; return 8 * (i >> 2) + 4 * n + (i & 3); }

struct Unit { int pm, pn; };
struct Gemm { const bf16_t* A; const bf16_t* Bt; int M, N, K; };

struct StaticOrder {
    int nM, nN, nwg, G, c;
    __host__ __device__ void init(int M, int N, int G_, int c_) { nM = M / BM; nN = N / BM; nwg = nM * nN; G = G_; c = c_; }
    __host__ __device__ bool next(int i, Unit& u) const {
        const long L = (long)i * G + c; if (L >= nwg) return false;
        int wgid = (int)L; { const int q = nwg / NXCD, r = nwg % NXCD, xcd = wgid % NXCD, off = wgid / NXCD; wgid = (xcd < r ? xcd * (q + 1) : r * (q + 1) + (xcd - r) * q) + off; }
        const int nig = WGM * nN, gid = wgid / nig, fm = gid * WGM, gsz = (nM - fm) < WGM ? (nM - fm) : WGM;
        u.pm = fm + ((wgid % nig) % gsz); u.pn = (wgid % nig) / gsz; return true;
    }
    __device__ __forceinline__ void a_ready(const Unit&) const {}
    __device__ __forceinline__ void done(const Unit&) const {}
};

__device__ __forceinline__ unsigned cvt_pk_bf16(float lo, float hi) { unsigned r; asm volatile("v_cvt_pk_bf16_f32 %0, %1, %2" : "=v"(r) : "v"(lo), "v"(hi)); return r; }
typedef float f32x2 __attribute__((ext_vector_type(2)));
#ifdef EPI_NT
#define ST16(p, v) __builtin_nontemporal_store((v), (p))
#else
#define ST16(p, v) (*(p) = (v))
#endif
__device__ __forceinline__ float fast_sigmoid(float x) { return __builtin_amdgcn_rcpf(1.0f + __builtin_amdgcn_exp2f(x * -1.4426950408889634f)); }
__device__ __forceinline__ float silu_f(float x) { return x * fast_sigmoid(x); }
__device__ __forceinline__ float gelu_tanh_f(float x) { const float z = 1.5957691216057308f * (x + 0.044715f * x * x * x); return x * fast_sigmoid(z); }
__device__ __forceinline__ float xrow16_sum(float x) {
    auto s = __builtin_amdgcn_permlane16_swap(__float_as_uint(x), __float_as_uint(x), false, false);
    x = __uint_as_float(s[0]) + __uint_as_float(s[1]);
    auto t = __builtin_amdgcn_permlane32_swap(__float_as_uint(x), __float_as_uint(x), false, false);
    return __uint_as_float(t[0]) + __uint_as_float(t[1]);
}
__device__ __forceinline__ float bf2f(unsigned short v) { return __uint_as_float(((unsigned)v) << 16); }
__device__ __forceinline__ float row_rstd32(const float* part, int fq) {
    const f32x4 a = *(const f32x4*)(part + fq * 8), b = *(const f32x4*)(part + fq * 8 + 4);
    float s = ((a[0] + a[1]) + (a[2] + a[3])) + ((b[0] + b[1]) + (b[2] + b[3]));
    s = xrow16_sum(s);
    return __builtin_amdgcn_rsqf(s * (1.0f / 2048.0f) + 1e-6f);
}
__device__ __forceinline__ u32x4 pack8(const f32x4 v0, const f32x4 v1) { u32x4 w; w.x = cvt_pk_bf16(v0[0], v0[1]); w.y = cvt_pk_bf16(v0[2], v0[3]); w.z = cvt_pk_bf16(v1[0], v1[1]); w.w = cvt_pk_bf16(v1[2], v1[3]); return w; }

template <int NOSTORE> struct EpiEvenInT {
    static constexpr bool PERM = true, AFTER_DRAIN = false, PRE_STATS = true;
    bf16_t* PROJ; float* IDX; const float* stats; bf16_t* IDXB;
    __device__ __forceinline__ void operator()(const f32x4 (&acc)[2][2][4][2], const Unit& u, int wr, int wc, int fr, int fq, const float (&rs)[2][4]) const {
        const int rowb = u.pm * BM + wr * 64 + fr, pn = u.pn;
        if (pn < 36) {
            const bool act = __builtin_amdgcn_readfirstlane((int)((pn >= 8 && pn < 16) || (pn >= 28))) != 0;
            if (act) {
#pragma unroll
                for (int ai = 0; ai < 2; ++ai)
#pragma unroll
                    for (int m = 0; m < 4; ++m) { bf16_t* rowp = PROJ + (size_t)(rowb + ai * HALF + m * 16) * 9216 + pn * BM + wc * 32 + fq * 8; const float r = rs[ai][m];
#pragma unroll
                        for (int bj = 0; bj < 2; ++bj) { f32x4 v0 = acc[ai][bj][m][0] * r, v1 = acc[ai][bj][m][1] * r;
#pragma unroll
                            for (int i = 0; i < 4; ++i) { v0[i] = silu_f(v0[i]); v1[i] = silu_f(v1[i]); }
                            const u32x4 pk_ = pack8(v0, v1); if (NOSTORE) asm volatile("" :: "v"(pk_)); else ST16((u32x4*)(rowp + bj * HALF), pk_); } }
            } else {
#pragma unroll
                for (int ai = 0; ai < 2; ++ai)
#pragma unroll
                    for (int m = 0; m < 4; ++m) { bf16_t* rowp = PROJ + (size_t)(rowb + ai * HALF + m * 16) * 9216 + pn * BM + wc * 32 + fq * 8; const float r = rs[ai][m];
#pragma unroll
                        for (int bj = 0; bj < 2; ++bj) { const f32x4 v0 = acc[ai][bj][m][0] * r, v1 = acc[ai][bj][m][1] * r;
                            const u32x4 pk_ = pack8(v0, v1); if (NOSTORE) asm volatile("" :: "v"(pk_)); else ST16((u32x4*)(rowp + bj * HALF), pk_); } }
            }
        } else {
#ifdef CHECK_SCORE
            const bool f32too = true;
#else
            const bool f32too = __builtin_amdgcn_readfirstlane((int)(pn == 40)) != 0;
#endif
#pragma unroll
            for (int ai = 0; ai < 2; ++ai)
#pragma unroll
                for (int m = 0; m < 4; ++m) { float* rowp = IDX + (size_t)(rowb + ai * HALF + m * 16) * 1280 + (pn - 36) * BM + wc * 32 + fq * 8; const float r = rs[ai][m];
                    bf16_t* rowb16 = IDXB + (size_t)(rowb + ai * HALF + m * 16) * 1280 + (pn - 36) * BM + wc * 32 + fq * 8;
#pragma unroll
                    for (int bj = 0; bj < 2; ++bj) { const f32x4 v0 = acc[ai][bj][m][0] * r, v1 = acc[ai][bj][m][1] * r; if (f32too) { ST16((f32x4*)(rowp + bj * HALF), v0); ST16((f32x4*)(rowp + bj * HALF + 4), v1); } ST16((u32x4*)(rowb16 + bj * HALF), pack8(v0, v1)); } }
        }
    }
};
typedef EpiEvenInT<0> EpiEvenIn;
struct EpiOddIn {
    static constexpr bool PERM = true, AFTER_DRAIN = false, PRE_STATS = true;
    bf16_t* PROJ; const float* stats; float* statsLN;
    __device__ __forceinline__ void operator()(const f32x4 (&acc)[2][2][4][2], const Unit& u, int wr, int wc, int fr, int fq, const float (&rs)[2][4]) const {
        const int rowb = u.pm * BM + wr * 64 + fr, pn = u.pn;
#define EPO_BODY(ACTF) _Pragma("unroll") for (int ai = 0; ai < 2; ++ai) _Pragma("unroll") for (int m = 0; m < 4; ++m) { const int row = rowb + ai * HALF + m * 16; bf16_t* rowp = PROJ + (size_t)row * 6144 + pn * BM + wc * 32 + fq * 8; const float r = rs[ai][m]; \
                float s1 = 0.f, s2 = 0.f; \
                _Pragma("unroll") for (int bj = 0; bj < 2; ++bj) { f32x4 v0 = acc[ai][bj][m][0] * r, v1 = acc[ai][bj][m][1] * r; \
                    _Pragma("unroll") for (int i = 0; i < 4; ++i) { v0[i] = ACTF(v0[i]); v1[i] = ACTF(v1[i]); } \
                    _Pragma("unroll") for (int i = 0; i < 4; ++i) { s1 += v0[i] + v1[i]; s2 += v0[i] * v0[i] + v1[i] * v1[i]; } \
                    ST16((u32x4*)(rowp + bj * HALF), pack8(v0, v1)); } \
                if (stat) { s1 = xrow16_sum(s1); s2 = xrow16_sum(s2); if (fq == 0) { float* sp = statsLN + ((size_t)row * 32 + (pn - 8) * 4 + wc) * 2; sp[0] = s1; sp[1] = s2; } } }
        const bool isg = __builtin_amdgcn_readfirstlane((int)(pn < 16)) != 0, stat = __builtin_amdgcn_readfirstlane((int)(pn >= 8 && pn < 16)) != 0;
        if (isg) { EPO_BODY(gelu_tanh_f) } else { EPO_BODY(silu_f) }
#undef EPO_BODY
    }
};
__device__ __forceinline__ void unpack8(const u32x4 w, f32x4& a, f32x4& b) {
    a[0] = __uint_as_float(w.x << 16); a[1] = __uint_as_float(w.x & 0xffff0000u); a[2] = __uint_as_float(w.y << 16); a[3] = __uint_as_float(w.y & 0xffff0000u);
    b[0] = __uint_as_float(w.z << 16); b[1] = __uint_as_float(w.z & 0xffff0000u); b[2] = __uint_as_float(w.w << 16); b[3] = __uint_as_float(w.w & 0xffff0000u); }
struct EpiOut {
    static constexpr bool PERM = true, AFTER_DRAIN = false, PRE_STATS = false;
    const bf16_t* hin; bf16_t* hout; float* statsO;
    __device__ __forceinline__ void operator()(const f32x4 (&acc_)[2][2][4][2], const Unit& u, int wr, int wc, int fr, int fq) const {
        f32x4 (&acc)[2][2][4][2] = const_cast<f32x4 (&)[2][2][4][2]>(acc_);
        const int rowb = u.pm * BM + wr * 64 + fr, col0 = u.pn * BM + wc * 32 + fq * 8;
        float ssr[2][4];
#pragma unroll
        for (int ai = 0; ai < 2; ++ai)
#pragma unroll
            for (int m = 0; m < 4; ++m) { const int row = rowb + ai * HALF + m * 16; float ss = 0.f;
#pragma unroll
                for (int bj = 0; bj < 2; ++bj) { const size_t off = (size_t)row * 2048 + col0 + bj * HALF;
                    f32x4 h0, h1; unpack8(*(const u32x4*)(hin + off), h0, h1); h0 += acc[ai][bj][m][0]; h1 += acc[ai][bj][m][1];
                    acc[ai][bj][m][0] = h0; acc[ai][bj][m][1] = h1;
#pragma unroll
                    for (int i = 0; i < 4; ++i) ss += h0[i] * h0[i] + h1[i] * h1[i]; }
                ssr[ai][m] = xrow16_sum(ss); if (m == 3) asm volatile("" ::: "memory"); }
        asm volatile("" ::: "memory");
#pragma unroll
        for (int ai = 0; ai < 2; ++ai)
#pragma unroll
            for (int m = 0; m < 4; ++m) { const int row = rowb + ai * HALF + m * 16;
#pragma unroll
                for (int bj = 0; bj < 2; ++bj) { const size_t off = (size_t)row * 2048 + col0 + bj * HALF; ST16((u32x4*)(hout + off), pack8(acc[ai][bj][m][0], acc[ai][bj][m][1])); }
                if (fq == 0) statsO[(size_t)row * 32 + u.pn * 4 + wc] = ssr[ai][m]; }
    }
};
struct EpiPE {
    static constexpr bool PERM = true, AFTER_DRAIN = false, PRE_STATS = false;
    bf16_t* E;
    __device__ __forceinline__ void operator()(const f32x4 (&acc)[2][2][4][2], const Unit& u, int wr, int wc, int fr, int fq) const {
        const int rowb = u.pm * BM + wr * 64 + fr, col0 = u.pn * BM + wc * 32 + fq * 8;
#pragma unroll
        for (int ai = 0; ai < 2; ++ai)
#pragma unroll
            for (int m = 0; m < 4; ++m)
#pragma unroll
                for (int bj = 0; bj < 2; ++bj) ST16((u32x4*)(E + (size_t)(rowb + ai * HALF + m * 16) * 2048 + col0 + bj * HALF), pack8(acc[ai][bj][m][0], acc[ai][bj][m][1]));
    }
};
template <bool LAST> struct EpiGateT {
    static constexpr bool PERM = true, AFTER_DRAIN = false, PRE_STATS = true;
    const bf16_t* hin; const bf16_t* E; const float* stats; bf16_t* hout; float* statsO; float* fout;
    __device__ __forceinline__ void operator()(const f32x4 (&acc_)[2][2][4][2], const Unit& u, int wr, int wc, int fr, int fq, const float (&rs_)[2][4]) const {
        f32x4 (&acc)[2][2][4][2] = const_cast<f32x4 (&)[2][2][4][2]>(acc_);
        const int rowb = u.pm * BM + wr * 64 + fr, col0 = u.pn * BM + wc * 32 + fq * 8;
        float rs[2][4];
#pragma unroll
        for (int ai = 0; ai < 2; ++ai)
#pragma unroll
            for (int m = 0; m < 4; ++m) rs[ai][m] = rs_[ai][m];
#pragma unroll
        for (int ai = 0; ai < 2; ++ai)
#pragma unroll
            for (int m = 0; m < 4; ++m) { const int row = rowb + ai * HALF + m * 16; const float r = rs[ai][m]; float ss = 0.f;
#pragma unroll
                for (int bj = 0; bj < 2; ++bj) { const size_t off = (size_t)row * 2048 + col0 + bj * HALF;
                    f32x4 e0, e1, h0, h1; unpack8(*(const u32x4*)(E + off), e0, e1); unpack8(*(const u32x4*)(hin + off), h0, h1);
                    f32x4 g0 = acc[ai][bj][m][0] * r, g1 = acc[ai][bj][m][1] * r;
#pragma unroll
                    for (int i = 0; i < 4; ++i) { g0[i] = fast_sigmoid(g0[i]); g1[i] = fast_sigmoid(g1[i]); }
                    h0 += g0 * e0; h1 += g1 * e1;
                    acc[ai][bj][m][0] = h0; acc[ai][bj][m][1] = h1;
#pragma unroll
                    for (int i = 0; i < 4; ++i) ss += h0[i] * h0[i] + h1[i] * h1[i]; }
                if (!LAST) rs[ai][m] = xrow16_sum(ss);
                if (m == 3) asm volatile("" ::: "memory"); }
        asm volatile("" ::: "memory");
#pragma unroll
        for (int ai = 0; ai < 2; ++ai)
#pragma unroll
            for (int m = 0; m < 4; ++m) { const int row = rowb + ai * HALF + m * 16;
#pragma unroll
                for (int bj = 0; bj < 2; ++bj) { const size_t off = (size_t)row * 2048 + col0 + bj * HALF; const f32x4 h0 = acc[ai][bj][m][0], h1 = acc[ai][bj][m][1];
                    if (LAST) { ST16((f32x4*)(fout + off), h0); ST16((f32x4*)(fout + off + 4), h1); } else ST16((u32x4*)(hout + off), pack8(h0, h1)); }
                if (!LAST) { if (fq == 0) statsO[(size_t)row * 32 + u.pn * 4 + wc] = rs[ai][m]; } }
    }
};

struct EpiNull {
    static constexpr bool PERM = true, AFTER_DRAIN = false, PRE_STATS = false;
    __device__ __forceinline__ void operator()(const f32x4 (&acc)[2][2][4][2], const Unit& u, int wr, int wc, int fr, int fq) const {
#pragma unroll
        for (int ai = 0; ai < 2; ++ai)
#pragma unroll
            for (int bj = 0; bj < 2; ++bj) asm volatile("" :: "v"(acc[ai][bj][0][0]), "v"(acc[ai][bj][0][1]), "v"(acc[ai][bj][1][0]), "v"(acc[ai][bj][1][1]), "v"(acc[ai][bj][2][0]), "v"(acc[ai][bj][2][1]), "v"(acc[ai][bj][3][0]), "v"(acc[ai][bj][3][1])); }
};
template <class Epi, class Sched, bool ALIGN_EPI = false, bool SP2 = false>
__device__ __forceinline__ void gemm_phase(PG8_LAS unsigned char* lds, const Gemm g, const Sched& S, const Epi& E, const int wid_in) {
    int tid_; asm volatile("v_mbcnt_lo_u32_b32 %0, -1, 0\n\tv_mbcnt_hi_u32_b32 %0, -1, %0" : "=v"(tid_)); int wid = wid_in; asm volatile("" : "+s"(wid)); tid_ += wid * 64; asm volatile("" : "+v"(tid_));
    const int tid = tid_, lane = tid & 63, wr = wid >> 2, wc = wid & 3, fr = lane & 15, fq = lane >> 4;
    const int K = g.K, nt = K / BK;
    unsigned voffA[2], voffB[2];
#pragma unroll
    for (int i = 0; i < 2; ++i) { int R, C; stage_rc(tid * 16 + i * 8192, R, C); const int Rb = Epi::PERM ? ((R & ~31) + perm32(R & 31)) : R;
        voffA[i] = (unsigned)(R * K + C) * 2u; voffB[i] = (unsigned)(Rb * K + C) * 2u; }
    const size_t kstep = (size_t)(BK * 2);
    const size_t hstep = (size_t)HALF * K * 2;
    const size_t tstep = 2 * hstep;
    const unsigned ldsw = (unsigned)wid * 1024u;
    const int aoff = lds_byte(wr * 64 + fr, fq * 8), boff = lds_byte(wc * 32 + fr, fq * 8);
#define PG8_SA(b, h) (((b) * 2 + (h)) * HTB)
#define PG8_SB(b, h) ((4 + (b) * 2 + (h)) * HTB)
#define PG8_STAGE(bufoff, gbase, voff) do { _Pragma("unroll") for (int _i = 0; _i < 2; ++_i) \
        __builtin_amdgcn_global_load_lds((const unsigned*)((const char*)(gbase) + (voff)[_i]), (PG8_LAS unsigned*)(lds + (bufoff) + ldsw + _i * 8192), 16, 0, 0); } while (0)
#define PG8_LDA(dst, b, h) do { _Pragma("unroll") for (int m = 0; m < 4; ++m) _Pragma("unroll") for (int k = 0; k < 2; ++k) dst[m][k] = *(const PG8_LAS bf16x8*)(lds + PG8_SA(b, h) + aoff + m * 2048 + k * 1024); } while (0)
#define PG8_LDB(dst, b, h) do { _Pragma("unroll") for (int n = 0; n < 2; ++n) _Pragma("unroll") for (int k = 0; k < 2; ++k) dst[n][k] = *(const PG8_LAS bf16x8*)(lds + PG8_SB(b, h) + boff + n * 2048 + k * 1024); } while (0)
#define PG8_MMA(ai, bj, At, Bt) do { __builtin_amdgcn_s_setprio(1); _Pragma("unroll") for (int m = 0; m < 4; ++m) _Pragma("unroll") for (int n = 0; n < 2; ++n) _Pragma("unroll") for (int k = 0; k < 2; ++k) \
        acc[ai][bj][m][n] = __builtin_amdgcn_mfma_f32_16x16x32_bf16(Bt[n][k], At[m][k], acc[ai][bj][m][n], 0, 0, 0); __builtin_amdgcn_s_setprio(0); } while (0)
#define PG8_WAIT_V(n) asm volatile("s_waitcnt vmcnt(" #n ")" ::: "memory")
#define PG8_WAIT_L(n) asm volatile("s_waitcnt lgkmcnt(" #n ")" ::: "memory")
#define PG8_BAR __builtin_amdgcn_s_barrier()
#define PG8_SCHED __builtin_amdgcn_sched_barrier(0)
    Unit cur, nxt; int ui = 0;
    if (!S.next(0, cur)) return;
    f32x4 acc[2][2][4][2];
#pragma unroll
    for (int a = 0; a < 2; ++a)
#pragma unroll
        for (int b = 0; b < 2; ++b)
#pragma unroll
            for (int m = 0; m < 4; ++m)
#pragma unroll
                for (int n = 0; n < 2; ++n) acc[a][b][m][n] = (f32x4){0.f, 0.f, 0.f, 0.f};
    bf16x8 At[4][2], B0[2][2], B1[2][2];
    const char* cA = (const char*)g.A + (size_t)cur.pm * tstep; const char* cB = (const char*)g.Bt + (size_t)cur.pn * tstep;
    S.a_ready(cur);
    if constexpr (SP2) {
        PG8_STAGE(PG8_SB(0, 0), cB, voffB); PG8_STAGE(PG8_SB(0, 1), cB + hstep, voffB); PG8_STAGE(PG8_SA(0, 0), cA, voffA); PG8_STAGE(PG8_SA(0, 1), cA + hstep, voffA);
        if constexpr (Epi::PRE_STATS) {
            const int prow = tid >> 1, phalf = tid & 1;
#pragma unroll 1
            for (int i0 = 0; ; i0 += 3) { Unit uu[3]; bool hv[3];
#pragma unroll
                for (int q = 0; q < 3; ++q) { hv[q] = S.next(i0 + q, uu[q]); if (!hv[q]) uu[q] = cur; }
                if (!hv[0]) break;
                f32x4 pv[3][4];
#pragma unroll
                for (int q = 0; q < 3; ++q) { const float* sp = E.stats + ((size_t)(uu[q].pm * BM + prow) * 32 + phalf * 16);
#pragma unroll
                    for (int x = 0; x < 4; ++x) pv[q][x] = *(const f32x4*)(sp + 4 * x); }
#pragma unroll
                for (int q = 0; q < 3; ++q) { const f32x4 t4 = (pv[q][0] + pv[q][1]) + (pv[q][2] + pv[q][3]); float sq = (t4[0] + t4[1]) + (t4[2] + t4[3]);
                    sq += __int_as_float(__builtin_amdgcn_mov_dpp(__float_as_int(sq), 0xB1, 0xF, 0xF, true));
                    if (hv[q]) *(PG8_LAS float*)(lds + STAGE_BYTES + ((i0 + q) * 256 + prow) * 4) = __builtin_amdgcn_rsqf(sq * (1.0f / 2048.0f) + 1e-6f); }
                if (!hv[2]) break; }
        }
        if (wr == 1) PG8_BAR;
        PG8_WAIT_V(2); PG8_BAR;
        PG8_STAGE(PG8_SB(1, 0), cB + kstep, voffB); PG8_STAGE(PG8_SA(1, 0), cA + kstep, voffA); PG8_STAGE(PG8_SB(1, 1), cB + hstep + kstep, voffB);
        PG8_WAIT_V(6); PG8_BAR;
    } else {
        PG8_STAGE(PG8_SB(0, 0), cB, voffB); PG8_STAGE(PG8_SA(0, 0), cA, voffA); PG8_STAGE(PG8_SB(0, 1), cB + hstep, voffB); PG8_STAGE(PG8_SA(0, 1), cA + hstep, voffA);
        if (wr == 1) PG8_BAR;
        PG8_WAIT_V(4); PG8_BAR;
        PG8_STAGE(PG8_SB(1, 0), cB + kstep, voffB); PG8_STAGE(PG8_SA(1, 0), cA + kstep, voffA); PG8_STAGE(PG8_SB(1, 1), cB + hstep + kstep, voffB);
        PG8_WAIT_V(6); PG8_BAR;
    }
    for (;;) {
        const bool has_next = S.next(ui + 1, nxt);
        const char* nA = has_next ? (const char*)g.A + (size_t)nxt.pm * tstep : cA; const char* nB = has_next ? (const char*)g.Bt + (size_t)nxt.pn * tstep : cB;
        for (int t = 0; t < nt; t += 2) {
            const bool last = (t == nt - 2);
            const char* a1 = cA + (size_t)(t + 1) * kstep;
            const char* a2 = last ? nA : cA + (size_t)(t + 2) * kstep; const char* b2 = last ? nB : cB + (size_t)(t + 2) * kstep;
            const char* a3 = a2 + kstep; const char* b3 = b2 + kstep;
            if (last && has_next) S.a_ready(nxt);
            if constexpr (SP2) {
            PG8_LDB(B0, 0, 0); PG8_LDB(B1, 0, 1); PG8_SCHED; PG8_LDA(At, 0, 0); PG8_STAGE(PG8_SA(1, 1), a1 + hstep, voffA);
            PG8_WAIT_V(8); PG8_WAIT_L(0); PG8_BAR; PG8_MMA(0, 0, At, B0); PG8_MMA(0, 1, At, B1); PG8_BAR; PG8_SCHED;
            PG8_LDA(At, 0, 1); PG8_STAGE(PG8_SB(0, 0), b2, voffB); PG8_STAGE(PG8_SB(0, 1), b2 + hstep, voffB); PG8_STAGE(PG8_SA(0, 0), a2, voffA);
            PG8_WAIT_V(8); PG8_WAIT_L(0); PG8_BAR; PG8_MMA(1, 0, At, B0); PG8_MMA(1, 1, At, B1); PG8_BAR; PG8_SCHED;
            PG8_LDB(B0, 1, 0); PG8_LDB(B1, 1, 1); PG8_SCHED; PG8_LDA(At, 1, 0); PG8_STAGE(PG8_SA(0, 1), a2 + hstep, voffA);
            PG8_WAIT_V(8); PG8_WAIT_L(0); PG8_BAR; PG8_MMA(0, 0, At, B0); PG8_MMA(0, 1, At, B1); PG8_BAR; PG8_SCHED;
            PG8_LDA(At, 1, 1); PG8_STAGE(PG8_SB(1, 0), b3, voffB); PG8_STAGE(PG8_SB(1, 1), b3 + hstep, voffB); PG8_STAGE(PG8_SA(1, 0), a3, voffA);
            PG8_WAIT_V(8); PG8_WAIT_L(0); PG8_BAR; PG8_MMA(1, 0, At, B0); PG8_MMA(1, 1, At, B1); PG8_BAR; PG8_SCHED;
            } else {
            PG8_LDB(B0, 0, 0); PG8_SCHED; PG8_LDA(At, 0, 0); PG8_STAGE(PG8_SA(1, 1), a1 + hstep, voffA);
            PG8_WAIT_L(8); PG8_BAR; PG8_WAIT_L(0); PG8_MMA(0, 0, At, B0); PG8_BAR; PG8_SCHED;
            PG8_LDB(B1, 0, 1); PG8_STAGE(PG8_SB(0, 0), b2, voffB);
            PG8_BAR; PG8_WAIT_L(0); PG8_MMA(0, 1, At, B1); PG8_BAR;
            PG8_LDA(At, 0, 1); PG8_STAGE(PG8_SA(0, 0), a2, voffA);
            PG8_BAR; PG8_WAIT_L(0); PG8_MMA(1, 0, At, B0); PG8_BAR; PG8_SCHED;
            PG8_STAGE(PG8_SB(0, 1), b2 + hstep, voffB);
            PG8_WAIT_V(6); PG8_BAR; PG8_MMA(1, 1, At, B1); PG8_BAR;
            PG8_LDB(B0, 1, 0); PG8_SCHED; PG8_LDA(At, 1, 0); PG8_STAGE(PG8_SA(0, 1), a2 + hstep, voffA);
            PG8_WAIT_L(8); PG8_BAR; PG8_WAIT_L(0); PG8_MMA(0, 0, At, B0); PG8_BAR; PG8_SCHED;
            PG8_LDB(B1, 1, 1); PG8_STAGE(PG8_SB(1, 0), b3, voffB);
            PG8_BAR; PG8_WAIT_L(0); PG8_MMA(0, 1, At, B1); PG8_BAR;
            PG8_LDA(At, 1, 1); PG8_STAGE(PG8_SA(1, 0), a3, voffA);
            PG8_BAR; PG8_WAIT_L(0); PG8_MMA(1, 0, At, B0); PG8_BAR; PG8_SCHED;
            PG8_STAGE(PG8_SB(1, 1), b3 + hstep, voffB);
            PG8_WAIT_V(6); PG8_BAR; PG8_MMA(1, 1, At, B1); PG8_BAR;
            }
        }
        if constexpr (ALIGN_EPI) { if (wr == 0) PG8_BAR; }
        if constexpr (Epi::PRE_STATS) { float rs[2][4];
#pragma unroll
            for (int ai = 0; ai < 2; ++ai)
#pragma unroll
                for (int m = 0; m < 4; ++m) rs[ai][m] = *(const PG8_LAS float*)(lds + STAGE_BYTES + (ui * 256 + ai * HALF + wr * 64 + m * 16 + fr) * 4);
            E(acc, cur, wr, wc, fr, fq, rs); S.done(cur); }
        else if constexpr (!Epi::AFTER_DRAIN) { E(acc, cur, wr, wc, fr, fq); S.done(cur); }
        if (!has_next) break;
#pragma unroll
        for (int a = 0; a < 2; ++a)
#pragma unroll
            for (int b = 0; b < 2; ++b)
#pragma unroll
                for (int m = 0; m < 4; ++m)
#pragma unroll
                    for (int n = 0; n < 2; ++n) acc[a][b][m][n] = (f32x4){0.f, 0.f, 0.f, 0.f};
        cur = nxt; cA = nA; cB = nB; ++ui;
        if constexpr (ALIGN_EPI) { if (wr == 1) PG8_BAR; }
    }
    PG8_WAIT_V(0);
    if constexpr (!ALIGN_EPI) { if (wr == 0) PG8_BAR; }
    PG8_BAR;
    if constexpr (Epi::AFTER_DRAIN) { E.fused(acc, cur, wr, wc, fr, fq, lds, wid, lane); S.done(cur); }
#undef PG8_SA
#undef PG8_SB
#undef PG8_STAGE
#undef PG8_LDA
#undef PG8_LDB
#undef PG8_MMA
#undef PG8_WAIT_V
#undef PG8_WAIT_L
#undef PG8_BAR
#undef PG8_SCHED
}
}

#ifndef LRU_STREAM
#define LRU_STREAM 1
#endif
constexpr int NWAVES = 8, NTHR = 512;
constexpr int BATCH = 2, SEQ = 4096, DM = 2048, M = BATCH * SEQ, DEPTH = 4;
constexpr int EVEN_IN = 10320, EVEN_INP = 10496, PROJ_LD = 9216, ODD_IN = 6144, IDX_LD = 1280;
constexpr int COL_GA = 2048, COL_Q = 4096, COL_K = 6144, COL_V = 6656, COL_GB = 7168;
constexpr int TOPK = 256;
#ifndef N_LAUNCHES
#define N_LAUNCHES 1
#endif
constexpr int NPHASE = 1 + 2 * 6 + 2 * 4;
#ifndef PROBE_REP
#define PROBE_REP 0
#endif
#define NREP(n) ((PROBE_REP == (n)) ? 3 : 1)

constexpr size_t MiB = 1u << 20;
constexpr size_t WS_CTL = 0, CTL_ZERO_BYTES = 32768;
constexpr size_t WS_STATA = 1 * MiB, WS_STATB = 2 * MiB, WS_STATLN = 3 * MiB, WS_LRUSUM = 5 * MiB, WS_BM = 6 * MiB, WS_KN = 10 * MiB, WS_PBF = 18 * MiB;
constexpr size_t WS_WSMALL = 34 * MiB, WS_WPE = 38 * MiB, WS_WGATE = 42 * MiB, WS_WEIN = 74 * MiB, WS_WEOUT = 156 * MiB, WS_WOIN = 188 * MiB, WS_WOOUT = 236 * MiB;
constexpr size_t WS_H = 252 * MiB, WS_AN = 316 * MiB, WS_PROJ = 348 * MiB, WS_YCAT = 492 * MiB, WS_IDX = WS_YCAT, WS_IDXB = WS_YCAT + 40 * MiB, WS_SC = 556 * MiB, WS_E = WS_SC, WS_END = 622 * MiB;
constexpr size_t SCB = (size_t)4096 * 64 * 65 / 2;
static_assert(WS_IDXB + (size_t)M * IDX_LD * 2 <= WS_SC && WS_SC + 2 * SCB * 4 <= WS_END && WS_IDX + (size_t)M * IDX_LD * 4 <= WS_SC && WS_PROJ + (size_t)M * PROJ_LD * 2 <= WS_YCAT, "ws map");
constexpr int CW_BAR = 4096;
static_assert((CW_BAR + 3456) * 4 <= (int)CTL_ZERO_BYTES, "control words inside the memset");

constexpr int RING_BYTES = 131072, LDS_BYTES = 147456, MISC_OFF = LDS_BYTES - 256, XTRA_OFF = RING_BYTES;

#define GAS __attribute__((address_space(1)))
#define LAS __attribute__((address_space(3)))
typedef unsigned short bf16;
typedef unsigned v4u __attribute__((ext_vector_type(4)));
typedef unsigned v2u __attribute__((ext_vector_type(2)));
typedef float f32x4 __attribute__((ext_vector_type(4)));
typedef GAS unsigned gu32;
#define RLX_AGENT __ATOMIC_RELAXED, __HIP_MEMORY_SCOPE_AGENT
#define LDS_WAIT() asm volatile("s_waitcnt lgkmcnt(0)" ::: "memory")
__device__ __forceinline__ unsigned f2bf(float f) { unsigned u = __builtin_bit_cast(unsigned, f); return (u + 0x7fffu + ((u >> 16) & 1u)) >> 16; }
__device__ __forceinline__ unsigned pk2(float lo, float hi) { return f2bf(lo) | (f2bf(hi) << 16); }
__device__ __forceinline__ float bflo(unsigned w) { return __uint_as_float(w << 16); }
__device__ __forceinline__ float bfhi(unsigned w) { return __uint_as_float(w & 0xffff0000u); }
__device__ __forceinline__ float bf2f(bf16 v) { return __uint_as_float(((unsigned)v) << 16); }
__device__ __forceinline__ float shx(float v, int o, int lane) { return __int_as_float(__builtin_amdgcn_ds_bpermute((lane ^ o) << 2, __float_as_int(v))); }
__device__ __forceinline__ int shx_i(int v, int o, int lane) { return __builtin_amdgcn_ds_bpermute((lane ^ o) << 2, v); }
__device__ __forceinline__ int wave_sum_i(int v, int lane) {
    v += __builtin_amdgcn_update_dpp(0, v, 0x111, 0xF, 0xF, true); v += __builtin_amdgcn_update_dpp(0, v, 0x112, 0xF, 0xF, true);
    v += __builtin_amdgcn_update_dpp(0, v, 0x114, 0xF, 0xF, true); v += __builtin_amdgcn_update_dpp(0, v, 0x118, 0xF, 0xF, true);
    v += __builtin_amdgcn_update_dpp(0, v, 0x142, 0xA, 0xF, true); v += __builtin_amdgcn_update_dpp(0, v, 0x143, 0xC, 0xF, true);
    return __builtin_amdgcn_readlane(v, 63);
}
__device__ __forceinline__ float wave_sum(float v, int lane) {
    v += __int_as_float(__builtin_amdgcn_update_dpp(0, __float_as_int(v), 0x111, 0xF, 0xF, true)); v += __int_as_float(__builtin_amdgcn_update_dpp(0, __float_as_int(v), 0x112, 0xF, 0xF, true));
    v += __int_as_float(__builtin_amdgcn_update_dpp(0, __float_as_int(v), 0x114, 0xF, 0xF, true)); v += __int_as_float(__builtin_amdgcn_update_dpp(0, __float_as_int(v), 0x118, 0xF, 0xF, true));
    v += __int_as_float(__builtin_amdgcn_update_dpp(0, __float_as_int(v), 0x142, 0xA, 0xF, true)); v += __int_as_float(__builtin_amdgcn_update_dpp(0, __float_as_int(v), 0x143, 0xC, 0xF, true));
    return __int_as_float(__builtin_amdgcn_readlane(__float_as_int(v), 63));
}
__device__ __forceinline__ int lane_id() { int l; asm volatile("v_mbcnt_lo_u32_b32 %0, -1, 0\n\tv_mbcnt_hi_u32_b32 %0, -1, %0" : "=v"(l)); return l; }
__device__ __forceinline__ int make_tid(int wave) { asm volatile("" : "+s"(wave)); int t = wave * 64 + lane_id(); asm volatile("" : "+v"(t)); return t; }
__device__ __forceinline__ float fexp(float x) { return __builtin_amdgcn_exp2f(x * 1.4426950408889634f); }
__device__ __forceinline__ float frcp(float x) { return __builtin_amdgcn_rcpf(x); }
__device__ __forceinline__ float frsq(float x) { return __builtin_amdgcn_rsqf(x); }
__device__ __forceinline__ float sigmoid_acc(float x) { return frcp(1.0f + fexp(-x)); }

#define XB_TMO      128
#define XB_XCNT(j)  (256  + 64 * (j))
#define XB_XSUB(j)  (1280 + 64 * (j))
#define XB_XGEN(j)  (2304 + 64 * (j))
#define XB_TOP      3328
#define XB_TOPGEN   3392
#define XCD_BAR_WORDS 3456
#define XB_SPIN_CAP (1u << 18)

__device__ __forceinline__ unsigned xb_ld(unsigned* p)              { return __hip_atomic_load(p, __ATOMIC_RELAXED, __HIP_MEMORY_SCOPE_AGENT); }
__device__ __forceinline__ unsigned xb_add(unsigned* p, unsigned v) { return __hip_atomic_fetch_add(p, v, __ATOMIC_RELAXED, __HIP_MEMORY_SCOPE_AGENT); }
__device__ __forceinline__ unsigned xb_xcc_id() { return (unsigned)__builtin_amdgcn_s_getreg((3 << 11) | 20) & 0xFu; }
#define XB_SPIN(cond, bar) do { unsigned _sp = 0; while (cond) { __builtin_amdgcn_s_sleep(1); \
    if ((++_sp & 255u) == 0u) { if (xb_ld(&(bar)[XB_TMO])) break; if (_sp > XB_SPIN_CAP) { atomicAdd(&(bar)[XB_TMO], 1u); break; } } } } while (0)

struct XcdBarrier {
    unsigned* bar; unsigned x;
    volatile LAS unsigned* st;
};

__device__ __forceinline__ XcdBarrier xcd_barrier_post(unsigned* bar, volatile LAS unsigned* st) {
    XcdBarrier b; b.bar = bar; b.x = xb_xcc_id(); b.st = st;
    if (threadIdx.x == 0) (void)xb_add(&bar[XB_XCNT(b.x)], 1u);
    return b;
}
__device__ __forceinline__ void xcd_barrier_complete(unsigned* bar, unsigned x, unsigned& nloc, unsigned& nx) {
    const unsigned G = gridDim.x * gridDim.y * gridDim.z;
    unsigned sum, cnt, mine, sp = 0u;
    for (;;) {
        sum = 0u; cnt = 0u; mine = 0u;
#pragma unroll
        for (unsigned j = 0; j < 16; ++j) { const unsigned c = xb_ld(&bar[XB_XCNT(j)]); sum += c; cnt += (c > 0u) ? 1u : 0u; mine = (j == x) ? c : mine; }
        if (sum == G) break;
        __builtin_amdgcn_s_sleep(1);
        if ((++sp & 255u) == 0u) { if (xb_ld(&bar[XB_TMO])) break; if (sp > XB_SPIN_CAP) { atomicAdd(&bar[XB_TMO], 1u); break; } }
    }
    nloc = mine > 0u ? mine : 1u; nx = cnt > 0u ? cnt : 1u;
}

__device__ __forceinline__ void xcd_barrier(const XcdBarrier& b, const bool thread0) {
    asm volatile("s_waitcnt vmcnt(0)" ::: "memory");
    __syncthreads();
    if (thread0) {
        unsigned* bar = b.bar;
        __builtin_amdgcn_s_waitcnt(0);
        unsigned nloc = b.st[0], nx = b.st[1];
        if (nloc == 0u) { xcd_barrier_complete(bar, b.x, nloc, nx); b.st[0] = nloc; b.st[1] = nx; }
        const unsigned old = xb_add(&bar[XB_XSUB(b.x)], 1u);
        const unsigned gen = old / nloc;
        if (old + 1u == (gen + 1u) * nloc) {
            __builtin_amdgcn_fence(__ATOMIC_RELEASE, "agent");
            asm volatile("s_waitcnt vmcnt(0)" ::: "memory");
            const unsigned og = xb_add(&bar[XB_TOP], 1u);
            const unsigned tg = og / nx;
            if (og + 1u == (tg + 1u) * nx) xb_add(&bar[XB_TOPGEN], 1u);
            else XB_SPIN(xb_ld(&bar[XB_TOPGEN]) == tg, bar);
            __builtin_amdgcn_fence(__ATOMIC_ACQUIRE, "agent");
            xb_add(&bar[XB_XGEN(b.x)], 1u);
            asm volatile("s_waitcnt vmcnt(0)" ::: "memory");
        } else {
            XB_SPIN(xb_ld(&bar[XB_XGEN(b.x)]) == gen, bar);
            __builtin_amdgcn_fence(__ATOMIC_ACQUIRE, "agent");
            asm volatile("s_waitcnt vmcnt(0)" ::: "memory");
        }
    }
    __syncthreads();
}


typedef const char __attribute__((address_space(4)))* kargp_t;
#define KARGS_OPEN() int koff_ = 0; asm volatile("" : "+s"(koff_)); const kargp_t kp = (kargp_t)__builtin_amdgcn_kernarg_segment_ptr() + koff_
#define KIN(i) ((const float*)(const __attribute__((address_space(1))) float*)(*(const float* const __attribute__((address_space(4)))*)(kp + 8 * (i))))
#define KOUT ((float*)(__attribute__((address_space(1))) float*)(*(float* const __attribute__((address_space(4)))*)(kp + 192)))
#define KWS ((unsigned char*)(__attribute__((address_space(1))) unsigned char*)(*(unsigned char* const __attribute__((address_space(4)))*)(kp + 200)))
#define KTHR(k) (*(const int __attribute__((address_space(4)))*)(kp + 216 + 4 * (k)))
struct Args { const float* in[24]; float* out; unsigned char* ws; int ph_lo, ph_hi; int thr[8]; };

__device__ __forceinline__ void p0_transpose_item(const float* W, int K, int N, bf16* WT, float* scr, int item, int lane, const float* gk = nullptr) {
    const int nblk = (N + 63) / 64, kb = item / nblk, nb = item % nblk, k0 = 64 * kb, n0 = 64 * nb;
    const int nc = n0 + lane; const float* src = W + (size_t)k0 * N + (nc < N ? nc : 0);
    float v[64];
#pragma unroll
    for (int i = 0; i < 64; ++i) v[i] = __builtin_nontemporal_load(src + (size_t)i * N);
#pragma unroll
    for (int i = 0; i < 64; ++i) scr[i * 65 + lane] = (nc < N) ? v[i] : 0.f;
    LDS_WAIT(); asm volatile("" ::: "memory");
    const int c = lane & 7;
    f32x4 ga = (f32x4){1.f, 1.f, 1.f, 1.f}, gb = ga; if (gk) { ga = *(const f32x4*)(gk + k0 + 8 * c); gb = *(const f32x4*)(gk + k0 + 8 * c + 4); }
#pragma unroll
    for (int jn = 0; jn < 8; ++jn) { const int n = (lane >> 3) + 8 * jn; const float* s = scr + (8 * c) * 65 + n;
        v4u o; o.x = pk2(s[0 * 65] * ga[0], s[1 * 65] * ga[1]); o.y = pk2(s[2 * 65] * ga[2], s[3 * 65] * ga[3]); o.z = pk2(s[4 * 65] * gb[0], s[5 * 65] * gb[1]); o.w = pk2(s[6 * 65] * gb[2], s[7 * 65] * gb[3]);
        if (n0 + n < N) *(v4u*)(WT + (size_t)(n0 + n) * K + k0 + 8 * c) = o; }
    LDS_WAIT(); asm volatile("" ::: "memory");
}

__device__ __forceinline__ size_t sc_off(int b, int t) { const int c = t >> 6; return (size_t)b * SCB + (size_t)2048 * c * (c + 1) + (size_t)(t & 63) * 64 * (c + 1); }

__device__ __forceinline__ void lru_tile(const kargp_t kp, int j, int b, int tile, int g, bool final_pass, unsigned char* lds, int wave, bool check = false) {
    const int tid = make_tid(wave);
    float* XC = (float*)lds; float* AA = (float*)(lds + 65536); float* QS = (float*)(lds + XTRA_OFF);
    const bf16* PROJ = (const bf16*)(KWS + WS_PROJ); float* LRUSUM = (float*)(KWS + WS_LRUSUM); bf16* YCAT = (bf16*)(KWS + WS_YCAT);
    const float* conv_w = KIN(5) + (size_t)j * 4 * 2048; const float* conv_b = KIN(6) + (size_t)j * 2048;
    const float* w_r = KIN(7) + ((size_t)j * 16 + g) * 16384; const float* b_r = KIN(8) + ((size_t)j * 16 + g) * 128;
    const float* w_i = KIN(9) + ((size_t)j * 16 + g) * 16384; const float* b_i = KIN(10) + ((size_t)j * 16 + g) * 128;
    const float* lam = KIN(11) + (size_t)j * 2048;
    const int t0 = tile * 128, c0 = g * 128; const size_t row0 = (size_t)b * SEQ + t0;
    __syncthreads();
    for (int e = tid; e < 4096; e += NTHR) { const int t = e >> 5, cq = (e & 31) * 4;
        f32x4 acc = *(const f32x4*)(conv_b + c0 + cq);
#pragma unroll
        for (int k = 0; k < 4; ++k) { const int tt = t0 + t + k - 3;
            if (tt >= 0) { const v2u xw = *(const v2u*)(PROJ + ((size_t)b * SEQ + tt) * PROJ_LD + c0 + cq); const f32x4 w = *(const f32x4*)(conv_w + (size_t)k * 2048 + c0 + cq);
                acc[0] += bflo(xw.x) * w[0]; acc[1] += bfhi(xw.x) * w[1]; acc[2] += bflo(xw.y) * w[2]; acc[3] += bfhi(xw.y) * w[3]; } }
        *(f32x4*)(XC + t * 128 + cq) = acc; }
    __syncthreads();
    const int jj = tid & 127, q = tid >> 7;
    float R[32], I[32];
#pragma unroll
    for (int tt = 0; tt < 32; ++tt) { R[tt] = 0.f; I[tt] = 0.f; }
#pragma unroll 1
    for (int i = 0; i < 128; i += 4) {
        float wr4[4], wi4[4];
#pragma unroll
        for (int ii = 0; ii < 4; ++ii) { wr4[ii] = w_r[(size_t)(i + ii) * 128 + jj]; wi4[ii] = w_i[(size_t)(i + ii) * 128 + jj]; }
#pragma unroll
        for (int tt = 0; tt < 32; ++tt) { const f32x4 x = *(const f32x4*)(XC + (32 * q + tt) * 128 + i);
#pragma unroll
            for (int ii = 0; ii < 4; ++ii) { R[tt] += x[ii] * wr4[ii]; I[tt] += x[ii] * wi4[ii]; } }
    }
    __syncthreads();
    const int c = c0 + jj;
    const float el = fexp(-lam[c]); const float sp = el * (1.0f - el * (0.5f - el * (0.33333333f - el * 0.25f))), br = b_r[jj], bi = b_i[jj];
    float h = 0.f, A = 1.f;
#pragma unroll
    for (int tt = 0; tt < 32; ++tt) { const int t = 32 * q + tt;
        const float r = sigmoid_acc(R[tt] + br), ig = sigmoid_acc(I[tt] + bi), la = -8.0f * r * sp, aa = fexp(la), mult = __builtin_amdgcn_sqrtf(fmaxf(1.0f - fexp(2.0f * la), 0.f));
        const float bx = mult * ig * XC[t * 128 + jj];
        h = aa * h + bx; A *= aa; XC[t * 128 + jj] = h; AA[t * 128 + jj] = A; }
    QS[(q * 128 + jj) * 2] = A; QS[(q * 128 + jj) * 2 + 1] = h;
    __syncthreads();
    if (!final_pass) {
        if (q == 3) { float At = 1.f, ht = 0.f;
#pragma unroll
            for (int qq = 0; qq < 4; ++qq) { const float Aq = QS[(qq * 128 + jj) * 2], hq = QS[(qq * 128 + jj) * 2 + 1]; ht = Aq * ht + hq; At *= Aq; }
            float* sp2 = LRUSUM + (((size_t)b * 32 + tile) * 2048 + c) * 2; sp2[0] = At; sp2[1] = ht; }
    } else {
        float carry = 0.f;
        for (int tl = 0; tl < tile; ++tl) { const float* sp2 = LRUSUM + (((size_t)b * 32 + tl) * 2048 + c) * 2; carry = sp2[0] * carry + sp2[1]; }
        for (int qq = 0; qq < q; ++qq) carry = QS[(qq * 128 + jj) * 2] * carry + QS[(qq * 128 + jj) * 2 + 1];
#pragma unroll 4
        for (int tt = 0; tt < 32; ++tt) { const int t = 32 * q + tt; const float hv = XC[t * 128 + jj] + AA[t * 128 + jj] * carry;
            const float ga = bf2f(PROJ[(row0 + t) * PROJ_LD + COL_GA + c]);
            bf16* yp = YCAT + (row0 + t) * 4096 + c; const float yv = hv * ga;
            if (!check) *yp = (bf16)f2bf(yv); else if (!(fabsf(bf2f(*yp) - yv) <= 1e-4f + 0.03f * fabsf(ga) + 0.03f * fabsf(yv))) atomicOr((unsigned*)(KWS + WS_CTL) + 8, 4u); }
    }
}

typedef short s_bf16x8 __attribute__((ext_vector_type(8)));
__device__ __forceinline__ void lru_raw_dma(const kargp_t kp, int it, unsigned char* lds, int wave, int lane) {
    const bf16* PROJ = (const bf16*)(KWS + WS_PROJ); const int b = it >> 9, t0 = ((it >> 4) & 31) * 128, c0 = (it & 15) * 128;
#pragma unroll 1
    for (int q = wave; q < 33; q += 8) { const int row = q * 4 + (lane >> 4), tt = t0 - 3 + row;
        __builtin_amdgcn_global_load_lds((const unsigned*)(PROJ + ((size_t)b * SEQ + (tt >= 0 ? tt : 0)) * PROJ_LD + c0 + (lane & 15) * 8), (LAS unsigned*)(lds + 98304 + q * 1024), 16, 0, 0); }
}
__device__ __forceinline__ void lru_tile_mfma(const kargp_t kp, int j, int it, int it_next, bool first, bool final_pass, bool stream, unsigned char* lds, int wave) {
    const bool gates = final_pass || stream;
    const int b = it >> 9, tile = (it >> 4) & 31, g = it & 15;
    const int tid = make_tid(wave), lane = tid & 63, fr = lane & 15, q4 = lane >> 4, wid = tid >> 6;
    float* XF = (float*)lds; unsigned char* XB = lds + 65536; const unsigned char* RAW = lds + 98304;
    const bf16* PROJ = (const bf16*)(KWS + WS_PROJ); float* LRUSUM = (float*)(KWS + WS_LRUSUM); bf16* YCAT = (bf16*)(KWS + WS_YCAT);
    const float* conv_w = KIN(5) + (size_t)j * 4 * 2048; const float* conv_b = KIN(6) + (size_t)j * 2048;
    const int t0 = tile * 128, c0 = g * 128; const size_t row0 = (size_t)b * SEQ + t0;
    if (first) { __syncthreads(); lru_raw_dma(kp, it, lds, wave, lane); }
    asm volatile("s_waitcnt vmcnt(0)" ::: "memory"); __syncthreads();
    const int jl = 16 * wid + fr, c = c0 + jl;
    const bf16* wtr = (const bf16*)(KWS + WS_WSMALL) + ((size_t)(j * 16 + g) * 128 + jl) * 128 + 8 * q4; const bf16* wti = wtr + (size_t)2 * 16 * 128 * 128;
    s_bf16x8 wr[4], wi[4];
#pragma unroll
    for (int ks = 0; ks < 4; ++ks) { wr[ks] = *(const s_bf16x8*)(wtr + ks * 32); wi[ks] = *(const s_bf16x8*)(wti + ks * 32); }
    const float el = fexp(-KIN(11)[(size_t)j * 2048 + c]); const float sp8 = -8.0f * 1.4426950408889634f * (el * (1.0f - el * (0.5f - el * (0.33333333f - el * 0.25f))));
    const float br = KIN(8)[(size_t)(j * 16 + g) * 128 + jl], bi = KIN(10)[(size_t)(j * 16 + g) * 128 + jl];
    v4u gav[4];
    if (gates) {
#pragma unroll
        for (int i = 0; i < 4; ++i) { const int e = tid + NTHR * i, t = e >> 4, ch = e & 15; gav[i] = *(const v4u*)(PROJ + (row0 + t) * PROJ_LD + COL_GA + c0 + ch * 8); } }
    {
        const int tb = tid >> 5, cq = (tid & 31) * 4; const f32x4 bias = *(const f32x4*)(conv_b + c0 + cq);
        f32x4 cw[4];
#pragma unroll
        for (int k = 0; k < 4; ++k) cw[k] = *(const f32x4*)(conv_w + (size_t)k * 2048 + c0 + cq);
        v2u xw[8][4];
#pragma unroll
        for (int i = 0; i < 8; ++i)
#pragma unroll
            for (int k = 0; k < 4; ++k) xw[i][k] = *(const v2u*)(RAW + (tb + 16 * i + k) * 256 + cq * 2);
#pragma unroll
        for (int i = 0; i < 8; ++i) { const int t = tb + 16 * i; f32x4 acc = bias;
#pragma unroll
            for (int k = 0; k < 4; ++k) { const float on = (t0 + t + k - 3) >= 0 ? 1.f : 0.f; const f32x4 w = cw[k] * on;
                acc[0] += bflo(xw[i][k].x) * w[0]; acc[1] += bfhi(xw[i][k].x) * w[1]; acc[2] += bflo(xw[i][k].y) * w[2]; acc[3] += bfhi(xw[i][k].y) * w[3]; }
            *(f32x4*)(XF + t * 128 + cq) = acc;
            *(v2u*)(XB + t * 256 + ((cq * 2) ^ ((t & 15) << 4))) = (v2u){pk2(acc[0], acc[1]), pk2(acc[2], acc[3])}; }
    }
    __syncthreads();
    if (it_next < 1024) lru_raw_dma(kp, it_next, lds, wave, lane);
    typedef float f32x2_ __attribute__((ext_vector_type(2))); f32x2_ sm[31];
    if (final_pass) {
#pragma unroll
        for (int tl = 0; tl < 31; ++tl) sm[tl] = *(const f32x2_*)(LRUSUM + (((size_t)b * 32 + tl) * 2048 + c) * 2); }
    f32x4 aR[8], aI[8];
#pragma unroll
    for (int m = 0; m < 8; ++m) { aR[m] = (f32x4){0.f, 0.f, 0.f, 0.f}; aI[m] = aR[m]; }
#pragma unroll
    for (int m = 0; m < 8; ++m)
#pragma unroll
        for (int ks = 0; ks < 4; ++ks) { const s_bf16x8 a = *(const s_bf16x8*)(XB + (16 * m + fr) * 256 + (((ks * 32 + 8 * q4) * 2) ^ (fr << 4)));
            aR[m] = __builtin_amdgcn_mfma_f32_16x16x32_bf16(a, wr[ks], aR[m], 0, 0, 0); aI[m] = __builtin_amdgcn_mfma_f32_16x16x32_bf16(a, wi[ks], aI[m], 0, 0, 0); }
    if (gates) { __syncthreads();
#pragma unroll
        for (int i = 0; i < 4; ++i) { const int e = tid + NTHR * i, t = e >> 4, ch = e & 15; *(v4u*)(XB + t * 256 + ch * 16) = gav[i]; }
        __syncthreads(); }
    float carry = 0.f, Atot = 1.f;
    if (final_pass) {
#pragma unroll
        for (int tl = 0; tl < 31; ++tl) carry = (tl < tile) ? sm[tl][0] * carry + sm[tl][1] : carry; }
    unsigned short gq[8][4];
    if (gates) {
#pragma unroll
        for (int m = 0; m < 8; ++m)
#pragma unroll
            for (int r = 0; r < 4; ++r) gq[m][r] = *(const unsigned short*)(XB + (16 * m + 4 * q4 + r) * 256 + jl * 2); }
#pragma unroll
    for (int m = 0; m < 8; ++m) {
        float hl[4], Al[4]; float h = 0.f, A = 1.f;
#pragma unroll
        for (int r = 0; r < 4; ++r) { const int t = 16 * m + 4 * q4 + r; const float x = XF[t * 128 + jl];
            const float rg = frcp(1.0f + fexp(-(aR[m][r] + br))), ig = frcp(1.0f + fexp(-(aI[m][r] + bi)));
            const float la2 = rg * sp8, aa = __builtin_amdgcn_exp2f(la2), mult = __builtin_amdgcn_sqrtf(fmaxf(1.0f - aa * aa, 0.f));
            h = aa * h + mult * ig * x; A *= aa; hl[r] = h; Al[r] = A; }
        float cin = carry, cq = carry, Ain = Atot;
        float Arow[4], hrow[4];
        {   const auto sA = __builtin_amdgcn_permlane16_swap(__float_as_uint(A), __float_as_uint(A), false, false); const auto sH = __builtin_amdgcn_permlane16_swap(__float_as_uint(h), __float_as_uint(h), false, false);
            const auto a02 = __builtin_amdgcn_permlane32_swap(sA[0], sA[0], false, false), a13 = __builtin_amdgcn_permlane32_swap(sA[1], sA[1], false, false);
            const auto h02 = __builtin_amdgcn_permlane32_swap(sH[0], sH[0], false, false), h13 = __builtin_amdgcn_permlane32_swap(sH[1], sH[1], false, false);
            Arow[0] = __uint_as_float(a02[0]); Arow[2] = __uint_as_float(a02[1]); Arow[1] = __uint_as_float(a13[0]); Arow[3] = __uint_as_float(a13[1]);
            hrow[0] = __uint_as_float(h02[0]); hrow[2] = __uint_as_float(h02[1]); hrow[1] = __uint_as_float(h13[0]); hrow[3] = __uint_as_float(h13[1]); }
#pragma unroll
        for (int qq = 0; qq < 4; ++qq) { const float Aq = Arow[qq], hq = hrow[qq];
            if (qq == q4) { cin = cq; Ain = Atot; }
            cq = Aq * cq + hq; Atot *= Aq; }
        carry = cq;
        if (final_pass) {
#pragma unroll
            for (int r = 0; r < 4; ++r) { const int t = 16 * m + 4 * q4 + r; const float hv = hl[r] + Al[r] * cin;
                bf16* gp = (bf16*)(XB + t * 256 + jl * 2); *gp = (bf16)f2bf(hv * bf2f(gq[m][r])); } }
        if (stream) {
#pragma unroll
            for (int r = 0; r < 4; ++r) { const int t = 16 * m + 4 * q4 + r; const float sg = bf2f(gq[m][r]); const float hv = hl[r] + Al[r] * cin, ac = Al[r] * Ain;
                *(bf16*)(XB + t * 256 + jl * 2) = (bf16)f2bf(hv * sg);
                *(unsigned*)(XF + t * 128 + jl) = (unsigned)f2bf(ac * sg); } }
    }
    if (gates) { __syncthreads();
        bf16* dstb = stream ? (bf16*)(KWS + WS_AN) + row0 * 2048 + c0 : YCAT + row0 * 4096 + c0; const int dld = stream ? 2048 : 4096;
#pragma unroll
        for (int i = 0; i < 4; ++i) { const int e = tid + NTHR * i, t = e >> 4, ch = e & 15; *(v4u*)(dstb + (size_t)t * dld + ch * 8) = *(const v4u*)(XB + t * 256 + ch * 16); } }
    if (stream) { bf16* WB = (bf16*)KOUT + (size_t)M * DM;
#pragma unroll
        for (int i = 0; i < 4; ++i) { const int e = tid + NTHR * i, t = e >> 4, ch = e & 15; const v4u a = *(const v4u*)(XF + t * 128 + ch * 8), b2 = *(const v4u*)(XF + t * 128 + ch * 8 + 4);
            *(v4u*)(WB + (row0 + t) * 2048 + c0 + ch * 8) = (v4u){(a.x & 0xffffu) | (a.y << 16), (a.z & 0xffffu) | (a.w << 16), (b2.x & 0xffffu) | (b2.y << 16), (b2.z & 0xffffu) | (b2.w << 16)}; } }
    if (!final_pass && q4 == 0) { float* s2 = LRUSUM + (((size_t)b * 32 + tile) * 2048 + c) * 2; s2[0] = Atot; s2[1] = carry; }
}
__device__ __forceinline__ void lru_carry4(const kargp_t kp, int it0, int Gs, float* CL, int wave) {
    const int tid = make_tid(wave), k = tid >> 7, ch = tid & 127, it = it0 + k * Gs;
    if (it < 1024) { const int b = it >> 9, tile = (it >> 4) & 31, c = (it & 15) * 128 + ch; const float* LRUSUM = (const float*)(KWS + WS_LRUSUM);
        typedef float f32x2_ __attribute__((ext_vector_type(2))); f32x2_ sm[31]; float carry = 0.f;
#pragma unroll
        for (int tl = 0; tl < 31; ++tl) sm[tl] = *(const f32x2_*)(LRUSUM + (((size_t)b * 32 + tl) * 2048 + c) * 2);
#pragma unroll
        for (int tl = 0; tl < 31; ++tl) carry = (tl < tile) ? sm[tl][0] * carry + sm[tl][1] : carry;
        CL[tid] = carry; }
}
__device__ __forceinline__ void lru_apply_item(const kargp_t kp, int it, const float* CL, int wave) {
    const int b = it >> 9, tile = (it >> 4) & 31, g = it & 15; const int tid = make_tid(wave);
    bf16* YCAT = (bf16*)(KWS + WS_YCAT); const bf16* WB = (const bf16*)KOUT + (size_t)M * DM; const bf16* UB = (const bf16*)(KWS + WS_AN);
    const int t0 = tile * 128, c0 = g * 128; const size_t row0 = (size_t)b * SEQ + t0;
    v4u uw[4], ww[4];
#pragma unroll
    for (int i = 0; i < 4; ++i) { const int e = tid + NTHR * i, t = e >> 4, ch = e & 15; uw[i] = *(const v4u*)(UB + (row0 + t) * 2048 + c0 + ch * 8); ww[i] = *(const v4u*)(WB + (row0 + t) * 2048 + c0 + ch * 8); }
#pragma unroll
    for (int i = 0; i < 4; ++i) { const int e = tid + NTHR * i, t = e >> 4, ch = e & 15; const f32x4 c0v = *(const f32x4*)(CL + ch * 8), c1v = *(const f32x4*)(CL + ch * 8 + 4);
        const v4u u = uw[i], w = ww[i]; v4u o;
        o.x = pk2(bflo(u.x) + bflo(w.x) * c0v[0], bfhi(u.x) + bfhi(w.x) * c0v[1]); o.y = pk2(bflo(u.y) + bflo(w.y) * c0v[2], bfhi(u.y) + bfhi(w.y) * c0v[3]);
        o.z = pk2(bflo(u.z) + bflo(w.z) * c1v[0], bfhi(u.z) + bfhi(w.z) * c1v[1]); o.w = pk2(bflo(u.w) + bflo(w.w) * c1v[2], bfhi(u.w) + bfhi(w.w) * c1v[3]);
        *(v4u*)(YCAT + (row0 + t) * 4096 + c0 + ch * 8) = o; }
}

__device__ __forceinline__ void knorm_item(const kargp_t kp, int j, int it, int wave, int lane) {
    const bf16* PROJ = (const bf16*)(KWS + WS_PROJ); bf16* KN = (bf16*)(KWS + WS_KN); const float* kg = KIN(13) + (size_t)j * 128;
    const float g0 = kg[lane * 2], g1 = kg[lane * 2 + 1];
    unsigned w[8];
#pragma unroll
    for (int p = 0; p < 8; ++p) { const int pr = it * 64 + wave * 8 + p, row = pr >> 2, g = pr & 3; w[p] = *(const unsigned*)(PROJ + (size_t)row * PROJ_LD + COL_K + g * 128 + lane * 2); }
    asm volatile("" ::: "memory");
#pragma unroll
    for (int p = 0; p < 8; ++p) { const int pr = it * 64 + wave * 8 + p, row = pr >> 2, g = pr & 3;
        const float x0 = bflo(w[p]), x1 = bfhi(w[p]); const float ss = wave_sum(x0 * x0 + x1 * x1, lane);
        const float rstd = frsq(ss * (1.0f / 128.0f) + 1e-6f);
        *(unsigned*)(KN + (size_t)row * 512 + g * 128 + lane * 2) = pk2(x0 * rstd * g0, x1 * rstd * g1); }
}

__device__ __forceinline__ void score_item(const kargp_t kp, int b, int c, int kt, unsigned char* lds, int wave, bool check = false) {
    const int tid = make_tid(wave); const float* IDX = (const float*)(KWS + WS_IDX); float* SC = (float*)(KWS + WS_SC);
    float* IQs = (float*)lds; float* IKs = (float*)(lds + 32768);
    const int q = tid & 63, kg = tid >> 6; const size_t qrow0 = (size_t)b * SEQ + c * 64, krow0 = (size_t)b * SEQ + kt * 64;
    __syncthreads();
    for (int e = tid; e < 4096; e += NTHR) { const int k = e >> 6, d = e & 63; IKs[k * 65 + d] = IDX[(krow0 + k) * IDX_LD + 1024 + d]; }
    float acc[8];
#pragma unroll
    for (int kk = 0; kk < 8; ++kk) acc[kk] = 0.f;
#pragma unroll 1
    for (int h = 0; h < 16; ++h) {
        __syncthreads();
        for (int e = tid; e < 4096; e += NTHR) { const int qq = e >> 6, d = e & 63; IQs[qq * 65 + d] = IDX[(qrow0 + qq) * IDX_LD + h * 64 + d]; }
        __syncthreads();
        const float w = IDX[(qrow0 + q) * IDX_LD + 1088 + h];
        float qv[64];
#pragma unroll
        for (int d = 0; d < 64; ++d) qv[d] = IQs[q * 65 + d];
#pragma unroll
        for (int kk = 0; kk < 8; ++kk) { const float* kr = IKs + (kg * 8 + kk) * 65; float dot = 0.f;
#pragma unroll
            for (int d = 0; d < 64; ++d) dot += qv[d] * kr[d];
            acc[kk] += w * fmaxf(dot, 0.f); }
    }
    float* dst = SC + sc_off(b, c * 64 + q) + kt * 64 + kg * 8;
#pragma unroll
    for (int kk = 0; kk < 8; ++kk) { if (!check) dst[kk] = acc[kk]; else if (!(fabsf(dst[kk] - acc[kk]) <= 1.0f + 0.02f * fabsf(acc[kk]))) atomicOr((unsigned*)(KWS + WS_CTL) + 8, 1u); }
}

__device__ __forceinline__ void score_wave_unit(const kargp_t kp, int b, int c, int qg, int ks, int lane, unsigned char* lds, int wave) {
    const bf16* IDXB = (const bf16*)(KWS + WS_IDXB); const float* IDX = (const float*)(KWS + WS_IDX); float* SC = (float*)(KWS + WS_SC);
    const int fr = lane & 15, fq = lane >> 4; const size_t qrow = (size_t)b * SEQ + c * 64 + qg * 16 + fr;
    s_bf16x8 bq[16][2];
#pragma unroll
    for (int h = 0; h < 16; ++h)
#pragma unroll
        for (int s = 0; s < 2; ++s) bq[h][s] = *(const s_bf16x8*)(IDXB + qrow * IDX_LD + h * 64 + s * 32 + 8 * fq);
    float w[16];
#pragma unroll
    for (int h4 = 0; h4 < 4; ++h4) { const f32x4 t = *(const f32x4*)(IDX + qrow * IDX_LD + 1088 + 4 * h4); w[4 * h4] = t[0]; w[4 * h4 + 1] = t[1]; w[4 * h4 + 2] = t[2]; w[4 * h4 + 3] = t[3]; }
    float* dst = SC + sc_off(b, c * 64 + qg * 16 + fr) + fq * 4;
    const int ntile = 4 * (c + 1);
    const bf16* kbase = IDXB + ((size_t)b * SEQ + fr) * IDX_LD + 1024 + 8 * fq;
    unsigned char* ring = lds + wave * 8192;
#define SC_DMA(S, KT) do { const int kn_ = (KT) < ntile ? (KT) : ks; const bf16* src_ = kbase + (size_t)kn_ * 16 * IDX_LD; \
        __builtin_amdgcn_global_load_lds((const unsigned*)src_, (LAS unsigned*)(ring + (S) * 2048), 16, 0, 0); __builtin_amdgcn_global_load_lds((const unsigned*)(src_ + 32), (LAS unsigned*)(ring + (S) * 2048 + 1024), 16, 0, 0); } while (0)
#define SC_TILE(S, KT, NW) do { if ((KT) < ntile) { asm volatile("s_waitcnt vmcnt(" #NW ")" ::: "memory"); \
        const s_bf16x8 a0 = *(const LAS s_bf16x8*)((LAS unsigned char*)ring + (S) * 2048 + lane * 16), a1 = *(const LAS s_bf16x8*)((LAS unsigned char*)ring + (S) * 2048 + 1024 + lane * 16); \
        asm volatile("s_waitcnt lgkmcnt(0)" ::: "memory"); SC_DMA(S, (KT) + 32); f32x4 sc = {0.f, 0.f, 0.f, 0.f}; \
        _Pragma("unroll") for (int h = 0; h < 16; ++h) { f32x4 acc = {0.f, 0.f, 0.f, 0.f}; \
            acc = __builtin_amdgcn_mfma_f32_16x16x32_bf16(a0, bq[h][0], acc, 0, 0, 0); acc = __builtin_amdgcn_mfma_f32_16x16x32_bf16(a1, bq[h][1], acc, 0, 0, 0); \
            _Pragma("unroll") for (int r = 0; r < 4; ++r) { const int ri_ = __float_as_int(acc[r]); sc[r] += w[h] * __int_as_float(ri_ > 0 ? ri_ : 0); } } \
        *(f32x4*)(dst + (KT) * 16) = sc; asm volatile("" ::: "memory"); } } while (0)
    SC_DMA(0, ks); SC_DMA(1, ks + 8); SC_DMA(2, ks + 16); SC_DMA(3, ks + 24);
    asm volatile("s_waitcnt vmcnt(0)" ::: "memory");
#pragma unroll 1
    for (int kt = ks; kt < ntile; kt += 32) { SC_TILE(0, kt, 10); SC_TILE(1, kt + 8, 10); SC_TILE(2, kt + 16, 10); SC_TILE(3, kt + 24, 10); }
#undef SC_DMA
#undef SC_TILE
}

template <int NV> __device__ __forceinline__ void select_query_nv(const kargp_t kp, int qi, int lane) {
    const float* SC = (const float*)(KWS + WS_SC); unsigned* BMr = (unsigned*)(KWS + WS_BM) + (size_t)qi * 128;
    const int b = qi >> 12, t = qi & 4095, nv = (t >> 6) + 1;
    const float* row = SC + sc_off(b, t);
    unsigned key[NV];
#pragma unroll
    for (int v = 0; v < NV; ++v) { unsigned k = 0u;
        if (v < nv) { const float s = row[v * 64 + lane] + 0.0f; const unsigned u = __float_as_uint(s); k = (u & 0x80000000u) ? ~u : (u | 0x80000000u); }
        key[v] = k; }
    unsigned tau = 0u; int ctau = 64 * nv;
    bool done = false;
#ifndef SELECT_NO_PK16
    {
        typedef unsigned short us2 __attribute__((ext_vector_type(2)));
        us2 hp[NV / 2];
#pragma unroll
        for (int v = 0; v < NV / 2; ++v) { const unsigned w_ = (key[2 * v] >> 16) | (key[2 * v + 1] & 0xffff0000u); hp[v] = __builtin_bit_cast(us2, w_); }
        for (int bit = 31; bit >= 16; --bit) {
            const unsigned cand = tau | (1u << bit); const unsigned short c1 = (unsigned short)((cand >> 16) - 1u); const us2 c2 = {c1, c1}; const us2 one2 = {1, 1}; us2 acc = {0, 0};
#pragma unroll
            for (int v = 0; v < NV / 2; ++v) { unsigned d_; asm("v_pk_sub_u16 %0, %1, %2 clamp\n\tv_pk_min_u16 %0, %0, %3" : "=&v"(d_) : "v"(__builtin_bit_cast(unsigned, hp[v])), "v"(__builtin_bit_cast(unsigned, c2)), "v"(__builtin_bit_cast(unsigned, one2)));
                acc += __builtin_bit_cast(us2, d_); }
            int cnt = (int)acc[0] + (int)acc[1];
            cnt = wave_sum_i(cnt, lane);
            if (cnt >= TOPK) { tau = cand; ctau = cnt; }
            if (cnt == TOPK) { done = true; break; }
        }
    }
    for (int bit = 15; bit >= 0 && !done; --bit) {
#else
    for (int bit = 31; bit >= 0; --bit) {
#endif
        const unsigned cand = tau | (1u << bit); int cnt = 0;
#pragma unroll
        for (int v = 0; v < NV; ++v) cnt += (key[v] >= cand) ? 1 : 0;
        cnt = wave_sum_i(cnt, lane);
        if (cnt >= TOPK) { tau = cand; ctau = cnt; }
        if (cnt == TOPK) break;
    }
    unsigned mylo = 0u, myhi = 0u;
    if (ctau == TOPK) {
#pragma unroll
        for (int v = 0; v < NV; ++v) {
            const unsigned long long sm = __ballot(key[v] >= tau);
            { const unsigned slo = (unsigned)sm, shi = (unsigned)(sm >> 32); asm volatile("s_nop 1\n\tv_writelane_b32 %0, %2, %4\n\tv_writelane_b32 %1, %3, %4" : "+v"(mylo), "+v"(myhi) : "s"(slo), "s"(shi), "i"(v)); }
            __builtin_amdgcn_sched_barrier(0);
        }
    } else {
        int ngt = 0;
#pragma unroll
        for (int v = 0; v < NV; ++v) ngt += __popcll(__ballot(key[v] > tau));
        int need = TOPK - ngt;
#pragma unroll
        for (int v = 0; v < NV; ++v) {
            const bool eq = key[v] == tau; const unsigned long long em = __ballot(eq);
            const int below = __builtin_amdgcn_mbcnt_hi((unsigned)(em >> 32), __builtin_amdgcn_mbcnt_lo((unsigned)em, 0u));
            const bool sel = (key[v] > tau) || (eq && below < need);
            need -= __popcll(em); if (need < 0) need = 0;
            const unsigned long long sm = __ballot(sel);
            { const unsigned slo = (unsigned)sm, shi = (unsigned)(sm >> 32); asm volatile("s_nop 1\n\tv_writelane_b32 %0, %2, %4\n\tv_writelane_b32 %1, %3, %4" : "+v"(mylo), "+v"(myhi) : "s"(slo), "s"(shi), "i"(v)); }
            __builtin_amdgcn_sched_barrier(0);
        }
    }
    *(v2u*)(BMr + 2 * lane) = (v2u){mylo, myhi};
}

__device__ __forceinline__ void select_query(const kargp_t kp, int qi, int lane) {
    const int nv = ((qi & 4095) >> 6) + 1;
    if (nv <= 4) { unsigned* BMr = (unsigned*)(KWS + WS_BM) + (size_t)qi * 128; const unsigned w0 = (lane < nv) ? 0xffffffffu : 0u; *(v2u*)(BMr + 2 * lane) = (v2u){w0, w0}; }
#ifndef SELECT_NV64_ONLY
    else if (nv <= 16) select_query_nv<16>(kp, qi, lane);
    else if (nv <= 32) select_query_nv<32>(kp, qi, lane);
    else if (nv <= 48) select_query_nv<48>(kp, qi, lane);
#endif
    else select_query_nv<64>(kp, qi, lane);
}

__device__ __forceinline__ float rel_bias_at(const kargp_t kp, int rel, int h) {
    const int n = rel < 0 ? -rel : rel; int bk = n;
    if (n >= 8) { bk = 8;
#pragma unroll
        for (int k = 1; k < 8; ++k) bk += (n >= KTHR(k)) ? 1 : 0; }
    bk += (rel > 0 ? 16 : 0);
    return KIN(3)[bk * 16 + h];
}

__device__ __forceinline__ void attn_query(const kargp_t kp, int j, int qi, unsigned char* lds, int wave, bool check = false) {
    const int tid = make_tid(wave), b = qi >> 12, t = qi & 4095, limit = ((t >> 6) + 1) * 64;
    const bf16* PROJ = (const bf16*)(KWS + WS_PROJ); const bf16* KN = (const bf16*)(KWS + WS_KN); const unsigned* BM = (const unsigned*)(KWS + WS_BM); bf16* YCAT = (bf16*)(KWS + WS_YCAT);
    int* sel = (int*)lds; int* wcnt = (int*)(lds + 1024); int* nselp = (int*)(lds + 1536); float* qs = (float*)(lds + 2048); float* lg = (float*)(lds + 10240);
    __syncthreads();
    unsigned wbits = 0u;
    if (tid < 128) { wbits = BM[(size_t)qi * 128 + tid]; if (tid * 32 >= limit) wbits = 0u; wcnt[tid] = __popc(wbits); }
    {
        const int h = tid >> 5, d = (tid & 31) * 4; const v2u qw = *(const v2u*)(PROJ + (size_t)qi * PROJ_LD + COL_Q + h * 128 + d);
        const float x0 = bflo(qw.x), x1 = bfhi(qw.x), x2 = bflo(qw.y), x3 = bfhi(qw.y); float ss = x0 * x0 + x1 * x1 + x2 * x2 + x3 * x3;
#pragma unroll
        for (int o = 1; o < 32; o <<= 1) ss += shx(ss, o, tid & 63);
        const float rstd = frsq(ss * (1.0f / 128.0f) + 1e-6f) * 0.08838834764831845f; const float* qg = KIN(12) + (size_t)j * 128 + d;
        qs[h * 128 + d] = x0 * rstd * qg[0]; qs[h * 128 + d + 1] = x1 * rstd * qg[1]; qs[h * 128 + d + 2] = x2 * rstd * qg[2]; qs[h * 128 + d + 3] = x3 * rstd * qg[3]; }
    __syncthreads();
    if (tid < 128) { int off = 0; for (int i = 0; i < tid; ++i) off += wcnt[i];
        unsigned w = wbits; while (w) { const int bp = __ffs(w) - 1; w &= w - 1; if (off < 256) sel[off] = tid * 32 + bp; ++off; }
        if (tid == 127) *nselp = off < 256 ? off : 256; }
    __syncthreads();
    const int n = *nselp;
    {
        const int k = tid & 255, hh = tid >> 8;
        if (k < n) { const int s = sel[k]; const bf16* krow = KN + ((size_t)b * SEQ + s) * 512;
#pragma unroll 1
            for (int gg = 0; gg < 2; ++gg) { const int g = hh * 2 + gg; float acc[4] = {0.f, 0.f, 0.f, 0.f};
#pragma unroll 1
                for (int d0 = 0; d0 < 128; d0 += 8) { const v4u kw = *(const v4u*)(krow + g * 128 + d0);
                    float kv[8] = {bflo(kw.x), bfhi(kw.x), bflo(kw.y), bfhi(kw.y), bflo(kw.z), bfhi(kw.z), bflo(kw.w), bfhi(kw.w)};
#pragma unroll
                    for (int r = 0; r < 4; ++r) { const float* qp = qs + (g * 4 + r) * 128 + d0;
#pragma unroll
                        for (int i = 0; i < 8; ++i) acc[r] += qp[i] * kv[i]; } }
#pragma unroll
                for (int r = 0; r < 4; ++r) { const int h = g * 4 + r; lg[h * 256 + k] = acc[r] + rel_bias_at(kp, s - t, h); } }
        } else {
#pragma unroll
            for (int r = 0; r < 8; ++r) lg[(hh * 8 + r) * 256 + k] = -INFINITY; }
    }
    __syncthreads();
    {
        const int h = tid >> 5, l32 = tid & 31; float v[8]; float mx = -INFINITY;
#pragma unroll
        for (int i = 0; i < 8; ++i) { v[i] = lg[h * 256 + l32 + 32 * i]; mx = fmaxf(mx, v[i]); }
#pragma unroll
        for (int o = 1; o < 32; o <<= 1) mx = fmaxf(mx, shx(mx, o, tid & 63));
        float sm = 0.f;
#pragma unroll
        for (int i = 0; i < 8; ++i) { v[i] = fexp(v[i] - mx); sm += v[i]; }
#pragma unroll
        for (int o = 1; o < 32; o <<= 1) sm += shx(sm, o, tid & 63);
        const float inv = frcp(sm);
#pragma unroll
        for (int i = 0; i < 8; ++i) lg[h * 256 + l32 + 32 * i] = v[i] * inv; }
    __syncthreads();
    {
        const int d = tid & 127, g = tid >> 7; float o[4] = {0.f, 0.f, 0.f, 0.f};
#pragma unroll 2
        for (int k = 0; k < n; ++k) { const int s = sel[k]; const float v = bf2f(PROJ[((size_t)b * SEQ + s) * PROJ_LD + COL_V + g * 128 + d]);
#pragma unroll
            for (int r = 0; r < 4; ++r) o[r] += lg[(g * 4 + r) * 256 + k] * v; }
#pragma unroll
        for (int r = 0; r < 4; ++r) { const int h = g * 4 + r; const float gbv = bf2f(PROJ[(size_t)qi * PROJ_LD + COL_GB + h * 128 + d]);
            bf16* yp = YCAT + (size_t)qi * 4096 + 2048 + h * 128 + d; const float yv = o[r] * gbv;
            if (!check) *yp = (bf16)f2bf(yv); else if (!(fabsf(bf2f(*yp) - yv) <= 1e-4f + 0.012f * fabsf(gbv) + 0.03f * fabsf(yv))) atomicOr((unsigned*)(KWS + WS_CTL) + 8, 2u); } }
}

__device__ __forceinline__ void sgu_item(const kargp_t kp, int j, int b, int ch, int g, unsigned char* lds, int wave) {
    const int tid = make_tid(wave); float* V = (float*)lds; float* MU = (float*)(lds + 65536); float* RS = MU + 128;
    const bf16* PROJ = (const bf16*)(KWS + WS_PROJ); const float* SLN = (const float*)(KWS + WS_STATLN); bf16* Y = (bf16*)(KWS + WS_YCAT);
    const float* lng = KIN(16) + (size_t)j * 2048, *lnb = KIN(17) + (size_t)j * 2048; const float* ws = KIN(18) + ((size_t)j * 16 + g) * 16384; const float* bs = KIN(19) + ((size_t)j * 16 + g) * 128;
    const size_t row0 = (size_t)b * SEQ + ch * 128;
    __syncthreads();
    if (tid < 128) { const float* sp = SLN + (row0 + tid) * 64; float s1 = 0.f, s2 = 0.f;
        for (int i = 0; i < 32; ++i) { s1 += sp[2 * i]; s2 += sp[2 * i + 1]; }
        const float mean = s1 * (1.0f / 2048.0f); const float var = fmaxf(s2 * (1.0f / 2048.0f) - mean * mean, 0.f); MU[tid] = mean; RS[tid] = frsq(var + 1e-6f); }
    __syncthreads();
    for (int e = tid; e < 2048; e += NTHR) { const int s = e >> 4, dq = (e & 15) * 8; const v4u w = *(const v4u*)(PROJ + (row0 + s) * ODD_IN + 2048 + g * 128 + dq);
        const float x[8] = {bflo(w.x), bfhi(w.x), bflo(w.y), bfhi(w.y), bflo(w.z), bfhi(w.z), bflo(w.w), bfhi(w.w)}; const float mu = MU[s], rs = RS[s];
#pragma unroll
        for (int i = 0; i < 8; ++i) { const int c = g * 128 + dq + i; V[s * 128 + dq + i] = (x[i] - mu) * rs * lng[c] + lnb[c]; } }
    __syncthreads();
    const int t = tid >> 2, dseg = (tid & 3) * 32, smax = (t < 64) ? 64 : 128;
    float acc[32];
#pragma unroll
    for (int i = 0; i < 32; ++i) acc[i] = 0.f;
#pragma unroll 2
    for (int s = 0; s < smax; ++s) { const float w = ws[t * 128 + s];
#pragma unroll
        for (int i4 = 0; i4 < 8; ++i4) { const f32x4 v = *(const f32x4*)(V + s * 128 + dseg + i4 * 4);
#pragma unroll
            for (int i = 0; i < 4; ++i) acc[i4 * 4 + i] += w * v[i]; } }
    const float bias = bs[t];
#pragma unroll
    for (int i8 = 0; i8 < 4; ++i8) { const int col = g * 128 + dseg + i8 * 8; const v4u uw = *(const v4u*)(PROJ + (row0 + t) * ODD_IN + col), gw = *(const v4u*)(PROJ + (row0 + t) * ODD_IN + 4096 + col);
        const float uu[8] = {bflo(uw.x), bfhi(uw.x), bflo(uw.y), bfhi(uw.y), bflo(uw.z), bfhi(uw.z), bflo(uw.w), bfhi(uw.w)};
        const float gg[8] = {bflo(gw.x), bfhi(gw.x), bflo(gw.y), bfhi(gw.y), bflo(gw.z), bfhi(gw.z), bflo(gw.w), bfhi(gw.w)};
        float y[8];
#pragma unroll
        for (int i = 0; i < 8; ++i) y[i] = uu[i] * (acc[i8 * 8 + i] + bias) * gg[i];
        v4u o; o.x = pk2(y[0], y[1]); o.y = pk2(y[2], y[3]); o.z = pk2(y[4], y[5]); o.w = pk2(y[6], y[7]);
        *(v4u*)(Y + (row0 + t) * 2048 + col) = o; }
}

namespace att {
using bf16x8 = __attribute__((ext_vector_type(8))) short;
using s16x4  = __attribute__((ext_vector_type(4))) short;
using f32x16 = __attribute__((ext_vector_type(16))) float;
using u32x4  = __attribute__((ext_vector_type(4))) unsigned;
constexpr int D = 128, QBLK = 32, KVBLK = 64;
constexpr int LDKK = 512, LDKV = PROJ_LD;
constexpr float THRL = 11.5f;
#ifndef ATT_SDEPTH
#define ATT_SDEPTH 1
#endif
constexpr int SDEPTH = ATT_SDEPTH;
constexpr int SHM_V = KVBLK * D * 2, SHM_K = KVBLK * D * 2;
constexpr int LDS_WS = 2 * SHM_V + 2 * SHM_K, LDS_LUT = LDS_WS + 8 * 64 * 4, LUT_N = 320, LDS_Q = LDS_LUT + 4 * LUT_N * 4, LDS_MS = LDS_Q + 8 * 8192, LDS_END = LDS_MS + 2048;
#define KSWZ(row, colB) ((row) * 256 + ((colB) ^ (((row) & 7) << 4)))
#define SBAR() __builtin_amdgcn_sched_barrier(0)
__device__ __forceinline__ int crow(int r, int hi) { return (r & 3) + 8 * (r >> 2) + 4 * hi; }
__device__ __forceinline__ unsigned cvtpk(float lo, float hi) { unsigned r; asm volatile("v_cvt_pk_bf16_f32 %0, %1, %2" : "=v"(r) : "v"(lo), "v"(hi)); return r; }
__device__ __forceinline__ float psw_max(float x) { auto rr = __builtin_amdgcn_permlane32_swap(__float_as_uint(x), __float_as_uint(x), false, false); return fmaxf(__uint_as_float(rr[0]), __uint_as_float(rr[1])); }
__device__ __forceinline__ float psw_sum(float x) { auto rr = __builtin_amdgcn_permlane32_swap(__float_as_uint(x), __float_as_uint(x), false, false); return __uint_as_float(rr[0]) + __uint_as_float(rr[1]); }

__device__ __forceinline__ float max3f(float x, float y, float z) { float r; asm("v_max3_f32 %0, %1, %2, %3" : "=v"(r) : "v"(x), "v"(y), "v"(z)); return r; }
template <bool NEAR> __device__ __forceinline__ void maskbias(f32x16& p0, f32x16& p1, unsigned w0, unsigned w1, const float* lutp) {
#pragma unroll
    for (int r = 0; r < 16; ++r) { const int cb = (r & 3) + 8 * (r >> 2);
        float a = p0[r], b = p1[r];
        if (NEAR) { a += lutp[cb]; b += lutp[32 + cb]; }
        const unsigned m0 = (unsigned)(((int)(w0 << (31 - cb))) >> 31), m1 = (unsigned)(((int)(w1 << (31 - cb))) >> 31);
        p0[r] = __uint_as_float((__float_as_uint(a) & m0) | (~m0 & 0xff800000u)); p1[r] = __uint_as_float((__float_as_uint(b) & m1) | (~m1 & 0xff800000u)); }
}
template <int VAR = 0> __device__ __forceinline__ void partialSM(f32x16& p0, f32x16& p1, float& m_reg, float& alpha, float boff) {
    if (VAR == 5) { alpha = 1.f; asm volatile("" : "+v"(p0), "+v"(p1)); return; }
    float pa = max3f(p0[0], p0[1], p0[2]), pb = max3f(p1[0], p1[1], p1[2]);
#pragma unroll
    for (int r = 3; r < 15; r += 2) { pa = max3f(pa, p0[r], p0[r + 1]); pb = max3f(pb, p1[r], p1[r + 1]); }
    float pmax = max3f(pa, pb, p0[15]); pmax = max3f(pmax, p1[15], p1[15]);
    pmax = psw_max(pmax) + boff;
    float mn;
    if (__builtin_expect(__all(pmax - m_reg <= THRL), 1)) { mn = m_reg; alpha = 1.f; }
    else { mn = fmaxf(m_reg, pmax); alpha = __builtin_amdgcn_exp2f(m_reg - mn); m_reg = mn; }
    const float sub = mn - boff;
#pragma unroll
    for (int r = 0; r < 16; ++r) { p0[r] -= sub; p1[r] -= sub; }
#pragma unroll
    for (int r = 0; r < 16; ++r) p0[r] = __builtin_amdgcn_exp2f(p0[r]);
}
template <int VAR = 0> __device__ __forceinline__ void finishSM(f32x16& p0, f32x16& p1, float alpha, float& l_reg, bf16x8& pa0, bf16x8& pa1, bf16x8& pa2, bf16x8& pa3) {
    if (VAR != 5) {
#pragma unroll
    for (int r = 0; r < 16; ++r) p1[r] = __builtin_amdgcn_exp2f(p1[r]);
    float ps = 0.f;
#pragma unroll
    for (int r = 0; r < 16; ++r) ps += p0[r];
#pragma unroll
    for (int r = 0; r < 16; ++r) ps += p1[r];
    ps = psw_sum(ps);
    l_reg = l_reg * alpha + ps; } else l_reg = 1.f;
#define PK4(P, BASE, OUT) do { unsigned a0 = cvtpk(P[BASE + 0], P[BASE + 1]), a1 = cvtpk(P[BASE + 2], P[BASE + 3]);   \
    unsigned b0 = cvtpk(P[BASE + 4], P[BASE + 5]), b1 = cvtpk(P[BASE + 6], P[BASE + 7]);                              \
    auto r0 = __builtin_amdgcn_permlane32_swap(a0, b0, false, false); auto r1 = __builtin_amdgcn_permlane32_swap(a1, b1, false, false); \
    u32x4 w = {r0[0], r1[0], r0[1], r1[1]}; OUT = *reinterpret_cast<bf16x8*>(&w); } while (0)
    PK4(p0, 0, pa0); PK4(p0, 8, pa1); PK4(p1, 0, pa2); PK4(p1, 8, pa3);
#undef PK4
}
__device__ __forceinline__ void qkt(f32x16& p0, f32x16& p1, const char* Ks, const char* qs, int r32, int hi) {
    p0 = f32x16{}; p1 = f32x16{};
#pragma unroll
    for (int d0 = 0; d0 < 8; ++d0) { const int cb = (d0 * 16 + hi * 8) * 2;
        const bf16x8 b0 = *reinterpret_cast<const bf16x8*>(Ks + KSWZ(r32, cb));
        const bf16x8 b1 = *reinterpret_cast<const bf16x8*>(Ks + KSWZ(32 + r32, cb));
        const bf16x8 qf = *reinterpret_cast<const bf16x8*>(qs + d0 * 1024);
        p0 = __builtin_amdgcn_mfma_f32_32x32x16_bf16(b0, qf, p0, 0, 0, 0);
        p1 = __builtin_amdgcn_mfma_f32_32x32x16_bf16(b1, qf, p1, 0, 0, 0); }
}
#define PK4(P, BASE, OUT) do { unsigned a0 = cvtpk(P[BASE + 0], P[BASE + 1]), a1 = cvtpk(P[BASE + 2], P[BASE + 3]);   \
    unsigned b0 = cvtpk(P[BASE + 4], P[BASE + 5]), b1 = cvtpk(P[BASE + 6], P[BASE + 7]);                              \
    auto r0 = __builtin_amdgcn_permlane32_swap(a0, b0, false, false); auto r1 = __builtin_amdgcn_permlane32_swap(a1, b1, false, false); \
    u32x4 w = {r0[0], r1[0], r0[1], r1[1]}; OUT = *reinterpret_cast<bf16x8*>(&w); } while (0)
__device__ __forceinline__ void qkt_fsm(f32x16& p0, f32x16& p1, const char* Ks, const char* qs, int r32, int hi, f32x16& q0, f32x16& q1, float alpha, float& l_reg, bf16x8& pa0, bf16x8& pa1, bf16x8& pa2, bf16x8& pa3) {
    p0 = f32x16{}; p1 = f32x16{};
    bf16x8 fb0[3], fb1[3], fq[3];
#define QK_LD(S, D0) do { const int cb_ = ((D0) * 16 + hi * 8) * 2; fb0[S] = *reinterpret_cast<const bf16x8*>(Ks + KSWZ(r32, cb_)); fb1[S] = *reinterpret_cast<const bf16x8*>(Ks + KSWZ(32 + r32, cb_)); fq[S] = *reinterpret_cast<const bf16x8*>(qs + (D0) * 1024); } while (0)
    SBAR(); QK_LD(0, 0); QK_LD(1, 1);
    float ps = 0.f;
#pragma unroll
    for (int d0 = 0; d0 < 8; ++d0) {
        SBAR();
        if (d0 + 2 < 8) QK_LD((d0 + 2) % 3, d0 + 2);
        p0 = __builtin_amdgcn_mfma_f32_32x32x16_bf16(fb0[d0 % 3], fq[d0 % 3], p0, 0, 0, 0);
        p1 = __builtin_amdgcn_mfma_f32_32x32x16_bf16(fb1[d0 % 3], fq[d0 % 3], p1, 0, 0, 0);
        q1[2 * d0] = __builtin_amdgcn_exp2f(q1[2 * d0]); q1[2 * d0 + 1] = __builtin_amdgcn_exp2f(q1[2 * d0 + 1]);
        ps += (q0[2 * d0] + q0[2 * d0 + 1]) + (q1[2 * d0] + q1[2 * d0 + 1]);
        if (d0 == 1) PK4(q0, 0, pa0);
        if (d0 == 3) PK4(q0, 8, pa1);
        if (d0 == 5) PK4(q1, 0, pa2);
    }
    SBAR();
    PK4(q1, 8, pa3);
    ps = psw_sum(ps); l_reg = l_reg * alpha + ps;
#undef QK_LD
}
#undef PK4
__device__ __forceinline__ int v_st(int k, int c) { const int kk = (k & ~0xC) | ((k & 4) << 1) | ((k & 8) >> 1); return ((kk >> 3) * 4 + (c >> 5)) * 512 + ((kk & 7) * 32 + (c & 31)) * 2; }
__device__ __forceinline__ int v_rd_base(int lane) { return ((lane & 3) << 3) | (((lane >> 2) & 3) << 6) | (((lane >> 4) & 1) << 5) | (((lane >> 5) & 1) << 8); }
constexpr int v_rd_off(int d0, int ks, int half) { return d0 * 512 + ks * 4096 + half * 2048; }
template <int OFF> __device__ __forceinline__ s16x4 tr_read(int vb) { s16x4 r; asm volatile("ds_read_b64_tr_b16 %0, %1 offset:%2" : "=&v"(r) : "v"(vb), "i"(OFF) : "memory"); return r; }
#define PV_PK(L, H) (bf16x8){L[0], L[1], L[2], L[3], H[0], H[1], H[2], H[3]}
#define PV_READ(S, D0) do { S[0] = tr_read<v_rd_off(D0, 0, 0)>(vb); S[1] = tr_read<v_rd_off(D0, 0, 1)>(vb); S[2] = tr_read<v_rd_off(D0, 1, 0)>(vb); S[3] = tr_read<v_rd_off(D0, 1, 1)>(vb); \
    S[4] = tr_read<v_rd_off(D0, 2, 0)>(vb); S[5] = tr_read<v_rd_off(D0, 2, 1)>(vb); S[6] = tr_read<v_rd_off(D0, 3, 0)>(vb); S[7] = tr_read<v_rd_off(D0, 3, 1)>(vb); } while (0)
#define PV_MMA(S, OD) do { OD = __builtin_amdgcn_mfma_f32_32x32x16_bf16(pa0, PV_PK(S[0], S[1]), OD, 0, 0, 0); OD = __builtin_amdgcn_mfma_f32_32x32x16_bf16(pa1, PV_PK(S[2], S[3]), OD, 0, 0, 0); \
    OD = __builtin_amdgcn_mfma_f32_32x32x16_bf16(pa2, PV_PK(S[4], S[5]), OD, 0, 0, 0); OD = __builtin_amdgcn_mfma_f32_32x32x16_bf16(pa3, PV_PK(S[6], S[7]), OD, 0, 0, 0); } while (0)
template <int VAR = 0> __device__ __forceinline__ void pv_d0(f32x16* o, int vb, bf16x8 pa0, bf16x8 pa1, bf16x8 pa2, bf16x8 pa3) {
    if (VAR == 2) { asm volatile("" :: "v"(pa0), "v"(pa1), "v"(pa2), "v"(pa3)); return; }
    s16x4 sa[8], sb[8];
    SBAR(); asm volatile("s_waitcnt lgkmcnt(0)" ::: "memory");
    PV_READ(sa, 0); PV_READ(sb, 1);
    asm volatile("s_waitcnt lgkmcnt(8)" ::: "memory"); SBAR(); PV_MMA(sa, o[0]); SBAR();
    PV_READ(sa, 2);
    asm volatile("s_waitcnt lgkmcnt(8)" ::: "memory"); SBAR(); PV_MMA(sb, o[1]); SBAR();
    PV_READ(sb, 3);
    asm volatile("s_waitcnt lgkmcnt(8)" ::: "memory"); SBAR(); PV_MMA(sa, o[2]); SBAR();
    asm volatile("s_waitcnt lgkmcnt(0)" ::: "memory"); SBAR(); PV_MMA(sb, o[3]); SBAR();
}
#define SGB_MV(NM, NV) do { _Pragma("unroll") for (int q_ = 0; q_ < (NM); ++q_) { __builtin_amdgcn_sched_group_barrier(0x008, 1, 0); __builtin_amdgcn_sched_group_barrier(0x002, (NV), 0); } } while (0)
__device__ __forceinline__ void pv_psm(f32x16* o, int vb, bf16x8 pa0, bf16x8 pa1, bf16x8 pa2, bf16x8 pa3, f32x16& p0, f32x16& p1, float& m_reg, float& alpha, float boff) {
    s16x4 sa[8], sb[8];
    SBAR(); asm volatile("s_waitcnt lgkmcnt(0)" ::: "memory");
    PV_READ(sa, 0); PV_READ(sb, 1);
    asm volatile("s_waitcnt lgkmcnt(8)" ::: "memory"); SBAR(); PV_MMA(sa, o[0]);
    float pa = max3f(p0[0], p0[1], p0[2]), pb = max3f(p1[0], p1[1], p1[2]);
#pragma unroll
    for (int r = 3; r < 15; r += 2) { pa = max3f(pa, p0[r], p0[r + 1]); pb = max3f(pb, p1[r], p1[r + 1]); }
    float pmax = max3f(pa, pb, p0[15]); pmax = max3f(pmax, p1[15], p1[15]);
    pmax = psw_max(pmax) + boff;
    asm volatile("" : "+v"(pmax));
    SGB_MV(4, 4); SBAR();
    PV_READ(sa, 2);
    asm volatile("s_waitcnt lgkmcnt(8)" ::: "memory"); SBAR(); PV_MMA(sb, o[1]);
    const bool keep = __all(pmax - m_reg <= THRL);
    const float mn = keep ? m_reg : fmaxf(m_reg, pmax); alpha = __builtin_amdgcn_exp2f(m_reg - mn); m_reg = mn;
    const float sub = mn - boff;
#pragma unroll
    for (int r = 0; r < 16; ++r) p0[r] -= sub;
    asm volatile("" : "+v"(p0));
    SGB_MV(4, 5); SBAR();
    PV_READ(sb, 3);
    asm volatile("s_waitcnt lgkmcnt(8)" ::: "memory"); SBAR(); PV_MMA(sa, o[2]);
#pragma unroll
    for (int r = 0; r < 16; ++r) p1[r] -= sub;
#pragma unroll
    for (int r = 0; r < 6; ++r) p0[r] = __builtin_amdgcn_exp2f(p0[r]);
    asm volatile("" : "+v"(p0), "+v"(p1));
    SGB_MV(4, 6); SBAR();
    asm volatile("s_waitcnt lgkmcnt(0)" ::: "memory"); SBAR(); PV_MMA(sb, o[3]);
#pragma unroll
    for (int r = 6; r < 16; ++r) p0[r] = __builtin_amdgcn_exp2f(p0[r]);
    asm volatile("" : "+v"(p0));
    SGB_MV(4, 3); SBAR();
}
#undef PV_PK
#undef PV_READ
#undef PV_MMA

template <int VAR> __device__ __forceinline__ void attn_unit(const kargp_t kp, int j, int b, int g, int c, char* lds, int wave) {
    const int tid = make_tid(wave), wid = tid >> 6, lane = tid & 63, r32 = lane & 31, hi = lane >> 5;
    const bf16* PROJ = (const bf16*)(KWS + WS_PROJ); const unsigned* BM = (const unsigned*)(KWS + WS_BM); bf16* YCAT = (bf16*)(KWS + (VAR ? WS_SC : WS_YCAT));
    const int hr = wid >> 1, h = g * 4 + hr, qh = wid & 1;
    const int t = c * 64 + qh * 32 + r32; const size_t qrow = (size_t)b * SEQ + t;
    const bf16* Kh = (const bf16*)(KWS + WS_KN) + (size_t)b * SEQ * LDKK + g * 128; const bf16* Vh = PROJ + (size_t)b * SEQ * LDKV + COL_V + g * 128;
    char* V_lds = lds; char* K_lds = lds + 2 * SHM_V;
    float* wsf = (float*)(lds + LDS_WS) + wid * 64; float* li_l = wsf; float* al_l = wsf + 32; float* LUT = (float*)(lds + LDS_LUT);
    const int NT0 = c + 1, NT = NT0 + (NT0 & 1);
    __syncthreads();
    for (int e = tid; e < 4 * LUT_N; e += NTHR) { const int rr = e / LUT_N, i = e % LUT_N; LUT[e] = rel_bias_at(kp, i - 192, g * 4 + rr) * 1.4426950408889634f; }
    const float bfar = rel_bias_at(kp, -200, h) * 1.4426950408889634f;
    float m_reg = -1e30f, l_reg = 0.f; f32x16 o[4] = {}; char* qs = lds + LDS_Q + wid * 8192 + lane * 16;
    {   float qf[64]; float ss = 0.f; const bf16* qp = PROJ + qrow * PROJ_LD + COL_Q + h * 128 + hi * 8;
#pragma unroll
        for (int d0 = 0; d0 < 8; ++d0) { const u32x4 w = *(const u32x4*)(qp + d0 * 16);
            qf[d0 * 8 + 0] = bflo(w.x); qf[d0 * 8 + 1] = bfhi(w.x); qf[d0 * 8 + 2] = bflo(w.y); qf[d0 * 8 + 3] = bfhi(w.y); qf[d0 * 8 + 4] = bflo(w.z); qf[d0 * 8 + 5] = bfhi(w.z); qf[d0 * 8 + 6] = bflo(w.w); qf[d0 * 8 + 7] = bfhi(w.w); }
#pragma unroll
        for (int i = 0; i < 64; ++i) ss += qf[i] * qf[i];
        ss = psw_sum(ss);
        const float f = frsq(ss * (1.0f / 128.0f) + 1e-6f) * (0.08838834764831845f * 1.4426950408889634f); const float* qg = KIN(12) + (size_t)j * 128 + hi * 8;
#pragma unroll
        for (int d0 = 0; d0 < 8; ++d0) { const f32x4 g0 = *(const f32x4*)(qg + d0 * 16), g1 = *(const f32x4*)(qg + d0 * 16 + 4);
            u32x4 w; w.x = cvtpk(qf[d0 * 8 + 0] * f * g0[0], qf[d0 * 8 + 1] * f * g0[1]); w.y = cvtpk(qf[d0 * 8 + 2] * f * g0[2], qf[d0 * 8 + 3] * f * g0[3]);
            w.z = cvtpk(qf[d0 * 8 + 4] * f * g1[0], qf[d0 * 8 + 5] * f * g1[1]); w.w = cvtpk(qf[d0 * 8 + 6] * f * g1[2], qf[d0 * 8 + 7] * f * g1[3]); *reinterpret_cast<u32x4*>(qs + d0 * 1024) = w; }
    }
    const int vb0 = (int)(uintptr_t)V_lds + v_rd_base(lane);
    const int krow_ = 8 * wid + (lane >> 4), kch_ = lane & 15;
    const bf16* ksrc0 = Kh + (size_t)krow_ * LDKK + ((kch_ ^ (krow_ & 7)) * 8); const bf16* ksrc1 = Kh + (size_t)(krow_ + 4) * LDKK + ((kch_ ^ ((krow_ + 4) & 7)) * 8);
    const int vkk_ = 8 * wid + ((lane & 31) >> 2), vk_ = (vkk_ & ~0xC) | ((vkk_ & 4) << 1) | ((vkk_ & 8) >> 1);
    const bf16* vsrc0 = Vh + (size_t)vk_ * LDKV + (lane >> 5) * 32 + (lane & 3) * 8; const bf16* vsrc1 = vsrc0 + 64;
    const unsigned* msrc = BM + ((size_t)b * SEQ + c * 64 + lane) * 128;
    char* MS = lds + LDS_MS;
#define DMAK(bb, k0) do { LAS unsigned* d_ = (LAS unsigned*)(K_lds + (bb) * SHM_K + wave * 2048); \
    __builtin_amdgcn_global_load_lds((const unsigned*)(ksrc0 + (size_t)(k0) * LDKK), d_, 16, 0, 0); __builtin_amdgcn_global_load_lds((const unsigned*)(ksrc1 + (size_t)(k0) * LDKK), d_ + 256, 16, 0, 0); } while (0)
#define DMAV(bb, k0) do { LAS unsigned* d_ = (LAS unsigned*)(V_lds + (bb) * SHM_V + wave * 2048); \
    __builtin_amdgcn_global_load_lds((const unsigned*)(vsrc0 + (size_t)(k0) * LDKV), d_, 16, 0, 0); __builtin_amdgcn_global_load_lds((const unsigned*)(vsrc1 + (size_t)(k0) * LDKV), d_ + 256, 16, 0, 0); } while (0)
#define DMAM(pr) do { if (wave == 0) __builtin_amdgcn_global_load_lds(msrc + 4 * (pr), (LAS unsigned*)(MS + ((pr) & 1) * 1024), 16, 0, 0); } while (0)
#define RESC(a) do { if (__any((a) < 1.f)) { if (hi == 0) al_l[r32] = (a); asm volatile("s_waitcnt lgkmcnt(0)" ::: "memory"); \
    _Pragma("unroll") for (int d = 0; d < 4; ++d) _Pragma("unroll") for (int r = 0; r < 16; ++r) o[d][r] *= al_l[crow(r, hi)]; } } while (0)
#define SCORE(P0, P1, jt) do { const bool near_ = (jt) >= c - 2; const v2u mw_ = *(const v2u*)(MS + (((jt) >> 1) & 1) * 1024 + (qh * 32 + r32) * 16 + ((jt) & 1) * 8); \
    if (VAR == 3) { P0 = f32x16{}; P1 = f32x16{}; asm volatile("" : "+v"(P0), "+v"(P1)); } else qkt(P0, P1, K_lds + ((jt) & 1) * SHM_K, qs, r32, hi); const unsigned w0_ = mw_.x >> (4 * hi), w1_ = mw_.y >> (4 * hi); \
    if (near_) { const float* lutp_ = LUT + hr * LUT_N + (64 * (jt) - t + 192 + 4 * hi); maskbias<true>(P0, P1, w0_, w1_, lutp_); } else if (VAR != 1) maskbias<false>(P0, P1, w0_, w1_, nullptr); else asm volatile("" :: "v"(w0_), "v"(w1_)); } while (0)
#define WAITBAR() do { asm volatile("s_waitcnt vmcnt(0)" ::: "memory"); __syncthreads(); } while (0)
#define HALF(ORD, Pc0, Pc1, alc, Pp0, Pp1, alp, jt) do { SBAR(); if ((jt) + 1 < NT) DMAK(((jt) + 1) & 1, ((jt) + 1) * KVBLK);     \
    if (ORD == 0) { SCORE(Pc0, Pc1, jt); finishSM<VAR>(Pp0, Pp1, alp, l_reg, pa0, pa1, pa2, pa3); SBAR(); pv_d0<VAR>(o, vb0 + (((jt) - 1) & 1) * SHM_V, pa0, pa1, pa2, pa3); } \
    else { finishSM<VAR>(Pp0, Pp1, alp, l_reg, pa0, pa1, pa2, pa3); SBAR(); pv_d0<VAR>(o, vb0 + (((jt) - 1) & 1) * SHM_V, pa0, pa1, pa2, pa3); SBAR(); SCORE(Pc0, Pc1, jt); } \
    partialSM<VAR>(Pc0, Pc1, m_reg, alc, ((jt) >= c - 2) ? 0.f : bfar); \
    WAITBAR(); if ((jt) + 1 < NT) DMAV(((jt) + 1) & 1, ((jt) + 1) * KVBLK); if ((((jt) & 1) == 0) && (jt) + 2 < NT) DMAM(((jt) + 2) >> 1); \
    RESC(alc); } while (0)
#define SCORE_QK(P0, P1, jt) qkt(P0, P1, K_lds + ((jt) & 1) * SHM_K, qs, r32, hi)
#define MASKB(P0, P1, jt) do { const bool near_ = (jt) >= c - 2; const v2u mw_ = *(const v2u*)(MS + (((jt) >> 1) & 1) * 1024 + (qh * 32 + r32) * 16 + ((jt) & 1) * 8); const unsigned w0_ = mw_.x >> (4 * hi), w1_ = mw_.y >> (4 * hi); \
    if (near_) { const float* lutp_ = LUT + hr * LUT_N + (64 * (jt) - t + 192 + 4 * hi); maskbias<true>(P0, P1, w0_, w1_, lutp_); } else maskbias<false>(P0, P1, w0_, w1_, nullptr); } while (0)
#define HALF2(Pc0, Pc1, alc, Pp0, Pp1, alp, jt) do { SBAR(); if ((jt) + 1 < NT) DMAK(((jt) + 1) & 1, ((jt) + 1) * KVBLK); \
    qkt_fsm(Pc0, Pc1, K_lds + ((jt) & 1) * SHM_K, qs, r32, hi, Pp0, Pp1, alp, l_reg, pa0, pa1, pa2, pa3); \
    SBAR(); MASKB(Pc0, Pc1, jt); \
    pv_psm(o, vb0 + (((jt) - 1) & 1) * SHM_V, pa0, pa1, pa2, pa3, Pc0, Pc1, m_reg, alc, ((jt) >= c - 2) ? 0.f : bfar); \
    WAITBAR(); if ((jt) + 1 < NT) DMAV(((jt) + 1) & 1, ((jt) + 1) * KVBLK); if ((((jt) & 1) == 0) && (jt) + 2 < NT) DMAM(((jt) + 2) >> 1); \
    RESC(alc); } while (0)
#define TILE_LOOP2() do { for (int jt = 1; jt + 1 < NT; jt += 2) { HALF2(pB0, pB1, alB, pA0, pA1, alA, jt); HALF2(pA0, pA1, alA, pB0, pB1, alB, jt + 1); } } while (0)
#define TILE_LOOP(ORD) do { for (int jt = 1; jt + 1 < NT; jt += 2) { HALF(ORD, pB0, pB1, alB, pA0, pA1, alA, jt); HALF(ORD, pA0, pA1, alA, pB0, pB1, alB, jt + 1); } } while (0)
    f32x16 pA0, pA1, pB0, pB1; float alA, alB; bf16x8 pa0, pa1, pa2, pa3;
    DMAM(0); DMAK(0, 0); DMAV(0, 0); WAITBAR();
    SBAR(); DMAK(1, KVBLK); SCORE(pA0, pA1, 0); partialSM<VAR>(pA0, pA1, m_reg, alA, (0 >= c - 2) ? 0.f : bfar);
    WAITBAR(); DMAV(1, KVBLK); if (2 < NT) DMAM(1);
#ifdef ATT_OLD_LOOP
    if (wave < 4) TILE_LOOP(0); else TILE_LOOP(1);
#else
    TILE_LOOP2();
#endif
    SBAR(); SCORE(pB0, pB1, NT - 1);
    finishSM<VAR>(pA0, pA1, alA, l_reg, pa0, pa1, pa2, pa3); SBAR();
    pv_d0<VAR>(o, vb0, pa0, pa1, pa2, pa3); partialSM<VAR>(pB0, pB1, m_reg, alB, 0.f);
    WAITBAR(); RESC(alB);
    finishSM<VAR>(pB0, pB1, alB, l_reg, pa0, pa1, pa2, pa3); SBAR();
    pv_d0<VAR>(o, vb0 + SHM_V, pa0, pa1, pa2, pa3);
    if (hi == 0) li_l[r32] = l_reg; asm volatile("s_waitcnt lgkmcnt(0)" ::: "memory");
    const size_t row0 = (size_t)b * SEQ + c * 64 + qh * 32;
    const int erow = lane >> 4, ech = lane & 15;
    u32x4 gw[8];
#pragma unroll
    for (int i = 0; i < 8; ++i) gw[i] = *(const u32x4*)(PROJ + (row0 + 4 * i + erow) * PROJ_LD + COL_GB + h * 128 + ech * 8);
    char* stg = lds + LDS_Q + wid * 8192;
#pragma unroll
    for (int r = 0; r < 16; ++r) { const int orow = crow(r, hi); const float rl = frcp(li_l[orow]);
#pragma unroll
        for (int d0 = 0; d0 < 4; ++d0) *(unsigned short*)(stg + orow * 256 + (((d0 * 32 + r32) * 2) ^ (((orow >> 2) & 1) << 6))) = (unsigned short)f2bf(o[d0][r] * rl); }
    asm volatile("s_waitcnt lgkmcnt(0)" ::: "memory");
#pragma unroll
    for (int i = 0; i < 8; ++i) { const int row = 4 * i + erow; const u32x4 ov = *(const u32x4*)(stg + row * 256 + ((ech * 16) ^ (((row >> 2) & 1) << 6))); const u32x4 g = gw[i];
        u32x4 y; y.x = pk2(bflo(ov.x) * bflo(g.x), bfhi(ov.x) * bfhi(g.x)); y.y = pk2(bflo(ov.y) * bflo(g.y), bfhi(ov.y) * bfhi(g.y));
        y.z = pk2(bflo(ov.z) * bflo(g.z), bfhi(ov.z) * bfhi(g.z)); y.w = pk2(bflo(ov.w) * bflo(g.w), bfhi(ov.w) * bfhi(g.w));
        *(u32x4*)(YCAT + (row0 + row) * 4096 + 2048 + h * 128 + ech * 8) = y; }
#undef DMAK
#undef DMAV
#undef DMAM
#undef RESC
#undef SCORE
#undef WAITBAR
#undef HALF
#undef TILE_LOOP
#undef HALF2
#undef TILE_LOOP2
#undef SCORE_QK
#undef MASKB
}
#undef KSWZ
#undef SBAR
}

__device__ __forceinline__ void sgu_item_mfma(const kargp_t kp, int j, int b, int ch, int g, unsigned char* lds, int wave) {
    const int tid = make_tid(wave), lane = tid & 63, fr = lane & 15, q4 = lane >> 4, wid = tid >> 6;
    unsigned char* VT = lds; float* MU = (float*)(lds + 32768); float* RS = MU + 128; unsigned char* UT = lds + 40960; unsigned char* GT = lds + 73728;
    const bf16* PROJ = (const bf16*)(KWS + WS_PROJ); const float* SLN = (const float*)(KWS + WS_STATLN); bf16* Y = (bf16*)(KWS + WS_YCAT);
    const float* lng = KIN(16) + (size_t)j * 2048, *lnb = KIN(17) + (size_t)j * 2048; const float* bs = KIN(19) + ((size_t)j * 16 + g) * 128;
    const size_t row0 = (size_t)b * SEQ + ch * 128;
    __syncthreads();
    const int srow = tid >> 2, sq = tid & 3; const f32x4* sp = (const f32x4*)(SLN + (row0 + srow) * 64) + sq * 4;
    f32x4 sv[4];
#pragma unroll
    for (int i = 0; i < 4; ++i) sv[i] = sp[i];
    const bf16* wsb = (const bf16*)(KWS + WS_WSMALL) + (size_t)2 * 32 * 16384 + ((size_t)(j * 16 + g) * 128 + 16 * wid + fr) * 128 + 8 * q4;
    s_bf16x8 af[4];
#pragma unroll
    for (int ks = 0; ks < 4; ++ks) af[ks] = *(const s_bf16x8*)(wsb + ks * 32);
    float bias[4];
#pragma unroll
    for (int r = 0; r < 4; ++r) bias[r] = bs[16 * wid + 4 * q4 + r];
    const int dq = (tid & 15) * 8;
    v4u vw[4];
#pragma unroll
    for (int i = 0; i < 4; ++i) { const int s_ = (tid + NTHR * i) >> 4; vw[i] = *(const v4u*)(PROJ + (row0 + s_) * ODD_IN + 2048 + g * 128 + dq); }
    const f32x4 g0 = *(const f32x4*)(lng + g * 128 + dq), g1 = *(const f32x4*)(lng + g * 128 + dq + 4), b0 = *(const f32x4*)(lnb + g * 128 + dq), b1 = *(const f32x4*)(lnb + g * 128 + dq + 4);
    v4u uw[4], gw_[4];
#pragma unroll
    for (int i = 0; i < 4; ++i) { const int e = tid + NTHR * i, t = e >> 4, chk = e & 15; const bf16* pr = PROJ + (row0 + t) * ODD_IN + g * 128 + chk * 8; uw[i] = *(const v4u*)pr; gw_[i] = *(const v4u*)(pr + 4096); }
    {   float s1 = 0.f, s2 = 0.f;
#pragma unroll
        for (int i = 0; i < 4; ++i) { s1 += sv[i][0] + sv[i][2]; s2 += sv[i][1] + sv[i][3]; }
        s1 += __int_as_float(__builtin_amdgcn_mov_dpp(__float_as_int(s1), 0xB1, 0xF, 0xF, true)); s2 += __int_as_float(__builtin_amdgcn_mov_dpp(__float_as_int(s2), 0xB1, 0xF, 0xF, true));
        s1 += __int_as_float(__builtin_amdgcn_mov_dpp(__float_as_int(s1), 0x4E, 0xF, 0xF, true)); s2 += __int_as_float(__builtin_amdgcn_mov_dpp(__float_as_int(s2), 0x4E, 0xF, 0xF, true));
        const float mean = s1 * (1.0f / 2048.0f); const float var = fmaxf(s2 * (1.0f / 2048.0f) - mean * mean, 0.f); if (sq == 0) { MU[srow] = mean; RS[srow] = frsq(var + 1e-6f); } }
#pragma unroll
    for (int i = 0; i < 4; ++i) { const int e = tid + NTHR * i, t = e >> 4, chk = e & 15; *(v4u*)(UT + t * 256 + chk * 16) = uw[i]; *(v4u*)(GT + t * 256 + chk * 16) = gw_[i]; }
    __syncthreads();
#pragma unroll
    for (int i = 0; i < 4; ++i) { const int s = (tid + NTHR * i) >> 4; const v4u w = vw[i];
        const float x[8] = {bflo(w.x), bfhi(w.x), bflo(w.y), bfhi(w.y), bflo(w.z), bfhi(w.z), bflo(w.w), bfhi(w.w)}; const float mu = MU[s], rs = RS[s];
#pragma unroll
        for (int k = 0; k < 8; ++k) { const int d = dq + k; const float v = (x[k] - mu) * rs * (k < 4 ? g0[k & 3] : g1[k & 3]) + (k < 4 ? b0[k & 3] : b1[k & 3]);
            *(bf16*)(VT + d * 256 + ((s * 2) ^ ((d & 15) << 4))) = (bf16)f2bf(v); } }
    __syncthreads();
    f32x4 acc[8];
#pragma unroll
    for (int n = 0; n < 8; ++n) acc[n] = (f32x4){0.f, 0.f, 0.f, 0.f};
    {
        s_bf16x8 bv[2][4];
#define SGU_LD(S, N) do { _Pragma("unroll") for (int ks = 0; ks < 4; ++ks) bv[S][ks] = *(const s_bf16x8*)(VT + (16 * (N) + fr) * 256 + (((ks * 32 + 8 * q4) * 2) ^ (fr << 4))); } while (0)
        SGU_LD(0, 0);
#pragma unroll
        for (int n = 0; n < 8; ++n) { __builtin_amdgcn_sched_barrier(0);
            if (n + 1 < 8) SGU_LD((n + 1) & 1, n + 1);
#pragma unroll
            for (int ks = 0; ks < 4; ++ks) acc[n] = __builtin_amdgcn_mfma_f32_16x16x32_bf16(af[ks], bv[n & 1][ks], acc[n], 0, 0, 0); }
        __builtin_amdgcn_sched_barrier(0);
#undef SGU_LD
    }
    unsigned short uq[4][8], gq[4][8];
#pragma unroll
    for (int r = 0; r < 4; ++r) { const int t = 16 * wid + 4 * q4 + r;
#pragma unroll
        for (int n = 0; n < 8; ++n) { uq[r][n] = *(const unsigned short*)(UT + t * 256 + (16 * n + fr) * 2); gq[r][n] = *(const unsigned short*)(GT + t * 256 + (16 * n + fr) * 2); } }
#pragma unroll
    for (int r = 0; r < 4; ++r) { const int t = 16 * wid + 4 * q4 + r;
#pragma unroll
        for (int n = 0; n < 8; ++n) *(bf16*)(UT + t * 256 + (16 * n + fr) * 2) = (bf16)f2bf(bf2f(uq[r][n]) * (acc[n][r] + bias[r]) * bf2f(gq[r][n])); }
    __syncthreads();
#pragma unroll
    for (int i = 0; i < 4; ++i) { const int e = tid + NTHR * i, t = e >> 4, chk = e & 15; *(v4u*)(Y + (row0 + t) * 2048 + g * 128 + chk * 8) = *(const v4u*)(UT + t * 256 + chk * 16); }
}

__global__ void __launch_bounds__(NTHR, 2) mega_fwd(Args args) {
    extern __shared__ __attribute__((aligned(16))) unsigned char lds[];
    const int wave = __builtin_amdgcn_readfirstlane((int)threadIdx.x >> 6);
    const int G = gridDim.x, bx = blockIdx.x;
#define LANE_ONLY() int lane_ = lane_id(); asm volatile("" : "+v"(lane_)); const int lane = lane_
#define LANE_OPAQUE() KARGS_OPEN(); int lane_ = lane_id(); asm volatile("" : "+v"(lane_)); const int lane = lane_

    volatile LAS unsigned* MISC = (volatile LAS unsigned*)((LAS unsigned char*)lds + MISC_OFF);
    if (threadIdx.x < 64) MISC[threadIdx.x] = 0u;
    __syncthreads();
    XcdBarrier bar; bar.bar = (unsigned*)(args.ws + WS_CTL) + CW_BAR; bar.x = 0; bar.st = nullptr;
    if (N_LAUNCHES == 1) bar = xcd_barrier_post((unsigned*)(args.ws + WS_CTL) + CW_BAR, MISC + 8);
#define GRID_BAR() do { if (N_LAUNCHES == 1) xcd_barrier(bar, wave == 0 && lane_id() == 0); } while (0)
    const int lo = args.ph_lo, hi = args.ph_hi;
#define IN(k) (lo <= (k) && (k) < hi)
#define SEAM(k) do { if (IN((k) + 1)) { GRID_BAR(); if (PROBE_REP == 9) { GRID_BAR(); GRID_BAR(); } } } while (0)
    const int gw = bx * NWAVES + wave, NGW = G * NWAVES;
#define ws KWS
#define HP ((bf16*)KOUT)
#define HQ ((bf16*)(ws + WS_AN))
#define PROJ ((bf16*)(ws + WS_PROJ))
#define YCAT ((bf16*)(ws + WS_YCAT))
#define IDX ((float*)(ws + WS_IDX))
#define EBL(l) ((bf16*)(ws + WS_H) + (size_t)((l) & 1) * M * DM)
#define EB EBL(layer)
#define STA ((float*)(ws + WS_STATA))
#define STB ((float*)(ws + WS_STATB))
#define SLN ((float*)(ws + WS_STATLN))
#define PBF ((bf16*)(ws + WS_PBF))
#define WPE ((bf16*)(ws + WS_WPE))
#define WGATE ((bf16*)(ws + WS_WGATE))
#define WEIN ((bf16*)(ws + WS_WEIN))
#define WEOUT ((bf16*)(ws + WS_WEOUT))
#define WOIN ((bf16*)(ws + WS_WOIN))
#define WOOUT ((bf16*)(ws + WS_WOOUT))
    LAS unsigned char* ldsl = (LAS unsigned char*)lds;

    if (IN(0)) { LANE_OPAQUE();
        float* scr = (float*)(lds + wave * 16640);
        for (int rep_ = 0; rep_ < NREP(8); ++rep_) {
        int base = 0, it = gw;
#define TRG(W, K, N, WT, GK) do { const int ni_ = ((K) / 64) * (((N) + 63) / 64); for (; it < base + ni_; it += NGW) p0_transpose_item((W), (K), (N), (WT), scr, it - base, lane, (GK)); base += ni_; } while (0)
#define TR(W, K, N, WT) TRG(W, K, N, WT, nullptr)
        TRG(KIN(4), 2048, EVEN_IN, WEIN, KIN(2));
        for (int j = 0; j < 2; ++j) TR(KIN(14) + (size_t)j * 4096 * 2048, 4096, 2048, WEOUT + (size_t)j * 2048 * 4096);
        TRG(KIN(15), 2048, ODD_IN, WOIN, KIN(2) + DM);
        TR(KIN(20), 2048, 2048, WOOUT);
        for (int l = 0; l < 4; ++l) TR(KIN(21) + (size_t)l * 256 * 2048, 256, 2048, WPE + (size_t)l * 2048 * 256);
        for (int l = 0; l < 3; ++l) TRG(KIN(23) + (size_t)l * 2048 * 2048, 2048, 2048, WGATE + (size_t)l * 2048 * 2048, KIN(22) + (size_t)l * DM);
        for (int jg = 0; jg < 32; ++jg) TR(KIN(7) + (size_t)jg * 16384, 128, 128, (bf16*)(ws + WS_WSMALL) + (size_t)jg * 16384);
        for (int jg = 0; jg < 32; ++jg) TR(KIN(9) + (size_t)jg * 16384, 128, 128, (bf16*)(ws + WS_WSMALL) + (size_t)(32 + jg) * 16384);
#undef TR
#undef TRG
        for (int j = 0; j < 2; ++j) { v4u* z = (v4u*)(WEIN + ((size_t)j * EVEN_INP + EVEN_IN) * 2048); const int n16 = (EVEN_INP - EVEN_IN) * 2048 / 8;
            for (int i = gw * 64 + lane; i < n16; i += NGW * 64) z[i] = (v4u){0u, 0u, 0u, 0u}; }
        for (int m = gw; m < M; m += NGW) { const f32x4* xr = (const f32x4*)(KIN(0) + (size_t)m * DM) + lane; float ss = 0.f;
            f32x4 xv[8];
#pragma unroll
            for (int jx = 0; jx < 8; ++jx) xv[jx] = __builtin_nontemporal_load(xr + 64 * jx);
            asm volatile("" ::: "memory");
#pragma unroll
            for (int jx = 0; jx < 8; ++jx) { const f32x4 v = xv[jx]; ss += (v[0] * v[0] + v[1] * v[1]) + (v[2] * v[2] + v[3] * v[3]);
                *(v2u*)(HP + (size_t)m * DM + (size_t)(lane + 64 * jx) * 4) = (v2u){pk2(v[0], v[1]), pk2(v[2], v[3])}; }
            ss = wave_sum(ss, lane); if (lane < 32) STA[(size_t)m * 32 + lane] = (lane == 0) ? ss : 0.f; }
        { const f32x4* w4 = (const f32x4*)KIN(18); bf16* wo = (bf16*)(ws + WS_WSMALL) + (size_t)2 * 32 * 16384; const int n4 = 2 * 16 * 128 * 128 / 4;
            for (int i = gw * 64 + lane; i < n4; i += NGW * 64) { f32x4 v = w4[i]; const int s = (i * 4) & 127, t = ((i * 4) >> 7) & 127; if (t < 64 && s >= 64) v = (f32x4){0.f, 0.f, 0.f, 0.f};
                *(v2u*)(wo + (size_t)i * 4) = (v2u){pk2(v[0], v[1]), pk2(v[2], v[3])}; } }
        { const f32x4* p4 = (const f32x4*)KIN(1); const int n4 = DEPTH * M * 256 / 4;
            for (int i = gw * 64 + lane; i < n4; i += 8 * NGW * 64) { f32x4 pv[8];
#pragma unroll
                for (int q = 0; q < 8; ++q) pv[q] = __builtin_nontemporal_load(p4 + ((i + q * NGW * 64 < n4) ? i + q * NGW * 64 : i));
                asm volatile("" ::: "memory");
#pragma unroll
                for (int q = 0; q < 8; ++q) if (i + q * NGW * 64 < n4) *(v2u*)(PBF + (size_t)(i + q * NGW * 64) * 4) = (v2u){pk2(pv[q][0], pv[q][1]), pk2(pv[q][2], pv[q][3])}; } }
        }
        SEAM(0);
    }

    int ph = 1;
#define PHASE_BEGIN() KARGS_OPEN(); int lyr_ = layer_it; asm volatile("" : "+s"(lyr_)); const int layer = lyr_, j = lyr_ >> 1; const bool last = (lyr_ == DEPTH - 1); (void)j; (void)last; (void)layer
    {
        constexpr int layer_it = 0;
        if ((layer_it & 1) == 0) {
            if (IN(ph)) { PHASE_BEGIN(); pg8::Gemm g{HP, WEIN + (size_t)j * EVEN_INP * 2048, M, EVEN_INP, 2048}; pg8::StaticOrder S; S.init(M, EVEN_INP, G, bx);
                pg8::EpiEvenIn E{PROJ, IDX, STA, (bf16*)(ws + WS_IDXB)}; for (int rep_ = 0; rep_ < NREP(1); ++rep_) pg8::gemm_phase<pg8::EpiEvenIn, pg8::StaticOrder, true, true>(ldsl, g, S, E, wave);
                if (bx >= 32 && G > 32) {
#pragma unroll 1
                    for (int l2 = 0; l2 < 2; ++l2) { const int ll = layer + l2; pg8::Gemm g2{PBF + (size_t)ll * M * 256, WPE + (size_t)ll * 2048 * 256, M, 2048, 256}; pg8::StaticOrder S2; S2.init(M, 2048, G - 32, bx - 32);
                        pg8::EpiPE E2{EBL(ll)}; pg8::gemm_phase<pg8::EpiPE, pg8::StaticOrder, true, true>(ldsl, g2, S2, E2, wave);  }
                    { LANE_ONLY(); float* scr = (float*)(lds + wave * 16640); const int gw2 = (bx - 32) * NWAVES + wave, NGW2 = (G - 32) * NWAVES; int base = 0, it = gw2;
#define TR2(W, K, N, WT, GK) do { const int ni_ = ((K) / 64) * (((N) + 63) / 64); for (; it < base + ni_; it += NGW2) p0_transpose_item((W), (K), (N), (WT), scr, it - base, lane, (GK)); base += ni_; } while (0)
                      if (layer == 0) { TR2(KIN(4) + (size_t)2048 * EVEN_IN, 2048, EVEN_IN, WEIN + (size_t)EVEN_INP * 2048, KIN(2) + 2 * DM); }
                      else { TR2(KIN(15) + (size_t)2048 * ODD_IN, 2048, ODD_IN, WOIN + (size_t)ODD_IN * 2048, KIN(2) + 3 * DM); TR2(KIN(20) + (size_t)2048 * 2048, 2048, 2048, WOOUT + (size_t)2048 * 2048, nullptr); TR2(KIN(23) + (size_t)3 * 2048 * 2048, 2048, 2048, WGATE + (size_t)3 * 2048 * 2048, KIN(22) + 3 * DM); }
#undef TR2
                    } }
#if PROBE_REP == 11 || PROBE_REP == 14
                __syncthreads();
                { pg8::EpiEvenInT<PROBE_REP == 11 ? 1 : 2> EN{PROJ, IDX, STA, (bf16*)(ws + WS_IDXB)}; for (int rep_ = 0; rep_ < 2; ++rep_) pg8::gemm_phase<pg8::EpiEvenInT<PROBE_REP == 11 ? 1 : 2>, pg8::StaticOrder, true, true>(ldsl, g, S, EN, wave); }
#endif
#if PROBE_REP == 10
                __syncthreads();
                { pg8::EpiNull EN; for (int rep_ = 0; rep_ < 2; ++rep_) pg8::gemm_phase<pg8::EpiNull, pg8::StaticOrder, true, true>(ldsl, g, S, EN, wave); }
#endif
                SEAM(ph); }
            ++ph;
            if (IN(ph)) { PHASE_BEGIN(); LANE_ONLY();
#ifdef NAIVE_LRU
                for (int it = bx; it < 1024; it += G) lru_tile(kp, j, it >> 9, (it >> 4) & 31, it & 15, false, lds, wave);
#else
                for (int rep_ = 0; rep_ < NREP(2); ++rep_)
                for (int it = bx; it < 1024; it += G) lru_tile_mfma(kp, j, it, it + G, it == bx, false, LRU_STREAM != 0, lds, wave);
#endif
#ifndef NO_KN
                for (int it = bx; it < 512; it += G) knorm_item(kp, j, it, wave, lane);
#endif
#ifdef NAIVE_SCORE
                for (int it = bx; it < 4160; it += G) { const int b = it / 2080; int r = it % 2080; int c = 0; while (r >= c + 1) { r -= c + 1; ++c; } score_item(kp, b, c, r, lds, wave); }
#else
                __syncthreads();
                for (int rep_ = 0; rep_ < NREP(3); ++rep_)
                for (int u = gw; u < 2048; u += NGW) { const int ks = u & 7, qg = (u >> 3) & 3, cp = (u >> 5) & 31, b = u >> 10;
                    score_wave_unit(kp, b, cp, qg, ks, lane, lds, wave); score_wave_unit(kp, b, 63 - cp, qg, ks, lane, lds, wave); }
#ifdef CHECK_SCORE
                GRID_BAR();
                for (int it = bx; it < 4160; it += G) { const int b = it / 2080; int r = it % 2080; int c = 0; while (r >= c + 1) { r -= c + 1; ++c; } score_item(kp, b, c, r, lds, wave, true); }
#endif
#endif
                SEAM(ph); }
            ++ph;
            if (IN(ph)) { PHASE_BEGIN(); LANE_ONLY();
#ifdef NAIVE_LRU
                for (int it = bx; it < 1024; it += G) lru_tile(kp, j, it >> 9, (it >> 4) & 31, it & 15, true, lds, wave);
#else
                for (int rep_ = 0; rep_ < NREP(2); ++rep_)
                for (int it = bx; it < 1024; it += (LRU_STREAM ? 4 : 1) * G) { if (LRU_STREAM) { __syncthreads(); lru_carry4(kp, it, G, (float*)lds, wave); __syncthreads();
#pragma unroll 1
                    for (int k4 = 0; k4 < 4; ++k4) if (it + k4 * G < 1024) lru_apply_item(kp, it + k4 * G, (const float*)lds + k4 * 128, wave); }
                  else lru_tile_mfma(kp, j, it, it + G, it == bx, true, false, lds, wave); }
#ifdef CHECK_LRU
                GRID_BAR();
                for (int it = bx; it < 1024; it += G) lru_tile(kp, j, it >> 9, (it >> 4) & 31, it & 15, true, lds, wave, true);
#endif
#endif
#ifndef NO_SEL
                for (int rep_ = 0; rep_ < NREP(4); ++rep_)
                for (int u = gw; u < M / 2; u += NGW) { const int b_ = u >> 11, t_ = u & 2047;
                    select_query(kp, b_ * SEQ + t_, lane); select_query(kp, b_ * SEQ + 4095 - t_, lane); }
#endif
                SEAM(ph); }
            ++ph;
            if (IN(ph)) { PHASE_BEGIN();
#ifdef NAIVE_ATTN
                for (int qi = bx; qi < M; qi += G) attn_query(kp, j, qi, lds, wave);
#else
                for (int rep_ = 0; rep_ < NREP(5); ++rep_)
                for (int u = bx; u < 256; u += G) { const int bg = u & 7, cp = u >> 3;

#pragma unroll 1
                    for (int k2 = 0; k2 < 2; ++k2) att::attn_unit<0>(kp, j, bg >> 2, bg & 3, k2 ? cp : 63 - cp, (char*)lds, wave); }
#if PROBE_REP >= 20 && PROBE_REP < 30
                for (int rep_ = 0; rep_ < 2; ++rep_) for (int u = bx; u < 256; u += G) { const int bg = u & 7, cp = u >> 3; att::attn_unit<PROBE_REP - 20>(kp, j, bg >> 2, bg & 3, 63 - cp, (char*)lds, wave); att::attn_unit<PROBE_REP - 20>(kp, j, bg >> 2, bg & 3, cp, (char*)lds, wave); }
#endif
#ifdef CHECK_ATTN
                GRID_BAR();
                for (int qi = bx; qi < M; qi += G) attn_query(kp, j, qi, lds, wave, true);
#endif
#endif
                SEAM(ph); }
            ++ph;
            if (IN(ph)) { PHASE_BEGIN();
                { pg8::Gemm g{YCAT, WEOUT + (size_t)j * 2048 * 4096, M, 2048, 4096}; pg8::StaticOrder S; S.init(M, 2048, G, bx);
                  pg8::EpiOut E{HP, HQ, STB}; pg8::gemm_phase<pg8::EpiOut, pg8::StaticOrder, true, true>(ldsl, g, S, E, wave);
#if PROBE_REP == 12
                  { pg8::EpiOut Ed{HP, (bf16*)(ws + WS_SC), (float*)(ws + WS_SC) + 16 * 1048576}; for (int rep_ = 0; rep_ < 2; ++rep_) pg8::gemm_phase<pg8::EpiOut, pg8::StaticOrder, true, true>(ldsl, g, S, Ed, wave); }
#endif
                }
                SEAM(ph); }
            ++ph;
        } else {
            if (IN(ph)) { PHASE_BEGIN(); pg8::Gemm g{HP, WOIN + (size_t)j * ODD_IN * 2048, M, ODD_IN, 2048}; pg8::StaticOrder S; S.init(M, ODD_IN, G, bx);
                pg8::EpiOddIn E{PROJ, STA, SLN}; for (int rep_ = 0; rep_ < NREP(6); ++rep_) pg8::gemm_phase<pg8::EpiOddIn, pg8::StaticOrder, true, true>(ldsl, g, S, E, wave); SEAM(ph); }
            ++ph;
            if (IN(ph)) { PHASE_BEGIN();
#ifndef NO_SGU
                for (int rep_ = 0; rep_ < NREP(7); ++rep_)
#ifdef NAIVE_SGU
                for (int it = bx; it < 1024; it += G) sgu_item(kp, j, it >> 9, (it >> 4) & 31, it & 15, lds, wave);
#else
                for (int it = bx; it < 1024; it += G) sgu_item_mfma(kp, j, it >> 9, (it >> 4) & 31, it & 15, lds, wave);
#endif
#endif
                SEAM(ph); }
            ++ph;
            if (IN(ph)) { PHASE_BEGIN();
                { pg8::Gemm g{YCAT, WOOUT + (size_t)j * 2048 * 2048, M, 2048, 2048}; pg8::StaticOrder S; S.init(M, 2048, G, bx);
                  pg8::EpiOut E{HP, HQ, STB}; pg8::gemm_phase<pg8::EpiOut, pg8::StaticOrder, true, true>(ldsl, g, S, E, wave);
#if PROBE_REP == 12
                  { pg8::EpiOut Ed{HP, (bf16*)(ws + WS_SC), (float*)(ws + WS_SC) + 16 * 1048576}; for (int rep_ = 0; rep_ < 2; ++rep_) pg8::gemm_phase<pg8::EpiOut, pg8::StaticOrder, true, true>(ldsl, g, S, Ed, wave); }
#endif
                }
                SEAM(ph); }
            ++ph;
        }
        if (IN(ph)) { PHASE_BEGIN(); pg8::Gemm g{HQ, WGATE + (size_t)layer * 2048 * 2048, M, 2048, 2048}; pg8::StaticOrder S; S.init(M, 2048, G, bx);
            typedef pg8::EpiGateT<layer_it == DEPTH - 1> EpiGate;
            EpiGate E{HQ, EB, STB, HP, STA, KOUT}; pg8::gemm_phase<EpiGate, pg8::StaticOrder, true, true>(ldsl, g, S, E, wave);
#if PROBE_REP == 13
            { pg8::EpiGateT<false> Ed{HQ, EB, STB, (bf16*)(ws + WS_SC), (float*)(ws + WS_SC) + 16 * 1048576, nullptr}; for (int rep_ = 0; rep_ < 2; ++rep_) pg8::gemm_phase<pg8::EpiGateT<false>, pg8::StaticOrder, true, true>(ldsl, g, S, Ed, wave); }
#endif

            if (layer_it != DEPTH - 1) SEAM(ph); }
        ++ph;
    }
    {
        constexpr int layer_it = 1;
        if ((layer_it & 1) == 0) {
            if (IN(ph)) { PHASE_BEGIN(); pg8::Gemm g{HP, WEIN + (size_t)j * EVEN_INP * 2048, M, EVEN_INP, 2048}; pg8::StaticOrder S; S.init(M, EVEN_INP, G, bx);
                pg8::EpiEvenIn E{PROJ, IDX, STA, (bf16*)(ws + WS_IDXB)}; for (int rep_ = 0; rep_ < NREP(1); ++rep_) pg8::gemm_phase<pg8::EpiEvenIn, pg8::StaticOrder, true, true>(ldsl, g, S, E, wave);
                if (bx >= 32 && G > 32) {
#pragma unroll 1
                    for (int l2 = 0; l2 < 2; ++l2) { const int ll = layer + l2; pg8::Gemm g2{PBF + (size_t)ll * M * 256, WPE + (size_t)ll * 2048 * 256, M, 2048, 256}; pg8::StaticOrder S2; S2.init(M, 2048, G - 32, bx - 32);
                        pg8::EpiPE E2{EBL(ll)}; pg8::gemm_phase<pg8::EpiPE, pg8::StaticOrder, true, true>(ldsl, g2, S2, E2, wave);  }
                    { LANE_ONLY(); float* scr = (float*)(lds + wave * 16640); const int gw2 = (bx - 32) * NWAVES + wave, NGW2 = (G - 32) * NWAVES; int base = 0, it = gw2;
#define TR2(W, K, N, WT, GK) do { const int ni_ = ((K) / 64) * (((N) + 63) / 64); for (; it < base + ni_; it += NGW2) p0_transpose_item((W), (K), (N), (WT), scr, it - base, lane, (GK)); base += ni_; } while (0)
                      if (layer == 0) { TR2(KIN(4) + (size_t)2048 * EVEN_IN, 2048, EVEN_IN, WEIN + (size_t)EVEN_INP * 2048, KIN(2) + 2 * DM); }
                      else { TR2(KIN(15) + (size_t)2048 * ODD_IN, 2048, ODD_IN, WOIN + (size_t)ODD_IN * 2048, KIN(2) + 3 * DM); TR2(KIN(20) + (size_t)2048 * 2048, 2048, 2048, WOOUT + (size_t)2048 * 2048, nullptr); TR2(KIN(23) + (size_t)3 * 2048 * 2048, 2048, 2048, WGATE + (size_t)3 * 2048 * 2048, KIN(22) + 3 * DM); }
#undef TR2
                    } }
#if PROBE_REP == 11 || PROBE_REP == 14
                __syncthreads();
                { pg8::EpiEvenInT<PROBE_REP == 11 ? 1 : 2> EN{PROJ, IDX, STA, (bf16*)(ws + WS_IDXB)}; for (int rep_ = 0; rep_ < 2; ++rep_) pg8::gemm_phase<pg8::EpiEvenInT<PROBE_REP == 11 ? 1 : 2>, pg8::StaticOrder, true, true>(ldsl, g, S, EN, wave); }
#endif
#if PROBE_REP == 10
                __syncthreads();
                { pg8::EpiNull EN; for (int rep_ = 0; rep_ < 2; ++rep_) pg8::gemm_phase<pg8::EpiNull, pg8::StaticOrder, true, true>(ldsl, g, S, EN, wave); }
#endif
                SEAM(ph); }
            ++ph;
            if (IN(ph)) { PHASE_BEGIN(); LANE_ONLY();
#ifdef NAIVE_LRU
                for (int it = bx; it < 1024; it += G) lru_tile(kp, j, it >> 9, (it >> 4) & 31, it & 15, false, lds, wave);
#else
                for (int rep_ = 0; rep_ < NREP(2); ++rep_)
                for (int it = bx; it < 1024; it += G) lru_tile_mfma(kp, j, it, it + G, it == bx, false, LRU_STREAM != 0, lds, wave);
#endif
#ifndef NO_KN
                for (int it = bx; it < 512; it += G) knorm_item(kp, j, it, wave, lane);
#endif
#ifdef NAIVE_SCORE
                for (int it = bx; it < 4160; it += G) { const int b = it / 2080; int r = it % 2080; int c = 0; while (r >= c + 1) { r -= c + 1; ++c; } score_item(kp, b, c, r, lds, wave); }
#else
                __syncthreads();
                for (int rep_ = 0; rep_ < NREP(3); ++rep_)
                for (int u = gw; u < 2048; u += NGW) { const int ks = u & 7, qg = (u >> 3) & 3, cp = (u >> 5) & 31, b = u >> 10;
                    score_wave_unit(kp, b, cp, qg, ks, lane, lds, wave); score_wave_unit(kp, b, 63 - cp, qg, ks, lane, lds, wave); }
#ifdef CHECK_SCORE
                GRID_BAR();
                for (int it = bx; it < 4160; it += G) { const int b = it / 2080; int r = it % 2080; int c = 0; while (r >= c + 1) { r -= c + 1; ++c; } score_item(kp, b, c, r, lds, wave, true); }
#endif
#endif
                SEAM(ph); }
            ++ph;
            if (IN(ph)) { PHASE_BEGIN(); LANE_ONLY();
#ifdef NAIVE_LRU
                for (int it = bx; it < 1024; it += G) lru_tile(kp, j, it >> 9, (it >> 4) & 31, it & 15, true, lds, wave);
#else
                for (int rep_ = 0; rep_ < NREP(2); ++rep_)
                for (int it = bx; it < 1024; it += (LRU_STREAM ? 4 : 1) * G) { if (LRU_STREAM) { __syncthreads(); lru_carry4(kp, it, G, (float*)lds, wave); __syncthreads();
#pragma unroll 1
                    for (int k4 = 0; k4 < 4; ++k4) if (it + k4 * G < 1024) lru_apply_item(kp, it + k4 * G, (const float*)lds + k4 * 128, wave); }
                  else lru_tile_mfma(kp, j, it, it + G, it == bx, true, false, lds, wave); }
#ifdef CHECK_LRU
                GRID_BAR();
                for (int it = bx; it < 1024; it += G) lru_tile(kp, j, it >> 9, (it >> 4) & 31, it & 15, true, lds, wave, true);
#endif
#endif
#ifndef NO_SEL
                for (int rep_ = 0; rep_ < NREP(4); ++rep_)
                for (int u = gw; u < M / 2; u += NGW) { const int b_ = u >> 11, t_ = u & 2047;
                    select_query(kp, b_ * SEQ + t_, lane); select_query(kp, b_ * SEQ + 4095 - t_, lane); }
#endif
                SEAM(ph); }
            ++ph;
            if (IN(ph)) { PHASE_BEGIN();
#ifdef NAIVE_ATTN
                for (int qi = bx; qi < M; qi += G) attn_query(kp, j, qi, lds, wave);
#else
                for (int rep_ = 0; rep_ < NREP(5); ++rep_)
                for (int u = bx; u < 256; u += G) { const int bg = u & 7, cp = u >> 3;

#pragma unroll 1
                    for (int k2 = 0; k2 < 2; ++k2) att::attn_unit<0>(kp, j, bg >> 2, bg & 3, k2 ? cp : 63 - cp, (char*)lds, wave); }
#if PROBE_REP >= 20 && PROBE_REP < 30
                for (int rep_ = 0; rep_ < 2; ++rep_) for (int u = bx; u < 256; u += G) { const int bg = u & 7, cp = u >> 3; att::attn_unit<PROBE_REP - 20>(kp, j, bg >> 2, bg & 3, 63 - cp, (char*)lds, wave); att::attn_unit<PROBE_REP - 20>(kp, j, bg >> 2, bg & 3, cp, (char*)lds, wave); }
#endif
#ifdef CHECK_ATTN
                GRID_BAR();
                for (int qi = bx; qi < M; qi += G) attn_query(kp, j, qi, lds, wave, true);
#endif
#endif
                SEAM(ph); }
            ++ph;
            if (IN(ph)) { PHASE_BEGIN();
                { pg8::Gemm g{YCAT, WEOUT + (size_t)j * 2048 * 4096, M, 2048, 4096}; pg8::StaticOrder S; S.init(M, 2048, G, bx);
                  pg8::EpiOut E{HP, HQ, STB}; pg8::gemm_phase<pg8::EpiOut, pg8::StaticOrder, true, true>(ldsl, g, S, E, wave);
#if PROBE_REP == 12
                  { pg8::EpiOut Ed{HP, (bf16*)(ws + WS_SC), (float*)(ws + WS_SC) + 16 * 1048576}; for (int rep_ = 0; rep_ < 2; ++rep_) pg8::gemm_phase<pg8::EpiOut, pg8::StaticOrder, true, true>(ldsl, g, S, Ed, wave); }
#endif
                }
                SEAM(ph); }
            ++ph;
        } else {
            if (IN(ph)) { PHASE_BEGIN(); pg8::Gemm g{HP, WOIN + (size_t)j * ODD_IN * 2048, M, ODD_IN, 2048}; pg8::StaticOrder S; S.init(M, ODD_IN, G, bx);
                pg8::EpiOddIn E{PROJ, STA, SLN}; for (int rep_ = 0; rep_ < NREP(6); ++rep_) pg8::gemm_phase<pg8::EpiOddIn, pg8::StaticOrder, true, true>(ldsl, g, S, E, wave); SEAM(ph); }
            ++ph;
            if (IN(ph)) { PHASE_BEGIN();
#ifndef NO_SGU
                for (int rep_ = 0; rep_ < NREP(7); ++rep_)
#ifdef NAIVE_SGU
                for (int it = bx; it < 1024; it += G) sgu_item(kp, j, it >> 9, (it >> 4) & 31, it & 15, lds, wave);
#else
                for (int it = bx; it < 1024; it += G) sgu_item_mfma(kp, j, it >> 9, (it >> 4) & 31, it & 15, lds, wave);
#endif
#endif
                SEAM(ph); }
            ++ph;
            if (IN(ph)) { PHASE_BEGIN();
                { pg8::Gemm g{YCAT, WOOUT + (size_t)j * 2048 * 2048, M, 2048, 2048}; pg8::StaticOrder S; S.init(M, 2048, G, bx);
                  pg8::EpiOut E{HP, HQ, STB}; pg8::gemm_phase<pg8::EpiOut, pg8::StaticOrder, true, true>(ldsl, g, S, E, wave);
#if PROBE_REP == 12
                  { pg8::EpiOut Ed{HP, (bf16*)(ws + WS_SC), (float*)(ws + WS_SC) + 16 * 1048576}; for (int rep_ = 0; rep_ < 2; ++rep_) pg8::gemm_phase<pg8::EpiOut, pg8::StaticOrder, true, true>(ldsl, g, S, Ed, wave); }
#endif
                }
                SEAM(ph); }
            ++ph;
        }
        if (IN(ph)) { PHASE_BEGIN(); pg8::Gemm g{HQ, WGATE + (size_t)layer * 2048 * 2048, M, 2048, 2048}; pg8::StaticOrder S; S.init(M, 2048, G, bx);
            typedef pg8::EpiGateT<layer_it == DEPTH - 1> EpiGate;
            EpiGate E{HQ, EB, STB, HP, STA, KOUT}; pg8::gemm_phase<EpiGate, pg8::StaticOrder, true, true>(ldsl, g, S, E, wave);
#if PROBE_REP == 13
            { pg8::EpiGateT<false> Ed{HQ, EB, STB, (bf16*)(ws + WS_SC), (float*)(ws + WS_SC) + 16 * 1048576, nullptr}; for (int rep_ = 0; rep_ < 2; ++rep_) pg8::gemm_phase<pg8::EpiGateT<false>, pg8::StaticOrder, true, true>(ldsl, g, S, Ed, wave); }
#endif

            if (layer_it != DEPTH - 1) SEAM(ph); }
        ++ph;
    }
    {
        constexpr int layer_it = 2;
        if ((layer_it & 1) == 0) {
            if (IN(ph)) { PHASE_BEGIN(); pg8::Gemm g{HP, WEIN + (size_t)j * EVEN_INP * 2048, M, EVEN_INP, 2048}; pg8::StaticOrder S; S.init(M, EVEN_INP, G, bx);
                pg8::EpiEvenIn E{PROJ, IDX, STA, (bf16*)(ws + WS_IDXB)}; for (int rep_ = 0; rep_ < NREP(1); ++rep_) pg8::gemm_phase<pg8::EpiEvenIn, pg8::StaticOrder, true, true>(ldsl, g, S, E, wave);
                if (bx >= 32 && G > 32) {
#pragma unroll 1
                    for (int l2 = 0; l2 < 2; ++l2) { const int ll = layer + l2; pg8::Gemm g2{PBF + (size_t)ll * M * 256, WPE + (size_t)ll * 2048 * 256, M, 2048, 256}; pg8::StaticOrder S2; S2.init(M, 2048, G - 32, bx - 32);
                        pg8::EpiPE E2{EBL(ll)}; pg8::gemm_phase<pg8::EpiPE, pg8::StaticOrder, true, true>(ldsl, g2, S2, E2, wave);  }
                    { LANE_ONLY(); float* scr = (float*)(lds + wave * 16640); const int gw2 = (bx - 32) * NWAVES + wave, NGW2 = (G - 32) * NWAVES; int base = 0, it = gw2;
#define TR2(W, K, N, WT, GK) do { const int ni_ = ((K) / 64) * (((N) + 63) / 64); for (; it < base + ni_; it += NGW2) p0_transpose_item((W), (K), (N), (WT), scr, it - base, lane, (GK)); base += ni_; } while (0)
                      if (layer == 0) { TR2(KIN(4) + (size_t)2048 * EVEN_IN, 2048, EVEN_IN, WEIN + (size_t)EVEN_INP * 2048, KIN(2) + 2 * DM); }
                      else { TR2(KIN(15) + (size_t)2048 * ODD_IN, 2048, ODD_IN, WOIN + (size_t)ODD_IN * 2048, KIN(2) + 3 * DM); TR2(KIN(20) + (size_t)2048 * 2048, 2048, 2048, WOOUT + (size_t)2048 * 2048, nullptr); TR2(KIN(23) + (size_t)3 * 2048 * 2048, 2048, 2048, WGATE + (size_t)3 * 2048 * 2048, KIN(22) + 3 * DM); }
#undef TR2
                    } }
#if PROBE_REP == 11 || PROBE_REP == 14
                __syncthreads();
                { pg8::EpiEvenInT<PROBE_REP == 11 ? 1 : 2> EN{PROJ, IDX, STA, (bf16*)(ws + WS_IDXB)}; for (int rep_ = 0; rep_ < 2; ++rep_) pg8::gemm_phase<pg8::EpiEvenInT<PROBE_REP == 11 ? 1 : 2>, pg8::StaticOrder, true, true>(ldsl, g, S, EN, wave); }
#endif
#if PROBE_REP == 10
                __syncthreads();
                { pg8::EpiNull EN; for (int rep_ = 0; rep_ < 2; ++rep_) pg8::gemm_phase<pg8::EpiNull, pg8::StaticOrder, true, true>(ldsl, g, S, EN, wave); }
#endif
                SEAM(ph); }
            ++ph;
            if (IN(ph)) { PHASE_BEGIN(); LANE_ONLY();
#ifdef NAIVE_LRU
                for (int it = bx; it < 1024; it += G) lru_tile(kp, j, it >> 9, (it >> 4) & 31, it & 15, false, lds, wave);
#else
                for (int rep_ = 0; rep_ < NREP(2); ++rep_)
                for (int it = bx; it < 1024; it += G) lru_tile_mfma(kp, j, it, it + G, it == bx, false, LRU_STREAM != 0, lds, wave);
#endif
#ifndef NO_KN
                for (int it = bx; it < 512; it += G) knorm_item(kp, j, it, wave, lane);
#endif
#ifdef NAIVE_SCORE
                for (int it = bx; it < 4160; it += G) { const int b = it / 2080; int r = it % 2080; int c = 0; while (r >= c + 1) { r -= c + 1; ++c; } score_item(kp, b, c, r, lds, wave); }
#else
                __syncthreads();
                for (int rep_ = 0; rep_ < NREP(3); ++rep_)
                for (int u = gw; u < 2048; u += NGW) { const int ks = u & 7, qg = (u >> 3) & 3, cp = (u >> 5) & 31, b = u >> 10;
                    score_wave_unit(kp, b, cp, qg, ks, lane, lds, wave); score_wave_unit(kp, b, 63 - cp, qg, ks, lane, lds, wave); }
#ifdef CHECK_SCORE
                GRID_BAR();
                for (int it = bx; it < 4160; it += G) { const int b = it / 2080; int r = it % 2080; int c = 0; while (r >= c + 1) { r -= c + 1; ++c; } score_item(kp, b, c, r, lds, wave, true); }
#endif
#endif
                SEAM(ph); }
            ++ph;
            if (IN(ph)) { PHASE_BEGIN(); LANE_ONLY();
#ifdef NAIVE_LRU
                for (int it = bx; it < 1024; it += G) lru_tile(kp, j, it >> 9, (it >> 4) & 31, it & 15, true, lds, wave);
#else
                for (int rep_ = 0; rep_ < NREP(2); ++rep_)
                for (int it = bx; it < 1024; it += (LRU_STREAM ? 4 : 1) * G) { if (LRU_STREAM) { __syncthreads(); lru_carry4(kp, it, G, (float*)lds, wave); __syncthreads();
#pragma unroll 1
                    for (int k4 = 0; k4 < 4; ++k4) if (it + k4 * G < 1024) lru_apply_item(kp, it + k4 * G, (const float*)lds + k4 * 128, wave); }
                  else lru_tile_mfma(kp, j, it, it + G, it == bx, true, false, lds, wave); }
#ifdef CHECK_LRU
                GRID_BAR();
                for (int it = bx; it < 1024; it += G) lru_tile(kp, j, it >> 9, (it >> 4) & 31, it & 15, true, lds, wave, true);
#endif
#endif
#ifndef NO_SEL
                for (int rep_ = 0; rep_ < NREP(4); ++rep_)
                for (int u = gw; u < M / 2; u += NGW) { const int b_ = u >> 11, t_ = u & 2047;
                    select_query(kp, b_ * SEQ + t_, lane); select_query(kp, b_ * SEQ + 4095 - t_, lane); }
#endif
                SEAM(ph); }
            ++ph;
            if (IN(ph)) { PHASE_BEGIN();
#ifdef NAIVE_ATTN
                for (int qi = bx; qi < M; qi += G) attn_query(kp, j, qi, lds, wave);
#else
                for (int rep_ = 0; rep_ < NREP(5); ++rep_)
                for (int u = bx; u < 256; u += G) { const int bg = u & 7, cp = u >> 3;

#pragma unroll 1
                    for (int k2 = 0; k2 < 2; ++k2) att::attn_unit<0>(kp, j, bg >> 2, bg & 3, k2 ? cp : 63 - cp, (char*)lds, wave); }
#if PROBE_REP >= 20 && PROBE_REP < 30
                for (int rep_ = 0; rep_ < 2; ++rep_) for (int u = bx; u < 256; u += G) { const int bg = u & 7, cp = u >> 3; att::attn_unit<PROBE_REP - 20>(kp, j, bg >> 2, bg & 3, 63 - cp, (char*)lds, wave); att::attn_unit<PROBE_REP - 20>(kp, j, bg >> 2, bg & 3, cp, (char*)lds, wave); }
#endif
#ifdef CHECK_ATTN
                GRID_BAR();
                for (int qi = bx; qi < M; qi += G) attn_query(kp, j, qi, lds, wave, true);
#endif
#endif
                SEAM(ph); }
            ++ph;
            if (IN(ph)) { PHASE_BEGIN();
                { pg8::Gemm g{YCAT, WEOUT + (size_t)j * 2048 * 4096, M, 2048, 4096}; pg8::StaticOrder S; S.init(M, 2048, G, bx);
                  pg8::EpiOut E{HP, HQ, STB}; pg8::gemm_phase<pg8::EpiOut, pg8::StaticOrder, true, true>(ldsl, g, S, E, wave);
#if PROBE_REP == 12
                  { pg8::EpiOut Ed{HP, (bf16*)(ws + WS_SC), (float*)(ws + WS_SC) + 16 * 1048576}; for (int rep_ = 0; rep_ < 2; ++rep_) pg8::gemm_phase<pg8::EpiOut, pg8::StaticOrder, true, true>(ldsl, g, S, Ed, wave); }
#endif
                }
                SEAM(ph); }
            ++ph;
        } else {
            if (IN(ph)) { PHASE_BEGIN(); pg8::Gemm g{HP, WOIN + (size_t)j * ODD_IN * 2048, M, ODD_IN, 2048}; pg8::StaticOrder S; S.init(M, ODD_IN, G, bx);
                pg8::EpiOddIn E{PROJ, STA, SLN}; for (int rep_ = 0; rep_ < NREP(6); ++rep_) pg8::gemm_phase<pg8::EpiOddIn, pg8::StaticOrder, true, true>(ldsl, g, S, E, wave); SEAM(ph); }
            ++ph;
            if (IN(ph)) { PHASE_BEGIN();
#ifndef NO_SGU
                for (int rep_ = 0; rep_ < NREP(7); ++rep_)
#ifdef NAIVE_SGU
                for (int it = bx; it < 1024; it += G) sgu_item(kp, j, it >> 9, (it >> 4) & 31, it & 15, lds, wave);
#else
                for (int it = bx; it < 1024; it += G) sgu_item_mfma(kp, j, it >> 9, (it >> 4) & 31, it & 15, lds, wave);
#endif
#endif
                SEAM(ph); }
            ++ph;
            if (IN(ph)) { PHASE_BEGIN();
                { pg8::Gemm g{YCAT, WOOUT + (size_t)j * 2048 * 2048, M, 2048, 2048}; pg8::StaticOrder S; S.init(M, 2048, G, bx);
                  pg8::EpiOut E{HP, HQ, STB}; pg8::gemm_phase<pg8::EpiOut, pg8::StaticOrder, true, true>(ldsl, g, S, E, wave);
#if PROBE_REP == 12
                  { pg8::EpiOut Ed{HP, (bf16*)(ws + WS_SC), (float*)(ws + WS_SC) + 16 * 1048576}; for (int rep_ = 0; rep_ < 2; ++rep_) pg8::gemm_phase<pg8::EpiOut, pg8::StaticOrder, true, true>(ldsl, g, S, Ed, wave); }
#endif
                }
                SEAM(ph); }
            ++ph;
        }
        if (IN(ph)) { PHASE_BEGIN(); pg8::Gemm g{HQ, WGATE + (size_t)layer * 2048 * 2048, M, 2048, 2048}; pg8::StaticOrder S; S.init(M, 2048, G, bx);
            typedef pg8::EpiGateT<layer_it == DEPTH - 1> EpiGate;
            EpiGate E{HQ, EB, STB, HP, STA, KOUT}; pg8::gemm_phase<EpiGate, pg8::StaticOrder, true, true>(ldsl, g, S, E, wave);
#if PROBE_REP == 13
            { pg8::EpiGateT<false> Ed{HQ, EB, STB, (bf16*)(ws + WS_SC), (float*)(ws + WS_SC) + 16 * 1048576, nullptr}; for (int rep_ = 0; rep_ < 2; ++rep_) pg8::gemm_phase<pg8::EpiGateT<false>, pg8::StaticOrder, true, true>(ldsl, g, S, Ed, wave); }
#endif

            if (layer_it != DEPTH - 1) SEAM(ph); }
        ++ph;
    }
    {
        constexpr int layer_it = 3;
        if ((layer_it & 1) == 0) {
            if (IN(ph)) { PHASE_BEGIN(); pg8::Gemm g{HP, WEIN + (size_t)j * EVEN_INP * 2048, M, EVEN_INP, 2048}; pg8::StaticOrder S; S.init(M, EVEN_INP, G, bx);
                pg8::EpiEvenIn E{PROJ, IDX, STA, (bf16*)(ws + WS_IDXB)}; for (int rep_ = 0; rep_ < NREP(1); ++rep_) pg8::gemm_phase<pg8::EpiEvenIn, pg8::StaticOrder, true, true>(ldsl, g, S, E, wave);
                if (bx >= 32 && G > 32) {
#pragma unroll 1
                    for (int l2 = 0; l2 < 2; ++l2) { const int ll = layer + l2; pg8::Gemm g2{PBF + (size_t)ll * M * 256, WPE + (size_t)ll * 2048 * 256, M, 2048, 256}; pg8::StaticOrder S2; S2.init(M, 2048, G - 32, bx - 32);
                        pg8::EpiPE E2{EBL(ll)}; pg8::gemm_phase<pg8::EpiPE, pg8::StaticOrder, true, true>(ldsl, g2, S2, E2, wave);  }
                    { LANE_ONLY(); float* scr = (float*)(lds + wave * 16640); const int gw2 = (bx - 32) * NWAVES + wave, NGW2 = (G - 32) * NWAVES; int base = 0, it = gw2;
#define TR2(W, K, N, WT, GK) do { const int ni_ = ((K) / 64) * (((N) + 63) / 64); for (; it < base + ni_; it += NGW2) p0_transpose_item((W), (K), (N), (WT), scr, it - base, lane, (GK)); base += ni_; } while (0)
                      if (layer == 0) { TR2(KIN(4) + (size_t)2048 * EVEN_IN, 2048, EVEN_IN, WEIN + (size_t)EVEN_INP * 2048, KIN(2) + 2 * DM); }
                      else { TR2(KIN(15) + (size_t)2048 * ODD_IN, 2048, ODD_IN, WOIN + (size_t)ODD_IN * 2048, KIN(2) + 3 * DM); TR2(KIN(20) + (size_t)2048 * 2048, 2048, 2048, WOOUT + (size_t)2048 * 2048, nullptr); TR2(KIN(23) + (size_t)3 * 2048 * 2048, 2048, 2048, WGATE + (size_t)3 * 2048 * 2048, KIN(22) + 3 * DM); }
#undef TR2
                    } }
#if PROBE_REP == 11 || PROBE_REP == 14
                __syncthreads();
                { pg8::EpiEvenInT<PROBE_REP == 11 ? 1 : 2> EN{PROJ, IDX, STA, (bf16*)(ws + WS_IDXB)}; for (int rep_ = 0; rep_ < 2; ++rep_) pg8::gemm_phase<pg8::EpiEvenInT<PROBE_REP == 11 ? 1 : 2>, pg8::StaticOrder, true, true>(ldsl, g, S, EN, wave); }
#endif
#if PROBE_REP == 10
                __syncthreads();
                { pg8::EpiNull EN; for (int rep_ = 0; rep_ < 2; ++rep_) pg8::gemm_phase<pg8::EpiNull, pg8::StaticOrder, true, true>(ldsl, g, S, EN, wave); }
#endif
                SEAM(ph); }
            ++ph;
            if (IN(ph)) { PHASE_BEGIN(); LANE_ONLY();
#ifdef NAIVE_LRU
                for (int it = bx; it < 1024; it += G) lru_tile(kp, j, it >> 9, (it >> 4) & 31, it & 15, false, lds, wave);
#else
                for (int rep_ = 0; rep_ < NREP(2); ++rep_)
                for (int it = bx; it < 1024; it += G) lru_tile_mfma(kp, j, it, it + G, it == bx, false, LRU_STREAM != 0, lds, wave);
#endif
#ifndef NO_KN
                for (int it = bx; it < 512; it += G) knorm_item(kp, j, it, wave, lane);
#endif
#ifdef NAIVE_SCORE
                for (int it = bx; it < 4160; it += G) { const int b = it / 2080; int r = it % 2080; int c = 0; while (r >= c + 1) { r -= c + 1; ++c; } score_item(kp, b, c, r, lds, wave); }
#else
                __syncthreads();
                for (int rep_ = 0; rep_ < NREP(3); ++rep_)
                for (int u = gw; u < 2048; u += NGW) { const int ks = u & 7, qg = (u >> 3) & 3, cp = (u >> 5) & 31, b = u >> 10;
                    score_wave_unit(kp, b, cp, qg, ks, lane, lds, wave); score_wave_unit(kp, b, 63 - cp, qg, ks, lane, lds, wave); }
#ifdef CHECK_SCORE
                GRID_BAR();
                for (int it = bx; it < 4160; it += G) { const int b = it / 2080; int r = it % 2080; int c = 0; while (r >= c + 1) { r -= c + 1; ++c; } score_item(kp, b, c, r, lds, wave, true); }
#endif
#endif
                SEAM(ph); }
            ++ph;
            if (IN(ph)) { PHASE_BEGIN(); LANE_ONLY();
#ifdef NAIVE_LRU
                for (int it = bx; it < 1024; it += G) lru_tile(kp, j, it >> 9, (it >> 4) & 31, it & 15, true, lds, wave);
#else
                for (int rep_ = 0; rep_ < NREP(2); ++rep_)
                for (int it = bx; it < 1024; it += (LRU_STREAM ? 4 : 1) * G) { if (LRU_STREAM) { __syncthreads(); lru_carry4(kp, it, G, (float*)lds, wave); __syncthreads();
#pragma unroll 1
                    for (int k4 = 0; k4 < 4; ++k4) if (it + k4 * G < 1024) lru_apply_item(kp, it + k4 * G, (const float*)lds + k4 * 128, wave); }
                  else lru_tile_mfma(kp, j, it, it + G, it == bx, true, false, lds, wave); }
#ifdef CHECK_LRU
                GRID_BAR();
                for (int it = bx; it < 1024; it += G) lru_tile(kp, j, it >> 9, (it >> 4) & 31, it & 15, true, lds, wave, true);
#endif
#endif
#ifndef NO_SEL
                for (int rep_ = 0; rep_ < NREP(4); ++rep_)
                for (int u = gw; u < M / 2; u += NGW) { const int b_ = u >> 11, t_ = u & 2047;
                    select_query(kp, b_ * SEQ + t_, lane); select_query(kp, b_ * SEQ + 4095 - t_, lane); }
#endif
                SEAM(ph); }
            ++ph;
            if (IN(ph)) { PHASE_BEGIN();
#ifdef NAIVE_ATTN
                for (int qi = bx; qi < M; qi += G) attn_query(kp, j, qi, lds, wave);
#else
                for (int rep_ = 0; rep_ < NREP(5); ++rep_)
                for (int u = bx; u < 256; u += G) { const int bg = u & 7, cp = u >> 3;

#pragma unroll 1
                    for (int k2 = 0; k2 < 2; ++k2) att::attn_unit<0>(kp, j, bg >> 2, bg & 3, k2 ? cp : 63 - cp, (char*)lds, wave); }
#if PROBE_REP >= 20 && PROBE_REP < 30
                for (int rep_ = 0; rep_ < 2; ++rep_) for (int u = bx; u < 256; u += G) { const int bg = u & 7, cp = u >> 3; att::attn_unit<PROBE_REP - 20>(kp, j, bg >> 2, bg & 3, 63 - cp, (char*)lds, wave); att::attn_unit<PROBE_REP - 20>(kp, j, bg >> 2, bg & 3, cp, (char*)lds, wave); }
#endif
#ifdef CHECK_ATTN
                GRID_BAR();
                for (int qi = bx; qi < M; qi += G) attn_query(kp, j, qi, lds, wave, true);
#endif
#endif
                SEAM(ph); }
            ++ph;
            if (IN(ph)) { PHASE_BEGIN();
                { pg8::Gemm g{YCAT, WEOUT + (size_t)j * 2048 * 4096, M, 2048, 4096}; pg8::StaticOrder S; S.init(M, 2048, G, bx);
                  pg8::EpiOut E{HP, HQ, STB}; pg8::gemm_phase<pg8::EpiOut, pg8::StaticOrder, true, true>(ldsl, g, S, E, wave);
#if PROBE_REP == 12
                  { pg8::EpiOut Ed{HP, (bf16*)(ws + WS_SC), (float*)(ws + WS_SC) + 16 * 1048576}; for (int rep_ = 0; rep_ < 2; ++rep_) pg8::gemm_phase<pg8::EpiOut, pg8::StaticOrder, true, true>(ldsl, g, S, Ed, wave); }
#endif
                }
                SEAM(ph); }
            ++ph;
        } else {
            if (IN(ph)) { PHASE_BEGIN(); pg8::Gemm g{HP, WOIN + (size_t)j * ODD_IN * 2048, M, ODD_IN, 2048}; pg8::StaticOrder S; S.init(M, ODD_IN, G, bx);
                pg8::EpiOddIn E{PROJ, STA, SLN}; for (int rep_ = 0; rep_ < NREP(6); ++rep_) pg8::gemm_phase<pg8::EpiOddIn, pg8::StaticOrder, true, true>(ldsl, g, S, E, wave); SEAM(ph); }
            ++ph;
            if (IN(ph)) { PHASE_BEGIN();
#ifndef NO_SGU
                for (int rep_ = 0; rep_ < NREP(7); ++rep_)
#ifdef NAIVE_SGU
                for (int it = bx; it < 1024; it += G) sgu_item(kp, j, it >> 9, (it >> 4) & 31, it & 15, lds, wave);
#else
                for (int it = bx; it < 1024; it += G) sgu_item_mfma(kp, j, it >> 9, (it >> 4) & 31, it & 15, lds, wave);
#endif
#endif
                SEAM(ph); }
            ++ph;
            if (IN(ph)) { PHASE_BEGIN();
                { pg8::Gemm g{YCAT, WOOUT + (size_t)j * 2048 * 2048, M, 2048, 2048}; pg8::StaticOrder S; S.init(M, 2048, G, bx);
                  pg8::EpiOut E{HP, HQ, STB}; pg8::gemm_phase<pg8::EpiOut, pg8::StaticOrder, true, true>(ldsl, g, S, E, wave);
#if PROBE_REP == 12
                  { pg8::EpiOut Ed{HP, (bf16*)(ws + WS_SC), (float*)(ws + WS_SC) + 16 * 1048576}; for (int rep_ = 0; rep_ < 2; ++rep_) pg8::gemm_phase<pg8::EpiOut, pg8::StaticOrder, true, true>(ldsl, g, S, Ed, wave); }
#endif
                }
                SEAM(ph); }
            ++ph;
        }
        if (IN(ph)) { PHASE_BEGIN(); pg8::Gemm g{HQ, WGATE + (size_t)layer * 2048 * 2048, M, 2048, 2048}; pg8::StaticOrder S; S.init(M, 2048, G, bx);
            typedef pg8::EpiGateT<layer_it == DEPTH - 1> EpiGate;
            EpiGate E{HQ, EB, STB, HP, STA, KOUT}; pg8::gemm_phase<EpiGate, pg8::StaticOrder, true, true>(ldsl, g, S, E, wave);
#if PROBE_REP == 13
            { pg8::EpiGateT<false> Ed{HQ, EB, STB, (bf16*)(ws + WS_SC), (float*)(ws + WS_SC) + 16 * 1048576, nullptr}; for (int rep_ = 0; rep_ < 2; ++rep_) pg8::gemm_phase<pg8::EpiGateT<false>, pg8::StaticOrder, true, true>(ldsl, g, S, Ed, wave); }
#endif

            if (layer_it != DEPTH - 1) SEAM(ph); }
        ++ph;
    }
#if defined(CHECK_SCORE) || defined(CHECK_ATTN) || defined(CHECK_LRU)
    if (IN(NPHASE - 1)) { KARGS_OPEN(); GRID_BAR(); if (bx == 0 && wave == 0 && lane_id() == 0 && __hip_atomic_load((unsigned*)(KWS + WS_CTL) + 8, __ATOMIC_RELAXED, __HIP_MEMORY_SCOPE_AGENT) != 0u) KOUT[0] = __builtin_nanf(""); }
#endif
#undef IN
#undef SEAM
#undef GRID_BAR
#undef HP
#undef HQ
#undef PROJ
#undef YCAT
#undef IDX
#undef EB
#undef STA
#undef STB
#undef SLN
#undef PBF
#undef WPE
#undef WGATE
#undef WEIN
#undef WEOUT
#undef WOIN
#undef WOOUT
#undef ws
}

extern "C" void kernel_launch(void* const* d_in, const int* in_sizes, int n_in, void* d_out, int out_size, void* d_ws, size_t ws_size, hipStream_t stream) {
    static int grid = 0;
    if (grid == 0) {
        if (n_in != 24 || out_size != M * DM || ws_size < WS_END) { fprintf(stderr, "kernel_launch: unexpected shapes (n_in %d out %d ws %zu)\n", n_in, out_size, ws_size); grid = -1; return; }
        int dev = 0, cus = 0, per_cu = 0;
        if (hipGetDevice(&dev) != hipSuccess || hipDeviceGetAttribute(&cus, hipDeviceAttributeMultiprocessorCount, dev) != hipSuccess) { grid = -1; return; }
        if (hipFuncSetAttribute((const void*)mega_fwd, hipFuncAttributeMaxDynamicSharedMemorySize, LDS_BYTES) != hipSuccess) { fprintf(stderr, "kernel_launch: hipFuncSetAttribute failed\n"); grid = -1; return; }
        if (hipOccupancyMaxActiveBlocksPerMultiprocessor(&per_cu, (const void*)mega_fwd, NTHR, LDS_BYTES) != hipSuccess || per_cu < 1) { fprintf(stderr, "kernel_launch: occupancy query says %d\n", per_cu); }
        (void)hipGetLastError();
        grid = cus;
        if (grid != 256) fprintf(stderr, "kernel_launch: %d CUs (built for 256)\n", grid);
    }
    if (grid < 0) return;
    (void)hipMemsetAsync((char*)d_ws + WS_CTL, 0, CTL_ZERO_BYTES, stream);
    Args a{};
    for (int i = 0; i < 24; ++i) a.in[i] = (const float*)d_in[i];
    a.out = (float*)d_out; a.ws = (unsigned char*)d_ws;
    for (int k = 0; k < 8; ++k) a.thr[k] = 1 << 30;
    for (int n = 8; n < 4096; ++n) { const float nf = (float)n; const float l = (float)log((double)(nf / 8.0f)); const float tt = (l / (float)log(16.0)) * 8.0f; int large = 8 + (int)tt; if (large > 15) large = 15;
        const int k = large - 8; for (int kk = 1; kk <= k; ++kk) if (n < a.thr[kk]) a.thr[kk] = n; }
    if (N_LAUNCHES == 1) { a.ph_lo = 0; a.ph_hi = NPHASE; hipLaunchKernelGGL(mega_fwd, dim3(grid), dim3(NTHR), LDS_BYTES, stream, a); }
    else { for (int p = 0; p < NPHASE; ++p) { a.ph_lo = p; a.ph_hi = p + 1; hipLaunchKernelGGL(mega_fwd, dim3(grid), dim3(NTHR), LDS_BYTES, stream, a); } }
}
```

```cpp
#include <hip/hip_runtime.h>
#include <cstdio>
#include <cstdint>
#include <cmath>
namespace pg8 {
#define PG8_LAS __attribute__((address_space(3)))
typedef unsigned short bf16_t;
typedef short bf16x8 __attribute__((ext_vector_type(8)));
typedef float f32x4 __attribute__((ext_vector_type(4)));
typedef unsigned u32x4 __attribute__((ext_vector_type(4)));
constexpr int BM = 256, BK = 64, HALF = 128, HTB = HALF * BK * 2  , STAGE_BYTES = 8 * HTB, NXCD = 8, WGM = 8;

__host__ __device__ __forceinline__ int lds_byte(int r, int c) { const int st = (r >> 4) * 2 + (c >> 5), rr = r & 15, cc = c & 31, ob = rr * 64 + cc * 2; return st * 1024 + (ob ^ (((ob >> 9) & 1) << 5)); }
__host__ __device__ __forceinline__ void stage_rc(int b, int& R, int& C) { const int st = b / 1024, sb = b % 1024, swz = sb ^ (((sb >> 9) & 1) << 5); R = (st >> 1) * 16 + swz / 64; C = (st & 1) * 32 + (swz % 64) / 2; }
__host__ __device__ __forceinline__ int perm32(int rho) { const int n = rho >> 4, i = rho & 15; return 8 * (i >> 2) + 4 * n + (i & 3); }

struct Unit { int pm, pn; };
struct Gemm { const bf16_t* A; const bf16_t* Bt; int M, N, K; };

struct StaticOrder {
    int nM, nN, nwg, G, c;
    __host__ __device__ void init(int M, int N, int G_, int c_) { nM = M / BM; nN = N / BM; nwg = nM * nN; G = G_; c = c_; }
    __host__ __device__ bool next(int i, Unit& u) const {
        const long L = (long)i * G + c; if (L >= nwg) return false;
        int wgid = (int)L; { const int q = nwg / NXCD, r = nwg % NXCD, xcd = wgid % NXCD, off = wgid / NXCD; wgid = (xcd < r ? xcd * (q + 1) : r * (q + 1) + (xcd - r) * q) + off; }
        const int nig = WGM * nN, gid = wgid / nig, fm = gid * WGM, gsz = (nM - fm) < WGM ? (nM - fm) : WGM;
        u.pm = fm + ((wgid % nig) % gsz); u.pn = (wgid % nig) / gsz; return true;
    }
    __device__ __forceinline__ void a_ready(const Unit&) const {}
    __device__ __forceinline__ void done(const Unit&) const {}
};

__device__ __forceinline__ unsigned cvt_pk_bf16(float lo, float hi) { unsigned r; asm volatile("v_cvt_pk_bf16_f32 %0, %1, %2" : "=v"(r) : "v"(lo), "v"(hi)); return r; }
typedef float f32x2 __attribute__((ext_vector_type(2)));
#ifdef EPI_NT
#define ST16(p, v) __builtin_nontemporal_store((v), (p))
#else
#define ST16(p, v) (*(p) = (v))
#endif
__device__ __forceinline__ float fast_sigmoid(float x) { return __builtin_amdgcn_rcpf(1.0f + __builtin_amdgcn_exp2f(x * -1.4426950408889634f)); }
__device__ __forceinline__ float silu_f(float x) { return x * fast_sigmoid(x); }
__device__ __forceinline__ float gelu_tanh_f(float x) { const float z = 1.5957691216057308f * (x + 0.044715f * x * x * x); return x * fast_sigmoid(z); }
__device__ __forceinline__ float xrow16_sum(float x) {
    auto s = __builtin_amdgcn_permlane16_swap(__float_as_uint(x), __float_as_uint(x), false, false);
    x = __uint_as_float(s[0]) + __uint_as_float(s[1]);
    auto t = __builtin_amdgcn_permlane32_swap(__float_as_uint(x), __float_as_uint(x), false, false);
    return __uint_as_float(t[0]) + __uint_as_float(t[1]);
}
__device__ __forceinline__ float bf2f(unsigned short v) { return __uint_as_float(((unsigned)v) << 16); }
__device__ __forceinline__ float row_rstd32(const float* part, int fq) {
    const f32x4 a = *(const f32x4*)(part + fq * 8), b = *(const f32x4*)(part + fq * 8 + 4);
    float s = ((a[0] + a[1]) + (a[2] + a[3])) + ((b[0] + b[1]) + (b[2] + b[3]));
    s = xrow16_sum(s);
    return __builtin_amdgcn_rsqf(s * (1.0f / 2048.0f) + 1e-6f);
}
__device__ __forceinline__ u32x4 pack8(const f32x4 v0, const f32x4 v1) { u32x4 w; w.x = cvt_pk_bf16(v0[0], v0[1]); w.y = cvt_pk_bf16(v0[2], v0[3]); w.z = cvt_pk_bf16(v1[0], v1[1]); w.w = cvt_pk_bf16(v1[2], v1[3]); return w; }

template <int NOSTORE> struct EpiEvenInT {
    static constexpr bool PERM = true, AFTER_DRAIN = false, PRE_STATS = true;
    bf16_t* PROJ; float* IDX; const float* stats; bf16_t* IDXB;
    __device__ __forceinline__ void operator()(const f32x4 (&acc)[2][2][4][2], const Unit& u, int wr, int wc, int fr, int fq, const float (&rs)[2][4]) const {
        const int rowb = u.pm * BM + wr * 64 + fr, pn = u.pn;
        if (pn < 36) {
            const bool act = __builtin_amdgcn_readfirstlane((int)((pn >= 8 && pn < 16) || (pn >= 28))) != 0;
            if (act) {
#pragma unroll
                for (int ai = 0; ai < 2; ++ai)
#pragma unroll
                    for (int m = 0; m < 4; ++m) { bf16_t* rowp = PROJ + (size_t)(rowb + ai * HALF + m * 16) * 9216 + pn * BM + wc * 32 + fq * 8; const float r = rs[ai][m];
#pragma unroll
                        for (int bj = 0; bj < 2; ++bj) { f32x4 v0 = acc[ai][bj][m][0] * r, v1 = acc[ai][bj][m][1] * r;
#pragma unroll
                            for (int i = 0; i < 4; ++i) { v0[i] = silu_f(v0[i]); v1[i] = silu_f(v1[i]); }
                            const u32x4 pk_ = pack8(v0, v1); if (NOSTORE) asm volatile("" :: "v"(pk_)); else ST16((u32x4*)(rowp + bj * HALF), pk_); } }
            } else {
#pragma unroll
                for (int ai = 0; ai < 2; ++ai)
#pragma unroll
                    for (int m = 0; m < 4; ++m) { bf16_t* rowp = PROJ + (size_t)(rowb + ai * HALF + m * 16) * 9216 + pn * BM + wc * 32 + fq * 8; const float r = rs[ai][m];
#pragma unroll
                        for (int bj = 0; bj < 2; ++bj) { const f32x4 v0 = acc[ai][bj][m][0] * r, v1 = acc[ai][bj][m][1] * r;
                            const u32x4 pk_ = pack8(v0, v1); if (NOSTORE) asm volatile("" :: "v"(pk_)); else ST16((u32x4*)(rowp + bj * HALF), pk_); } }
            }
        } else {
#ifdef CHECK_SCORE
            const bool f32too = true;
#else
            const bool f32too = __builtin_amdgcn_readfirstlane((int)(pn == 40)) != 0;
#endif
#pragma unroll
            for (int ai = 0; ai < 2; ++ai)
#pragma unroll
                for (int m = 0; m < 4; ++m) { float* rowp = IDX + (size_t)(rowb + ai * HALF + m * 16) * 1280 + (pn - 36) * BM + wc * 32 + fq * 8; const float r = rs[ai][m];
                    bf16_t* rowb16 = IDXB + (size_t)(rowb + ai * HALF + m * 16) * 1280 + (pn - 36) * BM + wc * 32 + fq * 8;
#pragma unroll
                    for (int bj = 0; bj < 2; ++bj) { const f32x4 v0 = acc[ai][bj][m][0] * r, v1 = acc[ai][bj][m][1] * r; if (f32too) { ST16((f32x4*)(rowp + bj * HALF), v0); ST16((f32x4*)(rowp + bj * HALF + 4), v1); } ST16((u32x4*)(rowb16 + bj * HALF), pack8(v0, v1)); } }
        }
    }
};
typedef EpiEvenInT<0> EpiEvenIn;
struct EpiOddIn {
    static constexpr bool PERM = true, AFTER_DRAIN = false, PRE_STATS = true;
    bf16_t* PROJ; const float* stats; float* statsLN;
    __device__ __forceinline__ void operator()(const f32x4 (&acc)[2][2][4][2], const Unit& u, int wr, int wc, int fr, int fq, const float (&rs)[2][4]) const {
        const int rowb = u.pm * BM + wr * 64 + fr, pn = u.pn;
#define EPO_BODY(ACTF) _Pragma("unroll") for (int ai = 0; ai < 2; ++ai) _Pragma("unroll") for (int m = 0; m < 4; ++m) { const int row = rowb + ai * HALF + m * 16; bf16_t* rowp = PROJ + (size_t)row * 6144 + pn * BM + wc * 32 + fq * 8; const float r = rs[ai][m]; \
                float s1 = 0.f, s2 = 0.f; \
                _Pragma("unroll") for (int bj = 0; bj < 2; ++bj) { f32x4 v0 = acc[ai][bj][m][0] * r, v1 = acc[ai][bj][m][1] * r; \
                    _Pragma("unroll") for (int i = 0; i < 4; ++i) { v0[i] = ACTF(v0[i]); v1[i] = ACTF(v1[i]); } \
                    _Pragma("unroll") for (int i = 0; i < 4; ++i) { s1 += v0[i] + v1[i]; s2 += v0[i] * v0[i] + v1[i] * v1[i]; } \
                    ST16((u32x4*)(rowp + bj * HALF), pack8(v0, v1)); } \
                if (stat) { s1 = xrow16_sum(s1); s2 = xrow16_sum(s2); if (fq == 0) { float* sp = statsLN + ((size_t)row * 32 + (pn - 8) * 4 + wc) * 2; sp[0] = s1; sp[1] = s2; } } }
        const bool isg = __builtin_amdgcn_readfirstlane((int)(pn < 16)) != 0, stat = __builtin_amdgcn_readfirstlane((int)(pn >= 8 && pn < 16)) != 0;
        if (isg) { EPO_BODY(gelu_tanh_f) } else { EPO_BODY(silu_f) }
#undef EPO_BODY
    }
};
__device__ __forceinline__ void unpack8(const u32x4 w, f32x4& a, f32x4& b) {
    a[0] = __uint_as_float(w.x << 16); a[1] = __uint_as_float(w.x & 0xffff0000u); a[2] = __uint_as_float(w.y << 16); a[3] = __uint_as_float(w.y & 0xffff0000u);
    b[0] = __uint_as_float(w.z << 16); b[1] = __uint_as_float(w.z & 0xffff0000u); b[2] = __uint_as_float(w.w << 16); b[3] = __uint_as_float(w.w & 0xffff0000u); }
struct EpiOut {
    static constexpr bool PERM = true, AFTER_DRAIN = false, PRE_STATS = false;
    const bf16_t* hin; bf16_t* hout; float* statsO;
    __device__ __forceinline__ void operator()(const f32x4 (&acc_)[2][2][4][2], const Unit& u, int wr, int wc, int fr, int fq) const {
        f32x4 (&acc)[2][2][4][2] = const_cast<f32x4 (&)[2][2][4][2]>(acc_);
        const int rowb = u.pm * BM + wr * 64 + fr, col0 = u.pn * BM + wc * 32 + fq * 8;
        float ssr[2][4];
#pragma unroll
        for (int ai = 0; ai < 2; ++ai)
#pragma unroll
            for (int m = 0; m < 4; ++m) { const int row = rowb + ai * HALF + m * 16; float ss = 0.f;
#pragma unroll
                for (int bj = 0; bj < 2; ++bj) { const size_t off = (size_t)row * 2048 + col0 + bj * HALF;
                    f32x4 h0, h1; unpack8(*(const u32x4*)(hin + off), h0, h1); h0 += acc[ai][bj][m][0]; h1 += acc[ai][bj][m][1];
                    acc[ai][bj][m][0] = h0; acc[ai][bj][m][1] = h1;
#pragma unroll
                    for (int i = 0; i < 4; ++i) ss += h0[i] * h0[i] + h1[i] * h1[i]; }
                ssr[ai][m] = xrow16_sum(ss); if (m == 3) asm volatile("" ::: "memory"); }
        asm volatile("" ::: "memory");
#pragma unroll
        for (int ai = 0; ai < 2; ++ai)
#pragma unroll
            for (int m = 0; m < 4; ++m) { const int row = rowb + ai * HALF + m * 16;
#pragma unroll
                for (int bj = 0; bj < 2; ++bj) { const size_t off = (size_t)row * 2048 + col0 + bj * HALF; ST16((u32x4*)(hout + off), pack8(acc[ai][bj][m][0], acc[ai][bj][m][1])); }
                if (fq == 0) statsO[(size_t)row * 32 + u.pn * 4 + wc] = ssr[ai][m]; }
    }
};
struct EpiPE {
    static constexpr bool PERM = true, AFTER_DRAIN = false, PRE_STATS = false;
    bf16_t* E;
    __device__ __forceinline__ void operator()(const f32x4 (&acc)[2][2][4][2], const Unit& u, int wr, int wc, int fr, int fq) const {
        const int rowb = u.pm * BM + wr * 64 + fr, col0 = u.pn * BM + wc * 32 + fq * 8;
#pragma unroll
        for (int ai = 0; ai < 2; ++ai)
#pragma unroll
            for (int m = 0; m < 4; ++m)
#pragma unroll
                for (int bj = 0; bj < 2; ++bj) ST16((u32x4*)(E + (size_t)(rowb + ai * HALF + m * 16) * 2048 + col0 + bj * HALF), pack8(acc[ai][bj][m][0], acc[ai][bj][m][1]));
    }
};
template <bool LAST> struct EpiGateT {
    static constexpr bool PERM = true, AFTER_DRAIN = false, PRE_STATS = true;
    const bf16_t* hin; const bf16_t* E; const float* stats; bf16_t* hout; float* statsO; float* fout;
    __device__ __forceinline__ void operator()(const f32x4 (&acc_)[2][2][4][2], const Unit& u, int wr, int wc, int fr, int fq, const float (&rs_)[2][4]) const {
        f32x4 (&acc)[2][2][4][2] = const_cast<f32x4 (&)[2][2][4][2]>(acc_);
        const int rowb = u.pm * BM + wr * 64 + fr, col0 = u.pn * BM + wc * 32 + fq * 8;
        float rs[2][4];
#pragma unroll
        for (int ai = 0; ai < 2; ++ai)
#pragma unroll
            for (int m = 0; m < 4; ++m) rs[ai][m] = rs_[ai][m];
#pragma unroll
        for (int ai = 0; ai < 2; ++ai)
#pragma unroll
            for (int m = 0; m < 4; ++m) { const int row = rowb + ai * HALF + m * 16; const float r = rs[ai][m]; float ss = 0.f;
#pragma unroll
                for (int bj = 0; bj < 2; ++bj) { const size_t off = (size_t)row * 2048 + col0 + bj * HALF;
                    f32x4 e0, e1, h0, h1; unpack8(*(const u32x4*)(E + off), e0, e1); unpack8(*(const u32x4*)(hin + off), h0, h1);
                    f32x4 g0 = acc[ai][bj][m][0] * r, g1 = acc[ai][bj][m][1] * r;
#pragma unroll
                    for (int i = 0; i < 4; ++i) { g0[i] = fast_sigmoid(g0[i]); g1[i] = fast_sigmoid(g1[i]); }
                    h0 += g0 * e0; h1 += g1 * e1;
                    acc[ai][bj][m][0] = h0; acc[ai][bj][m][1] = h1;
#pragma unroll
                    for (int i = 0; i < 4; ++i) ss += h0[i] * h0[i] + h1[i] * h1[i]; }
                if (!LAST) rs[ai][m] = xrow16_sum(ss);
                if (m == 3) asm volatile("" ::: "memory"); }
        asm volatile("" ::: "memory");
#pragma unroll
        for (int ai = 0; ai < 2; ++ai)
#pragma unroll
            for (int m = 0; m < 4; ++m) { const int row = rowb + ai * HALF + m * 16;
#pragma unroll
                for (int bj = 0; bj < 2; ++bj) { const size_t off = (size_t)row * 2048 + col0 + bj * HALF; const f32x4 h0 = acc[ai][bj][m][0], h1 = acc[ai][bj][m][1];
                    if (LAST) { ST16((f32x4*)(fout + off), h0); ST16((f32x4*)(fout + off + 4), h1); } else ST16((u32x4*)(hout + off), pack8(h0, h1)); }
                if (!LAST) { if (fq == 0) statsO[(size_t)row * 32 + u.pn * 4 + wc] = rs[ai][m]; } }
    }
};

struct EpiNull {
    static constexpr bool PERM = true, AFTER_DRAIN = false, PRE_STATS = false;
    __device__ __forceinline__ void operator()(const f32x4 (&acc)[2][2][4][2], const Unit& u, int wr, int wc, int fr, int fq) const {
#pragma unroll
        for (int ai = 0; ai < 2; ++ai)
#pragma unroll
            for (int bj = 0; bj < 2; ++bj) asm volatile("" :: "v"(acc[ai][bj][0][0]), "v"(acc[ai][bj][0][1]), "v"(acc[ai][bj][1][0]), "v"(acc[ai][bj][1][1]), "v"(acc[ai][bj][2][0]), "v"(acc[ai][bj][2][1]), "v"(acc[ai][bj][3][0]), "v"(acc[ai][bj][3][1])); }
};
template <class Epi, class Sched, bool ALIGN_EPI = false, bool SP2 = false>
__device__ __forceinline__ void gemm_phase(PG8_LAS unsigned char* lds, const Gemm g, const Sched& S, const Epi& E, const int wid_in) {
    int tid_; asm volatile("v_mbcnt_lo_u32_b32 %0, -1, 0\n\tv_mbcnt_hi_u32_b32 %0, -1, %0" : "=v"(tid_)); int wid = wid_in; asm volatile("" : "+s"(wid)); tid_ += wid * 64; asm volatile("" : "+v"(tid_));
    const int tid = tid_, lane = tid & 63, wr = wid >> 2, wc = wid & 3, fr = lane & 15, fq = lane >> 4;
    const int K = g.K, nt = K / BK;
    unsigned voffA[2], voffB[2];
#pragma unroll
    for (int i = 0; i < 2; ++i) { int R, C; stage_rc(tid * 16 + i * 8192, R, C); const int Rb = Epi::PERM ? ((R & ~31) + perm32(R & 31)) : R;
        voffA[i] = (unsigned)(R * K + C) * 2u; voffB[i] = (unsigned)(Rb * K + C) * 2u; }
    const size_t kstep = (size_t)(BK * 2);
    const size_t hstep = (size_t)HALF * K * 2;
    const size_t tstep = 2 * hstep;
    const unsigned ldsw = (unsigned)wid * 1024u;
    const int aoff = lds_byte(wr * 64 + fr, fq * 8), boff = lds_byte(wc * 32 + fr, fq * 8);
#define PG8_SA(b, h) (((b) * 2 + (h)) * HTB)
#define PG8_SB(b, h) ((4 + (b) * 2 + (h)) * HTB)
#define PG8_STAGE(bufoff, gbase, voff) do { _Pragma("unroll") for (int _i = 0; _i < 2; ++_i) \
        __builtin_amdgcn_global_load_lds((const unsigned*)((const char*)(gbase) + (voff)[_i]), (PG8_LAS unsigned*)(lds + (bufoff) + ldsw + _i * 8192), 16, 0, 0); } while (0)
#define PG8_LDA(dst, b, h) do { _Pragma("unroll") for (int m = 0; m < 4; ++m) _Pragma("unroll") for (int k = 0; k < 2; ++k) dst[m][k] = *(const PG8_LAS bf16x8*)(lds + PG8_SA(b, h) + aoff + m * 2048 + k * 1024); } while (0)
#define PG8_LDB(dst, b, h) do { _Pragma("unroll") for (int n = 0; n < 2; ++n) _Pragma("unroll") for (int k = 0; k < 2; ++k) dst[n][k] = *(const PG8_LAS bf16x8*)(lds + PG8_SB(b, h) + boff + n * 2048 + k * 1024); } while (0)
#define PG8_MMA(ai, bj, At, Bt) do { __builtin_amdgcn_s_setprio(1); _Pragma("unroll") for (int m = 0; m < 4; ++m) _Pragma("unroll") for (int n = 0; n < 2; ++n) _Pragma("unroll") for (int k = 0; k < 2; ++k) \
        acc[ai][bj][m][n] = __builtin_amdgcn_mfma_f32_16x16x32_bf16(Bt[n][k], At[m][k], acc[ai][bj][m][n], 0, 0, 0); __builtin_amdgcn_s_setprio(0); } while (0)
#define PG8_WAIT_V(n) asm volatile("s_waitcnt vmcnt(" #n ")" ::: "memory")
#define PG8_WAIT_L(n) asm volatile("s_waitcnt lgkmcnt(" #n ")" ::: "memory")
#define PG8_BAR __builtin_amdgcn_s_barrier()
#define PG8_SCHED __builtin_amdgcn_sched_barrier(0)
    Unit cur, nxt; int ui = 0;
    if (!S.next(0, cur)) return;
    f32x4 acc[2][2][4][2];
#pragma unroll
    for (int a = 0; a < 2; ++a)
#pragma unroll
        for (int b = 0; b < 2; ++b)
#pragma unroll
            for (int m = 0; m < 4; ++m)
#pragma unroll
                for (int n = 0; n < 2; ++n) acc[a][b][m][n] = (f32x4){0.f, 0.f, 0.f, 0.f};
    bf16x8 At[4][2], B0[2][2], B1[2][2];
    const char* cA = (const char*)g.A + (size_t)cur.pm * tstep; const char* cB = (const char*)g.Bt + (size_t)cur.pn * tstep;
    S.a_ready(cur);
    if constexpr (SP2) {
        PG8_STAGE(PG8_SB(0, 0), cB, voffB); PG8_STAGE(PG8_SB(0, 1), cB + hstep, voffB); PG8_STAGE(PG8_SA(0, 0), cA, voffA); PG8_STAGE(PG8_SA(0, 1), cA + hstep, voffA);
        if constexpr (Epi::PRE_STATS) {
            const int prow = tid >> 1, phalf = tid & 1;
#pragma unroll 1
            for (int i0 = 0; ; i0 += 3) { Unit uu[3]; bool hv[3];
#pragma unroll
                for (int q = 0; q < 3; ++q) { hv[q] = S.next(i0 + q, uu[q]); if (!hv[q]) uu[q] = cur; }
                if (!hv[0]) break;
                f32x4 pv[3][4];
#pragma unroll
                for (int q = 0; q < 3; ++q) { const float* sp = E.stats + ((size_t)(uu[q].pm * BM + prow) * 32 + phalf * 16);
#pragma unroll
                    for (int x = 0; x < 4; ++x) pv[q][x] = *(const f32x4*)(sp + 4 * x); }
#pragma unroll
                for (int q = 0; q < 3; ++q) { const f32x4 t4 = (pv[q][0] + pv[q][1]) + (pv[q][2] + pv[q][3]); float sq = (t4[0] + t4[1]) + (t4[2] + t4[3]);
                    sq += __int_as_float(__builtin_amdgcn_mov_dpp(__float_as_int(sq), 0xB1, 0xF, 0xF, true));
                    if (hv[q]) *(PG8_LAS float*)(lds + STAGE_BYTES + ((i0 + q) * 256 + prow) * 4) = __builtin_amdgcn_rsqf(sq * (1.0f / 2048.0f) + 1e-6f); }
                if (!hv[2]) break; }
        }
        if (wr == 1) PG8_BAR;
        PG8_WAIT_V(2); PG8_BAR;
        PG8_STAGE(PG8_SB(1, 0), cB + kstep, voffB); PG8_STAGE(PG8_SA(1, 0), cA + kstep, voffA); PG8_STAGE(PG8_SB(1, 1), cB + hstep + kstep, voffB);
        PG8_WAIT_V(6); PG8_BAR;
    } else {
        PG8_STAGE(PG8_SB(0, 0), cB, voffB); PG8_STAGE(PG8_SA(0, 0), cA, voffA); PG8_STAGE(PG8_SB(0, 1), cB + hstep, voffB); PG8_STAGE(PG8_SA(0, 1), cA + hstep, voffA);
        if (wr == 1) PG8_BAR;
        PG8_WAIT_V(4); PG8_BAR;
        PG8_STAGE(PG8_SB(1, 0), cB + kstep, voffB); PG8_STAGE(PG8_SA(1, 0), cA + kstep, voffA); PG8_STAGE(PG8_SB(1, 1), cB + hstep + kstep, voffB);
        PG8_WAIT_V(6); PG8_BAR;
    }
    for (;;) {
        const bool has_next = S.next(ui + 1, nxt);
        const char* nA = has_next ? (const char*)g.A + (size_t)nxt.pm * tstep : cA; const char* nB = has_next ? (const char*)g.Bt + (size_t)nxt.pn * tstep : cB;
        for (int t = 0; t < nt; t += 2) {
            const bool last = (t == nt - 2);
            const char* a1 = cA + (size_t)(t + 1) * kstep;
            const char* a2 = last ? nA : cA + (size_t)(t + 2) * kstep; const char* b2 = last ? nB : cB + (size_t)(t + 2) * kstep;
            const char* a3 = a2 + kstep; const char* b3 = b2 + kstep;
            if (last && has_next) S.a_ready(nxt);
            if constexpr (SP2) {
            PG8_LDB(B0, 0, 0); PG8_LDB(B1, 0, 1); PG8_SCHED; PG8_LDA(At, 0, 0); PG8_STAGE(PG8_SA(1, 1), a1 + hstep, voffA);
            PG8_WAIT_V(8); PG8_WAIT_L(0); PG8_BAR; PG8_MMA(0, 0, At, B0); PG8_MMA(0, 1, At, B1); PG8_BAR; PG8_SCHED;
            PG8_LDA(At, 0, 1); PG8_STAGE(PG8_SB(0, 0), b2, voffB); PG8_STAGE(PG8_SB(0, 1), b2 + hstep, voffB); PG8_STAGE(PG8_SA(0, 0), a2, voffA);
            PG8_WAIT_V(8); PG8_WAIT_L(0); PG8_BAR; PG8_MMA(1, 0, At, B0); PG8_MMA(1, 1, At, B1); PG8_BAR; PG8_SCHED;
            PG8_LDB(B0, 1, 0); PG8_LDB(B1, 1, 1); PG8_SCHED; PG8_LDA(At, 1, 0); PG8_STAGE(PG8_SA(0, 1), a2 + hstep, voffA);
            PG8_WAIT_V(8); PG8_WAIT_L(0); PG8_BAR; PG8_MMA(0, 0, At, B0); PG8_MMA(0, 1, At, B1); PG8_BAR; PG8_SCHED;
            PG8_LDA(At, 1, 1); PG8_STAGE(PG8_SB(1, 0), b3, voffB); PG8_STAGE(PG8_SB(1, 1), b3 + hstep, voffB); PG8_STAGE(PG8_SA(1, 0), a3, voffA);
            PG8_WAIT_V(8); PG8_WAIT_L(0); PG8_BAR; PG8_MMA(1, 0, At, B0); PG8_MMA(1, 1, At, B1); PG8_BAR; PG8_SCHED;
            } else {
            PG8_LDB(B0, 0, 0); PG8_SCHED; PG8_LDA(At, 0, 0); PG8_STAGE(PG8_SA(1, 1), a1 + hstep, voffA);
            PG8_WAIT_L(8); PG8_BAR; PG8_WAIT_L(0); PG8_MMA(0, 0, At, B0); PG8_BAR; PG8_SCHED;
            PG8_LDB(B1, 0, 1); PG8_STAGE(PG8_SB(0, 0), b2, voffB);
            PG8_BAR; PG8_WAIT_L(0); PG8_MMA(0, 1, At, B1); PG8_BAR;
            PG8_LDA(At, 0, 1); PG8_STAGE(PG8_SA(0, 0), a2, voffA);
            PG8_BAR; PG8_WAIT_L(0); PG8_MMA(1, 0, At, B0); PG8_BAR; PG8_SCHED;
            PG8_STAGE(PG8_SB(0, 1), b2 + hstep, voffB);
            PG8_WAIT_V(6); PG8_BAR; PG8_MMA(1, 1, At, B1); PG8_BAR;
            PG8_LDB(B0, 1, 0); PG8_SCHED; PG8_LDA(At, 1, 0); PG8_STAGE(PG8_SA(0, 1), a2 + hstep, voffA);
            PG8_WAIT_L(8); PG8_BAR; PG8_WAIT_L(0); PG8_MMA(0, 0, At, B0); PG8_BAR; PG8_SCHED;
            PG8_LDB(B1, 1, 1); PG8_STAGE(PG8_SB(1, 0), b3, voffB);
            PG8_BAR; PG8_WAIT_L(0); PG8_MMA(0, 1, At, B1); PG8_BAR;
            PG8_LDA(At, 1, 1); PG8_STAGE(PG8_SA(1, 0), a3, voffA);
            PG8_BAR; PG8_WAIT_L(0); PG8_MMA(1, 0, At, B0); PG8_BAR; PG8_SCHED;
            PG8_STAGE(PG8_SB(1, 1), b3 + hstep, voffB);
            PG8_WAIT_V(6); PG8_BAR; PG8_MMA(1, 1, At, B1); PG8_BAR;
            }
        }
        if constexpr (ALIGN_EPI) { if (wr == 0) PG8_BAR; }
        if constexpr (Epi::PRE_STATS) { float rs[2][4];
#pragma unroll
            for (int ai = 0; ai < 2; ++ai)
#pragma unroll
                for (int m = 0; m < 4; ++m) rs[ai][m] = *(const PG8_LAS float*)(lds + STAGE_BYTES + (ui * 256 + ai * HALF + wr * 64 + m * 16 + fr) * 4);
            E(acc, cur, wr, wc, fr, fq, rs); S.done(cur); }
        else if constexpr (!Epi::AFTER_DRAIN) { E(acc, cur, wr, wc, fr, fq); S.done(cur); }
        if (!has_next) break;
#pragma unroll
        for (int a = 0; a < 2; ++a)
#pragma unroll
            for (int b = 0; b < 2; ++b)
#pragma unroll
                for (int m = 0; m < 4; ++m)
#pragma unroll
                    for (int n = 0; n < 2; ++n) acc[a][b][m][n] = (f32x4){0.f, 0.f, 0.f, 0.f};
        cur = nxt; cA = nA; cB = nB; ++ui;
        if constexpr (ALIGN_EPI) { if (wr == 1) PG8_BAR; }
    }
    PG8_WAIT_V(0);
    if constexpr (!ALIGN_EPI) { if (wr == 0) PG8_BAR; }
    PG8_BAR;
    if constexpr (Epi::AFTER_DRAIN) { E.fused(acc, cur, wr, wc, fr, fq, lds, wid, lane); S.done(cur); }
#undef PG8_SA
#undef PG8_SB
#undef PG8_STAGE
#undef PG8_LDA
#undef PG8_LDB
#undef PG8_MMA
#undef PG8_WAIT_V
#undef PG8_WAIT_L
#undef PG8_BAR
#undef PG8_SCHED
}
}

#ifndef LRU_STREAM
#define LRU_STREAM 1
#endif
constexpr int NWAVES = 8, NTHR = 512;
constexpr int BATCH = 2, SEQ = 4096, DM = 2048, M = BATCH * SEQ, DEPTH = 4;
constexpr int EVEN_IN = 10320, EVEN_INP = 10496, PROJ_LD = 9216, ODD_IN = 6144, IDX_LD = 1280;
constexpr int COL_GA = 2048, COL_Q = 4096, COL_K = 6144, COL_V = 6656, COL_GB = 7168;
constexpr int TOPK = 256;
#ifndef N_LAUNCHES
#define N_LAUNCHES 1
#endif
constexpr int NPHASE = 1 + 2 * 6 + 2 * 4;
#ifndef PROBE_REP
#define PROBE_REP 0
#endif
#define NREP(n) ((PROBE_REP == (n)) ? 3 : 1)

constexpr size_t MiB = 1u << 20;
constexpr size_t WS_CTL = 0, CTL_ZERO_BYTES = 32768;
constexpr size_t WS_STATA = 1 * MiB, WS_STATB = 2 * MiB, WS_STATLN = 3 * MiB, WS_LRUSUM = 5 * MiB, WS_BM = 6 * MiB, WS_KN = 10 * MiB, WS_PBF = 18 * MiB;
constexpr size_t WS_WSMALL = 34 * MiB, WS_WPE = 38 * MiB, WS_WGATE = 42 * MiB, WS_WEIN = 74 * MiB, WS_WEOUT = 156 * MiB, WS_WOIN = 188 * MiB, WS_WOOUT = 236 * MiB;
constexpr size_t WS_H = 252 * MiB, WS_AN = 316 * MiB, WS_PROJ = 348 * MiB, WS_YCAT = 492 * MiB, WS_IDX = WS_YCAT, WS_IDXB = WS_YCAT + 40 * MiB, WS_SC = 556 * MiB, WS_E = WS_SC, WS_END = 622 * MiB;
constexpr size_t SCB = (size_t)4096 * 64 * 65 / 2;
static_assert(WS_IDXB + (size_t)M * IDX_LD * 2 <= WS_SC && WS_SC + 2 * SCB * 4 <= WS_END && WS_IDX + (size_t)M * IDX_LD * 4 <= WS_SC && WS_PROJ + (size_t)M * PROJ_LD * 2 <= WS_YCAT, "ws map");
constexpr int CW_BAR = 4096;
static_assert((CW_BAR + 3456) * 4 <= (int)CTL_ZERO_BYTES, "control words inside the memset");

constexpr int RING_BYTES = 131072, LDS_BYTES = 147456, MISC_OFF = LDS_BYTES - 256, XTRA_OFF = RING_BYTES;

#define GAS __attribute__((address_space(1)))
#define LAS __attribute__((address_space(3)))
typedef unsigned short bf16;
typedef unsigned v4u __attribute__((ext_vector_type(4)));
typedef unsigned v2u __attribute__((ext_vector_type(2)));
typedef float f32x4 __attribute__((ext_vector_type(4)));
typedef GAS unsigned gu32;
#define RLX_AGENT __ATOMIC_RELAXED, __HIP_MEMORY_SCOPE_AGENT
#define LDS_WAIT() asm volatile("s_waitcnt lgkmcnt(0)" ::: "memory")
__device__ __forceinline__ unsigned f2bf(float f) { unsigned u = __builtin_bit_cast(unsigned, f); return (u + 0x7fffu + ((u >> 16) & 1u)) >> 16; }
__device__ __forceinline__ unsigned pk2(float lo, float hi) { return f2bf(lo) | (f2bf(hi) << 16); }
__device__ __forceinline__ float bflo(unsigned w) { return __uint_as_float(w << 16); }
__device__ __forceinline__ float bfhi(unsigned w) { return __uint_as_float(w & 0xffff0000u); }
__device__ __forceinline__ float bf2f(bf16 v) { return __uint_as_float(((unsigned)v) << 16); }
__device__ __forceinline__ float shx(float v, int o, int lane) { return __int_as_float(__builtin_amdgcn_ds_bpermute((lane ^ o) << 2, __float_as_int(v))); }
__device__ __forceinline__ int shx_i(int v, int o, int lane) { return __builtin_amdgcn_ds_bpermute((lane ^ o) << 2, v); }
__device__ __forceinline__ int wave_sum_i(int v, int lane) {
    v += __builtin_amdgcn_update_dpp(0, v, 0x111, 0xF, 0xF, true); v += __builtin_amdgcn_update_dpp(0, v, 0x112, 0xF, 0xF, true);
    v += __builtin_amdgcn_update_dpp(0, v, 0x114, 0xF, 0xF, true); v += __builtin_amdgcn_update_dpp(0, v, 0x118, 0xF, 0xF, true);
    v += __builtin_amdgcn_update_dpp(0, v, 0x142, 0xA, 0xF, true); v += __builtin_amdgcn_update_dpp(0, v, 0x143, 0xC, 0xF, true);
    return __builtin_amdgcn_readlane(v, 63);
}
__device__ __forceinline__ float wave_sum(float v, int lane) {
    v += __int_as_float(__builtin_amdgcn_update_dpp(0, __float_as_int(v), 0x111, 0xF, 0xF, true)); v += __int_as_float(__builtin_amdgcn_update_dpp(0, __float_as_int(v), 0x112, 0xF, 0xF, true));
    v += __int_as_float(__builtin_amdgcn_update_dpp(0, __float_as_int(v), 0x114, 0xF, 0xF, true)); v += __int_as_float(__builtin_amdgcn_update_dpp(0, __float_as_int(v), 0x118, 0xF, 0xF, true));
    v += __int_as_float(__builtin_amdgcn_update_dpp(0, __float_as_int(v), 0x142, 0xA, 0xF, true)); v += __int_as_float(__builtin_amdgcn_update_dpp(0, __float_as_int(v), 0x143, 0xC, 0xF, true));
    return __int_as_float(__builtin_amdgcn_readlane(__float_as_int(v), 63));
}
__device__ __forceinline__ int lane_id() { int l; asm volatile("v_mbcnt_lo_u32_b32 %0, -1, 0\n\tv_mbcnt_hi_u32_b32 %0, -1, %0" : "=v"(l)); return l; }
__device__ __forceinline__ int make_tid(int wave) { asm volatile("" : "+s"(wave)); int t = wave * 64 + lane_id(); asm volatile("" : "+v"(t)); return t; }
__device__ __forceinline__ float fexp(float x) { return __builtin_amdgcn_exp2f(x * 1.4426950408889634f); }
__device__ __forceinline__ float frcp(float x) { return __builtin_amdgcn_rcpf(x); }
__device__ __forceinline__ float frsq(float x) { return __builtin_amdgcn_rsqf(x); }
__device__ __forceinline__ float sigmoid_acc(float x) { return frcp(1.0f + fexp(-x)); }

#define XB_TMO      128
#define XB_XCNT(j)  (256  + 64 * (j))
#define XB_XSUB(j)  (1280 + 64 * (j))
#define XB_XGEN(j)  (2304 + 64 * (j))
#define XB_TOP      3328
#define XB_TOPGEN   3392
#define XCD_BAR_WORDS 3456
#define XB_SPIN_CAP (1u << 18)

__device__ __forceinline__ unsigned xb_ld(unsigned* p)              { return __hip_atomic_load(p, __ATOMIC_RELAXED, __HIP_MEMORY_SCOPE_AGENT); }
__device__ __forceinline__ unsigned xb_add(unsigned* p, unsigned v) { return __hip_atomic_fetch_add(p, v, __ATOMIC_RELAXED, __HIP_MEMORY_SCOPE_AGENT); }
__device__ __forceinline__ unsigned xb_xcc_id() { return (unsigned)__builtin_amdgcn_s_getreg((3 << 11) | 20) & 0xFu; }
#define XB_SPIN(cond, bar) do { unsigned _sp = 0; while (cond) { __builtin_amdgcn_s_sleep(1); \
    if ((++_sp & 255u) == 0u) { if (xb_ld(&(bar)[XB_TMO])) break; if (_sp > XB_SPIN_CAP) { atomicAdd(&(bar)[XB_TMO], 1u); break; } } } } while (0)

struct XcdBarrier {
    unsigned* bar; unsigned x;
    volatile LAS unsigned* st;
};

__device__ __forceinline__ XcdBarrier xcd_barrier_post(unsigned* bar, volatile LAS unsigned* st) {
    XcdBarrier b; b.bar = bar; b.x = xb_xcc_id(); b.st = st;
    if (threadIdx.x == 0) (void)xb_add(&bar[XB_XCNT(b.x)], 1u);
    return b;
}
__device__ __forceinline__ void xcd_barrier_complete(unsigned* bar, unsigned x, unsigned& nloc, unsigned& nx) {
    const unsigned G = gridDim.x * gridDim.y * gridDim.z;
    unsigned sum, cnt, mine, sp = 0u;
    for (;;) {
        sum = 0u; cnt = 0u; mine = 0u;
#pragma unroll
        for (unsigned j = 0; j < 16; ++j) { const unsigned c = xb_ld(&bar[XB_XCNT(j)]); sum += c; cnt += (c > 0u) ? 1u : 0u; mine = (j == x) ? c : mine; }
        if (sum == G) break;
        __builtin_amdgcn_s_sleep(1);
        if ((++sp & 255u) == 0u) { if (xb_ld(&bar[XB_TMO])) break; if (sp > XB_SPIN_CAP) { atomicAdd(&bar[XB_TMO], 1u); break; } }
    }
    nloc = mine > 0u ? mine : 1u; nx = cnt > 0u ? cnt : 1u;
}

__device__ __forceinline__ void xcd_barrier(const XcdBarrier& b, const bool thread0) {
    asm volatile("s_waitcnt vmcnt(0)" ::: "memory");
    __syncthreads();
    if (thread0) {
        unsigned* bar = b.bar;
        __builtin_amdgcn_s_waitcnt(0);
        unsigned nloc = b.st[0], nx = b.st[1];
        if (nloc == 0u) { xcd_barrier_complete(bar, b.x, nloc, nx); b.st[0] = nloc; b.st[1] = nx; }
        const unsigned old = xb_add(&bar[XB_XSUB(b.x)], 1u);
        const unsigned gen = old / nloc;
        if (old + 1u == (gen + 1u) * nloc) {
            __builtin_amdgcn_fence(__ATOMIC_RELEASE, "agent");
            asm volatile("s_waitcnt vmcnt(0)" ::: "memory");
            const unsigned og = xb_add(&bar[XB_TOP], 1u);
            const unsigned tg = og / nx;
            if (og + 1u == (tg + 1u) * nx) xb_add(&bar[XB_TOPGEN], 1u);
            else XB_SPIN(xb_ld(&bar[XB_TOPGEN]) == tg, bar);
            __builtin_amdgcn_fence(__ATOMIC_ACQUIRE, "agent");
            xb_add(&bar[XB_XGEN(b.x)], 1u);
            asm volatile("s_waitcnt vmcnt(0)" ::: "memory");
        } else {
            XB_SPIN(xb_ld(&bar[XB_XGEN(b.x)]) == gen, bar);
            __builtin_amdgcn_fence(__ATOMIC_ACQUIRE, "agent");
            asm volatile("s_waitcnt vmcnt(0)" ::: "memory");
        }
    }
    __syncthreads();
}


typedef const char __attribute__((address_space(4)))* kargp_t;
#define KARGS_OPEN() int koff_ = 0; asm volatile("" : "+s"(koff_)); const kargp_t kp = (kargp_t)__builtin_amdgcn_kernarg_segment_ptr() + koff_
#define KIN(i) ((const float*)(const __attribute__((address_space(1))) float*)(*(const float* const __attribute__((address_space(4)))*)(kp + 8 * (i))))
#define KOUT ((float*)(__attribute__((address_space(1))) float*)(*(float* const __attribute__((address_space(4)))*)(kp + 192)))
#define KWS ((unsigned char*)(__attribute__((address_space(1))) unsigned char*)(*(unsigned char* const __attribute__((address_space(4)))*)(kp + 200)))
#define KTHR(k) (*(const int __attribute__((address_space(4)))*)(kp + 216 + 4 * (k)))
struct Args { const float* in[24]; float* out; unsigned char* ws; int ph_lo, ph_hi; int thr[8]; };

__device__ __forceinline__ void p0_transpose_item(const float* W, int K, int N, bf16* WT, float* scr, int item, int lane, const float* gk = nullptr) {
    const int nblk = (N + 63) / 64, kb = item / nblk, nb = item % nblk, k0 = 64 * kb, n0 = 64 * nb;
    const int nc = n0 + lane; const float* src = W + (size_t)k0 * N + (nc < N ? nc : 0);
    float v[64];
#pragma unroll
    for (int i = 0; i < 64; ++i) v[i] = __builtin_nontemporal_load(src + (size_t)i * N);
#pragma unroll
    for (int i = 0; i < 64; ++i) scr[i * 65 + lane] = (nc < N) ? v[i] : 0.f;
    LDS_WAIT(); asm volatile("" ::: "memory");
    const int c = lane & 7;
    f32x4 ga = (f32x4){1.f, 1.f, 1.f, 1.f}, gb = ga; if (gk) { ga = *(const f32x4*)(gk + k0 + 8 * c); gb = *(const f32x4*)(gk + k0 + 8 * c + 4); }
#pragma unroll
    for (int jn = 0; jn < 8; ++jn) { const int n = (lane >> 3) + 8 * jn; const float* s = scr + (8 * c) * 65 + n;
        v4u o; o.x = pk2(s[0 * 65] * ga[0], s[1 * 65] * ga[1]); o.y = pk2(s[2 * 65] * ga[2], s[3 * 65] * ga[3]); o.z = pk2(s[4 * 65] * gb[0], s[5 * 65] * gb[1]); o.w = pk2(s[6 * 65] * gb[2], s[7 * 65] * gb[3]);
        if (n0 + n < N) *(v4u*)(WT + (size_t)(n0 + n) * K + k0 + 8 * c) = o; }
    LDS_WAIT(); asm volatile("" ::: "memory");
}

__device__ __forceinline__ size_t sc_off(int b, int t) { const int c = t >> 6; return (size_t)b * SCB + (size_t)2048 * c * (c + 1) + (size_t)(t & 63) * 64 * (c + 1); }

__device__ __forceinline__ void lru_tile(const kargp_t kp, int j, int b, int tile, int g, bool final_pass, unsigned char* lds, int wave, bool check = false) {
    const int tid = make_tid(wave);
    float* XC = (float*)lds; float* AA = (float*)(lds + 65536); float* QS = (float*)(lds + XTRA_OFF);
    const bf16* PROJ = (const bf16*)(KWS + WS_PROJ); float* LRUSUM = (float*)(KWS + WS_LRUSUM); bf16* YCAT = (bf16*)(KWS + WS_YCAT);
    const float* conv_w = KIN(5) + (size_t)j * 4 * 2048; const float* conv_b = KIN(6) + (size_t)j * 2048;
    const float* w_r = KIN(7) + ((size_t)j * 16 + g) * 16384; const float* b_r = KIN(8) + ((size_t)j * 16 + g) * 128;
    const float* w_i = KIN(9) + ((size_t)j * 16 + g) * 16384; const float* b_i = KIN(10) + ((size_t)j * 16 + g) * 128;
    const float* lam = KIN(11) + (size_t)j * 2048;
    const int t0 = tile * 128, c0 = g * 128; const size_t row0 = (size_t)b * SEQ + t0;
    __syncthreads();
    for (int e = tid; e < 4096; e += NTHR) { const int t = e >> 5, cq = (e & 31) * 4;
        f32x4 acc = *(const f32x4*)(conv_b + c0 + cq);
#pragma unroll
        for (int k = 0; k < 4; ++k) { const int tt = t0 + t + k - 3;
            if (tt >= 0) { const v2u xw = *(const v2u*)(PROJ + ((size_t)b * SEQ + tt) * PROJ_LD + c0 + cq); const f32x4 w = *(const f32x4*)(conv_w + (size_t)k * 2048 + c0 + cq);
                acc[0] += bflo(xw.x) * w[0]; acc[1] += bfhi(xw.x) * w[1]; acc[2] += bflo(xw.y) * w[2]; acc[3] += bfhi(xw.y) * w[3]; } }
        *(f32x4*)(XC + t * 128 + cq) = acc; }
    __syncthreads();
    const int jj = tid & 127, q = tid >> 7;
    float R[32], I[32];
#pragma unroll
    for (int tt = 0; tt < 32; ++tt) { R[tt] = 0.f; I[tt] = 0.f; }
#pragma unroll 1
    for (int i = 0; i < 128; i += 4) {
        float wr4[4], wi4[4];
#pragma unroll
        for (int ii = 0; ii < 4; ++ii) { wr4[ii] = w_r[(size_t)(i + ii) * 128 + jj]; wi4[ii] = w_i[(size_t)(i + ii) * 128 + jj]; }
#pragma unroll
        for (int tt = 0; tt < 32; ++tt) { const f32x4 x = *(const f32x4*)(XC + (32 * q + tt) * 128 + i);
#pragma unroll
            for (int ii = 0; ii < 4; ++ii) { R[tt] += x[ii] * wr4[ii]; I[tt] += x[ii] * wi4[ii]; } }
    }
    __syncthreads();
    const int c = c0 + jj;
    const float el = fexp(-lam[c]); const float sp = el * (1.0f - el * (0.5f - el * (0.33333333f - el * 0.25f))), br = b_r[jj], bi = b_i[jj];
    float h = 0.f, A = 1.f;
#pragma unroll
    for (int tt = 0; tt < 32; ++tt) { const int t = 32 * q + tt;
        const float r = sigmoid_acc(R[tt] + br), ig = sigmoid_acc(I[tt] + bi), la = -8.0f * r * sp, aa = fexp(la), mult = __builtin_amdgcn_sqrtf(fmaxf(1.0f - fexp(2.0f * la), 0.f));
        const float bx = mult * ig * XC[t * 128 + jj];
        h = aa * h + bx; A *= aa; XC[t * 128 + jj] = h; AA[t * 128 + jj] = A; }
    QS[(q * 128 + jj) * 2] = A; QS[(q * 128 + jj) * 2 + 1] = h;
    __syncthreads();
    if (!final_pass) {
        if (q == 3) { float At = 1.f, ht = 0.f;
#pragma unroll
            for (int qq = 0; qq < 4; ++qq) { const float Aq = QS[(qq * 128 + jj) * 2], hq = QS[(qq * 128 + jj) * 2 + 1]; ht = Aq * ht + hq; At *= Aq; }
            float* sp2 = LRUSUM + (((size_t)b * 32 + tile) * 2048 + c) * 2; sp2[0] = At; sp2[1] = ht; }
    } else {
        float carry = 0.f;
        for (int tl = 0; tl < tile; ++tl) { const float* sp2 = LRUSUM + (((size_t)b * 32 + tl) * 2048 + c) * 2; carry = sp2[0] * carry + sp2[1]; }
        for (int qq = 0; qq < q; ++qq) carry = QS[(qq * 128 + jj) * 2] * carry + QS[(qq * 128 + jj) * 2 + 1];
#pragma unroll 4
        for (int tt = 0; tt < 32; ++tt) { const int t = 32 * q + tt; const float hv = XC[t * 128 + jj] + AA[t * 128 + jj] * carry;
            const float ga = bf2f(PROJ[(row0 + t) * PROJ_LD + COL_GA + c]);
            bf16* yp = YCAT + (row0 + t) * 4096 + c; const float yv = hv * ga;
            if (!check) *yp = (bf16)f2bf(yv); else if (!(fabsf(bf2f(*yp) - yv) <= 1e-4f + 0.03f * fabsf(ga) + 0.03f * fabsf(yv))) atomicOr((unsigned*)(KWS + WS_CTL) + 8, 4u); }
    }
}

typedef short s_bf16x8 __attribute__((ext_vector_type(8)));
__device__ __forceinline__ void lru_raw_dma(const kargp_t kp, int it, unsigned char* lds, int wave, int lane) {
    const bf16* PROJ = (const bf16*)(KWS + WS_PROJ); const int b = it >> 9, t0 = ((it >> 4) & 31) * 128, c0 = (it & 15) * 128;
#pragma unroll 1
    for (int q = wave; q < 33; q += 8) { const int row = q * 4 + (lane >> 4), tt = t0 - 3 + row;
        __builtin_amdgcn_global_load_lds((const unsigned*)(PROJ + ((size_t)b * SEQ + (tt >= 0 ? tt : 0)) * PROJ_LD + c0 + (lane & 15) * 8), (LAS unsigned*)(lds + 98304 + q * 1024), 16, 0, 0); }
}
__device__ __forceinline__ void lru_tile_mfma(const kargp_t kp, int j, int it, int it_next, bool first, bool final_pass, bool stream, unsigned char* lds, int wave) {
    const bool gates = final_pass || stream;
    const int b = it >> 9, tile = (it >> 4) & 31, g = it & 15;
    const int tid = make_tid(wave), lane = tid & 63, fr = lane & 15, q4 = lane >> 4, wid = tid >> 6;
    float* XF = (float*)lds; unsigned char* XB = lds + 65536; const unsigned char* RAW = lds + 98304;
    const bf16* PROJ = (const bf16*)(KWS + WS_PROJ); float* LRUSUM = (float*)(KWS + WS_LRUSUM); bf16* YCAT = (bf16*)(KWS + WS_YCAT);
    const float* conv_w = KIN(5) + (size_t)j * 4 * 2048; const float* conv_b = KIN(6) + (size_t)j * 2048;
    const int t0 = tile * 128, c0 = g * 128; const size_t row0 = (size_t)b * SEQ + t0;
    if (first) { __syncthreads(); lru_raw_dma(kp, it, lds, wave, lane); }
    asm volatile("s_waitcnt vmcnt(0)" ::: "memory"); __syncthreads();
    const int jl = 16 * wid + fr, c = c0 + jl;
    const bf16* wtr = (const bf16*)(KWS + WS_WSMALL) + ((size_t)(j * 16 + g) * 128 + jl) * 128 + 8 * q4; const bf16* wti = wtr + (size_t)2 * 16 * 128 * 128;
    s_bf16x8 wr[4], wi[4];
#pragma unroll
    for (int ks = 0; ks < 4; ++ks) { wr[ks] = *(const s_bf16x8*)(wtr + ks * 32); wi[ks] = *(const s_bf16x8*)(wti + ks * 32); }
    const float el = fexp(-KIN(11)[(size_t)j * 2048 + c]); const float sp8 = -8.0f * 1.4426950408889634f * (el * (1.0f - el * (0.5f - el * (0.33333333f - el * 0.25f))));
    const float br = KIN(8)[(size_t)(j * 16 + g) * 128 + jl], bi = KIN(10)[(size_t)(j * 16 + g) * 128 + jl];
    v4u gav[4];
    if (gates) {
#pragma unroll
        for (int i = 0; i < 4; ++i) { const int e = tid + NTHR * i, t = e >> 4, ch = e & 15; gav[i] = *(const v4u*)(PROJ + (row0 + t) * PROJ_LD + COL_GA + c0 + ch * 8); } }
    {
        const int tb = tid >> 5, cq = (tid & 31) * 4; const f32x4 bias = *(const f32x4*)(conv_b + c0 + cq);
        f32x4 cw[4];
#pragma unroll
        for (int k = 0; k < 4; ++k) cw[k] = *(const f32x4*)(conv_w + (size_t)k * 2048 + c0 + cq);
        v2u xw[8][4];
#pragma unroll
        for (int i = 0; i < 8; ++i)
#pragma unroll
            for (int k = 0; k < 4; ++k) xw[i][k] = *(const v2u*)(RAW + (tb + 16 * i + k) * 256 + cq * 2);
#pragma unroll
        for (int i = 0; i < 8; ++i) { const int t = tb + 16 * i; f32x4 acc = bias;
#pragma unroll
            for (int k = 0; k < 4; ++k) { const float on = (t0 + t + k - 3) >= 0 ? 1.f : 0.f; const f32x4 w = cw[k] * on;
                acc[0] += bflo(xw[i][k].x) * w[0]; acc[1] += bfhi(xw[i][k].x) * w[1]; acc[2] += bflo(xw[i][k].y) * w[2]; acc[3] += bfhi(xw[i][k].y) * w[3]; }
            *(f32x4*)(XF + t * 128 + cq) = acc;
            *(v2u*)(XB + t * 256 + ((cq * 2) ^ ((t & 15) << 4))) = (v2u){pk2(acc[0], acc[1]), pk2(acc[2], acc[3])}; }
    }
    __syncthreads();
    if (it_next < 1024) lru_raw_dma(kp, it_next, lds, wave, lane);
    typedef float f32x2_ __attribute__((ext_vector_type(2))); f32x2_ sm[31];
    if (final_pass) {
#pragma unroll
        for (int tl = 0; tl < 31; ++tl) sm[tl] = *(const f32x2_*)(LRUSUM + (((size_t)b * 32 + tl) * 2048 + c) * 2); }
    f32x4 aR[8], aI[8];
#pragma unroll
    for (int m = 0; m < 8; ++m) { aR[m] = (f32x4){0.f, 0.f, 0.f, 0.f}; aI[m] = aR[m]; }
#pragma unroll
    for (int m = 0; m < 8; ++m)
#pragma unroll
        for (int ks = 0; ks < 4; ++ks) { const s_bf16x8 a = *(const s_bf16x8*)(XB + (16 * m + fr) * 256 + (((ks * 32 + 8 * q4) * 2) ^ (fr << 4)));
            aR[m] = __builtin_amdgcn_mfma_f32_16x16x32_bf16(a, wr[ks], aR[m], 0, 0, 0); aI[m] = __builtin_amdgcn_mfma_f32_16x16x32_bf16(a, wi[ks], aI[m], 0, 0, 0); }
    if (gates) { __syncthreads();
#pragma unroll
        for (int i = 0; i < 4; ++i) { const int e = tid + NTHR * i, t = e >> 4, ch = e & 15; *(v4u*)(XB + t * 256 + ch * 16) = gav[i]; }
        __syncthreads(); }
    float carry = 0.f, Atot = 1.f;
    if (final_pass) {
#pragma unroll
        for (int tl = 0; tl < 31; ++tl) carry = (tl < tile) ? sm[tl][0] * carry + sm[tl][1] : carry; }
    unsigned short gq[8][4];
    if (gates) {
#pragma unroll
        for (int m = 0; m < 8; ++m)
#pragma unroll
            for (int r = 0; r < 4; ++r) gq[m][r] = *(const unsigned short*)(XB + (16 * m + 4 * q4 + r) * 256 + jl * 2); }
#pragma unroll
    for (int m = 0; m < 8; ++m) {
        float hl[4], Al[4]; float h = 0.f, A = 1.f;
#pragma unroll
        for (int r = 0; r < 4; ++r) { const int t = 16 * m + 4 * q4 + r; const float x = XF[t * 128 + jl];
            const float rg = frcp(1.0f + fexp(-(aR[m][r] + br))), ig = frcp(1.0f + fexp(-(aI[m][r] + bi)));
            const float la2 = rg * sp8, aa = __builtin_amdgcn_exp2f(la2), mult = __builtin_amdgcn_sqrtf(fmaxf(1.0f - aa * aa, 0.f));
            h = aa * h + mult * ig * x; A *= aa; hl[r] = h; Al[r] = A; }
        float cin = carry, cq = carry, Ain = Atot;
        float Arow[4], hrow[4];
        {   const auto sA = __builtin_amdgcn_permlane16_swap(__float_as_uint(A), __float_as_uint(A), false, false); const auto sH = __builtin_amdgcn_permlane16_swap(__float_as_uint(h), __float_as_uint(h), false, false);
            const auto a02 = __builtin_amdgcn_permlane32_swap(sA[0], sA[0], false, false), a13 = __builtin_amdgcn_permlane32_swap(sA[1], sA[1], false, false);
            const auto h02 = __builtin_amdgcn_permlane32_swap(sH[0], sH[0], false, false), h13 = __builtin_amdgcn_permlane32_swap(sH[1], sH[1], false, false);
            Arow[0] = __uint_as_float(a02[0]); Arow[2] = __uint_as_float(a02[1]); Arow[1] = __uint_as_float(a13[0]); Arow[3] = __uint_as_float(a13[1]);
            hrow[0] = __uint_as_float(h02[0]); hrow[2] = __uint_as_float(h02[1]); hrow[1] = __uint_as_float(h13[0]); hrow[3] = __uint_as_float(h13[1]); }
#pragma unroll
        for (int qq = 0; qq < 4; ++qq) { const float Aq = Arow[qq], hq = hrow[qq];
            if (qq == q4) { cin = cq; Ain = Atot; }
            cq = Aq * cq + hq; Atot *= Aq; }
        carry = cq;
        if (final_pass) {
#pragma unroll
            for (int r = 0; r < 4; ++r) { const int t = 16 * m + 4 * q4 + r; const float hv = hl[r] + Al[r] * cin;
                bf16* gp = (bf16*)(XB + t * 256 + jl * 2); *gp = (bf16)f2bf(hv * bf2f(gq[m][r])); } }
        if (stream) {
#pragma unroll
            for (int r = 0; r < 4; ++r) { const int t = 16 * m + 4 * q4 + r; const float sg = bf2f(gq[m][r]); const float hv = hl[r] + Al[r] * cin, ac = Al[r] * Ain;
                *(bf16*)(XB + t * 256 + jl * 2) = (bf16)f2bf(hv * sg);
                *(unsigned*)(XF + t * 128 + jl) = (unsigned)f2bf(ac * sg); } }
    }
    if (gates) { __syncthreads();
        bf16* dstb = stream ? (bf16*)(KWS + WS_AN) + row0 * 2048 + c0 : YCAT + row0 * 4096 + c0; const int dld = stream ? 2048 : 4096;
#pragma unroll
        for (int i = 0; i < 4; ++i) { const int e = tid + NTHR * i, t = e >> 4, ch = e & 15; *(v4u*)(dstb + (size_t)t * dld + ch * 8) = *(const v4u*)(XB + t * 256 + ch * 16); } }
    if (stream) { bf16* WB = (bf16*)KOUT + (size_t)M * DM;
#pragma unroll
        for (int i = 0; i < 4; ++i) { const int e = tid + NTHR * i, t = e >> 4, ch = e & 15; const v4u a = *(const v4u*)(XF + t * 128 + ch * 8), b2 = *(const v4u*)(XF + t * 128 + ch * 8 + 4);
            *(v4u*)(WB + (row0 + t) * 2048 + c0 + ch * 8) = (v4u){(a.x & 0xffffu) | (a.y << 16), (a.z & 0xffffu) | (a.w << 16), (b2.x & 0xffffu) | (b2.y << 16), (b2.z & 0xffffu) | (b2.w << 16)}; } }
    if (!final_pass && q4 == 0) { float* s2 = LRUSUM + (((size_t)b * 32 + tile) * 2048 + c) * 2; s2[0] = Atot; s2[1] = carry; }
}
__device__ __forceinline__ void lru_carry4(const kargp_t kp, int it0, int Gs, float* CL, int wave) {
    const int tid = make_tid(wave), k = tid >> 7, ch = tid & 127, it = it0 + k * Gs;
    if (it < 1024) { const int b = it >> 9, tile = (it >> 4) & 31, c = (it & 15) * 128 + ch; const float* LRUSUM = (const float*)(KWS + WS_LRUSUM);
        typedef float f32x2_ __attribute__((ext_vector_type(2))); f32x2_ sm[31]; float carry = 0.f;
#pragma unroll
        for (int tl = 0; tl < 31; ++tl) sm[tl] = *(const f32x2_*)(LRUSUM + (((size_t)b * 32 + tl) * 2048 + c) * 2);
#pragma unroll
        for (int tl = 0; tl < 31; ++tl) carry = (tl < tile) ? sm[tl][0] * carry + sm[tl][1] : carry;
        CL[tid] = carry; }
}
__device__ __forceinline__ void lru_apply_item(const kargp_t kp, int it, const float* CL, int wave) {
    const int b = it >> 9, tile = (it >> 4) & 31, g = it & 15; const int tid = make_tid(wave);
    bf16* YCAT = (bf16*)(KWS + WS_YCAT); const bf16* WB = (const bf16*)KOUT + (size_t)M * DM; const bf16* UB = (const bf16*)(KWS + WS_AN);
    const int t0 = tile * 128, c0 = g * 128; const size_t row0 = (size_t)b * SEQ + t0;
    v4u uw[4], ww[4];
#pragma unroll
    for (int i = 0; i < 4; ++i) { const int e = tid + NTHR * i, t = e >> 4, ch = e & 15; uw[i] = *(const v4u*)(UB + (row0 + t) * 2048 + c0 + ch * 8); ww[i] = *(const v4u*)(WB + (row0 + t) * 2048 + c0 + ch * 8); }
#pragma unroll
    for (int i = 0; i < 4; ++i) { const int e = tid + NTHR * i, t = e >> 4, ch = e & 15; const f32x4 c0v = *(const f32x4*)(CL + ch * 8), c1v = *(const f32x4*)(CL + ch * 8 + 4);
        const v4u u = uw[i], w = ww[i]; v4u o;
        o.x = pk2(bflo(u.x) + bflo(w.x) * c0v[0], bfhi(u.x) + bfhi(w.x) * c0v[1]); o.y = pk2(bflo(u.y) + bflo(w.y) * c0v[2], bfhi(u.y) + bfhi(w.y) * c0v[3]);
        o.z = pk2(bflo(u.z) + bflo(w.z) * c1v[0], bfhi(u.z) + bfhi(w.z) * c1v[1]); o.w = pk2(bflo(u.w) + bflo(w.w) * c1v[2], bfhi(u.w) + bfhi(w.w) * c1v[3]);
        *(v4u*)(YCAT + (row0 + t) * 4096 + c0 + ch * 8) = o; }
}

__device__ __forceinline__ void knorm_item(const kargp_t kp, int j, int it, int wave, int lane) {
    const bf16* PROJ = (const bf16*)(KWS + WS_PROJ); bf16* KN = (bf16*)(KWS + WS_KN); const float* kg = KIN(13) + (size_t)j * 128;
    const float g0 = kg[lane * 2], g1 = kg[lane * 2 + 1];
    unsigned w[8];
#pragma unroll
    for (int p = 0; p < 8; ++p) { const int pr = it * 64 + wave * 8 + p, row = pr >> 2, g = pr & 3; w[p] = *(const unsigned*)(PROJ + (size_t)row * PROJ_LD + COL_K + g * 128 + lane * 2); }
    asm volatile("" ::: "memory");
#pragma unroll
    for (int p = 0; p < 8; ++p) { const int pr = it * 64 + wave * 8 + p, row = pr >> 2, g = pr & 3;
        const float x0 = bflo(w[p]), x1 = bfhi(w[p]); const float ss = wave_sum(x0 * x0 + x1 * x1, lane);
        const float rstd = frsq(ss * (1.0f / 128.0f) + 1e-6f);
        *(unsigned*)(KN + (size_t)row * 512 + g * 128 + lane * 2) = pk2(x0 * rstd * g0, x1 * rstd * g1); }
}

__device__ __forceinline__ void score_item(const kargp_t kp, int b, int c, int kt, unsigned char* lds, int wave, bool check = false) {
    const int tid = make_tid(wave); const float* IDX = (const float*)(KWS + WS_IDX); float* SC = (float*)(KWS + WS_SC);
    float* IQs = (float*)lds; float* IKs = (float*)(lds + 32768);
    const int q = tid & 63, kg = tid >> 6; const size_t qrow0 = (size_t)b * SEQ + c * 64, krow0 = (size_t)b * SEQ + kt * 64;
    __syncthreads();
    for (int e = tid; e < 4096; e += NTHR) { const int k = e >> 6, d = e & 63; IKs[k * 65 + d] = IDX[(krow0 + k) * IDX_LD + 1024 + d]; }
    float acc[8];
#pragma unroll
    for (int kk = 0; kk < 8; ++kk) acc[kk] = 0.f;
#pragma unroll 1
    for (int h = 0; h < 16; ++h) {
        __syncthreads();
        for (int e = tid; e < 4096; e += NTHR) { const int qq = e >> 6, d = e & 63; IQs[qq * 65 + d] = IDX[(qrow0 + qq) * IDX_LD + h * 64 + d]; }
        __syncthreads();
        const float w = IDX[(qrow0 + q) * IDX_LD + 1088 + h];
        float qv[64];
#pragma unroll
        for (int d = 0; d < 64; ++d) qv[d] = IQs[q * 65 + d];
#pragma unroll
        for (int kk = 0; kk < 8; ++kk) { const float* kr = IKs + (kg * 8 + kk) * 65; float dot = 0.f;
#pragma unroll
            for (int d = 0; d < 64; ++d) dot += qv[d] * kr[d];
            acc[kk] += w * fmaxf(dot, 0.f); }
    }
    float* dst = SC + sc_off(b, c * 64 + q) + kt * 64 + kg * 8;
#pragma unroll
    for (int kk = 0; kk < 8; ++kk) { if (!check) dst[kk] = acc[kk]; else if (!(fabsf(dst[kk] - acc[kk]) <= 1.0f + 0.02f * fabsf(acc[kk]))) atomicOr((unsigned*)(KWS + WS_CTL) + 8, 1u); }
}

__device__ __forceinline__ void score_wave_unit(const kargp_t kp, int b, int c, int qg, int ks, int lane, unsigned char* lds, int wave) {
    const bf16* IDXB = (const bf16*)(KWS + WS_IDXB); const float* IDX = (const float*)(KWS + WS_IDX); float* SC = (float*)(KWS + WS_SC);
    const int fr = lane & 15, fq = lane >> 4; const size_t qrow = (size_t)b * SEQ + c * 64 + qg * 16 + fr;
    s_bf16x8 bq[16][2];
#pragma unroll
    for (int h = 0; h < 16; ++h)
#pragma unroll
        for (int s = 0; s < 2; ++s) bq[h][s] = *(const s_bf16x8*)(IDXB + qrow * IDX_LD + h * 64 + s * 32 + 8 * fq);
    float w[16];
#pragma unroll
    for (int h4 = 0; h4 < 4; ++h4) { const f32x4 t = *(const f32x4*)(IDX + qrow * IDX_LD + 1088 + 4 * h4); w[4 * h4] = t[0]; w[4 * h4 + 1] = t[1]; w[4 * h4 + 2] = t[2]; w[4 * h4 + 3] = t[3]; }
    float* dst = SC + sc_off(b, c * 64 + qg * 16 + fr) + fq * 4;
    const int ntile = 4 * (c + 1);
    const bf16* kbase = IDXB + ((size_t)b * SEQ + fr) * IDX_LD + 1024 + 8 * fq;
    unsigned char* ring = lds + wave * 8192;
#define SC_DMA(S, KT) do { const int kn_ = (KT) < ntile ? (KT) : ks; const bf16* src_ = kbase + (size_t)kn_ * 16 * IDX_LD; \
        __builtin_amdgcn_global_load_lds((const unsigned*)src_, (LAS unsigned*)(ring + (S) * 2048), 16, 0, 0); __builtin_amdgcn_global_load_lds((const unsigned*)(src_ + 32), (LAS unsigned*)(ring + (S) * 2048 + 1024), 16, 0, 0); } while (0)
#define SC_TILE(S, KT, NW) do { if ((KT) < ntile) { asm volatile("s_waitcnt vmcnt(" #NW ")" ::: "memory"); \
        const s_bf16x8 a0 = *(const LAS s_bf16x8*)((LAS unsigned char*)ring + (S) * 2048 + lane * 16), a1 = *(const LAS s_bf16x8*)((LAS unsigned char*)ring + (S) * 2048 + 1024 + lane * 16); \
        asm volatile("s_waitcnt lgkmcnt(0)" ::: "memory"); SC_DMA(S, (KT) + 32); f32x4 sc = {0.f, 0.f, 0.f, 0.f}; \
        _Pragma("unroll") for (int h = 0; h < 16; ++h) { f32x4 acc = {0.f, 0.f, 0.f, 0.f}; \
            acc = __builtin_amdgcn_mfma_f32_16x16x32_bf16(a0, bq[h][0], acc, 0, 0, 0); acc = __builtin_amdgcn_mfma_f32_16x16x32_bf16(a1, bq[h][1], acc, 0, 0, 0); \
            _Pragma("unroll") for (int r = 0; r < 4; ++r) { const int ri_ = __float_as_int(acc[r]); sc[r] += w[h] * __int_as_float(ri_ > 0 ? ri_ : 0); } } \
        *(f32x4*)(dst + (KT) * 16) = sc; asm volatile("" ::: "memory"); } } while (0)
    SC_DMA(0, ks); SC_DMA(1, ks + 8); SC_DMA(2, ks + 16); SC_DMA(3, ks + 24);
    asm volatile("s_waitcnt vmcnt(0)" ::: "memory");
#pragma unroll 1
    for (int kt = ks; kt < ntile; kt += 32) { SC_TILE(0, kt, 10); SC_TILE(1, kt + 8, 10); SC_TILE(2, kt + 16, 10); SC_TILE(3, kt + 24, 10); }
#undef SC_DMA
#undef SC_TILE
}

template <int NV> __device__ __forceinline__ void select_query_nv(const kargp_t kp, int qi, int lane) {
    const float* SC = (const float*)(KWS + WS_SC); unsigned* BMr = (unsigned*)(KWS + WS_BM) + (size_t)qi * 128;
    const int b = qi >> 12, t = qi & 4095, nv = (t >> 6) + 1;
    const float* row = SC + sc_off(b, t);
    unsigned key[NV];
#pragma unroll
    for (int v = 0; v < NV; ++v) { unsigned k = 0u;
        if (v < nv) { const float s = row[v * 64 + lane] + 0.0f; const unsigned u = __float_as_uint(s); k = (u & 0x80000000u) ? ~u : (u | 0x80000000u); }
        key[v] = k; }
    unsigned tau = 0u; int ctau = 64 * nv;
    bool done = false;
#ifndef SELECT_NO_PK16
    {
        typedef unsigned short us2 __attribute__((ext_vector_type(2)));
        us2 hp[NV / 2];
#pragma unroll
        for (int v = 0; v < NV / 2; ++v) { const unsigned w_ = (key[2 * v] >> 16) | (key[2 * v + 1] & 0xffff0000u); hp[v] = __builtin_bit_cast(us2, w_); }
        for (int bit = 31; bit >= 16; --bit) {
            const unsigned cand = tau | (1u << bit); const unsigned short c1 = (unsigned short)((cand >> 16) - 1u); const us2 c2 = {c1, c1}; const us2 one2 = {1, 1}; us2 acc = {0, 0};
#pragma unroll
            for (int v = 0; v < NV / 2; ++v) { unsigned d_; asm("v_pk_sub_u16 %0, %1, %2 clamp\n\tv_pk_min_u16 %0, %0, %3" : "=&v"(d_) : "v"(__builtin_bit_cast(unsigned, hp[v])), "v"(__builtin_bit_cast(unsigned, c2)), "v"(__builtin_bit_cast(unsigned, one2)));
                acc += __builtin_bit_cast(us2, d_); }
            int cnt = (int)acc[0] + (int)acc[1];
            cnt = wave_sum_i(cnt, lane);
            if (cnt >= TOPK) { tau = cand; ctau = cnt; }
            if (cnt == TOPK) { done = true; break; }
        }
    }
    for (int bit = 15; bit >= 0 && !done; --bit) {
#else
    for (int bit = 31; bit >= 0; --bit) {
#endif
        const unsigned cand = tau | (1u << bit); int cnt = 0;
#pragma unroll
        for (int v = 0; v < NV; ++v) cnt += (key[v] >= cand) ? 1 : 0;
        cnt = wave_sum_i(cnt, lane);
        if (cnt >= TOPK) { tau = cand; ctau = cnt; }
        if (cnt == TOPK) break;
    }
    unsigned mylo = 0u, myhi = 0u;
    if (ctau == TOPK) {
#pragma unroll
        for (int v = 0; v < NV; ++v) {
            const unsigned long long sm = __ballot(key[v] >= tau);
            { const unsigned slo = (unsigned)sm, shi = (unsigned)(sm >> 32); asm volatile("s_nop 1\n\tv_writelane_b32 %0, %2, %4\n\tv_writelane_b32 %1, %3, %4" : "+v"(mylo), "+v"(myhi) : "s"(slo), "s"(shi), "i"(v)); }
            __builtin_amdgcn_sched_barrier(0);
        }
    } else {
        int ngt = 0;
#pragma unroll
        for (int v = 0; v < NV; ++v) ngt += __popcll(__ballot(key[v] > tau));
        int need = TOPK - ngt;
#pragma unroll
        for (int v = 0; v < NV; ++v) {
            const bool eq = key[v] == tau; const unsigned long long em = __ballot(eq);
            const int below = __builtin_amdgcn_mbcnt_hi((unsigned)(em >> 32), __builtin_amdgcn_mbcnt_lo((unsigned)em, 0u));
            const bool sel = (key[v] > tau) || (eq && below < need);
            need -= __popcll(em); if (need < 0) need = 0;
            const unsigned long long sm = __ballot(sel);
            { const unsigned slo = (unsigned)sm, shi = (unsigned)(sm >> 32); asm volatile("s_nop 1\n\tv_writelane_b32 %0, %2, %4\n\tv_writelane_b32 %1, %3, %4" : "+v"(mylo), "+v"(myhi) : "s"(slo), "s"(shi), "i"(v)); }
            __builtin_amdgcn_sched_barrier(0);
        }
    }
    *(v2u*)(BMr + 2 * lane) = (v2u){mylo, myhi};
}

__device__ __forceinline__ void select_query(const kargp_t kp, int qi, int lane) {
    const int nv = ((qi & 4095) >> 6) + 1;
    if (nv <= 4) { unsigned* BMr = (unsigned*)(KWS + WS_BM) + (size_t)qi * 128; const unsigned w0 = (lane < nv) ? 0xffffffffu : 0u; *(v2u*)(BMr + 2 * lane) = (v2u){w0, w0}; }
#ifndef SELECT_NV64_ONLY
    else if (nv <= 16) select_query_nv<16>(kp, qi, lane);
    else if (nv <= 32) select_query_nv<32>(kp, qi, lane);
    else if (nv <= 48) select_query_nv<48>(kp, qi, lane);
#endif
    else select_query_nv<64>(kp, qi, lane);
}

__device__ __forceinline__ float rel_bias_at(const kargp_t kp, int rel, int h) {
    const int n = rel < 0 ? -rel : rel; int bk = n;
    if (n >= 8) { bk = 8;
#pragma unroll
        for (int k = 1; k < 8; ++k) bk += (n >= KTHR(k)) ? 1 : 0; }
    bk += (rel > 0 ? 16 : 0);
    return KIN(3)[bk * 16 + h];
}

__device__ __forceinline__ void attn_query(const kargp_t kp, int j, int qi, unsigned char* lds, int wave, bool check = false) {
    const int tid = make_tid(wave), b = qi >> 12, t = qi & 4095, limit = ((t >> 6) + 1) * 64;
    const bf16* PROJ = (const bf16*)(KWS + WS_PROJ); const bf16* KN = (const bf16*)(KWS + WS_KN); const unsigned* BM = (const unsigned*)(KWS + WS_BM); bf16* YCAT = (bf16*)(KWS + WS_YCAT);
    int* sel = (int*)lds; int* wcnt = (int*)(lds + 1024); int* nselp = (int*)(lds + 1536); float* qs = (float*)(lds + 2048); float* lg = (float*)(lds + 10240);
    __syncthreads();
    unsigned wbits = 0u;
    if (tid < 128) { wbits = BM[(size_t)qi * 128 + tid]; if (tid * 32 >= limit) wbits = 0u; wcnt[tid] = __popc(wbits); }
    {
        const int h = tid >> 5, d = (tid & 31) * 4; const v2u qw = *(const v2u*)(PROJ + (size_t)qi * PROJ_LD + COL_Q + h * 128 + d);
        const float x0 = bflo(qw.x), x1 = bfhi(qw.x), x2 = bflo(qw.y), x3 = bfhi(qw.y); float ss = x0 * x0 + x1 * x1 + x2 * x2 + x3 * x3;
#pragma unroll
        for (int o = 1; o < 32; o <<= 1) ss += shx(ss, o, tid & 63);
        const float rstd = frsq(ss * (1.0f / 128.0f) + 1e-6f) * 0.08838834764831845f; const float* qg = KIN(12) + (size_t)j * 128 + d;
        qs[h * 128 + d] = x0 * rstd * qg[0]; qs[h * 128 + d + 1] = x1 * rstd * qg[1]; qs[h * 128 + d + 2] = x2 * rstd * qg[2]; qs[h * 128 + d + 3] = x3 * rstd * qg[3]; }
    __syncthreads();
    if (tid < 128) { int off = 0; for (int i = 0; i < tid; ++i) off += wcnt[i];
        unsigned w = wbits; while (w) { const int bp = __ffs(w) - 1; w &= w - 1; if (off < 256) sel[off] = tid * 32 + bp; ++off; }
        if (tid == 127) *nselp = off < 256 ? off : 256; }
    __syncthreads();
    const int n = *nselp;
    {
        const int k = tid & 255, hh = tid >> 8;
        if (k < n) { const int s = sel[k]; const bf16* krow = KN + ((size_t)b * SEQ + s) * 512;
#pragma unroll 1
            for (int gg = 0; gg < 2; ++gg) { const int g = hh * 2 + gg; float acc[4] = {0.f, 0.f, 0.f, 0.f};
#pragma unroll 1
                for (int d0 = 0; d0 < 128; d0 += 8) { const v4u kw = *(const v4u*)(krow + g * 128 + d0);
                    float kv[8] = {bflo(kw.x), bfhi(kw.x), bflo(kw.y), bfhi(kw.y), bflo(kw.z), bfhi(kw.z), bflo(kw.w), bfhi(kw.w)};
#pragma unroll
                    for (int r = 0; r < 4; ++r) { const float* qp = qs + (g * 4 + r) * 128 + d0;
#pragma unroll
                        for (int i = 0; i < 8; ++i) acc[r] += qp[i] * kv[i]; } }
#pragma unroll
                for (int r = 0; r < 4; ++r) { const int h = g * 4 + r; lg[h * 256 + k] = acc[r] + rel_bias_at(kp, s - t, h); } }
        } else {
#pragma unroll
            for (int r = 0; r < 8; ++r) lg[(hh * 8 + r) * 256 + k] = -INFINITY; }
    }
    __syncthreads();
    {
        const int h = tid >> 5, l32 = tid & 31; float v[8]; float mx = -INFINITY;
#pragma unroll
        for (int i = 0; i < 8; ++i) { v[i] = lg[h * 256 + l32 + 32 * i]; mx = fmaxf(mx, v[i]); }
#pragma unroll
        for (int o = 1; o < 32; o <<= 1) mx = fmaxf(mx, shx(mx, o, tid & 63));
        float sm = 0.f;
#pragma unroll
        for (int i = 0; i < 8; ++i) { v[i] = fexp(v[i] - mx); sm += v[i]; }
#pragma unroll
        for (int o = 1; o < 32; o <<= 1) sm += shx(sm, o, tid & 63);
        const float inv = frcp(sm);
#pragma unroll
        for (int i = 0; i < 8; ++i) lg[h * 256 + l32 + 32 * i] = v[i] * inv; }
    __syncthreads();
    {
        const int d = tid & 127, g = tid >> 7; float o[4] = {0.f, 0.f, 0.f, 0.f};
#pragma unroll 2
        for (int k = 0; k < n; ++k) { const int s = sel[k]; const float v = bf2f(PROJ[((size_t)b * SEQ + s) * PROJ_LD + COL_V + g * 128 + d]);
#pragma unroll
            for (int r = 0; r < 4; ++r) o[r] += lg[(g * 4 + r) * 256 + k] * v; }
#pragma unroll
        for (int r = 0; r < 4; ++r) { const int h = g * 4 + r; const float gbv = bf2f(PROJ[(size_t)qi * PROJ_LD + COL_GB + h * 128 + d]);
            bf16* yp = YCAT + (size_t)qi * 4096 + 2048 + h * 128 + d; const float yv = o[r] * gbv;
            if (!check) *yp = (bf16)f2bf(yv); else if (!(fabsf(bf2f(*yp) - yv) <= 1e-4f + 0.012f * fabsf(gbv) + 0.03f * fabsf(yv))) atomicOr((unsigned*)(KWS + WS_CTL) + 8, 2u); } }
}

__device__ __forceinline__ void sgu_item(const kargp_t kp, int j, int b, int ch, int g, unsigned char* lds, int wave) {
    const int tid = make_tid(wave); float* V = (float*)lds; float* MU = (float*)(lds + 65536); float* RS = MU + 128;
    const bf16* PROJ = (const bf16*)(KWS + WS_PROJ); const float* SLN = (const float*)(KWS + WS_STATLN); bf16* Y = (bf16*)(KWS + WS_YCAT);
    const float* lng = KIN(16) + (size_t)j * 2048, *lnb = KIN(17) + (size_t)j * 2048; const float* ws = KIN(18) + ((size_t)j * 16 + g) * 16384; const float* bs = KIN(19) + ((size_t)j * 16 + g) * 128;
    const size_t row0 = (size_t)b * SEQ + ch * 128;
    __syncthreads();
    if (tid < 128) { const float* sp = SLN + (row0 + tid) * 64; float s1 = 0.f, s2 = 0.f;
        for (int i = 0; i < 32; ++i) { s1 += sp[2 * i]; s2 += sp[2 * i + 1]; }
        const float mean = s1 * (1.0f / 2048.0f); const float var = fmaxf(s2 * (1.0f / 2048.0f) - mean * mean, 0.f); MU[tid] = mean; RS[tid] = frsq(var + 1e-6f); }
    __syncthreads();
    for (int e = tid; e < 2048; e += NTHR) { const int s = e >> 4, dq = (e & 15) * 8; const v4u w = *(const v4u*)(PROJ + (row0 + s) * ODD_IN + 2048 + g * 128 + dq);
        const float x[8] = {bflo(w.x), bfhi(w.x), bflo(w.y), bfhi(w.y), bflo(w.z), bfhi(w.z), bflo(w.w), bfhi(w.w)}; const float mu = MU[s], rs = RS[s];
#pragma unroll
        for (int i = 0; i < 8; ++i) { const int c = g * 128 + dq + i; V[s * 128 + dq + i] = (x[i] - mu) * rs * lng[c] + lnb[c]; } }
    __syncthreads();
    const int t = tid >> 2, dseg = (tid & 3) * 32, smax = (t < 64) ? 64 : 128;
    float acc[32];
#pragma unroll
    for (int i = 0; i < 32; ++i) acc[i] = 0.f;
#pragma unroll 2
    for (int s = 0; s < smax; ++s) { const float w = ws[t * 128 + s];
#pragma unroll
        for (int i4 = 0; i4 < 8; ++i4) { const f32x4 v = *(const f32x4*)(V + s * 128 + dseg + i4 * 4);
#pragma unroll
            for (int i = 0; i < 4; ++i) acc[i4 * 4 + i] += w * v[i]; } }
    const float bias = bs[t];
#pragma unroll
    for (int i8 = 0; i8 < 4; ++i8) { const int col = g * 128 + dseg + i8 * 8; const v4u uw = *(const v4u*)(PROJ + (row0 + t) * ODD_IN + col), gw = *(const v4u*)(PROJ + (row0 + t) * ODD_IN + 4096 + col);
        const float uu[8] = {bflo(uw.x), bfhi(uw.x), bflo(uw.y), bfhi(uw.y), bflo(uw.z), bfhi(uw.z), bflo(uw.w), bfhi(uw.w)};
        const float gg[8] = {bflo(gw.x), bfhi(gw.x), bflo(gw.y), bfhi(gw.y), bflo(gw.z), bfhi(gw.z), bflo(gw.w), bfhi(gw.w)};
        float y[8];
#pragma unroll
        for (int i = 0; i < 8; ++i) y[i] = uu[i] * (acc[i8 * 8 + i] + bias) * gg[i];
        v4u o; o.x = pk2(y[0], y[1]); o.y = pk2(y[2], y[3]); o.z = pk2(y[4], y[5]); o.w = pk2(y[6], y[7]);
        *(v4u*)(Y + (row0 + t) * 2048 + col) = o; }
}

namespace att {
using bf16x8 = __attribute__((ext_vector_type(8))) short;
using s16x4  = __attribute__((ext_vector_type(4))) short;
using f32x16 = __attribute__((ext_vector_type(16))) float;
using u32x4  = __attribute__((ext_vector_type(4))) unsigned;
constexpr int D = 128, QBLK = 32, KVBLK = 64;
constexpr int LDKK = 512, LDKV = PROJ_LD;
constexpr float THRL = 11.5f;
#ifndef ATT_SDEPTH
#define ATT_SDEPTH 1
#endif
constexpr int SDEPTH = ATT_SDEPTH;
constexpr int SHM_V = KVBLK * D * 2, SHM_K = KVBLK * D * 2;
constexpr int LDS_WS = 2 * SHM_V + 2 * SHM_K, LDS_LUT = LDS_WS + 8 * 64 * 4, LUT_N = 320, LDS_Q = LDS_LUT + 4 * LUT_N * 4, LDS_MS = LDS_Q + 8 * 8192, LDS_END = LDS_MS + 2048;
#define KSWZ(row, colB) ((row) * 256 + ((colB) ^ (((row) & 7) << 4)))
#define SBAR() __builtin_amdgcn_sched_barrier(0)
__device__ __forceinline__ int crow(int r, int hi) { return (r & 3) + 8 * (r >> 2) + 4 * hi; }
__device__ __forceinline__ unsigned cvtpk(float lo, float hi) { unsigned r; asm volatile("v_cvt_pk_bf16_f32 %0, %1, %2" : "=v"(r) : "v"(lo), "v"(hi)); return r; }
__device__ __forceinline__ float psw_max(float x) { auto rr = __builtin_amdgcn_permlane32_swap(__float_as_uint(x), __float_as_uint(x), false, false); return fmaxf(__uint_as_float(rr[0]), __uint_as_float(rr[1])); }
__device__ __forceinline__ float psw_sum(float x) { auto rr = __builtin_amdgcn_permlane32_swap(__float_as_uint(x), __float_as_uint(x), false, false); return __uint_as_float(rr[0]) + __uint_as_float(rr[1]); }

__device__ __forceinline__ float max3f(float x, float y, float z) { float r; asm("v_max3_f32 %0, %1, %2, %3" : "=v"(r) : "v"(x), "v"(y), "v"(z)); return r; }
template <bool NEAR> __device__ __forceinline__ void maskbias(f32x16& p0, f32x16& p1, unsigned w0, unsigned w1, const float* lutp) {
#pragma unroll
    for (int r = 0; r < 16; ++r) { const int cb = (r & 3) + 8 * (r >> 2);
        float a = p0[r], b = p1[r];
        if (NEAR) { a += lutp[cb]; b += lutp[32 + cb]; }
        const unsigned m0 = (unsigned)(((int)(w0 << (31 - cb))) >> 31), m1 = (unsigned)(((int)(w1 << (31 - cb))) >> 31);
        p0[r] = __uint_as_float((__float_as_uint(a) & m0) | (~m0 & 0xff800000u)); p1[r] = __uint_as_float((__float_as_uint(b) & m1) | (~m1 & 0xff800000u)); }
}
template <int VAR = 0> __device__ __forceinline__ void partialSM(f32x16& p0, f32x16& p1, float& m_reg, float& alpha, float boff) {
    if (VAR == 5) { alpha = 1.f; asm volatile("" : "+v"(p0), "+v"(p1)); return; }
    float pa = max3f(p0[0], p0[1], p0[2]), pb = max3f(p1[0], p1[1], p1[2]);
#pragma unroll
    for (int r = 3; r < 15; r += 2) { pa = max3f(pa, p0[r], p0[r + 1]); pb = max3f(pb, p1[r], p1[r + 1]); }
    float pmax = max3f(pa, pb, p0[15]); pmax = max3f(pmax, p1[15], p1[15]);
    pmax = psw_max(pmax) + boff;
    float mn;
    if (__builtin_expect(__all(pmax - m_reg <= THRL), 1)) { mn = m_reg; alpha = 1.f; }
    else { mn = fmaxf(m_reg, pmax); alpha = __builtin_amdgcn_exp2f(m_reg - mn); m_reg = mn; }
    const float sub = mn - boff;
#pragma unroll
    for (int r = 0; r < 16; ++r) { p0[r] -= sub; p1[r] -= sub; }
#pragma unroll
    for (int r = 0; r < 16; ++r) p0[r] = __builtin_amdgcn_exp2f(p0[r]);
}
template <int VAR = 0> __device__ __forceinline__ void finishSM(f32x16& p0, f32x16& p1, float alpha, float& l_reg, bf16x8& pa0, bf16x8& pa1, bf16x8& pa2, bf16x8& pa3) {
    if (VAR != 5) {
#pragma unroll
    for (int r = 0; r < 16; ++r) p1[r] = __builtin_amdgcn_exp2f(p1[r]);
    float ps = 0.f;
#pragma unroll
    for (int r = 0; r < 16; ++r) ps += p0[r];
#pragma unroll
    for (int r = 0; r < 16; ++r) ps += p1[r];
    ps = psw_sum(ps);
    l_reg = l_reg * alpha + ps; } else l_reg = 1.f;
#define PK4(P, BASE, OUT) do { unsigned a0 = cvtpk(P[BASE + 0], P[BASE + 1]), a1 = cvtpk(P[BASE + 2], P[BASE + 3]);   \
    unsigned b0 = cvtpk(P[BASE + 4], P[BASE + 5]), b1 = cvtpk(P[BASE + 6], P[BASE + 7]);                              \
    auto r0 = __builtin_amdgcn_permlane32_swap(a0, b0, false, false); auto r1 = __builtin_amdgcn_permlane32_swap(a1, b1, false, false); \
    u32x4 w = {r0[0], r1[0], r0[1], r1[1]}; OUT = *reinterpret_cast<bf16x8*>(&w); } while (0)
    PK4(p0, 0, pa0); PK4(p0, 8, pa1); PK4(p1, 0, pa2); PK4(p1, 8, pa3);
#undef PK4
}
__device__ __forceinline__ void qkt(f32x16& p0, f32x16& p1, const char* Ks, const char* qs, int r32, int hi) {
    p0 = f32x16{}; p1 = f32x16{};
#pragma unroll
    for (int d0 = 0; d0 < 8; ++d0) { const int cb = (d0 * 16 + hi * 8) * 2;
        const bf16x8 b0 = *reinterpret_cast<const bf16x8*>(Ks + KSWZ(r32, cb));
        const bf16x8 b1 = *reinterpret_cast<const bf16x8*>(Ks + KSWZ(32 + r32, cb));
        const bf16x8 qf = *reinterpret_cast<const bf16x8*>(qs + d0 * 1024);
        p0 = __builtin_amdgcn_mfma_f32_32x32x16_bf16(b0, qf, p0, 0, 0, 0);
        p1 = __builtin_amdgcn_mfma_f32_32x32x16_bf16(b1, qf, p1, 0, 0, 0); }
}
#define PK4(P, BASE, OUT) do { unsigned a0 = cvtpk(P[BASE + 0], P[BASE + 1]), a1 = cvtpk(P[BASE + 2], P[BASE + 3]);   \
    unsigned b0 = cvtpk(P[BASE + 4], P[BASE + 5]), b1 = cvtpk(P[BASE + 6], P[BASE + 7]);                              \
    auto r0 = __builtin_amdgcn_permlane32_swap(a0, b0, false, false); auto r1 = __builtin_amdgcn_permlane32_swap(a1, b1, false, false); \
    u32x4 w = {r0[0], r1[0], r0[1], r1[1]}; OUT = *reinterpret_cast<bf16x8*>(&w); } while (0)
__device__ __forceinline__ void qkt_fsm(f32x16& p0, f32x16& p1, const char* Ks, const char* qs, int r32, int hi, f32x16& q0, f32x16& q1, float alpha, float& l_reg, bf16x8& pa0, bf16x8& pa1, bf16x8& pa2, bf16x8& pa3) {
    p0 = f32x16{}; p1 = f32x16{};
    bf16x8 fb0[3], fb1[3], fq[3];
#define QK_LD(S, D0) do { const int cb_ = ((D0) * 16 + hi * 8) * 2; fb0[S] = *reinterpret_cast<const bf16x8*>(Ks + KSWZ(r32, cb_)); fb1[S] = *reinterpret_cast<const bf16x8*>(Ks + KSWZ(32 + r32, cb_)); fq[S] = *reinterpret_cast<const bf16x8*>(qs + (D0) * 1024); } while (0)
    SBAR(); QK_LD(0, 0); QK_LD(1, 1);
    float ps = 0.f;
#pragma unroll
    for (int d0 = 0; d0 < 8; ++d0) {
        SBAR();
        if (d0 + 2 < 8) QK_LD((d0 + 2) % 3, d0 + 2);
        p0 = __builtin_amdgcn_mfma_f32_32x32x16_bf16(fb0[d0 % 3], fq[d0 % 3], p0, 0, 0, 0);
        p1 = __builtin_amdgcn_mfma_f32_32x32x16_bf16(fb1[d0 % 3], fq[d0 % 3], p1, 0, 0, 0);
        q1[2 * d0] = __builtin_amdgcn_exp2f(q1[2 * d0]); q1[2 * d0 + 1] = __builtin_amdgcn_exp2f(q1[2 * d0 + 1]);
        ps += (q0[2 * d0] + q0[2 * d0 + 1]) + (q1[2 * d0] + q1[2 * d0 + 1]);
        if (d0 == 1) PK4(q0, 0, pa0);
        if (d0 == 3) PK4(q0, 8, pa1);
        if (d0 == 5) PK4(q1, 0, pa2);
    }
    SBAR();
    PK4(q1, 8, pa3);
    ps = psw_sum(ps); l_reg = l_reg * alpha + ps;
#undef QK_LD
}
#undef PK4
__device__ __forceinline__ int v_st(int k, int c) { const int kk = (k & ~0xC) | ((k & 4) << 1) | ((k & 8) >> 1); return ((kk >> 3) * 4 + (c >> 5)) * 512 + ((kk & 7) * 32 + (c & 31)) * 2; }
__device__ __forceinline__ int v_rd_base(int lane) { return ((lane & 3) << 3) | (((lane >> 2) & 3) << 6) | (((lane >> 4) & 1) << 5) | (((lane >> 5) & 1) << 8); }
constexpr int v_rd_off(int d0, int ks, int half) { return d0 * 512 + ks * 4096 + half * 2048; }
template <int OFF> __device__ __forceinline__ s16x4 tr_read(int vb) { s16x4 r; asm volatile("ds_read_b64_tr_b16 %0, %1 offset:%2" : "=&v"(r) : "v"(vb), "i"(OFF) : "memory"); return r; }
#define PV_PK(L, H) (bf16x8){L[0], L[1], L[2], L[3], H[0], H[1], H[2], H[3]}
#define PV_READ(S, D0) do { S[0] = tr_read<v_rd_off(D0, 0, 0)>(vb); S[1] = tr_read<v_rd_off(D0, 0, 1)>(vb); S[2] = tr_read<v_rd_off(D0, 1, 0)>(vb); S[3] = tr_read<v_rd_off(D0, 1, 1)>(vb); \
    S[4] = tr_read<v_rd_off(D0, 2, 0)>(vb); S[5] = tr_read<v_rd_off(D0, 2, 1)>(vb); S[6] = tr_read<v_rd_off(D0, 3, 0)>(vb); S[7] = tr_read<v_rd_off(D0, 3, 1)>(vb); } while (0)
#define PV_MMA(S, OD) do { OD = __builtin_amdgcn_mfma_f32_32x32x16_bf16(pa0, PV_PK(S[0], S[1]), OD, 0, 0, 0); OD = __builtin_amdgcn_mfma_f32_32x32x16_bf16(pa1, PV_PK(S[2], S[3]), OD, 0, 0, 0); \
    OD = __builtin_amdgcn_mfma_f32_32x32x16_bf16(pa2, PV_PK(S[4], S[5]), OD, 0, 0, 0); OD = __builtin_amdgcn_mfma_f32_32x32x16_bf16(pa3, PV_PK(S[6], S[7]), OD, 0, 0, 0); } while (0)
template <int VAR = 0> __device__ __forceinline__ void pv_d0(f32x16* o, int vb, bf16x8 pa0, bf16x8 pa1, bf16x8 pa2, bf16x8 pa3) {
    if (VAR == 2) { asm volatile("" :: "v"(pa0), "v"(pa1), "v"(pa2), "v"(pa3)); return; }
    s16x4 sa[8], sb[8];
    SBAR(); asm volatile("s_waitcnt lgkmcnt(0)" ::: "memory");
    PV_READ(sa, 0); PV_READ(sb, 1);
    asm volatile("s_waitcnt lgkmcnt(8)" ::: "memory"); SBAR(); PV_MMA(sa, o[0]); SBAR();
    PV_READ(sa, 2);
    asm volatile("s_waitcnt lgkmcnt(8)" ::: "memory"); SBAR(); PV_MMA(sb, o[1]); SBAR();
    PV_READ(sb, 3);
    asm volatile("s_waitcnt lgkmcnt(8)" ::: "memory"); SBAR(); PV_MMA(sa, o[2]); SBAR();
    asm volatile("s_waitcnt lgkmcnt(0)" ::: "memory"); SBAR(); PV_MMA(sb, o[3]); SBAR();
}
#define SGB_MV(NM, NV) do { _Pragma("unroll") for (int q_ = 0; q_ < (NM); ++q_) { __builtin_amdgcn_sched_group_barrier(0x008, 1, 0); __builtin_amdgcn_sched_group_barrier(0x002, (NV), 0); } } while (0)
__device__ __forceinline__ void pv_psm(f32x16* o, int vb, bf16x8 pa0, bf16x8 pa1, bf16x8 pa2, bf16x8 pa3, f32x16& p0, f32x16& p1, float& m_reg, float& alpha, float boff) {
    s16x4 sa[8], sb[8];
    SBAR(); asm volatile("s_waitcnt lgkmcnt(0)" ::: "memory");
    PV_READ(sa, 0); PV_READ(sb, 1);
    asm volatile("s_waitcnt lgkmcnt(8)" ::: "memory"); SBAR(); PV_MMA(sa, o[0]);
    float pa = max3f(p0[0], p0[1], p0[2]), pb = max3f(p1[0], p1[1], p1[2]);
#pragma unroll
    for (int r = 3; r < 15; r += 2) { pa = max3f(pa, p0[r], p0[r + 1]); pb = max3f(pb, p1[r], p1[r + 1]); }
    float pmax = max3f(pa, pb, p0[15]); pmax = max3f(pmax, p1[15], p1[15]);
    pmax = psw_max(pmax) + boff;
    asm volatile("" : "+v"(pmax));
    SGB_MV(4, 4); SBAR();
    PV_READ(sa, 2);
    asm volatile("s_waitcnt lgkmcnt(8)" ::: "memory"); SBAR(); PV_MMA(sb, o[1]);
    const bool keep = __all(pmax - m_reg <= THRL);
    const float mn = keep ? m_reg : fmaxf(m_reg, pmax); alpha = __builtin_amdgcn_exp2f(m_reg - mn); m_reg = mn;
    const float sub = mn - boff;
#pragma unroll
    for (int r = 0; r < 16; ++r) p0[r] -= sub;
    asm volatile("" : "+v"(p0));
    SGB_MV(4, 5); SBAR();
    PV_READ(sb, 3);
    asm volatile("s_waitcnt lgkmcnt(8)" ::: "memory"); SBAR(); PV_MMA(sa, o[2]);
#pragma unroll
    for (int r = 0; r < 16; ++r) p1[r] -= sub;
#pragma unroll
    for (int r = 0; r < 6; ++r) p0[r] = __builtin_amdgcn_exp2f(p0[r]);
    asm volatile("" : "+v"(p0), "+v"(p1));
    SGB_MV(4, 6); SBAR();
    asm volatile("s_waitcnt lgkmcnt(0)" ::: "memory"); SBAR(); PV_MMA(sb, o[3]);
#pragma unroll
    for (int r = 6; r < 16; ++r) p0[r] = __builtin_amdgcn_exp2f(p0[r]);
    asm volatile("" : "+v"(p0));
    SGB_MV(4, 3); SBAR();
}
#undef PV_PK
#undef PV_READ
#undef PV_MMA

template <int VAR> __device__ __forceinline__ void attn_unit(const kargp_t kp, int j, int b, int g, int c, char* lds, int wave) {
    const int tid = make_tid(wave), wid = tid >> 6, lane = tid & 63, r32 = lane & 31, hi = lane >> 5;
    const bf16* PROJ = (const bf16*)(KWS + WS_PROJ); const unsigned* BM = (const unsigned*)(KWS + WS_BM); bf16* YCAT = (bf16*)(KWS + (VAR ? WS_SC : WS_YCAT));
    const int hr = wid >> 1, h = g * 4 + hr, qh = wid & 1;
    const int t = c * 64 + qh * 32 + r32; const size_t qrow = (size_t)b * SEQ + t;
    const bf16* Kh = (const bf16*)(KWS + WS_KN) + (size_t)b * SEQ * LDKK + g * 128; const bf16* Vh = PROJ + (size_t)b * SEQ * LDKV + COL_V + g * 128;
    char* V_lds = lds; char* K_lds = lds + 2 * SHM_V;
    float* wsf = (float*)(lds + LDS_WS) + wid * 64; float* li_l = wsf; float* al_l = wsf + 32; float* LUT = (float*)(lds + LDS_LUT);
    const int NT0 = c + 1, NT = NT0 + (NT0 & 1);
    __syncthreads();
    for (int e = tid; e < 4 * LUT_N; e += NTHR) { const int rr = e / LUT_N, i = e % LUT_N; LUT[e] = rel_bias_at(kp, i - 192, g * 4 + rr) * 1.4426950408889634f; }
    const float bfar = rel_bias_at(kp, -200, h) * 1.4426950408889634f;
    float m_reg = -1e30f, l_reg = 0.f; f32x16 o[4] = {}; char* qs = lds + LDS_Q + wid * 8192 + lane * 16;
    {   float qf[64]; float ss = 0.f; const bf16* qp = PROJ + qrow * PROJ_LD + COL_Q + h * 128 + hi * 8;
#pragma unroll
        for (int d0 = 0; d0 < 8; ++d0) { const u32x4 w = *(const u32x4*)(qp + d0 * 16);
            qf[d0 * 8 + 0] = bflo(w.x); qf[d0 * 8 + 1] = bfhi(w.x); qf[d0 * 8 + 2] = bflo(w.y); qf[d0 * 8 + 3] = bfhi(w.y); qf[d0 * 8 + 4] = bflo(w.z); qf[d0 * 8 + 5] = bfhi(w.z); qf[d0 * 8 + 6] = bflo(w.w); qf[d0 * 8 + 7] = bfhi(w.w); }
#pragma unroll
        for (int i = 0; i < 64; ++i) ss += qf[i] * qf[i];
        ss = psw_sum(ss);
        const float f = frsq(ss * (1.0f / 128.0f) + 1e-6f) * (0.08838834764831845f * 1.4426950408889634f); const float* qg = KIN(12) + (size_t)j * 128 + hi * 8;
#pragma unroll
        for (int d0 = 0; d0 < 8; ++d0) { const f32x4 g0 = *(const f32x4*)(qg + d0 * 16), g1 = *(const f32x4*)(qg + d0 * 16 + 4);
            u32x4 w; w.x = cvtpk(qf[d0 * 8 + 0] * f * g0[0], qf[d0 * 8 + 1] * f * g0[1]); w.y = cvtpk(qf[d0 * 8 + 2] * f * g0[2], qf[d0 * 8 + 3] * f * g0[3]);
            w.z = cvtpk(qf[d0 * 8 + 4] * f * g1[0], qf[d0 * 8 + 5] * f * g1[1]); w.w = cvtpk(qf[d0 * 8 + 6] * f * g1[2], qf[d0 * 8 + 7] * f * g1[3]); *reinterpret_cast<u32x4*>(qs + d0 * 1024) = w; }
    }
    const int vb0 = (int)(uintptr_t)V_lds + v_rd_base(lane);
    const int krow_ = 8 * wid + (lane >> 4), kch_ = lane & 15;
    const bf16* ksrc0 = Kh + (size_t)krow_ * LDKK + ((kch_ ^ (krow_ & 7)) * 8); const bf16* ksrc1 = Kh + (size_t)(krow_ + 4) * LDKK + ((kch_ ^ ((krow_ + 4) & 7)) * 8);
    const int vkk_ = 8 * wid + ((lane & 31) >> 2), vk_ = (vkk_ & ~0xC) | ((vkk_ & 4) << 1) | ((vkk_ & 8) >> 1);
    const bf16* vsrc0 = Vh + (size_t)vk_ * LDKV + (lane >> 5) * 32 + (lane & 3) * 8; const bf16* vsrc1 = vsrc0 + 64;
    const unsigned* msrc = BM + ((size_t)b * SEQ + c * 64 + lane) * 128;
    char* MS = lds + LDS_MS;
#define DMAK(bb, k0) do { LAS unsigned* d_ = (LAS unsigned*)(K_lds + (bb) * SHM_K + wave * 2048); \
    __builtin_amdgcn_global_load_lds((const unsigned*)(ksrc0 + (size_t)(k0) * LDKK), d_, 16, 0, 0); __builtin_amdgcn_global_load_lds((const unsigned*)(ksrc1 + (size_t)(k0) * LDKK), d_ + 256, 16, 0, 0); } while (0)
#define DMAV(bb, k0) do { LAS unsigned* d_ = (LAS unsigned*)(V_lds + (bb) * SHM_V + wave * 2048); \
    __builtin_amdgcn_global_load_lds((const unsigned*)(vsrc0 + (size_t)(k0) * LDKV), d_, 16, 0, 0); __builtin_amdgcn_global_load_lds((const unsigned*)(vsrc1 + (size_t)(k0) * LDKV), d_ + 256, 16, 0, 0); } while (0)
#define DMAM(pr) do { if (wave == 0) __builtin_amdgcn_global_load_lds(msrc + 4 * (pr), (LAS unsigned*)(MS + ((pr) & 1) * 1024), 16, 0, 0); } while (0)
#define RESC(a) do { if (__any((a) < 1.f)) { if (hi == 0) al_l[r32] = (a); asm volatile("s_waitcnt lgkmcnt(0)" ::: "memory"); \
    _Pragma("unroll") for (int d = 0; d < 4; ++d) _Pragma("unroll") for (int r = 0; r < 16; ++r) o[d][r] *= al_l[crow(r, hi)]; } } while (0)
#define SCORE(P0, P1, jt) do { const bool near_ = (jt) >= c - 2; const v2u mw_ = *(const v2u*)(MS + (((jt) >> 1) & 1) * 1024 + (qh * 32 + r32) * 16 + ((jt) & 1) * 8); \
    if (VAR == 3) { P0 = f32x16{}; P1 = f32x16{}; asm volatile("" : "+v"(P0), "+v"(P1)); } else qkt(P0, P1, K_lds + ((jt) & 1) * SHM_K, qs, r32, hi); const unsigned w0_ = mw_.x >> (4 * hi), w1_ = mw_.y >> (4 * hi); \
    if (near_) { const float* lutp_ = LUT + hr * LUT_N + (64 * (jt) - t + 192 + 4 * hi); maskbias<true>(P0, P1, w0_, w1_, lutp_); } else if (VAR != 1) maskbias<false>(P0, P1, w0_, w1_, nullptr); else asm volatile("" :: "v"(w0_), "v"(w1_)); } while (0)
#define WAITBAR() do { asm volatile("s_waitcnt vmcnt(0)" ::: "memory"); __syncthreads(); } while (0)
#define HALF(ORD, Pc0, Pc1, alc, Pp0, Pp1, alp, jt) do { SBAR(); if ((jt) + 1 < NT) DMAK(((jt) + 1) & 1, ((jt) + 1) * KVBLK);     \
    if (ORD == 0) { SCORE(Pc0, Pc1, jt); finishSM<VAR>(Pp0, Pp1, alp, l_reg, pa0, pa1, pa2, pa3); SBAR(); pv_d0<VAR>(o, vb0 + (((jt) - 1) & 1) * SHM_V, pa0, pa1, pa2, pa3); } \
    else { finishSM<VAR>(Pp0, Pp1, alp, l_reg, pa0, pa1, pa2, pa3); SBAR(); pv_d0<VAR>(o, vb0 + (((jt) - 1) & 1) * SHM_V, pa0, pa1, pa2, pa3); SBAR(); SCORE(Pc0, Pc1, jt); } \
    partialSM<VAR>(Pc0, Pc1, m_reg, alc, ((jt) >= c - 2) ? 0.f : bfar); \
    WAITBAR(); if ((jt) + 1 < NT) DMAV(((jt) + 1) & 1, ((jt) + 1) * KVBLK); if ((((jt) & 1) == 0) && (jt) + 2 < NT) DMAM(((jt) + 2) >> 1); \
    RESC(alc); } while (0)
#define SCORE_QK(P0, P1, jt) qkt(P0, P1, K_lds + ((jt) & 1) * SHM_K, qs, r32, hi)
#define MASKB(P0, P1, jt) do { const bool near_ = (jt) >= c - 2; const v2u mw_ = *(const v2u*)(MS + (((jt) >> 1) & 1) * 1024 + (qh * 32 + r32) * 16 + ((jt) & 1) * 8); const unsigned w0_ = mw_.x >> (4 * hi), w1_ = mw_.y >> (4 * hi); \
    if (near_) { const float* lutp_ = LUT + hr * LUT_N + (64 * (jt) - t + 192 + 4 * hi); maskbias<true>(P0, P1, w0_, w1_, lutp_); } else maskbias<false>(P0, P1, w0_, w1_, nullptr); } while (0)
#define HALF2(Pc0, Pc1, alc, Pp0, Pp1, alp, jt) do { SBAR(); if ((jt) + 1 < NT) DMAK(((jt) + 1) & 1, ((jt) + 1) * KVBLK); \
    qkt_fsm(Pc0, Pc1, K_lds + ((jt) & 1) * SHM_K, qs, r32, hi, Pp0, Pp1, alp, l_reg, pa0, pa1, pa2, pa3); \
    SBAR(); MASKB(Pc0, Pc1, jt); \
    pv_psm(o, vb0 + (((jt) - 1) & 1) * SHM_V, pa0, pa1, pa2, pa3, Pc0, Pc1, m_reg, alc, ((jt) >= c - 2) ? 0.f : bfar); \
    WAITBAR(); if ((jt) + 1 < NT) DMAV(((jt) + 1) & 1, ((jt) + 1) * KVBLK); if ((((jt) & 1) == 0) && (jt) + 2 < NT) DMAM(((jt) + 2) >> 1); \
    RESC(alc); } while (0)
#define TILE_LOOP2() do { for (int jt = 1; jt + 1 < NT; jt += 2) { HALF2(pB0, pB1, alB, pA0, pA1, alA, jt); HALF2(pA0, pA1, alA, pB0, pB1, alB, jt + 1); } } while (0)
#define TILE_LOOP(ORD) do { for (int jt = 1; jt + 1 < NT; jt += 2) { HALF(ORD, pB0, pB1, alB, pA0, pA1, alA, jt); HALF(ORD, pA0, pA1, alA, pB0, pB1, alB, jt + 1); } } while (0)
    f32x16 pA0, pA1, pB0, pB1; float alA, alB; bf16x8 pa0, pa1, pa2, pa3;
    DMAM(0); DMAK(0, 0); DMAV(0, 0); WAITBAR();
    SBAR(); DMAK(1, KVBLK); SCORE(pA0, pA1, 0); partialSM<VAR>(pA0, pA1, m_reg, alA, (0 >= c - 2) ? 0.f : bfar);
    WAITBAR(); DMAV(1, KVBLK); if (2 < NT) DMAM(1);
#ifdef ATT_OLD_LOOP
    if (wave < 4) TILE_LOOP(0); else TILE_LOOP(1);
#else
    TILE_LOOP2();
#endif
    SBAR(); SCORE(pB0, pB1, NT - 1);
    finishSM<VAR>(pA0, pA1, alA, l_reg, pa0, pa1, pa2, pa3); SBAR();
    pv_d0<VAR>(o, vb0, pa0, pa1, pa2, pa3); partialSM<VAR>(pB0, pB1, m_reg, alB, 0.f);
    WAITBAR(); RESC(alB);
    finishSM<VAR>(pB0, pB1, alB, l_reg, pa0, pa1, pa2, pa3); SBAR();
    pv_d0<VAR>(o, vb0 + SHM_V, pa0, pa1, pa2, pa3);
    if (hi == 0) li_l[r32] = l_reg; asm volatile("s_waitcnt lgkmcnt(0)" ::: "memory");
    const size_t row0 = (size_t)b * SEQ + c * 64 + qh * 32;
    const int erow = lane >> 4, ech = lane & 15;
    u32x4 gw[8];
#pragma unroll
    for (int i = 0; i < 8; ++i) gw[i] = *(const u32x4*)(PROJ + (row0 + 4 * i + erow) * PROJ_LD + COL_GB + h * 128 + ech * 8);
    char* stg = lds + LDS_Q + wid * 8192;
#pragma unroll
    for (int r = 0; r < 16; ++r) { const int orow = crow(r, hi); const float rl = frcp(li_l[orow]);
#pragma unroll
        for (int d0 = 0; d0 < 4; ++d0) *(unsigned short*)(stg + orow * 256 + (((d0 * 32 + r32) * 2) ^ (((orow >> 2) & 1) << 6))) = (unsigned short)f2bf(o[d0][r] * rl); }
    asm volatile("s_waitcnt lgkmcnt(0)" ::: "memory");
#pragma unroll
    for (int i = 0; i < 8; ++i) { const int row = 4 * i + erow; const u32x4 ov = *(const u32x4*)(stg + row * 256 + ((ech * 16) ^ (((row >> 2) & 1) << 6))); const u32x4 g = gw[i];
        u32x4 y; y.x = pk2(bflo(ov.x) * bflo(g.x), bfhi(ov.x) * bfhi(g.x)); y.y = pk2(bflo(ov.y) * bflo(g.y), bfhi(ov.y) * bfhi(g.y));
        y.z = pk2(bflo(ov.z) * bflo(g.z), bfhi(ov.z) * bfhi(g.z)); y.w = pk2(bflo(ov.w) * bflo(g.w), bfhi(ov.w) * bfhi(g.w));
        *(u32x4*)(YCAT + (row0 + row) * 4096 + 2048 + h * 128 + ech * 8) = y; }
#undef DMAK
#undef DMAV
#undef DMAM
#undef RESC
#undef SCORE
#undef WAITBAR
#undef HALF
#undef TILE_LOOP
#undef HALF2
#undef TILE_LOOP2
#undef SCORE_QK
#undef MASKB
}
#undef KSWZ
#undef SBAR
}

__device__ __forceinline__ void sgu_item_mfma(const kargp_t kp, int j, int b, int ch, int g, unsigned char* lds, int wave) {
    const int tid = make_tid(wave), lane = tid & 63, fr = lane & 15, q4 = lane >> 4, wid = tid >> 6;
    unsigned char* VT = lds; float* MU = (float*)(lds + 32768); float* RS = MU + 128; unsigned char* UT = lds + 40960; unsigned char* GT = lds + 73728;
    const bf16* PROJ = (const bf16*)(KWS + WS_PROJ); const float* SLN = (const float*)(KWS + WS_STATLN); bf16* Y = (bf16*)(KWS + WS_YCAT);
    const float* lng = KIN(16) + (size_t)j * 2048, *lnb = KIN(17) + (size_t)j * 2048; const float* bs = KIN(19) + ((size_t)j * 16 + g) * 128;
    const size_t row0 = (size_t)b * SEQ + ch * 128;
    __syncthreads();
    const int srow = tid >> 2, sq = tid & 3; const f32x4* sp = (const f32x4*)(SLN + (row0 + srow) * 64) + sq * 4;
    f32x4 sv[4];
#pragma unroll
    for (int i = 0; i < 4; ++i) sv[i] = sp[i];
    const bf16* wsb = (const bf16*)(KWS + WS_WSMALL) + (size_t)2 * 32 * 16384 + ((size_t)(j * 16 + g) * 128 + 16 * wid + fr) * 128 + 8 * q4;
    s_bf16x8 af[4];
#pragma unroll
    for (int ks = 0; ks < 4; ++ks) af[ks] = *(const s_bf16x8*)(wsb + ks * 32);
    float bias[4];
#pragma unroll
    for (int r = 0; r < 4; ++r) bias[r] = bs[16 * wid + 4 * q4 + r];
    const int dq = (tid & 15) * 8;
    v4u vw[4];
#pragma unroll
    for (int i = 0; i < 4; ++i) { const int s_ = (tid + NTHR * i) >> 4; vw[i] = *(const v4u*)(PROJ + (row0 + s_) * ODD_IN + 2048 + g * 128 + dq); }
    const f32x4 g0 = *(const f32x4*)(lng + g * 128 + dq), g1 = *(const f32x4*)(lng + g * 128 + dq + 4), b0 = *(const f32x4*)(lnb + g * 128 + dq), b1 = *(const f32x4*)(lnb + g * 128 + dq + 4);
    v4u uw[4], gw_[4];
#pragma unroll
    for (int i = 0; i < 4; ++i) { const int e = tid + NTHR * i, t = e >> 4, chk = e & 15; const bf16* pr = PROJ + (row0 + t) * ODD_IN + g * 128 + chk * 8; uw[i] = *(const v4u*)pr; gw_[i] = *(const v4u*)(pr + 4096); }
    {   float s1 = 0.f, s2 = 0.f;
#pragma unroll
        for (int i = 0; i < 4; ++i) { s1 += sv[i][0] + sv[i][2]; s2 += sv[i][1] + sv[i][3]; }
        s1 += __int_as_float(__builtin_amdgcn_mov_dpp(__float_as_int(s1), 0xB1, 0xF, 0xF, true)); s2 += __int_as_float(__builtin_amdgcn_mov_dpp(__float_as_int(s2), 0xB1, 0xF, 0xF, true));
        s1 += __int_as_float(__builtin_amdgcn_mov_dpp(__float_as_int(s1), 0x4E, 0xF, 0xF, true)); s2 += __int_as_float(__builtin_amdgcn_mov_dpp(__float_as_int(s2), 0x4E, 0xF, 0xF, true));
        const float mean = s1 * (1.0f / 2048.0f); const float var = fmaxf(s2 * (1.0f / 2048.0f) - mean * mean, 0.f); if (sq == 0) { MU[srow] = mean; RS[srow] = frsq(var + 1e-6f); } }
#pragma unroll
    for (int i = 0; i < 4; ++i) { const int e = tid + NTHR * i, t = e >> 4, chk = e & 15; *(v4u*)(UT + t * 256 + chk * 16) = uw[i]; *(v4u*)(GT + t * 256 + chk * 16) = gw_[i]; }
    __syncthreads();
#pragma unroll
    for (int i = 0; i < 4; ++i) { const int s = (tid + NTHR * i) >> 4; const v4u w = vw[i];
        const float x[8] = {bflo(w.x), bfhi(w.x), bflo(w.y), bfhi(w.y), bflo(w.z), bfhi(w.z), bflo(w.w), bfhi(w.w)}; const float mu = MU[s], rs = RS[s];
#pragma unroll
        for (int k = 0; k < 8; ++k) { const int d = dq + k; const float v = (x[k] - mu) * rs * (k < 4 ? g0[k & 3] : g1[k & 3]) + (k < 4 ? b0[k & 3] : b1[k & 3]);
            *(bf16*)(VT + d * 256 + ((s * 2) ^ (((d & 15) ^ ((d >> 4) & 7)) << 4))) = (bf16)f2bf(v); } }
    __syncthreads();
    f32x4 acc[8];
#pragma unroll
    for (int n = 0; n < 8; ++n) acc[n] = (f32x4){0.f, 0.f, 0.f, 0.f};
    {
        s_bf16x8 bv[2][4];
#define SGU_LD(S, N) do { _Pragma("unroll") for (int ks = 0; ks < 4; ++ks) bv[S][ks] = *(const s_bf16x8*)(VT + (16 * (N) + fr) * 256 + (((ks * 32 + 8 * q4) * 2) ^ ((fr ^ ((N) & 7)) << 4))); } while (0)
        SGU_LD(0, 0);
#pragma unroll
        for (int n = 0; n < 8; ++n) { __builtin_amdgcn_sched_barrier(0);
            if (n + 1 < 8) SGU_LD((n + 1) & 1, n + 1);
#pragma unroll
            for (int ks = 0; ks < 4; ++ks) acc[n] = __builtin_amdgcn_mfma_f32_16x16x32_bf16(af[ks], bv[n & 1][ks], acc[n], 0, 0, 0); }
        __builtin_amdgcn_sched_barrier(0);
#undef SGU_LD
    }
    unsigned short uq[4][8], gq[4][8];
#pragma unroll
    for (int r = 0; r < 4; ++r) { const int t = 16 * wid + 4 * q4 + r;
#pragma unroll
        for (int n = 0; n < 8; ++n) { uq[r][n] = *(const unsigned short*)(UT + t * 256 + (16 * n + fr) * 2); gq[r][n] = *(const unsigned short*)(GT + t * 256 + (16 * n + fr) * 2); } }
#pragma unroll
    for (int r = 0; r < 4; ++r) { const int t = 16 * wid + 4 * q4 + r;
#pragma unroll
        for (int n = 0; n < 8; ++n) *(bf16*)(UT + t * 256 + (16 * n + fr) * 2) = (bf16)f2bf(bf2f(uq[r][n]) * (acc[n][r] + bias[r]) * bf2f(gq[r][n])); }
    __syncthreads();
#pragma unroll
    for (int i = 0; i < 4; ++i) { const int e = tid + NTHR * i, t = e >> 4, chk = e & 15; *(v4u*)(Y + (row0 + t) * 2048 + g * 128 + chk * 8) = *(const v4u*)(UT + t * 256 + chk * 16); }
}

__global__ void __launch_bounds__(NTHR, 2) mega_fwd(Args args) {
    extern __shared__ __attribute__((aligned(16))) unsigned char lds[];
    const int wave = __builtin_amdgcn_readfirstlane((int)threadIdx.x >> 6);
    const int G = gridDim.x, bx = blockIdx.x;
#define LANE_ONLY() int lane_ = lane_id(); asm volatile("" : "+v"(lane_)); const int lane = lane_
#define LANE_OPAQUE() KARGS_OPEN(); int lane_ = lane_id(); asm volatile("" : "+v"(lane_)); const int lane = lane_

    volatile LAS unsigned* MISC = (volatile LAS unsigned*)((LAS unsigned char*)lds + MISC_OFF);
    if (threadIdx.x < 64) MISC[threadIdx.x] = 0u;
    __syncthreads();
    XcdBarrier bar; bar.bar = (unsigned*)(args.ws + WS_CTL) + CW_BAR; bar.x = 0; bar.st = nullptr;
    if (N_LAUNCHES == 1) bar = xcd_barrier_post((unsigned*)(args.ws + WS_CTL) + CW_BAR, MISC + 8);
#define GRID_BAR() do { if (N_LAUNCHES == 1) xcd_barrier(bar, wave == 0 && lane_id() == 0); } while (0)
    const int lo = args.ph_lo, hi = args.ph_hi;
#define IN(k) (lo <= (k) && (k) < hi)
#define SEAM(k) do { if (IN((k) + 1)) { GRID_BAR(); if (PROBE_REP == 9) { GRID_BAR(); GRID_BAR(); } } } while (0)
    const int gw = bx * NWAVES + wave, NGW = G * NWAVES;
#define ws KWS
#define HP ((bf16*)KOUT)
#define HQ ((bf16*)(ws + WS_AN))
#define PROJ ((bf16*)(ws + WS_PROJ))
#define YCAT ((bf16*)(ws + WS_YCAT))
#define IDX ((float*)(ws + WS_IDX))
#define EBL(l) ((bf16*)(ws + WS_H) + (size_t)((l) & 1) * M * DM)
#define EB EBL(layer)
#define STA ((float*)(ws + WS_STATA))
#define STB ((float*)(ws + WS_STATB))
#define SLN ((float*)(ws + WS_STATLN))
#define PBF ((bf16*)(ws + WS_PBF))
#define WPE ((bf16*)(ws + WS_WPE))
#define WGATE ((bf16*)(ws + WS_WGATE))
#define WEIN ((bf16*)(ws + WS_WEIN))
#define WEOUT ((bf16*)(ws + WS_WEOUT))
#define WOIN ((bf16*)(ws + WS_WOIN))
#define WOOUT ((bf16*)(ws + WS_WOOUT))
    LAS unsigned char* ldsl = (LAS unsigned char*)lds;

    if (IN(0)) { LANE_OPAQUE();
        float* scr = (float*)(lds + wave * 16640);
        for (int rep_ = 0; rep_ < NREP(8); ++rep_) {
        int base = 0, it = gw;
#define TRG(W, K, N, WT, GK) do { const int ni_ = ((K) / 64) * (((N) + 63) / 64); for (; it < base + ni_; it += NGW) p0_transpose_item((W), (K), (N), (WT), scr, it - base, lane, (GK)); base += ni_; } while (0)
#define TR(W, K, N, WT) TRG(W, K, N, WT, nullptr)
        TRG(KIN(4), 2048, EVEN_IN, WEIN, KIN(2));
        for (int j = 0; j < 2; ++j) TR(KIN(14) + (size_t)j * 4096 * 2048, 4096, 2048, WEOUT + (size_t)j * 2048 * 4096);
        TRG(KIN(15), 2048, ODD_IN, WOIN, KIN(2) + DM);
        TR(KIN(20), 2048, 2048, WOOUT);
        for (int l = 0; l < 4; ++l) TR(KIN(21) + (size_t)l * 256 * 2048, 256, 2048, WPE + (size_t)l * 2048 * 256);
        for (int l = 0; l < 3; ++l) TRG(KIN(23) + (size_t)l * 2048 * 2048, 2048, 2048, WGATE + (size_t)l * 2048 * 2048, KIN(22) + (size_t)l * DM);
        for (int jg = 0; jg < 32; ++jg) TR(KIN(7) + (size_t)jg * 16384, 128, 128, (bf16*)(ws + WS_WSMALL) + (size_t)jg * 16384);
        for (int jg = 0; jg < 32; ++jg) TR(KIN(9) + (size_t)jg * 16384, 128, 128, (bf16*)(ws + WS_WSMALL) + (size_t)(32 + jg) * 16384);
#undef TR
#undef TRG
        for (int j = 0; j < 2; ++j) { v4u* z = (v4u*)(WEIN + ((size_t)j * EVEN_INP + EVEN_IN) * 2048); const int n16 = (EVEN_INP - EVEN_IN) * 2048 / 8;
            for (int i = gw * 64 + lane; i < n16; i += NGW * 64) z[i] = (v4u){0u, 0u, 0u, 0u}; }
        for (int m = gw; m < M; m += NGW) { const f32x4* xr = (const f32x4*)(KIN(0) + (size_t)m * DM) + lane; float ss = 0.f;
            f32x4 xv[8];
#pragma unroll
            for (int jx = 0; jx < 8; ++jx) xv[jx] = __builtin_nontemporal_load(xr + 64 * jx);
            asm volatile("" ::: "memory");
#pragma unroll
            for (int jx = 0; jx < 8; ++jx) { const f32x4 v = xv[jx]; ss += (v[0] * v[0] + v[1] * v[1]) + (v[2] * v[2] + v[3] * v[3]);
                *(v2u*)(HP + (size_t)m * DM + (size_t)(lane + 64 * jx) * 4) = (v2u){pk2(v[0], v[1]), pk2(v[2], v[3])}; }
            ss = wave_sum(ss, lane); if (lane < 32) STA[(size_t)m * 32 + lane] = (lane == 0) ? ss : 0.f; }
        { const f32x4* w4 = (const f32x4*)KIN(18); bf16* wo = (bf16*)(ws + WS_WSMALL) + (size_t)2 * 32 * 16384; const int n4 = 2 * 16 * 128 * 128 / 4;
            for (int i = gw * 64 + lane; i < n4; i += NGW * 64) { f32x4 v = w4[i]; const int s = (i * 4) & 127, t = ((i * 4) >> 7) & 127; if (t < 64 && s >= 64) v = (f32x4){0.f, 0.f, 0.f, 0.f};
                *(v2u*)(wo + (size_t)i * 4) = (v2u){pk2(v[0], v[1]), pk2(v[2], v[3])}; } }
        { const f32x4* p4 = (const f32x4*)KIN(1); const int n4 = DEPTH * M * 256 / 4;
            for (int i = gw * 64 + lane; i < n4; i += 8 * NGW * 64) { f32x4 pv[8];
#pragma unroll
                for (int q = 0; q < 8; ++q) pv[q] = __builtin_nontemporal_load(p4 + ((i + q * NGW * 64 < n4) ? i + q * NGW * 64 : i));
                asm volatile("" ::: "memory");
#pragma unroll
                for (int q = 0; q < 8; ++q) if (i + q * NGW * 64 < n4) *(v2u*)(PBF + (size_t)(i + q * NGW * 64) * 4) = (v2u){pk2(pv[q][0], pv[q][1]), pk2(pv[q][2], pv[q][3])}; } }
        }
        SEAM(0);
    }

    int ph = 1;
#define PHASE_BEGIN() KARGS_OPEN(); int lyr_ = layer_it; asm volatile("" : "+s"(lyr_)); const int layer = lyr_, j = lyr_ >> 1; const bool last = (lyr_ == DEPTH - 1); (void)j; (void)last; (void)layer
    {
        constexpr int layer_it = 0;
        if ((layer_it & 1) == 0) {
            if (IN(ph)) { PHASE_BEGIN(); pg8::Gemm g{HP, WEIN + (size_t)j * EVEN_INP * 2048, M, EVEN_INP, 2048}; pg8::StaticOrder S; S.init(M, EVEN_INP, G, bx);
                pg8::EpiEvenIn E{PROJ, IDX, STA, (bf16*)(ws + WS_IDXB)}; for (int rep_ = 0; rep_ < NREP(1); ++rep_) pg8::gemm_phase<pg8::EpiEvenIn, pg8::StaticOrder, true, true>(ldsl, g, S, E, wave);
                if (bx >= 32 && G > 32) {
#pragma unroll 1
                    for (int l2 = 0; l2 < 2; ++l2) { const int ll = layer + l2; pg8::Gemm g2{PBF + (size_t)ll * M * 256, WPE + (size_t)ll * 2048 * 256, M, 2048, 256}; pg8::StaticOrder S2; S2.init(M, 2048, G - 32, bx - 32);
                        pg8::EpiPE E2{EBL(ll)}; pg8::gemm_phase<pg8::EpiPE, pg8::StaticOrder, true, true>(ldsl, g2, S2, E2, wave);  }
                    { LANE_ONLY(); float* scr = (float*)(lds + wave * 16640); const int gw2 = (bx - 32) * NWAVES + wave, NGW2 = (G - 32) * NWAVES; int base = 0, it = gw2;
#define TR2(W, K, N, WT, GK) do { const int ni_ = ((K) / 64) * (((N) + 63) / 64); for (; it < base + ni_; it += NGW2) p0_transpose_item((W), (K), (N), (WT), scr, it - base, lane, (GK)); base += ni_; } while (0)
                      if (layer == 0) { TR2(KIN(4) + (size_t)2048 * EVEN_IN, 2048, EVEN_IN, WEIN + (size_t)EVEN_INP * 2048, KIN(2) + 2 * DM); }
                      else { TR2(KIN(15) + (size_t)2048 * ODD_IN, 2048, ODD_IN, WOIN + (size_t)ODD_IN * 2048, KIN(2) + 3 * DM); TR2(KIN(20) + (size_t)2048 * 2048, 2048, 2048, WOOUT + (size_t)2048 * 2048, nullptr); TR2(KIN(23) + (size_t)3 * 2048 * 2048, 2048, 2048, WGATE + (size_t)3 * 2048 * 2048, KIN(22) + 3 * DM); }
#undef TR2
                    } }
#if PROBE_REP == 11 || PROBE_REP == 14
                __syncthreads();
                { pg8::EpiEvenInT<PROBE_REP == 11 ? 1 : 2> EN{PROJ, IDX, STA, (bf16*)(ws + WS_IDXB)}; for (int rep_ = 0; rep_ < 2; ++rep_) pg8::gemm_phase<pg8::EpiEvenInT<PROBE_REP == 11 ? 1 : 2>, pg8::StaticOrder, true, true>(ldsl, g, S, EN, wave); }
#endif
#if PROBE_REP == 10
                __syncthreads();
                { pg8::EpiNull EN; for (int rep_ = 0; rep_ < 2; ++rep_) pg8::gemm_phase<pg8::EpiNull, pg8::StaticOrder, true, true>(ldsl, g, S, EN, wave); }
#endif
                SEAM(ph); }
            ++ph;
            if (IN(ph)) { PHASE_BEGIN(); LANE_ONLY();
#ifdef NAIVE_LRU
                for (int it = bx; it < 1024; it += G) lru_tile(kp, j, it >> 9, (it >> 4) & 31, it & 15, false, lds, wave);
#else
                for (int rep_ = 0; rep_ < NREP(2); ++rep_)
                for (int it = bx; it < 1024; it += G) lru_tile_mfma(kp, j, it, it + G, it == bx, false, LRU_STREAM != 0, lds, wave);
#endif
#ifndef NO_KN
                for (int it = bx; it < 512; it += G) knorm_item(kp, j, it, wave, lane);
#endif
#ifdef NAIVE_SCORE
                for (int it = bx; it < 4160; it += G) { const int b = it / 2080; int r = it % 2080; int c = 0; while (r >= c + 1) { r -= c + 1; ++c; } score_item(kp, b, c, r, lds, wave); }
#else
                __syncthreads();
                for (int rep_ = 0; rep_ < NREP(3); ++rep_)
                for (int u = gw; u < 2048; u += NGW) { const int ks = u & 7, qg = (u >> 3) & 3, cp = (u >> 5) & 31, b = u >> 10;
                    score_wave_unit(kp, b, cp, qg, ks, lane, lds, wave); score_wave_unit(kp, b, 63 - cp, qg, ks, lane, lds, wave); }
#ifdef CHECK_SCORE
                GRID_BAR();
                for (int it = bx; it < 4160; it += G) { const int b = it / 2080; int r = it % 2080; int c = 0; while (r >= c + 1) { r -= c + 1; ++c; } score_item(kp, b, c, r, lds, wave, true); }
#endif
#endif
                SEAM(ph); }
            ++ph;
            if (IN(ph)) { PHASE_BEGIN(); LANE_ONLY();
#ifdef NAIVE_LRU
                for (int it = bx; it < 1024; it += G) lru_tile(kp, j, it >> 9, (it >> 4) & 31, it & 15, true, lds, wave);
#else
                for (int rep_ = 0; rep_ < NREP(2); ++rep_)
                for (int it = bx; it < 1024; it += (LRU_STREAM ? 4 : 1) * G) { if (LRU_STREAM) { __syncthreads(); lru_carry4(kp, it, G, (float*)lds, wave); __syncthreads();
#pragma unroll 1
                    for (int k4 = 0; k4 < 4; ++k4) if (it + k4 * G < 1024) lru_apply_item(kp, it + k4 * G, (const float*)lds + k4 * 128, wave); }
                  else lru_tile_mfma(kp, j, it, it + G, it == bx, true, false, lds, wave); }
#ifdef CHECK_LRU
                GRID_BAR();
                for (int it = bx; it < 1024; it += G) lru_tile(kp, j, it >> 9, (it >> 4) & 31, it & 15, true, lds, wave, true);
#endif
#endif
#ifndef NO_SEL
                for (int rep_ = 0; rep_ < NREP(4); ++rep_)
                for (int u = gw; u < M / 2; u += NGW) { const int b_ = u >> 11, t_ = u & 2047;
                    select_query(kp, b_ * SEQ + t_, lane); select_query(kp, b_ * SEQ + 4095 - t_, lane); }
#endif
                SEAM(ph); }
            ++ph;
            if (IN(ph)) { PHASE_BEGIN();
#ifdef NAIVE_ATTN
                for (int qi = bx; qi < M; qi += G) attn_query(kp, j, qi, lds, wave);
#else
                for (int rep_ = 0; rep_ < NREP(5); ++rep_)
                for (int u = bx; u < 256; u += G) { const int bg = u & 7, cp = u >> 3;

#pragma unroll 1
                    for (int k2 = 0; k2 < 2; ++k2) att::attn_unit<0>(kp, j, bg >> 2, bg & 3, k2 ? cp : 63 - cp, (char*)lds, wave); }
#if PROBE_REP >= 20 && PROBE_REP < 30
                for (int rep_ = 0; rep_ < 2; ++rep_) for (int u = bx; u < 256; u += G) { const int bg = u & 7, cp = u >> 3; att::attn_unit<PROBE_REP - 20>(kp, j, bg >> 2, bg & 3, 63 - cp, (char*)lds, wave); att::attn_unit<PROBE_REP - 20>(kp, j, bg >> 2, bg & 3, cp, (char*)lds, wave); }
#endif
#ifdef CHECK_ATTN
                GRID_BAR();
                for (int qi = bx; qi < M; qi += G) attn_query(kp, j, qi, lds, wave, true);
#endif
#endif
                SEAM(ph); }
            ++ph;
            if (IN(ph)) { PHASE_BEGIN();
                { pg8::Gemm g{YCAT, WEOUT + (size_t)j * 2048 * 4096, M, 2048, 4096}; pg8::StaticOrder S; S.init(M, 2048, G, bx);
                  pg8::EpiOut E{HP, HQ, STB}; pg8::gemm_phase<pg8::EpiOut, pg8::StaticOrder, true, true>(ldsl, g, S, E, wave);
#if PROBE_REP == 12
                  { pg8::EpiOut Ed{HP, (bf16*)(ws + WS_SC), (float*)(ws + WS_SC) + 16 * 1048576}; for (int rep_ = 0; rep_ < 2; ++rep_) pg8::gemm_phase<pg8::EpiOut, pg8::StaticOrder, true, true>(ldsl, g, S, Ed, wave); }
#endif
                }
                SEAM(ph); }
            ++ph;
        } else {
            if (IN(ph)) { PHASE_BEGIN(); pg8::Gemm g{HP, WOIN + (size_t)j * ODD_IN * 2048, M, ODD_IN, 2048}; pg8::StaticOrder S; S.init(M, ODD_IN, G, bx);
                pg8::EpiOddIn E{PROJ, STA, SLN}; for (int rep_ = 0; rep_ < NREP(6); ++rep_) pg8::gemm_phase<pg8::EpiOddIn, pg8::StaticOrder, true, true>(ldsl, g, S, E, wave); SEAM(ph); }
            ++ph;
            if (IN(ph)) { PHASE_BEGIN();
#ifndef NO_SGU
                for (int rep_ = 0; rep_ < NREP(7); ++rep_)
#ifdef NAIVE_SGU
                for (int it = bx; it < 1024; it += G) sgu_item(kp, j, it >> 9, (it >> 4) & 31, it & 15, lds, wave);
#else
                for (int it = bx; it < 1024; it += G) sgu_item_mfma(kp, j, it >> 9, (it >> 4) & 31, it & 15, lds, wave);
#endif
#endif
                SEAM(ph); }
            ++ph;
            if (IN(ph)) { PHASE_BEGIN();
                { pg8::Gemm g{YCAT, WOOUT + (size_t)j * 2048 * 2048, M, 2048, 2048}; pg8::StaticOrder S; S.init(M, 2048, G, bx);
                  pg8::EpiOut E{HP, HQ, STB}; pg8::gemm_phase<pg8::EpiOut, pg8::StaticOrder, true, true>(ldsl, g, S, E, wave);
#if PROBE_REP == 12
                  { pg8::EpiOut Ed{HP, (bf16*)(ws + WS_SC), (float*)(ws + WS_SC) + 16 * 1048576}; for (int rep_ = 0; rep_ < 2; ++rep_) pg8::gemm_phase<pg8::EpiOut, pg8::StaticOrder, true, true>(ldsl, g, S, Ed, wave); }
#endif
                }
                SEAM(ph); }
            ++ph;
        }
        if (IN(ph)) { PHASE_BEGIN(); pg8::Gemm g{HQ, WGATE + (size_t)layer * 2048 * 2048, M, 2048, 2048}; pg8::StaticOrder S; S.init(M, 2048, G, bx);
            typedef pg8::EpiGateT<layer_it == DEPTH - 1> EpiGate;
            EpiGate E{HQ, EB, STB, HP, STA, KOUT}; pg8::gemm_phase<EpiGate, pg8::StaticOrder, true, true>(ldsl, g, S, E, wave);
#if PROBE_REP == 13
            { pg8::EpiGateT<false> Ed{HQ, EB, STB, (bf16*)(ws + WS_SC), (float*)(ws + WS_SC) + 16 * 1048576, nullptr}; for (int rep_ = 0; rep_ < 2; ++rep_) pg8::gemm_phase<pg8::EpiGateT<false>, pg8::StaticOrder, true, true>(ldsl, g, S, Ed, wave); }
#endif

            if (layer_it != DEPTH - 1) SEAM(ph); }
        ++ph;
    }
    {
        constexpr int layer_it = 1;
        if ((layer_it & 1) == 0) {
            if (IN(ph)) { PHASE_BEGIN(); pg8::Gemm g{HP, WEIN + (size_t)j * EVEN_INP * 2048, M, EVEN_INP, 2048}; pg8::StaticOrder S; S.init(M, EVEN_INP, G, bx);
                pg8::EpiEvenIn E{PROJ, IDX, STA, (bf16*)(ws + WS_IDXB)}; for (int rep_ = 0; rep_ < NREP(1); ++rep_) pg8::gemm_phase<pg8::EpiEvenIn, pg8::StaticOrder, true, true>(ldsl, g, S, E, wave);
                if (bx >= 32 && G > 32) {
#pragma unroll 1
                    for (int l2 = 0; l2 < 2; ++l2) { const int ll = layer + l2; pg8::Gemm g2{PBF + (size_t)ll * M * 256, WPE + (size_t)ll * 2048 * 256, M, 2048, 256}; pg8::StaticOrder S2; S2.init(M, 2048, G - 32, bx - 32);
                        pg8::EpiPE E2{EBL(ll)}; pg8::gemm_phase<pg8::EpiPE, pg8::StaticOrder, true, true>(ldsl, g2, S2, E2, wave);  }
                    { LANE_ONLY(); float* scr = (float*)(lds + wave * 16640); const int gw2 = (bx - 32) * NWAVES + wave, NGW2 = (G - 32) * NWAVES; int base = 0, it = gw2;
#define TR2(W, K, N, WT, GK) do { const int ni_ = ((K) / 64) * (((N) + 63) / 64); for (; it < base + ni_; it += NGW2) p0_transpose_item((W), (K), (N), (WT), scr, it - base, lane, (GK)); base += ni_; } while (0)
                      if (layer == 0) { TR2(KIN(4) + (size_t)2048 * EVEN_IN, 2048, EVEN_IN, WEIN + (size_t)EVEN_INP * 2048, KIN(2) + 2 * DM); }
                      else { TR2(KIN(15) + (size_t)2048 * ODD_IN, 2048, ODD_IN, WOIN + (size_t)ODD_IN * 2048, KIN(2) + 3 * DM); TR2(KIN(20) + (size_t)2048 * 2048, 2048, 2048, WOOUT + (size_t)2048 * 2048, nullptr); TR2(KIN(23) + (size_t)3 * 2048 * 2048, 2048, 2048, WGATE + (size_t)3 * 2048 * 2048, KIN(22) + 3 * DM); }
#undef TR2
                    } }
#if PROBE_REP == 11 || PROBE_REP == 14
                __syncthreads();
                { pg8::EpiEvenInT<PROBE_REP == 11 ? 1 : 2> EN{PROJ, IDX, STA, (bf16*)(ws + WS_IDXB)}; for (int rep_ = 0; rep_ < 2; ++rep_) pg8::gemm_phase<pg8::EpiEvenInT<PROBE_REP == 11 ? 1 : 2>, pg8::StaticOrder, true, true>(ldsl, g, S, EN, wave); }
#endif
#if PROBE_REP == 10
                __syncthreads();
                { pg8::EpiNull EN; for (int rep_ = 0; rep_ < 2; ++rep_) pg8::gemm_phase<pg8::EpiNull, pg8::StaticOrder, true, true>(ldsl, g, S, EN, wave); }
#endif
                SEAM(ph); }
            ++ph;
            if (IN(ph)) { PHASE_BEGIN(); LANE_ONLY();
#ifdef NAIVE_LRU
                for (int it = bx; it < 1024; it += G) lru_tile(kp, j, it >> 9, (it >> 4) & 31, it & 15, false, lds, wave);
#else
                for (int rep_ = 0; rep_ < NREP(2); ++rep_)
                for (int it = bx; it < 1024; it += G) lru_tile_mfma(kp, j, it, it + G, it == bx, false, LRU_STREAM != 0, lds, wave);
#endif
#ifndef NO_KN
                for (int it = bx; it < 512; it += G) knorm_item(kp, j, it, wave, lane);
#endif
#ifdef NAIVE_SCORE
                for (int it = bx; it < 4160; it += G) { const int b = it / 2080; int r = it % 2080; int c = 0; while (r >= c + 1) { r -= c + 1; ++c; } score_item(kp, b, c, r, lds, wave); }
#else
                __syncthreads();
                for (int rep_ = 0; rep_ < NREP(3); ++rep_)
                for (int u = gw; u < 2048; u += NGW) { const int ks = u & 7, qg = (u >> 3) & 3, cp = (u >> 5) & 31, b = u >> 10;
                    score_wave_unit(kp, b, cp, qg, ks, lane, lds, wave); score_wave_unit(kp, b, 63 - cp, qg, ks, lane, lds, wave); }
#ifdef CHECK_SCORE
                GRID_BAR();
                for (int it = bx; it < 4160; it += G) { const int b = it / 2080; int r = it % 2080; int c = 0; while (r >= c + 1) { r -= c + 1; ++c; } score_item(kp, b, c, r, lds, wave, true); }
#endif
#endif
                SEAM(ph); }
            ++ph;
            if (IN(ph)) { PHASE_BEGIN(); LANE_ONLY();
#ifdef NAIVE_LRU
                for (int it = bx; it < 1024; it += G) lru_tile(kp, j, it >> 9, (it >> 4) & 31, it & 15, true, lds, wave);
#else
                for (int rep_ = 0; rep_ < NREP(2); ++rep_)
                for (int it = bx; it < 1024; it += (LRU_STREAM ? 4 : 1) * G) { if (LRU_STREAM) { __syncthreads(); lru_carry4(kp, it, G, (float*)lds, wave); __syncthreads();
#pragma unroll 1
                    for (int k4 = 0; k4 < 4; ++k4) if (it + k4 * G < 1024) lru_apply_item(kp, it + k4 * G, (const float*)lds + k4 * 128, wave); }
                  else lru_tile_mfma(kp, j, it, it + G, it == bx, true, false, lds, wave); }
#ifdef CHECK_LRU
                GRID_BAR();
                for (int it = bx; it < 1024; it += G) lru_tile(kp, j, it >> 9, (it >> 4) & 31, it & 15, true, lds, wave, true);
#endif
#endif
#ifndef NO_SEL
                for (int rep_ = 0; rep_ < NREP(4); ++rep_)
                for (int u = gw; u < M / 2; u += NGW) { const int b_ = u >> 11, t_ = u & 2047;
                    select_query(kp, b_ * SEQ + t_, lane); select_query(kp, b_ * SEQ + 4095 - t_, lane); }
#endif
                SEAM(ph); }
            ++ph;
            if (IN(ph)) { PHASE_BEGIN();
#ifdef NAIVE_ATTN
                for (int qi = bx; qi < M; qi += G) attn_query(kp, j, qi, lds, wave);
#else
                for (int rep_ = 0; rep_ < NREP(5); ++rep_)
                for (int u = bx; u < 256; u += G) { const int bg = u & 7, cp = u >> 3;

#pragma unroll 1
                    for (int k2 = 0; k2 < 2; ++k2) att::attn_unit<0>(kp, j, bg >> 2, bg & 3, k2 ? cp : 63 - cp, (char*)lds, wave); }
#if PROBE_REP >= 20 && PROBE_REP < 30
                for (int rep_ = 0; rep_ < 2; ++rep_) for (int u = bx; u < 256; u += G) { const int bg = u & 7, cp = u >> 3; att::attn_unit<PROBE_REP - 20>(kp, j, bg >> 2, bg & 3, 63 - cp, (char*)lds, wave); att::attn_unit<PROBE_REP - 20>(kp, j, bg >> 2, bg & 3, cp, (char*)lds, wave); }
#endif
#ifdef CHECK_ATTN
                GRID_BAR();
                for (int qi = bx; qi < M; qi += G) attn_query(kp, j, qi, lds, wave, true);
#endif
#endif
                SEAM(ph); }
            ++ph;
            if (IN(ph)) { PHASE_BEGIN();
                { pg8::Gemm g{YCAT, WEOUT + (size_t)j * 2048 * 4096, M, 2048, 4096}; pg8::StaticOrder S; S.init(M, 2048, G, bx);
                  pg8::EpiOut E{HP, HQ, STB}; pg8::gemm_phase<pg8::EpiOut, pg8::StaticOrder, true, true>(ldsl, g, S, E, wave);
#if PROBE_REP == 12
                  { pg8::EpiOut Ed{HP, (bf16*)(ws + WS_SC), (float*)(ws + WS_SC) + 16 * 1048576}; for (int rep_ = 0; rep_ < 2; ++rep_) pg8::gemm_phase<pg8::EpiOut, pg8::StaticOrder, true, true>(ldsl, g, S, Ed, wave); }
#endif
                }
                SEAM(ph); }
            ++ph;
        } else {
            if (IN(ph)) { PHASE_BEGIN(); pg8::Gemm g{HP, WOIN + (size_t)j * ODD_IN * 2048, M, ODD_IN, 2048}; pg8::StaticOrder S; S.init(M, ODD_IN, G, bx);
                pg8::EpiOddIn E{PROJ, STA, SLN}; for (int rep_ = 0; rep_ < NREP(6); ++rep_) pg8::gemm_phase<pg8::EpiOddIn, pg8::StaticOrder, true, true>(ldsl, g, S, E, wave); SEAM(ph); }
            ++ph;
            if (IN(ph)) { PHASE_BEGIN();
#ifndef NO_SGU
                for (int rep_ = 0; rep_ < NREP(7); ++rep_)
#ifdef NAIVE_SGU
                for (int it = bx; it < 1024; it += G) sgu_item(kp, j, it >> 9, (it >> 4) & 31, it & 15, lds, wave);
#else
                for (int it = bx; it < 1024; it += G) sgu_item_mfma(kp, j, it >> 9, (it >> 4) & 31, it & 15, lds, wave);
#endif
#endif
                SEAM(ph); }
            ++ph;
            if (IN(ph)) { PHASE_BEGIN();
                { pg8::Gemm g{YCAT, WOOUT + (size_t)j * 2048 * 2048, M, 2048, 2048}; pg8::StaticOrder S; S.init(M, 2048, G, bx);
                  pg8::EpiOut E{HP, HQ, STB}; pg8::gemm_phase<pg8::EpiOut, pg8::StaticOrder, true, true>(ldsl, g, S, E, wave);
#if PROBE_REP == 12
                  { pg8::EpiOut Ed{HP, (bf16*)(ws + WS_SC), (float*)(ws + WS_SC) + 16 * 1048576}; for (int rep_ = 0; rep_ < 2; ++rep_) pg8::gemm_phase<pg8::EpiOut, pg8::StaticOrder, true, true>(ldsl, g, S, Ed, wave); }
#endif
                }
                SEAM(ph); }
            ++ph;
        }
        if (IN(ph)) { PHASE_BEGIN(); pg8::Gemm g{HQ, WGATE + (size_t)layer * 2048 * 2048, M, 2048, 2048}; pg8::StaticOrder S; S.init(M, 2048, G, bx);
            typedef pg8::EpiGateT<layer_it == DEPTH - 1> EpiGate;
            EpiGate E{HQ, EB, STB, HP, STA, KOUT}; pg8::gemm_phase<EpiGate, pg8::StaticOrder, true, true>(ldsl, g, S, E, wave);
#if PROBE_REP == 13
            { pg8::EpiGateT<false> Ed{HQ, EB, STB, (bf16*)(ws + WS_SC), (float*)(ws + WS_SC) + 16 * 1048576, nullptr}; for (int rep_ = 0; rep_ < 2; ++rep_) pg8::gemm_phase<pg8::EpiGateT<false>, pg8::StaticOrder, true, true>(ldsl, g, S, Ed, wave); }
#endif

            if (layer_it != DEPTH - 1) SEAM(ph); }
        ++ph;
    }
    {
        constexpr int layer_it = 2;
        if ((layer_it & 1) == 0) {
            if (IN(ph)) { PHASE_BEGIN(); pg8::Gemm g{HP, WEIN + (size_t)j * EVEN_INP * 2048, M, EVEN_INP, 2048}; pg8::StaticOrder S; S.init(M, EVEN_INP, G, bx);
                pg8::EpiEvenIn E{PROJ, IDX, STA, (bf16*)(ws + WS_IDXB)}; for (int rep_ = 0; rep_ < NREP(1); ++rep_) pg8::gemm_phase<pg8::EpiEvenIn, pg8::StaticOrder, true, true>(ldsl, g, S, E, wave);
                if (bx >= 32 && G > 32) {
#pragma unroll 1
                    for (int l2 = 0; l2 < 2; ++l2) { const int ll = layer + l2; pg8::Gemm g2{PBF + (size_t)ll * M * 256, WPE + (size_t)ll * 2048 * 256, M, 2048, 256}; pg8::StaticOrder S2; S2.init(M, 2048, G - 32, bx - 32);
                        pg8::EpiPE E2{EBL(ll)}; pg8::gemm_phase<pg8::EpiPE, pg8::StaticOrder, true, true>(ldsl, g2, S2, E2, wave);  }
                    { LANE_ONLY(); float* scr = (float*)(lds + wave * 16640); const int gw2 = (bx - 32) * NWAVES + wave, NGW2 = (G - 32) * NWAVES; int base = 0, it = gw2;
#define TR2(W, K, N, WT, GK) do { const int ni_ = ((K) / 64) * (((N) + 63) / 64); for (; it < base + ni_; it += NGW2) p0_transpose_item((W), (K), (N), (WT), scr, it - base, lane, (GK)); base += ni_; } while (0)
                      if (layer == 0) { TR2(KIN(4) + (size_t)2048 * EVEN_IN, 2048, EVEN_IN, WEIN + (size_t)EVEN_INP * 2048, KIN(2) + 2 * DM); }
                      else { TR2(KIN(15) + (size_t)2048 * ODD_IN, 2048, ODD_IN, WOIN + (size_t)ODD_IN * 2048, KIN(2) + 3 * DM); TR2(KIN(20) + (size_t)2048 * 2048, 2048, 2048, WOOUT + (size_t)2048 * 2048, nullptr); TR2(KIN(23) + (size_t)3 * 2048 * 2048, 2048, 2048, WGATE + (size_t)3 * 2048 * 2048, KIN(22) + 3 * DM); }
#undef TR2
                    } }
#if PROBE_REP == 11 || PROBE_REP == 14
                __syncthreads();
                { pg8::EpiEvenInT<PROBE_REP == 11 ? 1 : 2> EN{PROJ, IDX, STA, (bf16*)(ws + WS_IDXB)}; for (int rep_ = 0; rep_ < 2; ++rep_) pg8::gemm_phase<pg8::EpiEvenInT<PROBE_REP == 11 ? 1 : 2>, pg8::StaticOrder, true, true>(ldsl, g, S, EN, wave); }
#endif
#if PROBE_REP == 10
                __syncthreads();
                { pg8::EpiNull EN; for (int rep_ = 0; rep_ < 2; ++rep_) pg8::gemm_phase<pg8::EpiNull, pg8::StaticOrder, true, true>(ldsl, g, S, EN, wave); }
#endif
                SEAM(ph); }
            ++ph;
            if (IN(ph)) { PHASE_BEGIN(); LANE_ONLY();
#ifdef NAIVE_LRU
                for (int it = bx; it < 1024; it += G) lru_tile(kp, j, it >> 9, (it >> 4) & 31, it & 15, false, lds, wave);
#else
                for (int rep_ = 0; rep_ < NREP(2); ++rep_)
                for (int it = bx; it < 1024; it += G) lru_tile_mfma(kp, j, it, it + G, it == bx, false, LRU_STREAM != 0, lds, wave);
#endif
#ifndef NO_KN
                for (int it = bx; it < 512; it += G) knorm_item(kp, j, it, wave, lane);
#endif
#ifdef NAIVE_SCORE
                for (int it = bx; it < 4160; it += G) { const int b = it / 2080; int r = it % 2080; int c = 0; while (r >= c + 1) { r -= c + 1; ++c; } score_item(kp, b, c, r, lds, wave); }
#else
                __syncthreads();
                for (int rep_ = 0; rep_ < NREP(3); ++rep_)
                for (int u = gw; u < 2048; u += NGW) { const int ks = u & 7, qg = (u >> 3) & 3, cp = (u >> 5) & 31, b = u >> 10;
                    score_wave_unit(kp, b, cp, qg, ks, lane, lds, wave); score_wave_unit(kp, b, 63 - cp, qg, ks, lane, lds, wave); }
#ifdef CHECK_SCORE
                GRID_BAR();
                for (int it = bx; it < 4160; it += G) { const int b = it / 2080; int r = it % 2080; int c = 0; while (r >= c + 1) { r -= c + 1; ++c; } score_item(kp, b, c, r, lds, wave, true); }
#endif
#endif
                SEAM(ph); }
            ++ph;
            if (IN(ph)) { PHASE_BEGIN(); LANE_ONLY();
#ifdef NAIVE_LRU
                for (int it = bx; it < 1024; it += G) lru_tile(kp, j, it >> 9, (it >> 4) & 31, it & 15, true, lds, wave);
#else
                for (int rep_ = 0; rep_ < NREP(2); ++rep_)
                for (int it = bx; it < 1024; it += (LRU_STREAM ? 4 : 1) * G) { if (LRU_STREAM) { __syncthreads(); lru_carry4(kp, it, G, (float*)lds, wave); __syncthreads();
#pragma unroll 1
                    for (int k4 = 0; k4 < 4; ++k4) if (it + k4 * G < 1024) lru_apply_item(kp, it + k4 * G, (const float*)lds + k4 * 128, wave); }
                  else lru_tile_mfma(kp, j, it, it + G, it == bx, true, false, lds, wave); }
#ifdef CHECK_LRU
                GRID_BAR();
                for (int it = bx; it < 1024; it += G) lru_tile(kp, j, it >> 9, (it >> 4) & 31, it & 15, true, lds, wave, true);
#endif
#endif
#ifndef NO_SEL
                for (int rep_ = 0; rep_ < NREP(4); ++rep_)
                for (int u = gw; u < M / 2; u += NGW) { const int b_ = u >> 11, t_ = u & 2047;
                    select_query(kp, b_ * SEQ + t_, lane); select_query(kp, b_ * SEQ + 4095 - t_, lane); }
#endif
                SEAM(ph); }
            ++ph;
            if (IN(ph)) { PHASE_BEGIN();
#ifdef NAIVE_ATTN
                for (int qi = bx; qi < M; qi += G) attn_query(kp, j, qi, lds, wave);
#else
                for (int rep_ = 0; rep_ < NREP(5); ++rep_)
                for (int u = bx; u < 256; u += G) { const int bg = u & 7, cp = u >> 3;

#pragma unroll 1
                    for (int k2 = 0; k2 < 2; ++k2) att::attn_unit<0>(kp, j, bg >> 2, bg & 3, k2 ? cp : 63 - cp, (char*)lds, wave); }
#if PROBE_REP >= 20 && PROBE_REP < 30
                for (int rep_ = 0; rep_ < 2; ++rep_) for (int u = bx; u < 256; u += G) { const int bg = u & 7, cp = u >> 3; att::attn_unit<PROBE_REP - 20>(kp, j, bg >> 2, bg & 3, 63 - cp, (char*)lds, wave); att::attn_unit<PROBE_REP - 20>(kp, j, bg >> 2, bg & 3, cp, (char*)lds, wave); }
#endif
#ifdef CHECK_ATTN
                GRID_BAR();
                for (int qi = bx; qi < M; qi += G) attn_query(kp, j, qi, lds, wave, true);
#endif
#endif
                SEAM(ph); }
            ++ph;
            if (IN(ph)) { PHASE_BEGIN();
                { pg8::Gemm g{YCAT, WEOUT + (size_t)j * 2048 * 4096, M, 2048, 4096}; pg8::StaticOrder S; S.init(M, 2048, G, bx);
                  pg8::EpiOut E{HP, HQ, STB}; pg8::gemm_phase<pg8::EpiOut, pg8::StaticOrder, true, true>(ldsl, g, S, E, wave);
#if PROBE_REP == 12
                  { pg8::EpiOut Ed{HP, (bf16*)(ws + WS_SC), (float*)(ws + WS_SC) + 16 * 1048576}; for (int rep_ = 0; rep_ < 2; ++rep_) pg8::gemm_phase<pg8::EpiOut, pg8::StaticOrder, true, true>(ldsl, g, S, Ed, wave); }
#endif
                }
                SEAM(ph); }
            ++ph;
        } else {
            if (IN(ph)) { PHASE_BEGIN(); pg8::Gemm g{HP, WOIN + (size_t)j * ODD_IN * 2048, M, ODD_IN, 2048}; pg8::StaticOrder S; S.init(M, ODD_IN, G, bx);
                pg8::EpiOddIn E{PROJ, STA, SLN}; for (int rep_ = 0; rep_ < NREP(6); ++rep_) pg8::gemm_phase<pg8::EpiOddIn, pg8::StaticOrder, true, true>(ldsl, g, S, E, wave); SEAM(ph); }
            ++ph;
            if (IN(ph)) { PHASE_BEGIN();
#ifndef NO_SGU
                for (int rep_ = 0; rep_ < NREP(7); ++rep_)
#ifdef NAIVE_SGU
                for (int it = bx; it < 1024; it += G) sgu_item(kp, j, it >> 9, (it >> 4) & 31, it & 15, lds, wave);
#else
                for (int it = bx; it < 1024; it += G) sgu_item_mfma(kp, j, it >> 9, (it >> 4) & 31, it & 15, lds, wave);
#endif
#endif
                SEAM(ph); }
            ++ph;
            if (IN(ph)) { PHASE_BEGIN();
                { pg8::Gemm g{YCAT, WOOUT + (size_t)j * 2048 * 2048, M, 2048, 2048}; pg8::StaticOrder S; S.init(M, 2048, G, bx);
                  pg8::EpiOut E{HP, HQ, STB}; pg8::gemm_phase<pg8::EpiOut, pg8::StaticOrder, true, true>(ldsl, g, S, E, wave);
#if PROBE_REP == 12
                  { pg8::EpiOut Ed{HP, (bf16*)(ws + WS_SC), (float*)(ws + WS_SC) + 16 * 1048576}; for (int rep_ = 0; rep_ < 2; ++rep_) pg8::gemm_phase<pg8::EpiOut, pg8::StaticOrder, true, true>(ldsl, g, S, Ed, wave); }
#endif
                }
                SEAM(ph); }
            ++ph;
        }
        if (IN(ph)) { PHASE_BEGIN(); pg8::Gemm g{HQ, WGATE + (size_t)layer * 2048 * 2048, M, 2048, 2048}; pg8::StaticOrder S; S.init(M, 2048, G, bx);
            typedef pg8::EpiGateT<layer_it == DEPTH - 1> EpiGate;
            EpiGate E{HQ, EB, STB, HP, STA, KOUT}; pg8::gemm_phase<EpiGate, pg8::StaticOrder, true, true>(ldsl, g, S, E, wave);
#if PROBE_REP == 13
            { pg8::EpiGateT<false> Ed{HQ, EB, STB, (bf16*)(ws + WS_SC), (float*)(ws + WS_SC) + 16 * 1048576, nullptr}; for (int rep_ = 0; rep_ < 2; ++rep_) pg8::gemm_phase<pg8::EpiGateT<false>, pg8::StaticOrder, true, true>(ldsl, g, S, Ed, wave); }
#endif

            if (layer_it != DEPTH - 1) SEAM(ph); }
        ++ph;
    }
    {
        constexpr int layer_it = 3;
        if ((layer_it & 1) == 0) {
            if (IN(ph)) { PHASE_BEGIN(); pg8::Gemm g{HP, WEIN + (size_t)j * EVEN_INP * 2048, M, EVEN_INP, 2048}; pg8::StaticOrder S; S.init(M, EVEN_INP, G, bx);
                pg8::EpiEvenIn E{PROJ, IDX, STA, (bf16*)(ws + WS_IDXB)}; for (int rep_ = 0; rep_ < NREP(1); ++rep_) pg8::gemm_phase<pg8::EpiEvenIn, pg8::StaticOrder, true, true>(ldsl, g, S, E, wave);
                if (bx >= 32 && G > 32) {
#pragma unroll 1
                    for (int l2 = 0; l2 < 2; ++l2) { const int ll = layer + l2; pg8::Gemm g2{PBF + (size_t)ll * M * 256, WPE + (size_t)ll * 2048 * 256, M, 2048, 256}; pg8::StaticOrder S2; S2.init(M, 2048, G - 32, bx - 32);
                        pg8::EpiPE E2{EBL(ll)}; pg8::gemm_phase<pg8::EpiPE, pg8::StaticOrder, true, true>(ldsl, g2, S2, E2, wave);  }
                    { LANE_ONLY(); float* scr = (float*)(lds + wave * 16640); const int gw2 = (bx - 32) * NWAVES + wave, NGW2 = (G - 32) * NWAVES; int base = 0, it = gw2;
#define TR2(W, K, N, WT, GK) do { const int ni_ = ((K) / 64) * (((N) + 63) / 64); for (; it < base + ni_; it += NGW2) p0_transpose_item((W), (K), (N), (WT), scr, it - base, lane, (GK)); base += ni_; } while (0)
                      if (layer == 0) { TR2(KIN(4) + (size_t)2048 * EVEN_IN, 2048, EVEN_IN, WEIN + (size_t)EVEN_INP * 2048, KIN(2) + 2 * DM); }
                      else { TR2(KIN(15) + (size_t)2048 * ODD_IN, 2048, ODD_IN, WOIN + (size_t)ODD_IN * 2048, KIN(2) + 3 * DM); TR2(KIN(20) + (size_t)2048 * 2048, 2048, 2048, WOOUT + (size_t)2048 * 2048, nullptr); TR2(KIN(23) + (size_t)3 * 2048 * 2048, 2048, 2048, WGATE + (size_t)3 * 2048 * 2048, KIN(22) + 3 * DM); }
#undef TR2
                    } }
#if PROBE_REP == 11 || PROBE_REP == 14
                __syncthreads();
                { pg8::EpiEvenInT<PROBE_REP == 11 ? 1 : 2> EN{PROJ, IDX, STA, (bf16*)(ws + WS_IDXB)}; for (int rep_ = 0; rep_ < 2; ++rep_) pg8::gemm_phase<pg8::EpiEvenInT<PROBE_REP == 11 ? 1 : 2>, pg8::StaticOrder, true, true>(ldsl, g, S, EN, wave); }
#endif
#if PROBE_REP == 10
                __syncthreads();
                { pg8::EpiNull EN; for (int rep_ = 0; rep_ < 2; ++rep_) pg8::gemm_phase<pg8::EpiNull, pg8::StaticOrder, true, true>(ldsl, g, S, EN, wave); }
#endif
                SEAM(ph); }
            ++ph;
            if (IN(ph)) { PHASE_BEGIN(); LANE_ONLY();
#ifdef NAIVE_LRU
                for (int it = bx; it < 1024; it += G) lru_tile(kp, j, it >> 9, (it >> 4) & 31, it & 15, false, lds, wave);
#else
                for (int rep_ = 0; rep_ < NREP(2); ++rep_)
                for (int it = bx; it < 1024; it += G) lru_tile_mfma(kp, j, it, it + G, it == bx, false, LRU_STREAM != 0, lds, wave);
#endif
#ifndef NO_KN
                for (int it = bx; it < 512; it += G) knorm_item(kp, j, it, wave, lane);
#endif
#ifdef NAIVE_SCORE
                for (int it = bx; it < 4160; it += G) { const int b = it / 2080; int r = it % 2080; int c = 0; while (r >= c + 1) { r -= c + 1; ++c; } score_item(kp, b, c, r, lds, wave); }
#else
                __syncthreads();
                for (int rep_ = 0; rep_ < NREP(3); ++rep_)
                for (int u = gw; u < 2048; u += NGW) { const int ks = u & 7, qg = (u >> 3) & 3, cp = (u >> 5) & 31, b = u >> 10;
                    score_wave_unit(kp, b, cp, qg, ks, lane, lds, wave); score_wave_unit(kp, b, 63 - cp, qg, ks, lane, lds, wave); }
#ifdef CHECK_SCORE
                GRID_BAR();
                for (int it = bx; it < 4160; it += G) { const int b = it / 2080; int r = it % 2080; int c = 0; while (r >= c + 1) { r -= c + 1; ++c; } score_item(kp, b, c, r, lds, wave, true); }
#endif
#endif
                SEAM(ph); }
            ++ph;
            if (IN(ph)) { PHASE_BEGIN(); LANE_ONLY();
#ifdef NAIVE_LRU
                for (int it = bx; it < 1024; it += G) lru_tile(kp, j, it >> 9, (it >> 4) & 31, it & 15, true, lds, wave);
#else
                for (int rep_ = 0; rep_ < NREP(2); ++rep_)
                for (int it = bx; it < 1024; it += (LRU_STREAM ? 4 : 1) * G) { if (LRU_STREAM) { __syncthreads(); lru_carry4(kp, it, G, (float*)lds, wave); __syncthreads();
#pragma unroll 1
                    for (int k4 = 0; k4 < 4; ++k4) if (it + k4 * G < 1024) lru_apply_item(kp, it + k4 * G, (const float*)lds + k4 * 128, wave); }
                  else lru_tile_mfma(kp, j, it, it + G, it == bx, true, false, lds, wave); }
#ifdef CHECK_LRU
                GRID_BAR();
                for (int it = bx; it < 1024; it += G) lru_tile(kp, j, it >> 9, (it >> 4) & 31, it & 15, true, lds, wave, true);
#endif
#endif
#ifndef NO_SEL
                for (int rep_ = 0; rep_ < NREP(4); ++rep_)
                for (int u = gw; u < M / 2; u += NGW) { const int b_ = u >> 11, t_ = u & 2047;
                    select_query(kp, b_ * SEQ + t_, lane); select_query(kp, b_ * SEQ + 4095 - t_, lane); }
#endif
                SEAM(ph); }
            ++ph;
            if (IN(ph)) { PHASE_BEGIN();
#ifdef NAIVE_ATTN
                for (int qi = bx; qi < M; qi += G) attn_query(kp, j, qi, lds, wave);
#else
                for (int rep_ = 0; rep_ < NREP(5); ++rep_)
                for (int u = bx; u < 256; u += G) { const int bg = u & 7, cp = u >> 3;

#pragma unroll 1
                    for (int k2 = 0; k2 < 2; ++k2) att::attn_unit<0>(kp, j, bg >> 2, bg & 3, k2 ? cp : 63 - cp, (char*)lds, wave); }
#if PROBE_REP >= 20 && PROBE_REP < 30
                for (int rep_ = 0; rep_ < 2; ++rep_) for (int u = bx; u < 256; u += G) { const int bg = u & 7, cp = u >> 3; att::attn_unit<PROBE_REP - 20>(kp, j, bg >> 2, bg & 3, 63 - cp, (char*)lds, wave); att::attn_unit<PROBE_REP - 20>(kp, j, bg >> 2, bg & 3, cp, (char*)lds, wave); }
#endif
#ifdef CHECK_ATTN
                GRID_BAR();
                for (int qi = bx; qi < M; qi += G) attn_query(kp, j, qi, lds, wave, true);
#endif
#endif
                SEAM(ph); }
            ++ph;
            if (IN(ph)) { PHASE_BEGIN();
                { pg8::Gemm g{YCAT, WEOUT + (size_t)j * 2048 * 4096, M, 2048, 4096}; pg8::StaticOrder S; S.init(M, 2048, G, bx);
                  pg8::EpiOut E{HP, HQ, STB}; pg8::gemm_phase<pg8::EpiOut, pg8::StaticOrder, true, true>(ldsl, g, S, E, wave);
#if PROBE_REP == 12
                  { pg8::EpiOut Ed{HP, (bf16*)(ws + WS_SC), (float*)(ws + WS_SC) + 16 * 1048576}; for (int rep_ = 0; rep_ < 2; ++rep_) pg8::gemm_phase<pg8::EpiOut, pg8::StaticOrder, true, true>(ldsl, g, S, Ed, wave); }
#endif
                }
                SEAM(ph); }
            ++ph;
        } else {
            if (IN(ph)) { PHASE_BEGIN(); pg8::Gemm g{HP, WOIN + (size_t)j * ODD_IN * 2048, M, ODD_IN, 2048}; pg8::StaticOrder S; S.init(M, ODD_IN, G, bx);
                pg8::EpiOddIn E{PROJ, STA, SLN}; for (int rep_ = 0; rep_ < NREP(6); ++rep_) pg8::gemm_phase<pg8::EpiOddIn, pg8::StaticOrder, true, true>(ldsl, g, S, E, wave); SEAM(ph); }
            ++ph;
            if (IN(ph)) { PHASE_BEGIN();
#ifndef NO_SGU
                for (int rep_ = 0; rep_ < NREP(7); ++rep_)
#ifdef NAIVE_SGU
                for (int it = bx; it < 1024; it += G) sgu_item(kp, j, it >> 9, (it >> 4) & 31, it & 15, lds, wave);
#else
                for (int it = bx; it < 1024; it += G) sgu_item_mfma(kp, j, it >> 9, (it >> 4) & 31, it & 15, lds, wave);
#endif
#endif
                SEAM(ph); }
            ++ph;
            if (IN(ph)) { PHASE_BEGIN();
                { pg8::Gemm g{YCAT, WOOUT + (size_t)j * 2048 * 2048, M, 2048, 2048}; pg8::StaticOrder S; S.init(M, 2048, G, bx);
                  pg8::EpiOut E{HP, HQ, STB}; pg8::gemm_phase<pg8::EpiOut, pg8::StaticOrder, true, true>(ldsl, g, S, E, wave);
#if PROBE_REP == 12
                  { pg8::EpiOut Ed{HP, (bf16*)(ws + WS_SC), (float*)(ws + WS_SC) + 16 * 1048576}; for (int rep_ = 0; rep_ < 2; ++rep_) pg8::gemm_phase<pg8::EpiOut, pg8::StaticOrder, true, true>(ldsl, g, S, Ed, wave); }
#endif
                }
                SEAM(ph); }
            ++ph;
        }
        if (IN(ph)) { PHASE_BEGIN(); pg8::Gemm g{HQ, WGATE + (size_t)layer * 2048 * 2048, M, 2048, 2048}; pg8::StaticOrder S; S.init(M, 2048, G, bx);
            typedef pg8::EpiGateT<layer_it == DEPTH - 1> EpiGate;
            EpiGate E{HQ, EB, STB, HP, STA, KOUT}; pg8::gemm_phase<EpiGate, pg8::StaticOrder, true, true>(ldsl, g, S, E, wave);
#if PROBE_REP == 13
            { pg8::EpiGateT<false> Ed{HQ, EB, STB, (bf16*)(ws + WS_SC), (float*)(ws + WS_SC) + 16 * 1048576, nullptr}; for (int rep_ = 0; rep_ < 2; ++rep_) pg8::gemm_phase<pg8::EpiGateT<false>, pg8::StaticOrder, true, true>(ldsl, g, S, Ed, wave); }
#endif

            if (layer_it != DEPTH - 1) SEAM(ph); }
        ++ph;
    }
#if defined(CHECK_SCORE) || defined(CHECK_ATTN) || defined(CHECK_LRU)
    if (IN(NPHASE - 1)) { KARGS_OPEN(); GRID_BAR(); if (bx == 0 && wave == 0 && lane_id() == 0 && __hip_atomic_load((unsigned*)(KWS + WS_CTL) + 8, __ATOMIC_RELAXED, __HIP_MEMORY_SCOPE_AGENT) != 0u) KOUT[0] = __builtin_nanf(""); }
#endif
#undef IN
#undef SEAM
#undef GRID_BAR
#undef HP
#undef HQ
#undef PROJ
#undef YCAT
#undef IDX
#undef EB
#undef STA
#undef STB
#undef SLN
#undef PBF
#undef WPE
#undef WGATE
#undef WEIN
#undef WEOUT
#undef WOIN
#undef WOOUT
#undef ws
}

extern "C" void kernel_launch(void* const* d_in, const int* in_sizes, int n_in, void* d_out, int out_size, void* d_ws, size_t ws_size, hipStream_t stream) {
    static int grid = 0;
    if (grid == 0) {
        if (n_in != 24 || out_size != M * DM || ws_size < WS_END) { fprintf(stderr, "kernel_launch: unexpected shapes (n_in %d out %d ws %zu)\n", n_in, out_size, ws_size); grid = -1; return; }
        int dev = 0, cus = 0, per_cu = 0;
        if (hipGetDevice(&dev) != hipSuccess || hipDeviceGetAttribute(&cus, hipDeviceAttributeMultiprocessorCount, dev) != hipSuccess) { grid = -1; return; }
        if (hipFuncSetAttribute((const void*)mega_fwd, hipFuncAttributeMaxDynamicSharedMemorySize, LDS_BYTES) != hipSuccess) { fprintf(stderr, "kernel_launch: hipFuncSetAttribute failed\n"); grid = -1; return; }
        if (hipOccupancyMaxActiveBlocksPerMultiprocessor(&per_cu, (const void*)mega_fwd, NTHR, LDS_BYTES) != hipSuccess || per_cu < 1) { fprintf(stderr, "kernel_launch: occupancy query says %d\n", per_cu); }
        (void)hipGetLastError();
        grid = cus;
        if (grid != 256) fprintf(stderr, "kernel_launch: %d CUs (built for 256)\n", grid);
    }
    if (grid < 0) return;
    (void)hipMemsetAsync((char*)d_ws + WS_CTL, 0, CTL_ZERO_BYTES, stream);
    Args a{};
    for (int i = 0; i < 24; ++i) a.in[i] = (const float*)d_in[i];
    a.out = (float*)d_out; a.ws = (unsigned char*)d_ws;
    for (int k = 0; k < 8; ++k) a.thr[k] = 1 << 30;
    for (int n = 8; n < 4096; ++n) { const float nf = (float)n; const float l = (float)log((double)(nf / 8.0f)); const float tt = (l / (float)log(16.0)) * 8.0f; int large = 8 + (int)tt; if (large > 15) large = 15;
        const int k = large - 8; for (int kk = 1; kk <= k; ++kk) if (n < a.thr[kk]) a.thr[kk] = n; }
    if (N_LAUNCHES == 1) { a.ph_lo = 0; a.ph_hi = NPHASE; hipLaunchKernelGGL(mega_fwd, dim3(grid), dim3(NTHR), LDS_BYTES, stream, a); }
    else { for (int p = 0; p < NPHASE; ++p) { a.ph_lo = p; a.ph_hi = p + 1; hipLaunchKernelGGL(mega_fwd, dim3(grid), dim3(NTHR), LDS_BYTES, stream, a); } }
}
```

```cpp
#include <hip/hip_runtime.h>
#include <cstdio>
#include <cstdint>
#include <cmath>
namespace pg8 {
#define PG8_LAS __attribute__((address_space(3)))
typedef unsigned short bf16_t;
typedef short bf16x8 __attribute__((ext_vector_type(8)));
typedef float f32x4 __attribute__((ext_vector_type(4)));
typedef unsigned u32x4 __attribute__((ext_vector_type(4)));
constexpr int BM = 256, BK = 64, HALF = 128, HTB = HALF * BK * 2  , STAGE_BYTES = 8 * HTB, NXCD = 8, WGM = 8;

__host__ __device__ __forceinline__ int lds_byte(int r, int c) { const int st = (r >> 4) * 2 + (c >> 5), rr = r & 15, cc = c & 31, ob = rr * 64 + cc * 2; return st * 1024 + (ob ^ (((ob >> 9) & 1) << 5)); }
__host__ __device__ __forceinline__ void stage_rc(int b, int& R, int& C) { const int st = b / 1024, sb = b % 1024, swz = sb ^ (((sb >> 9) & 1) << 5); R = (st >> 1) * 16 + swz / 64; C = (st & 1) * 32 + (swz % 64) / 2; }
__host__ __device__ __forceinline__ int perm32(int rho) { const int n = rho >> 4, i = rho & 15; return 8 * (i >> 2) + 4 * n + (i & 3); }

struct Unit { int pm, pn; };
struct Gemm { const bf16_t* A; const bf16_t* Bt; int M, N, K; };

struct StaticOrder {
    int nM, nN, nwg, G, c;
    __host__ __device__ void init(int M, int N, int G_, int c_) { nM = M / BM; nN = N / BM; nwg = nM * nN; G = G_; c = c_; }
    __host__ __device__ bool next(int i, Unit& u) const {
        const long L = (long)i * G + c; if (L >= nwg) return false;
        int wgid = (int)L; { const int q = nwg / NXCD, r = nwg % NXCD, xcd = wgid % NXCD, off = wgid / NXCD; wgid = (xcd < r ? xcd * (q + 1) : r * (q + 1) + (xcd - r) * q) + off; }
        const int nig = WGM * nN, gid = wgid / nig, fm = gid * WGM, gsz = (nM - fm) < WGM ? (nM - fm) : WGM;
        u.pm = fm + ((wgid % nig) % gsz); u.pn = (wgid % nig) / gsz; return true;
    }
    __device__ __forceinline__ void a_ready(const Unit&) const {}
    __device__ __forceinline__ void done(const Unit&) const {}
};

__device__ __forceinline__ unsigned cvt_pk_bf16(float lo, float hi) { unsigned r; asm volatile("v_cvt_pk_bf16_f32 %0, %1, %2" : "=v"(r) : "v"(lo), "v"(hi)); return r; }
typedef float f32x2 __attribute__((ext_vector_type(2)));
#ifdef EPI_NT
#define ST16(p, v) __builtin_nontemporal_store((v), (p))
#else
#define ST16(p, v) (*(p) = (v))
#endif
__device__ __forceinline__ float fast_sigmoid(float x) { return __builtin_amdgcn_rcpf(1.0f + __builtin_amdgcn_exp2f(x * -1.4426950408889634f)); }
__device__ __forceinline__ float silu_f(float x) { return x * fast_sigmoid(x); }
__device__ __forceinline__ float gelu_tanh_f(float x) { const float z = 1.5957691216057308f * (x + 0.044715f * x * x * x); return x * fast_sigmoid(z); }
__device__ __forceinline__ float xrow16_sum(float x) {
    auto s = __builtin_amdgcn_permlane16_swap(__float_as_uint(x), __float_as_uint(x), false, false);
    x = __uint_as_float(s[0]) + __uint_as_float(s[1]);
    auto t = __builtin_amdgcn_permlane32_swap(__float_as_uint(x), __float_as_uint(x), false, false);
    return __uint_as_float(t[0]) + __uint_as_float(t[1]);
}
__device__ __forceinline__ float bf2f(unsigned short v) { return __uint_as_float(((unsigned)v) << 16); }
__device__ __forceinline__ float row_rstd32(const float* part, int fq) {
    const f32x4 a = *(const f32x4*)(part + fq * 8), b = *(const f32x4*)(part + fq * 8 + 4);
    float s = ((a[0] + a[1]) + (a[2] + a[3])) + ((b[0] + b[1]) + (b[2] + b[3]));
    s = xrow16_sum(s);
    return __builtin_amdgcn_rsqf(s * (1.0f / 2048.0f) + 1e-6f);
}
__device__ __forceinline__ u32x4 pack8(const f32x4 v0, const f32x4 v1) { u32x4 w; w.x = cvt_pk_bf16(v0[0], v0[1]); w.y = cvt_pk_bf16(v0[2], v0[3]); w.z = cvt_pk_bf16(v1[0], v1[1]); w.w = cvt_pk_bf16(v1[2], v1[3]); return w; }

template <int NOSTORE> struct EpiEvenInT {
    static constexpr bool PERM = true, AFTER_DRAIN = false, PRE_STATS = true;
    bf16_t* PROJ; float* IDX; const float* stats; bf16_t* IDXB;
    __device__ __forceinline__ void operator()(const f32x4 (&acc)[2][2][4][2], const Unit& u, int wr, int wc, int fr, int fq, const float (&rs)[2][4]) const {
        const int rowb = u.pm * BM + wr * 64 + fr, pn = u.pn;
        if (pn < 36) {
            const bool act = __builtin_amdgcn_readfirstlane((int)((pn >= 8 && pn < 16) || (pn >= 28))) != 0;
            if (act) {
#pragma unroll
                for (int ai = 0; ai < 2; ++ai)
#pragma unroll
                    for (int m = 0; m < 4; ++m) { bf16_t* rowp = PROJ + (size_t)(rowb + ai * HALF + m * 16) * 9216 + pn * BM + wc * 32 + fq * 8; const float r = rs[ai][m];
#pragma unroll
                        for (int bj = 0; bj < 2; ++bj) { f32x4 v0 = acc[ai][bj][m][0] * r, v1 = acc[ai][bj][m][1] * r;
#pragma unroll
                            for (int i = 0; i < 4; ++i) { v0[i] = silu_f(v0[i]); v1[i] = silu_f(v1[i]); }
                            const u32x4 pk_ = pack8(v0, v1); if (NOSTORE) asm volatile("" :: "v"(pk_)); else ST16((u32x4*)(rowp + bj * HALF), pk_); } }
            } else {
#pragma unroll
                for (int ai = 0; ai < 2; ++ai)
#pragma unroll
                    for (int m = 0; m < 4; ++m) { bf16_t* rowp = PROJ + (size_t)(rowb + ai * HALF + m * 16) * 9216 + pn * BM + wc * 32 + fq * 8; const float r = rs[ai][m];
#pragma unroll
                        for (int bj = 0; bj < 2; ++bj) { const f32x4 v0 = acc[ai][bj][m][0] * r, v1 = acc[ai][bj][m][1] * r;
                            const u32x4 pk_ = pack8(v0, v1); if (NOSTORE) asm volatile("" :: "v"(pk_)); else ST16((u32x4*)(rowp + bj * HALF), pk_); } }
            }
        } else {
#ifdef CHECK_SCORE
            const bool f32too = true;
#else
            const bool f32too = __builtin_amdgcn_readfirstlane((int)(pn == 40)) != 0;
#endif
#pragma unroll
            for (int ai = 0; ai < 2; ++ai)
#pragma unroll
                for (int m = 0; m < 4; ++m) { float* rowp = IDX + (size_t)(rowb + ai * HALF + m * 16) * 1280 + (pn - 36) * BM + wc * 32 + fq * 8; const float r = rs[ai][m];
                    bf16_t* rowb16 = IDXB + (size_t)(rowb + ai * HALF + m * 16) * 1280 + (pn - 36) * BM + wc * 32 + fq * 8;
#pragma unroll
                    for (int bj = 0; bj < 2; ++bj) { const f32x4 v0 = acc[ai][bj][m][0] * r, v1 = acc[ai][bj][m][1] * r; if (f32too) { ST16((f32x4*)(rowp + bj * HALF), v0); ST16((f32x4*)(rowp + bj * HALF + 4), v1); } ST16((u32x4*)(rowb16 + bj * HALF), pack8(v0, v1)); } }
        }
    }
};
typedef EpiEvenInT<0> EpiEvenIn;
struct EpiOddIn {
    static constexpr bool PERM = true, AFTER_DRAIN = false, PRE_STATS = true;
    bf16_t* PROJ; const float* stats; float* statsLN;
    __device__ __forceinline__ void operator()(const f32x4 (&acc)[2][2][4][2], const Unit& u, int wr, int wc, int fr, int fq, const float (&rs)[2][4]) const {
        const int rowb = u.pm * BM + wr * 64 + fr, pn = u.pn;
#define EPO_BODY(ACTF) _Pragma("unroll") for (int ai = 0; ai < 2; ++ai) _Pragma("unroll") for (int m = 0; m < 4; ++m) { const int row = rowb + ai * HALF + m * 16; bf16_t* rowp = PROJ + (size_t)row * 6144 + pn * BM + wc * 32 + fq * 8; const float r = rs[ai][m]; \
                float s1 = 0.f, s2 = 0.f; \
                _Pragma("unroll") for (int bj = 0; bj < 2; ++bj) { f32x4 v0 = acc[ai][bj][m][0] * r, v1 = acc[ai][bj][m][1] * r; \
                    _Pragma("unroll") for (int i = 0; i < 4; ++i) { v0[i] = ACTF(v0[i]); v1[i] = ACTF(v1[i]); } \
                    _Pragma("unroll") for (int i = 0; i < 4; ++i) { s1 += v0[i] + v1[i]; s2 += v0[i] * v0[i] + v1[i] * v1[i]; } \
                    ST16((u32x4*)(rowp + bj * HALF), pack8(v0, v1)); } \
                if (stat) { s1 = xrow16_sum(s1); s2 = xrow16_sum(s2); if (fq == 0) { float* sp = statsLN + ((size_t)row * 32 + (pn - 8) * 4 + wc) * 2; sp[0] = s1; sp[1] = s2; } } }
        const bool isg = __builtin_amdgcn_readfirstlane((int)(pn < 16)) != 0, stat = __builtin_amdgcn_readfirstlane((int)(pn >= 8 && pn < 16)) != 0;
        if (isg) { EPO_BODY(gelu_tanh_f) } else { EPO_BODY(silu_f) }
#undef EPO_BODY
    }
};
__device__ __forceinline__ void unpack8(const u32x4 w, f32x4& a, f32x4& b) {
    a[0] = __uint_as_float(w.x << 16); a[1] = __uint_as_float(w.x & 0xffff0000u); a[2] = __uint_as_float(w.y << 16); a[3] = __uint_as_float(w.y & 0xffff0000u);
    b[0] = __uint_as_float(w.z << 16); b[1] = __uint_as_float(w.z & 0xffff0000u); b[2] = __uint_as_float(w.w << 16); b[3] = __uint_as_float(w.w & 0xffff0000u); }
struct EpiOut {
    static constexpr bool PERM = true, AFTER_DRAIN = false, PRE_STATS = false;
    const bf16_t* hin; bf16_t* hout; float* statsO;
    __device__ __forceinline__ void operator()(const f32x4 (&acc_)[2][2][4][2], const Unit& u, int wr, int wc, int fr, int fq) const {
        f32x4 (&acc)[2][2][4][2] = const_cast<f32x4 (&)[2][2][4][2]>(acc_);
        const int rowb = u.pm * BM + wr * 64 + fr, col0 = u.pn * BM + wc * 32 + fq * 8;
        float ssr[2][4];
#pragma unroll
        for (int ai = 0; ai < 2; ++ai)
#pragma unroll
            for (int m = 0; m < 4; ++m) { const int row = rowb + ai * HALF + m * 16; float ss = 0.f;
#pragma unroll
                for (int bj = 0; bj < 2; ++bj) { const size_t off = (size_t)row * 2048 + col0 + bj * HALF;
                    f32x4 h0, h1; unpack8(*(const u32x4*)(hin + off), h0, h1); h0 += acc[ai][bj][m][0]; h1 += acc[ai][bj][m][1];
                    acc[ai][bj][m][0] = h0; acc[ai][bj][m][1] = h1;
#pragma unroll
                    for (int i = 0; i < 4; ++i) ss += h0[i] * h0[i] + h1[i] * h1[i]; }
                ssr[ai][m] = xrow16_sum(ss); if (m == 3) asm volatile("" ::: "memory"); }
        asm volatile("" ::: "memory");
#pragma unroll
        for (int ai = 0; ai < 2; ++ai)
#pragma unroll
            for (int m = 0; m < 4; ++m) { const int row = rowb + ai * HALF + m * 16;
#pragma unroll
                for (int bj = 0; bj < 2; ++bj) { const size_t off = (size_t)row * 2048 + col0 + bj * HALF; ST16((u32x4*)(hout + off), pack8(acc[ai][bj][m][0], acc[ai][bj][m][1])); }
                if (fq == 0) statsO[(size_t)row * 32 + u.pn * 4 + wc] = ssr[ai][m]; }
    }
};
struct EpiPE {
    static constexpr bool PERM = true, AFTER_DRAIN = false, PRE_STATS = false;
    bf16_t* E;
    __device__ __forceinline__ void operator()(const f32x4 (&acc)[2][2][4][2], const Unit& u, int wr, int wc, int fr, int fq) const {
        const int rowb = u.pm * BM + wr * 64 + fr, col0 = u.pn * BM + wc * 32 + fq * 8;
#pragma unroll
        for (int ai = 0; ai < 2; ++ai)
#pragma unroll
            for (int m = 0; m < 4; ++m)
#pragma unroll
                for (int bj = 0; bj < 2; ++bj) ST16((u32x4*)(E + (size_t)(rowb + ai * HALF + m * 16) * 2048 + col0 + bj * HALF), pack8(acc[ai][bj][m][0], acc[ai][bj][m][1]));
    }
};
template <bool LAST> struct EpiGateT {
    static constexpr bool PERM = true, AFTER_DRAIN = false, PRE_STATS = true;
    const bf16_t* hin; const bf16_t* E; const float* stats; bf16_t* hout; float* statsO; float* fout;
    __device__ __forceinline__ void operator()(const f32x4 (&acc_)[2][2][4][2], const Unit& u, int wr, int wc, int fr, int fq, const float (&rs_)[2][4]) const {
        f32x4 (&acc)[2][2][4][2] = const_cast<f32x4 (&)[2][2][4][2]>(acc_);
        const int rowb = u.pm * BM + wr * 64 + fr, col0 = u.pn * BM + wc * 32 + fq * 8;
        float rs[2][4];
#pragma unroll
        for (int ai = 0; ai < 2; ++ai)
#pragma unroll
            for (int m = 0; m < 4; ++m) rs[ai][m] = rs_[ai][m];
#pragma unroll
        for (int ai = 0; ai < 2; ++ai)
#pragma unroll
            for (int m = 0; m < 4; ++m) { const int row = rowb + ai * HALF + m * 16; const float r = rs[ai][m]; float ss = 0.f;
#pragma unroll
                for (int bj = 0; bj < 2; ++bj) { const size_t off = (size_t)row * 2048 + col0 + bj * HALF;
                    f32x4 e0, e1, h0, h1; unpack8(*(const u32x4*)(E + off), e0, e1); unpack8(*(const u32x4*)(hin + off), h0, h1);
                    f32x4 g0 = acc[ai][bj][m][0] * r, g1 = acc[ai][bj][m][1] * r;
#pragma unroll
                    for (int i = 0; i < 4; ++i) { g0[i] = fast_sigmoid(g0[i]); g1[i] = fast_sigmoid(g1[i]); }
                    h0 += g0 * e0; h1 += g1 * e1;
                    acc[ai][bj][m][0] = h0; acc[ai][bj][m][1] = h1;
#pragma unroll
                    for (int i = 0; i < 4; ++i) ss += h0[i] * h0[i] + h1[i] * h1[i]; }
                if (!LAST) rs[ai][m] = xrow16_sum(ss);
                if (m == 3) asm volatile("" ::: "memory"); }
        asm volatile("" ::: "memory");
#pragma unroll
        for (int ai = 0; ai < 2; ++ai)
#pragma unroll
            for (int m = 0; m < 4; ++m) { const int row = rowb + ai * HALF + m * 16;
#pragma unroll
                for (int bj = 0; bj < 2; ++bj) { const size_t off = (size_t)row * 2048 + col0 + bj * HALF; const f32x4 h0 = acc[ai][bj][m][0], h1 = acc[ai][bj][m][1];
                    if (LAST) { ST16((f32x4*)(fout + off), h0); ST16((f32x4*)(fout + off + 4), h1); } else ST16((u32x4*)(hout + off), pack8(h0, h1)); }
                if (!LAST) { if (fq == 0) statsO[(size_t)row * 32 + u.pn * 4 + wc] = rs[ai][m]; } }
    }
};

struct EpiNull {
    static constexpr bool PERM = true, AFTER_DRAIN = false, PRE_STATS = false;
    __device__ __forceinline__ void operator()(const f32x4 (&acc)[2][2][4][2], const Unit& u, int wr, int wc, int fr, int fq) const {
#pragma unroll
        for (int ai = 0; ai < 2; ++ai)
#pragma unroll
            for (int bj = 0; bj < 2; ++bj) asm volatile("" :: "v"(acc[ai][bj][0][0]), "v"(acc[ai][bj][0][1]), "v"(acc[ai][bj][1][0]), "v"(acc[ai][bj][1][1]), "v"(acc[ai][bj][2][0]), "v"(acc[ai][bj][2][1]), "v"(acc[ai][bj][3][0]), "v"(acc[ai][bj][3][1])); }
};
template <class Epi, class Sched, bool ALIGN_EPI = false, bool SP2 = false>
__device__ __forceinline__ void gemm_phase(PG8_LAS unsigned char* lds, const Gemm g, const Sched& S, const Epi& E, const int wid_in) {
    int tid_; asm volatile("v_mbcnt_lo_u32_b32 %0, -1, 0\n\tv_mbcnt_hi_u32_b32 %0, -1, %0" : "=v"(tid_)); int wid = wid_in; asm volatile("" : "+s"(wid)); tid_ += wid * 64; asm volatile("" : "+v"(tid_));
    const int tid = tid_, lane = tid & 63, wr = wid >> 2, wc = wid & 3, fr = lane & 15, fq = lane >> 4;
    const int K = g.K, nt = K / BK;
    unsigned voffA[2], voffB[2];
#pragma unroll
    for (int i = 0; i < 2; ++i) { int R, C; stage_rc(tid * 16 + i * 8192, R, C); const int Rb = Epi::PERM ? ((R & ~31) + perm32(R & 31)) : R;
        voffA[i] = (unsigned)(R * K + C) * 2u; voffB[i] = (unsigned)(Rb * K + C) * 2u; }
    const size_t kstep = (size_t)(BK * 2);
    const size_t hstep = (size_t)HALF * K * 2;
    const size_t tstep = 2 * hstep;
    const unsigned ldsw = (unsigned)wid * 1024u;
    const int aoff = lds_byte(wr * 64 + fr, fq * 8), boff = lds_byte(wc * 32 + fr, fq * 8);
#define PG8_SA(b, h) (((b) * 2 + (h)) * HTB)
#define PG8_SB(b, h) ((4 + (b) * 2 + (h)) * HTB)
#define PG8_STAGE(bufoff, gbase, voff) do { _Pragma("unroll") for (int _i = 0; _i < 2; ++_i) \
        __builtin_amdgcn_global_load_lds((const unsigned*)((const char*)(gbase) + (voff)[_i]), (PG8_LAS unsigned*)(lds + (bufoff) + ldsw + _i * 8192), 16, 0, 0); } while (0)
#define PG8_LDA(dst, b, h) do { _Pragma("unroll") for (int m = 0; m < 4; ++m) _Pragma("unroll") for (int k = 0; k < 2; ++k) dst[m][k] = *(const PG8_LAS bf16x8*)(lds + PG8_SA(b, h) + aoff + m * 2048 + k * 1024); } while (0)
#define PG8_LDB(dst, b, h) do { _Pragma("unroll") for (int n = 0; n < 2; ++n) _Pragma("unroll") for (int k = 0; k < 2; ++k) dst[n][k] = *(const PG8_LAS bf16x8*)(lds + PG8_SB(b, h) + boff + n * 2048 + k * 1024); } while (0)
#define PG8_MMA(ai, bj, At, Bt) do { __builtin_amdgcn_s_setprio(1); _Pragma("unroll") for (int m = 0; m < 4; ++m) _Pragma("unroll") for (int n = 0; n < 2; ++n) _Pragma("unroll") for (int k = 0; k < 2; ++k) \
        acc[ai][bj][m][n] = __builtin_amdgcn_mfma_f32_16x16x32_bf16(Bt[n][k], At[m][k], acc[ai][bj][m][n], 0, 0, 0); __builtin_amdgcn_s_setprio(0); } while (0)
#define PG8_WAIT_V(n) asm volatile("s_waitcnt vmcnt(" #n ")" ::: "memory")
#define PG8_WAIT_L(n) asm volatile("s_waitcnt lgkmcnt(" #n ")" ::: "memory")
#define PG8_BAR __builtin_amdgcn_s_barrier()
#define PG8_SCHED __builtin_amdgcn_sched_barrier(0)
    Unit cur, nxt; int ui = 0;
    if (!S.next(0, cur)) return;
    f32x4 acc[2][2][4][2];
#pragma unroll
    for (int a = 0; a < 2; ++a)
#pragma unroll
        for (int b = 0; b < 2; ++b)
#pragma unroll
            for (int m = 0; m < 4; ++m)
#pragma unroll
                for (int n = 0; n < 2; ++n) acc[a][b][m][n] = (f32x4){0.f, 0.f, 0.f, 0.f};
    bf16x8 At[4][2], B0[2][2], B1[2][2];
    const char* cA = (const char*)g.A + (size_t)cur.pm * tstep; const char* cB = (const char*)g.Bt + (size_t)cur.pn * tstep;
    S.a_ready(cur);
    if constexpr (SP2) {
        PG8_STAGE(PG8_SB(0, 0), cB, voffB); PG8_STAGE(PG8_SB(0, 1), cB + hstep, voffB); PG8_STAGE(PG8_SA(0, 0), cA, voffA); PG8_STAGE(PG8_SA(0, 1), cA + hstep, voffA);
        if constexpr (Epi::PRE_STATS) {
            const int prow = tid >> 1, phalf = tid & 1;
#pragma unroll 1
            for (int i0 = 0; ; i0 += 3) { Unit uu[3]; bool hv[3];
#pragma unroll
                for (int q = 0; q < 3; ++q) { hv[q] = S.next(i0 + q, uu[q]); if (!hv[q]) uu[q] = cur; }
                if (!hv[0]) break;
                f32x4 pv[3][4];
#pragma unroll
                for (int q = 0; q < 3; ++q) { const float* sp = E.stats + ((size_t)(uu[q].pm * BM + prow) * 32 + phalf * 16);
#pragma unroll
                    for (int x = 0; x < 4; ++x) pv[q][x] = *(const f32x4*)(sp + 4 * x); }
#pragma unroll
                for (int q = 0; q < 3; ++q) { const f32x4 t4 = (pv[q][0] + pv[q][1]) + (pv[q][2] + pv[q][3]); float sq = (t4[0] + t4[1]) + (t4[2] + t4[3]);
                    sq += __int_as_float(__builtin_amdgcn_mov_dpp(__float_as_int(sq), 0xB1, 0xF, 0xF, true));
                    if (hv[q]) *(PG8_LAS float*)(lds + STAGE_BYTES + ((i0 + q) * 256 + prow) * 4) = __builtin_amdgcn_rsqf(sq * (1.0f / 2048.0f) + 1e-6f); }
                if (!hv[2]) break; }
        }
        if (wr == 1) PG8_BAR;
        PG8_WAIT_V(2); PG8_BAR;
        PG8_STAGE(PG8_SB(1, 0), cB + kstep, voffB); PG8_STAGE(PG8_SA(1, 0), cA + kstep, voffA); PG8_STAGE(PG8_SB(1, 1), cB + hstep + kstep, voffB);
        PG8_WAIT_V(6); PG8_BAR;
    } else {
        PG8_STAGE(PG8_SB(0, 0), cB, voffB); PG8_STAGE(PG8_SA(0, 0), cA, voffA); PG8_STAGE(PG8_SB(0, 1), cB + hstep, voffB); PG8_STAGE(PG8_SA(0, 1), cA + hstep, voffA);
        if (wr == 1) PG8_BAR;
        PG8_WAIT_V(4); PG8_BAR;
        PG8_STAGE(PG8_SB(1, 0), cB + kstep, voffB); PG8_STAGE(PG8_SA(1, 0), cA + kstep, voffA); PG8_STAGE(PG8_SB(1, 1), cB + hstep + kstep, voffB);
        PG8_WAIT_V(6); PG8_BAR;
    }
    for (;;) {
        const bool has_next = S.next(ui + 1, nxt);
        const char* nA = has_next ? (const char*)g.A + (size_t)nxt.pm * tstep : cA; const char* nB = has_next ? (const char*)g.Bt + (size_t)nxt.pn * tstep : cB;
        for (int t = 0; t < nt; t += 2) {
            const bool last = (t == nt - 2);
            const char* a1 = cA + (size_t)(t + 1) * kstep;
            const char* a2 = last ? nA : cA + (size_t)(t + 2) * kstep; const char* b2 = last ? nB : cB + (size_t)(t + 2) * kstep;
            const char* a3 = a2 + kstep; const char* b3 = b2 + kstep;
            if (last && has_next) S.a_ready(nxt);
            if constexpr (SP2) {
            PG8_LDB(B0, 0, 0); PG8_LDB(B1, 0, 1); PG8_SCHED; PG8_LDA(At, 0, 0); PG8_STAGE(PG8_SA(1, 1), a1 + hstep, voffA);
            PG8_WAIT_V(8); PG8_WAIT_L(0); PG8_BAR; PG8_MMA(0, 0, At, B0); PG8_MMA(0, 1, At, B1); PG8_BAR; PG8_SCHED;
            PG8_LDA(At, 0, 1); PG8_STAGE(PG8_SB(0, 0), b2, voffB); PG8_STAGE(PG8_SB(0, 1), b2 + hstep, voffB); PG8_STAGE(PG8_SA(0, 0), a2, voffA);
            PG8_WAIT_V(8); PG8_WAIT_L(0); PG8_BAR; PG8_MMA(1, 0, At, B0); PG8_MMA(1, 1, At, B1); PG8_BAR; PG8_SCHED;
            PG8_LDB(B0, 1, 0); PG8_LDB(B1, 1, 1); PG8_SCHED; PG8_LDA(At, 1, 0); PG8_STAGE(PG8_SA(0, 1), a2 + hstep, voffA);
            PG8_WAIT_V(8); PG8_WAIT_L(0); PG8_BAR; PG8_MMA(0, 0, At, B0); PG8_MMA(0, 1, At, B1); PG8_BAR; PG8_SCHED;
            PG8_LDA(At, 1, 1); PG8_STAGE(PG8_SB(1, 0), b3, voffB); PG8_STAGE(PG8_SB(1, 1), b3 + hstep, voffB); PG8_STAGE(PG8_SA(1, 0), a3, voffA);
            PG8_WAIT_V(8); PG8_WAIT_L(0); PG8_BAR; PG8_MMA(1, 0, At, B0); PG8_MMA(1, 1, At, B1); PG8_BAR; PG8_SCHED;
            } else {
            PG8_LDB(B0, 0, 0); PG8_SCHED; PG8_LDA(At, 0, 0); PG8_STAGE(PG8_SA(1, 1), a1 + hstep, voffA);
            PG8_WAIT_L(8); PG8_BAR; PG8_WAIT_L(0); PG8_MMA(0, 0, At, B0); PG8_BAR; PG8_SCHED;
            PG8_LDB(B1, 0, 1); PG8_STAGE(PG8_SB(0, 0), b2, voffB);
            PG8_BAR; PG8_WAIT_L(0); PG8_MMA(0, 1, At, B1); PG8_BAR;
            PG8_LDA(At, 0, 1); PG8_STAGE(PG8_SA(0, 0), a2, voffA);
            PG8_BAR; PG8_WAIT_L(0); PG8_MMA(1, 0, At, B0); PG8_BAR; PG8_SCHED;
            PG8_STAGE(PG8_SB(0, 1), b2 + hstep, voffB);
            PG8_WAIT_V(6); PG8_BAR; PG8_MMA(1, 1, At, B1); PG8_BAR;
            PG8_LDB(B0, 1, 0); PG8_SCHED; PG8_LDA(At, 1, 0); PG8_STAGE(PG8_SA(0, 1), a2 + hstep, voffA);
            PG8_WAIT_L(8); PG8_BAR; PG8_WAIT_L(0); PG8_MMA(0, 0, At, B0); PG8_BAR; PG8_SCHED;
            PG8_LDB(B1, 1, 1); PG8_STAGE(PG8_SB(1, 0), b3, voffB);
            PG8_BAR; PG8_WAIT_L(0); PG8_MMA(0, 1, At, B1); PG8_BAR;
            PG8_LDA(At, 1, 1); PG8_STAGE(PG8_SA(1, 0), a3, voffA);
            PG8_BAR; PG8_WAIT_L(0); PG8_MMA(1, 0, At, B0); PG8_BAR; PG8_SCHED;
            PG8_STAGE(PG8_SB(1, 1), b3 + hstep, voffB);
            PG8_WAIT_V(6); PG8_BAR; PG8_MMA(1, 1, At, B1); PG8_BAR;
            }
        }
        if constexpr (ALIGN_EPI) { if (wr == 0) PG8_BAR; }
        if constexpr (Epi::PRE_STATS) { float rs[2][4];
#pragma unroll
            for (int ai = 0; ai < 2; ++ai)
#pragma unroll
                for (int m = 0; m < 4; ++m) rs[ai][m] = *(const PG8_LAS float*)(lds + STAGE_BYTES + (ui * 256 + ai * HALF + wr * 64 + m * 16 + fr) * 4);
            E(acc, cur, wr, wc, fr, fq, rs); S.done(cur); }
        else if constexpr (!Epi::AFTER_DRAIN) { E(acc, cur, wr, wc, fr, fq); S.done(cur); }
        if (!has_next) break;
#pragma unroll
        for (int a = 0; a < 2; ++a)
#pragma unroll
            for (int b = 0; b < 2; ++b)
#pragma unroll
                for (int m = 0; m < 4; ++m)
#pragma unroll
                    for (int n = 0; n < 2; ++n) acc[a][b][m][n] = (f32x4){0.f, 0.f, 0.f, 0.f};
        cur = nxt; cA = nA; cB = nB; ++ui;
        if constexpr (ALIGN_EPI) { if (wr == 1) PG8_BAR; }
    }
    PG8_WAIT_V(0);
    if constexpr (!ALIGN_EPI) { if (wr == 0) PG8_BAR; }
    PG8_BAR;
    if constexpr (Epi::AFTER_DRAIN) { E.fused(acc, cur, wr, wc, fr, fq, lds, wid, lane); S.done(cur); }
#undef PG8_SA
#undef PG8_SB
#undef PG8_STAGE
#undef PG8_LDA
#undef PG8_LDB
#undef PG8_MMA
#undef PG8_WAIT_V
#undef PG8_WAIT_L
#undef PG8_BAR
#undef PG8_SCHED
}
}

#ifndef LRU_STREAM
#define LRU_STREAM 1
#endif
constexpr int NWAVES = 8, NTHR = 512;
constexpr int BATCH = 2, SEQ = 4096, DM = 2048, M = BATCH * SEQ, DEPTH = 4;
constexpr int EVEN_IN = 10320, EVEN_INP = 10496, PROJ_LD = 9216, ODD_IN = 6144, IDX_LD = 1280;
constexpr int COL_GA = 2048, COL_Q = 4096, COL_K = 6144, COL_V = 6656, COL_GB = 7168;
constexpr int TOPK = 256;
#ifndef N_LAUNCHES
#define N_LAUNCHES 1
#endif
constexpr int NPHASE = 1 + 2 * 6 + 2 * 4;
#ifndef PROBE_REP
#define PROBE_REP 0
#endif
#define NREP(n) ((PROBE_REP == (n)) ? 3 : 1)

constexpr size_t MiB = 1u << 20;
constexpr size_t WS_CTL = 0, CTL_ZERO_BYTES = 32768;
constexpr size_t WS_STATA = 1 * MiB, WS_STATB = 2 * MiB, WS_STATLN = 3 * MiB, WS_LRUSUM = 5 * MiB, WS_BM = 6 * MiB, WS_KN = 10 * MiB, WS_PBF = 18 * MiB;
constexpr size_t WS_WSMALL = 34 * MiB, WS_WPE = 38 * MiB, WS_WGATE = 42 * MiB, WS_WEIN = 74 * MiB, WS_WEOUT = 156 * MiB, WS_WOIN = 188 * MiB, WS_WOOUT = 236 * MiB;
constexpr size_t WS_H = 252 * MiB, WS_AN = 316 * MiB, WS_PROJ = 348 * MiB, WS_YCAT = 492 * MiB, WS_IDX = WS_YCAT, WS_IDXB = WS_YCAT + 40 * MiB, WS_SC = 556 * MiB, WS_E = WS_SC, WS_END = 622 * MiB;
constexpr size_t SCB = (size_t)4096 * 64 * 65 / 2;
static_assert(WS_IDXB + (size_t)M * IDX_LD * 2 <= WS_SC && WS_SC + 2 * SCB * 4 <= WS_END && WS_IDX + (size_t)M * IDX_LD * 4 <= WS_SC && WS_PROJ + (size_t)M * PROJ_LD * 2 <= WS_YCAT, "ws map");
constexpr int CW_BAR = 4096;
static_assert((CW_BAR + 3456) * 4 <= (int)CTL_ZERO_BYTES, "control words inside the memset");

constexpr int RING_BYTES = 131072, LDS_BYTES = 147456, MISC_OFF = LDS_BYTES - 256, XTRA_OFF = RING_BYTES;

#define GAS __attribute__((address_space(1)))
#define LAS __attribute__((address_space(3)))
typedef unsigned short bf16;
typedef unsigned v4u __attribute__((ext_vector_type(4)));
typedef unsigned v2u __attribute__((ext_vector_type(2)));
typedef float f32x4 __attribute__((ext_vector_type(4)));
typedef GAS unsigned gu32;
#define RLX_AGENT __ATOMIC_RELAXED, __HIP_MEMORY_SCOPE_AGENT
#define LDS_WAIT() asm volatile("s_waitcnt lgkmcnt(0)" ::: "memory")
__device__ __forceinline__ unsigned f2bf(float f) { unsigned u = __builtin_bit_cast(unsigned, f); return (u + 0x7fffu + ((u >> 16) & 1u)) >> 16; }
__device__ __forceinline__ unsigned pk2(float lo, float hi) { return f2bf(lo) | (f2bf(hi) << 16); }
__device__ __forceinline__ float bflo(unsigned w) { return __uint_as_float(w << 16); }
__device__ __forceinline__ float bfhi(unsigned w) { return __uint_as_float(w & 0xffff0000u); }
__device__ __forceinline__ float bf2f(bf16 v) { return __uint_as_float(((unsigned)v) << 16); }
__device__ __forceinline__ float shx(float v, int o, int lane) { return __int_as_float(__builtin_amdgcn_ds_bpermute((lane ^ o) << 2, __float_as_int(v))); }
__device__ __forceinline__ int shx_i(int v, int o, int lane) { return __builtin_amdgcn_ds_bpermute((lane ^ o) << 2, v); }
__device__ __forceinline__ int wave_sum_i(int v, int lane) {
    v += __builtin_amdgcn_update_dpp(0, v, 0x111, 0xF, 0xF, true); v += __builtin_amdgcn_update_dpp(0, v, 0x112, 0xF, 0xF, true);
    v += __builtin_amdgcn_update_dpp(0, v, 0x114, 0xF, 0xF, true); v += __builtin_amdgcn_update_dpp(0, v, 0x118, 0xF, 0xF, true);
    v += __builtin_amdgcn_update_dpp(0, v, 0x142, 0xA, 0xF, true); v += __builtin_amdgcn_update_dpp(0, v, 0x143, 0xC, 0xF, true);
    return __builtin_amdgcn_readlane(v, 63);
}
__device__ __forceinline__ float wave_sum(float v, int lane) {
    v += __int_as_float(__builtin_amdgcn_update_dpp(0, __float_as_int(v), 0x111, 0xF, 0xF, true)); v += __int_as_float(__builtin_amdgcn_update_dpp(0, __float_as_int(v), 0x112, 0xF, 0xF, true));
    v += __int_as_float(__builtin_amdgcn_update_dpp(0, __float_as_int(v), 0x114, 0xF, 0xF, true)); v += __int_as_float(__builtin_amdgcn_update_dpp(0, __float_as_int(v), 0x118, 0xF, 0xF, true));
    v += __int_as_float(__builtin_amdgcn_update_dpp(0, __float_as_int(v), 0x142, 0xA, 0xF, true)); v += __int_as_float(__builtin_amdgcn_update_dpp(0, __float_as_int(v), 0x143, 0xC, 0xF, true));
    return __int_as_float(__builtin_amdgcn_readlane(__float_as_int(v), 63));
}
__device__ __forceinline__ int lane_id() { int l; asm volatile("v_mbcnt_lo_u32_b32 %0, -1, 0\n\tv_mbcnt_hi_u32_b32 %0, -1, %0" : "=v"(l)); return l; }
__device__ __forceinline__ int make_tid(int wave) { asm volatile("" : "+s"(wave)); int t = wave * 64 + lane_id(); asm volatile("" : "+v"(t)); return t; }
__device__ __forceinline__ float fexp(float x) { return __builtin_amdgcn_exp2f(x * 1.4426950408889634f); }
__device__ __forceinline__ float frcp(float x) { return __builtin_amdgcn_rcpf(x); }
__device__ __forceinline__ float frsq(float x) { return __builtin_amdgcn_rsqf(x); }
__device__ __forceinline__ float sigmoid_acc(float x) { return frcp(1.0f + fexp(-x)); }

#define XB_TMO      128
#define XB_XCNT(j)  (256  + 64 * (j))
#define XB_XSUB(j)  (1280 + 64 * (j))
#define XB_XGEN(j)  (2304 + 64 * (j))
#define XB_TOP      3328
#define XB_TOPGEN   3392
#define XCD_BAR_WORDS 3456
#define XB_SPIN_CAP (1u << 18)

__device__ __forceinline__ unsigned xb_ld(unsigned* p)              { return __hip_atomic_load(p, __ATOMIC_RELAXED, __HIP_MEMORY_SCOPE_AGENT); }
__device__ __forceinline__ unsigned xb_add(unsigned* p, unsigned v) { return __hip_atomic_fetch_add(p, v, __ATOMIC_RELAXED, __HIP_MEMORY_SCOPE_AGENT); }
__device__ __forceinline__ unsigned xb_xcc_id() { return (unsigned)__builtin_amdgcn_s_getreg((3 << 11) | 20) & 0xFu; }
#define XB_SPIN(cond, bar) do { unsigned _sp = 0; while (cond) { __builtin_amdgcn_s_sleep(1); \
    if ((++_sp & 255u) == 0u) { if (xb_ld(&(bar)[XB_TMO])) break; if (_sp > XB_SPIN_CAP) { atomicAdd(&(bar)[XB_TMO], 1u); break; } } } } while (0)

struct XcdBarrier {
    unsigned* bar; unsigned x;
    volatile LAS unsigned* st;
};

__device__ __forceinline__ XcdBarrier xcd_barrier_post(unsigned* bar, volatile LAS unsigned* st) {
    XcdBarrier b; b.bar = bar; b.x = xb_xcc_id(); b.st = st;
    if (threadIdx.x == 0) (void)xb_add(&bar[XB_XCNT(b.x)], 1u);
    return b;
}
__device__ __forceinline__ void xcd_barrier_complete(unsigned* bar, unsigned x, unsigned& nloc, unsigned& nx) {
    const unsigned G = gridDim.x * gridDim.y * gridDim.z;
    unsigned sum, cnt, mine, sp = 0u;
    for (;;) {
        sum = 0u; cnt = 0u; mine = 0u;
#pragma unroll
        for (unsigned j = 0; j < 16; ++j) { const unsigned c = xb_ld(&bar[XB_XCNT(j)]); sum += c; cnt += (c > 0u) ? 1u : 0u; mine = (j == x) ? c : mine; }
        if (sum == G) break;
        __builtin_amdgcn_s_sleep(1);
        if ((++sp & 255u) == 0u) { if (xb_ld(&bar[XB_TMO])) break; if (sp > XB_SPIN_CAP) { atomicAdd(&bar[XB_TMO], 1u); break; } }
    }
    nloc = mine > 0u ? mine : 1u; nx = cnt > 0u ? cnt : 1u;
}

__device__ __forceinline__ void xcd_barrier(const XcdBarrier& b, const bool thread0) {
    asm volatile("s_waitcnt vmcnt(0)" ::: "memory");
    __syncthreads();
    if (thread0) {
        unsigned* bar = b.bar;
        __builtin_amdgcn_s_waitcnt(0);
        unsigned nloc = b.st[0], nx = b.st[1];
        if (nloc == 0u) { xcd_barrier_complete(bar, b.x, nloc, nx); b.st[0] = nloc; b.st[1] = nx; }
        const unsigned old = xb_add(&bar[XB_XSUB(b.x)], 1u);
        const unsigned gen = old / nloc;
        if (old + 1u == (gen + 1u) * nloc) {
            __builtin_amdgcn_fence(__ATOMIC_RELEASE, "agent");
            asm volatile("s_waitcnt vmcnt(0)" ::: "memory");
            const unsigned og = xb_add(&bar[XB_TOP], 1u);
            const unsigned tg = og / nx;
            if (og + 1u == (tg + 1u) * nx) xb_add(&bar[XB_TOPGEN], 1u);
            else XB_SPIN(xb_ld(&bar[XB_TOPGEN]) == tg, bar);
            __builtin_amdgcn_fence(__ATOMIC_ACQUIRE, "agent");
            xb_add(&bar[XB_XGEN(b.x)], 1u);
            asm volatile("s_waitcnt vmcnt(0)" ::: "memory");
        } else {
            XB_SPIN(xb_ld(&bar[XB_XGEN(b.x)]) == gen, bar);
            __builtin_amdgcn_fence(__ATOMIC_ACQUIRE, "agent");
            asm volatile("s_waitcnt vmcnt(0)" ::: "memory");
        }
    }
    __syncthreads();
}


typedef const char __attribute__((address_space(4)))* kargp_t;
#define KARGS_OPEN() int koff_ = 0; asm volatile("" : "+s"(koff_)); const kargp_t kp = (kargp_t)__builtin_amdgcn_kernarg_segment_ptr() + koff_
#define KIN(i) ((const float*)(const __attribute__((address_space(1))) float*)(*(const float* const __attribute__((address_space(4)))*)(kp + 8 * (i))))
#define KOUT ((float*)(__attribute__((address_space(1))) float*)(*(float* const __attribute__((address_space(4)))*)(kp + 192)))
#define KWS ((unsigned char*)(__attribute__((address_space(1))) unsigned char*)(*(unsigned char* const __attribute__((address_space(4)))*)(kp + 200)))
#define KTHR(k) (*(const int __attribute__((address_space(4)))*)(kp + 216 + 4 * (k)))
struct Args { const float* in[24]; float* out; unsigned char* ws; int ph_lo, ph_hi; int thr[8]; };

__device__ __forceinline__ void p0_transpose_item(const float* W, int K, int N, bf16* WT, float* scr, int item, int lane, const float* gk = nullptr) {
    const int nblk = (N + 63) / 64, kb = item / nblk, nb = item % nblk, k0 = 64 * kb, n0 = 64 * nb;
    const int nc = n0 + lane; const float* src = W + (size_t)k0 * N + (nc < N ? nc : 0);
    float v[64];
#pragma unroll
    for (int i = 0; i < 64; ++i) v[i] = __builtin_nontemporal_load(src + (size_t)i * N);
#pragma unroll
    for (int i = 0; i < 64; ++i) scr[i * 65 + lane] = (nc < N) ? v[i] : 0.f;
    LDS_WAIT(); asm volatile("" ::: "memory");
    const int c = lane & 7;
    f32x4 ga = (f32x4){1.f, 1.f, 1.f, 1.f}, gb = ga; if (gk) { ga = *(const f32x4*)(gk + k0 + 8 * c); gb = *(const f32x4*)(gk + k0 + 8 * c + 4); }
#pragma unroll
    for (int jn = 0; jn < 8; ++jn) { const int n = (lane >> 3) + 8 * jn; const float* s = scr + (8 * c) * 65 + n;
        v4u o; o.x = pk2(s[0 * 65] * ga[0], s[1 * 65] * ga[1]); o.y = pk2(s[2 * 65] * ga[2], s[3 * 65] * ga[3]); o.z = pk2(s[4 * 65] * gb[0], s[5 * 65] * gb[1]); o.w = pk2(s[6 * 65] * gb[2], s[7 * 65] * gb[3]);
        if (n0 + n < N) *(v4u*)(WT + (size_t)(n0 + n) * K + k0 + 8 * c) = o; }
    LDS_WAIT(); asm volatile("" ::: "memory");
}

__device__ __forceinline__ size_t sc_off(int b, int t) { const int c = t >> 6; return (size_t)b * SCB + (size_t)2048 * c * (c + 1) + (size_t)(t & 63) * 64 * (c + 1); }

__device__ __forceinline__ void lru_tile(const kargp_t kp, int j, int b, int tile, int g, bool final_pass, unsigned char* lds, int wave, bool check = false) {
    const int tid = make_tid(wave);
    float* XC = (float*)lds; float* AA = (float*)(lds + 65536); float* QS = (float*)(lds + XTRA_OFF);
    const bf16* PROJ = (const bf16*)(KWS + WS_PROJ); float* LRUSUM = (float*)(KWS + WS_LRUSUM); bf16* YCAT = (bf16*)(KWS + WS_YCAT);
    const float* conv_w = KIN(5) + (size_t)j * 4 * 2048; const float* conv_b = KIN(6) + (size_t)j * 2048;
    const float* w_r = KIN(7) + ((size_t)j * 16 + g) * 16384; const float* b_r = KIN(8) + ((size_t)j * 16 + g) * 128;
    const float* w_i = KIN(9) + ((size_t)j * 16 + g) * 16384; const float* b_i = KIN(10) + ((size_t)j * 16 + g) * 128;
    const float* lam = KIN(11) + (size_t)j * 2048;
    const int t0 = tile * 128, c0 = g * 128; const size_t row0 = (size_t)b * SEQ + t0;
    __syncthreads();
    for (int e = tid; e < 4096; e += NTHR) { const int t = e >> 5, cq = (e & 31) * 4;
        f32x4 acc = *(const f32x4*)(conv_b + c0 + cq);
#pragma unroll
        for (int k = 0; k < 4; ++k) { const int tt = t0 + t + k - 3;
            if (tt >= 0) { const v2u xw = *(const v2u*)(PROJ + ((size_t)b * SEQ + tt) * PROJ_LD + c0 + cq); const f32x4 w = *(const f32x4*)(conv_w + (size_t)k * 2048 + c0 + cq);
                acc[0] += bflo(xw.x) * w[0]; acc[1] += bfhi(xw.x) * w[1]; acc[2] += bflo(xw.y) * w[2]; acc[3] += bfhi(xw.y) * w[3]; } }
        *(f32x4*)(XC + t * 128 + cq) = acc; }
    __syncthreads();
    const int jj = tid & 127, q = tid >> 7;
    float R[32], I[32];
#pragma unroll
    for (int tt = 0; tt < 32; ++tt) { R[tt] = 0.f; I[tt] = 0.f; }
#pragma unroll 1
    for (int i = 0; i < 128; i += 4) {
        float wr4[4], wi4[4];
#pragma unroll
        for (int ii = 0; ii < 4; ++ii) { wr4[ii] = w_r[(size_t)(i + ii) * 128 + jj]; wi4[ii] = w_i[(size_t)(i + ii) * 128 + jj]; }
#pragma unroll
        for (int tt = 0; tt < 32; ++tt) { const f32x4 x = *(const f32x4*)(XC + (32 * q + tt) * 128 + i);
#pragma unroll
            for (int ii = 0; ii < 4; ++ii) { R[tt] += x[ii] * wr4[ii]; I[tt] += x[ii] * wi4[ii]; } }
    }
    __syncthreads();
    const int c = c0 + jj;
    const float el = fexp(-lam[c]); const float sp = el * (1.0f - el * (0.5f - el * (0.33333333f - el * 0.25f))), br = b_r[jj], bi = b_i[jj];
    float h = 0.f, A = 1.f;
#pragma unroll
    for (int tt = 0; tt < 32; ++tt) { const int t = 32 * q + tt;
        const float r = sigmoid_acc(R[tt] + br), ig = sigmoid_acc(I[tt] + bi), la = -8.0f * r * sp, aa = fexp(la), mult = __builtin_amdgcn_sqrtf(fmaxf(1.0f - fexp(2.0f * la), 0.f));
        const float bx = mult * ig * XC[t * 128 + jj];
        h = aa * h + bx; A *= aa; XC[t * 128 + jj] = h; AA[t * 128 + jj] = A; }
    QS[(q * 128 + jj) * 2] = A; QS[(q * 128 + jj) * 2 + 1] = h;
    __syncthreads();
    if (!final_pass) {
        if (q == 3) { float At = 1.f, ht = 0.f;
#pragma unroll
            for (int qq = 0; qq < 4; ++qq) { const float Aq = QS[(qq * 128 + jj) * 2], hq = QS[(qq * 128 + jj) * 2 + 1]; ht = Aq * ht + hq; At *= Aq; }
            float* sp2 = LRUSUM + (((size_t)b * 32 + tile) * 2048 + c) * 2; sp2[0] = At; sp2[1] = ht; }
    } else {
        float carry = 0.f;
        for (int tl = 0; tl < tile; ++tl) { const float* sp2 = LRUSUM + (((size_t)b * 32 + tl) * 2048 + c) * 2; carry = sp2[0] * carry + sp2[1]; }
        for (int qq = 0; qq < q; ++qq) carry = QS[(qq * 128 + jj) * 2] * carry + QS[(qq * 128 + jj) * 2 + 1];
#pragma unroll 4
        for (int tt = 0; tt < 32; ++tt) { const int t = 32 * q + tt; const float hv = XC[t * 128 + jj] + AA[t * 128 + jj] * carry;
            const float ga = bf2f(PROJ[(row0 + t) * PROJ_LD + COL_GA + c]);
            bf16* yp = YCAT + (row0 + t) * 4096 + c; const float yv = hv * ga;
            if (!check) *yp = (bf16)f2bf(yv); else if (!(fabsf(bf2f(*yp) - yv) <= 1e-4f + 0.03f * fabsf(ga) + 0.03f * fabsf(yv))) atomicOr((unsigned*)(KWS + WS_CTL) + 8, 4u); }
    }
}

typedef short s_bf16x8 __attribute__((ext_vector_type(8)));
__device__ __forceinline__ void lru_raw_dma(const kargp_t kp, int it, unsigned char* lds, int wave, int lane) {
    const bf16* PROJ = (const bf16*)(KWS + WS_PROJ); const int b = it >> 9, t0 = ((it >> 4) & 31) * 128, c0 = (it & 15) * 128;
#pragma unroll 1
    for (int q = wave; q < 33; q += 8) { const int row = q * 4 + (lane >> 4), tt = t0 - 3 + row;
        __builtin_amdgcn_global_load_lds((const unsigned*)(PROJ + ((size_t)b * SEQ + (tt >= 0 ? tt : 0)) * PROJ_LD + c0 + (lane & 15) * 8), (LAS unsigned*)(lds + 98304 + q * 1024), 16, 0, 0); }
}
__device__ __forceinline__ void lru_tile_mfma(const kargp_t kp, int j, int it, int it_next, bool first, bool final_pass, bool stream, unsigned char* lds, int wave) {
    const bool gates = final_pass || stream;
    const int b = it >> 9, tile = (it >> 4) & 31, g = it & 15;
    const int tid = make_tid(wave), lane = tid & 63, fr = lane & 15, q4 = lane >> 4, wid = tid >> 6;
    float* XF = (float*)lds; unsigned char* XB = lds + 65536; const unsigned char* RAW = lds + 98304;
    const bf16* PROJ = (const bf16*)(KWS + WS_PROJ); float* LRUSUM = (float*)(KWS + WS_LRUSUM); bf16* YCAT = (bf16*)(KWS + WS_YCAT);
    const float* conv_w = KIN(5) + (size_t)j * 4 * 2048; const float* conv_b = KIN(6) + (size_t)j * 2048;
    const int t0 = tile * 128, c0 = g * 128; const size_t row0 = (size_t)b * SEQ + t0;
    if (first) { __syncthreads(); lru_raw_dma(kp, it, lds, wave, lane); }
    asm volatile("s_waitcnt vmcnt(0)" ::: "memory"); __syncthreads();
    const int jl = 16 * wid + fr, c = c0 + jl;
    const bf16* wtr = (const bf16*)(KWS + WS_WSMALL) + ((size_t)(j * 16 + g) * 128 + jl) * 128 + 8 * q4; const bf16* wti = wtr + (size_t)2 * 16 * 128 * 128;
    s_bf16x8 wr[4], wi[4];
#pragma unroll
    for (int ks = 0; ks < 4; ++ks) { wr[ks] = *(const s_bf16x8*)(wtr + ks * 32); wi[ks] = *(const s_bf16x8*)(wti + ks * 32); }
    const float el = fexp(-KIN(11)[(size_t)j * 2048 + c]); const float sp8 = -8.0f * 1.4426950408889634f * (el * (1.0f - el * (0.5f - el * (0.33333333f - el * 0.25f))));
    const float br = KIN(8)[(size_t)(j * 16 + g) * 128 + jl], bi = KIN(10)[(size_t)(j * 16 + g) * 128 + jl];
    v4u gav[4];
    if (gates) {
#pragma unroll
        for (int i = 0; i < 4; ++i) { const int e = tid + NTHR * i, t = e >> 4, ch = e & 15; gav[i] = *(const v4u*)(PROJ + (row0 + t) * PROJ_LD + COL_GA + c0 + ch * 8); } }
    {
        const int tb = tid >> 5, cq = (tid & 31) * 4; const f32x4 bias = *(const f32x4*)(conv_b + c0 + cq);
        f32x4 cw[4];
#pragma unroll
        for (int k = 0; k < 4; ++k) cw[k] = *(const f32x4*)(conv_w + (size_t)k * 2048 + c0 + cq);
        v2u xw[8][4];
#pragma unroll
        for (int i = 0; i < 8; ++i)
#pragma unroll
            for (int k = 0; k < 4; ++k) xw[i][k] = *(const v2u*)(RAW + (tb + 16 * i + k) * 256 + cq * 2);
#pragma unroll
        for (int i = 0; i < 8; ++i) { const int t = tb + 16 * i; f32x4 acc = bias;
#pragma unroll
            for (int k = 0; k < 4; ++k) { const float on = (t0 + t + k - 3) >= 0 ? 1.f : 0.f; const f32x4 w = cw[k] * on;
                acc[0] += bflo(xw[i][k].x) * w[0]; acc[1] += bfhi(xw[i][k].x) * w[1]; acc[2] += bflo(xw[i][k].y) * w[2]; acc[3] += bfhi(xw[i][k].y) * w[3]; }
            *(f32x4*)(XF + t * 128 + (cq ^ (((t >> 2) & 3) << 4))) = acc;
            *(v2u*)(XB + t * 256 + ((cq * 2) ^ ((t & 15) << 4))) = (v2u){pk2(acc[0], acc[1]), pk2(acc[2], acc[3])}; }
    }
    __syncthreads();
    if (it_next < 1024) lru_raw_dma(kp, it_next, lds, wave, lane);
    typedef float f32x2_ __attribute__((ext_vector_type(2))); f32x2_ sm[31];
    if (final_pass) {
#pragma unroll
        for (int tl = 0; tl < 31; ++tl) sm[tl] = *(const f32x2_*)(LRUSUM + (((size_t)b * 32 + tl) * 2048 + c) * 2); }
    f32x4 aR[8], aI[8];
#pragma unroll
    for (int m = 0; m < 8; ++m) { aR[m] = (f32x4){0.f, 0.f, 0.f, 0.f}; aI[m] = aR[m]; }
#pragma unroll
    for (int m = 0; m < 8; ++m)
#pragma unroll
        for (int ks = 0; ks < 4; ++ks) { const s_bf16x8 a = *(const s_bf16x8*)(XB + (16 * m + fr) * 256 + (((ks * 32 + 8 * q4) * 2) ^ (fr << 4)));
            aR[m] = __builtin_amdgcn_mfma_f32_16x16x32_bf16(a, wr[ks], aR[m], 0, 0, 0); aI[m] = __builtin_amdgcn_mfma_f32_16x16x32_bf16(a, wi[ks], aI[m], 0, 0, 0); }
    if (gates) { __syncthreads();
#pragma unroll
        for (int i = 0; i < 4; ++i) { const int e = tid + NTHR * i, t = e >> 4, ch = e & 15; *(v4u*)(XB + t * 256 + ((ch * 16) ^ (((t >> 2) & 3) << 5))) = gav[i]; }
        __syncthreads(); }
    float carry = 0.f, Atot = 1.f;
    if (final_pass) {
#pragma unroll
        for (int tl = 0; tl < 31; ++tl) carry = (tl < tile) ? sm[tl][0] * carry + sm[tl][1] : carry; }
    unsigned short gq[8][4];
    if (gates) {
#pragma unroll
        for (int m = 0; m < 8; ++m)
#pragma unroll
            for (int r = 0; r < 4; ++r) gq[m][r] = *(const unsigned short*)(XB + (16 * m + 4 * q4 + r) * 256 + ((jl * 2) ^ (q4 << 5))); }
#pragma unroll
    for (int m = 0; m < 8; ++m) {
        float hl[4], Al[4]; float h = 0.f, A = 1.f;
#pragma unroll
        for (int r = 0; r < 4; ++r) { const int t = 16 * m + 4 * q4 + r; const float x = XF[t * 128 + (jl ^ (q4 << 4))];
            const float rg = frcp(1.0f + fexp(-(aR[m][r] + br))), ig = frcp(1.0f + fexp(-(aI[m][r] + bi)));
            const float la2 = rg * sp8, aa = __builtin_amdgcn_exp2f(la2), mult = __builtin_amdgcn_sqrtf(fmaxf(1.0f - aa * aa, 0.f));
            h = aa * h + mult * ig * x; A *= aa; hl[r] = h; Al[r] = A; }
        float cin = carry, cq = carry, Ain = Atot;
        float Arow[4], hrow[4];
        {   const auto sA = __builtin_amdgcn_permlane16_swap(__float_as_uint(A), __float_as_uint(A), false, false); const auto sH = __builtin_amdgcn_permlane16_swap(__float_as_uint(h), __float_as_uint(h), false, false);
            const auto a02 = __builtin_amdgcn_permlane32_swap(sA[0], sA[0], false, false), a13 = __builtin_amdgcn_permlane32_swap(sA[1], sA[1], false, false);
            const auto h02 = __builtin_amdgcn_permlane32_swap(sH[0], sH[0], false, false), h13 = __builtin_amdgcn_permlane32_swap(sH[1], sH[1], false, false);
            Arow[0] = __uint_as_float(a02[0]); Arow[2] = __uint_as_float(a02[1]); Arow[1] = __uint_as_float(a13[0]); Arow[3] = __uint_as_float(a13[1]);
            hrow[0] = __uint_as_float(h02[0]); hrow[2] = __uint_as_float(h02[1]); hrow[1] = __uint_as_float(h13[0]); hrow[3] = __uint_as_float(h13[1]); }
#pragma unroll
        for (int qq = 0; qq < 4; ++qq) { const float Aq = Arow[qq], hq = hrow[qq];
            if (qq == q4) { cin = cq; Ain = Atot; }
            cq = Aq * cq + hq; Atot *= Aq; }
        carry = cq;
        if (final_pass) {
#pragma unroll
            for (int r = 0; r < 4; ++r) { const int t = 16 * m + 4 * q4 + r; const float hv = hl[r] + Al[r] * cin;
                bf16* gp = (bf16*)(XB + t * 256 + ((jl * 2) ^ (q4 << 5))); *gp = (bf16)f2bf(hv * bf2f(gq[m][r])); } }
        if (stream) {
#pragma unroll
            for (int r = 0; r < 4; ++r) { const int t = 16 * m + 4 * q4 + r; const float sg = bf2f(gq[m][r]); const float hv = hl[r] + Al[r] * cin, ac = Al[r] * Ain;
                *(bf16*)(XB + t * 256 + ((jl * 2) ^ (q4 << 5))) = (bf16)f2bf(hv * sg);
                *(unsigned*)(XF + t * 128 + (jl ^ (q4 << 4))) = (unsigned)f2bf(ac * sg); } }
    }
    if (gates) { __syncthreads();
        bf16* dstb = stream ? (bf16*)(KWS + WS_AN) + row0 * 2048 + c0 : YCAT + row0 * 4096 + c0; const int dld = stream ? 2048 : 4096;
#pragma unroll
        for (int i = 0; i < 4; ++i) { const int e = tid + NTHR * i, t = e >> 4, ch = e & 15; *(v4u*)(dstb + (size_t)t * dld + ch * 8) = *(const v4u*)(XB + t * 256 + ((ch * 16) ^ (((t >> 2) & 3) << 5))); } }
    if (stream) { bf16* WB = (bf16*)KOUT + (size_t)M * DM;
#pragma unroll
        for (int i = 0; i < 4; ++i) { const int e = tid + NTHR * i, t = e >> 4, ch = e & 15; const int xc_ = (ch * 8) ^ (((t >> 2) & 3) << 4); const v4u a = *(const v4u*)(XF + t * 128 + xc_), b2 = *(const v4u*)(XF + t * 128 + xc_ + 4);
            *(v4u*)(WB + (row0 + t) * 2048 + c0 + ch * 8) = (v4u){(a.x & 0xffffu) | (a.y << 16), (a.z & 0xffffu) | (a.w << 16), (b2.x & 0xffffu) | (b2.y << 16), (b2.z & 0xffffu) | (b2.w << 16)}; } }
    if (!final_pass && q4 == 0) { float* s2 = LRUSUM + (((size_t)b * 32 + tile) * 2048 + c) * 2; s2[0] = Atot; s2[1] = carry; }
}
__device__ __forceinline__ void lru_carry4(const kargp_t kp, int it0, int Gs, float* CL, int wave) {
    const int tid = make_tid(wave), k = tid >> 7, ch = tid & 127, it = it0 + k * Gs;
    if (it < 1024) { const int b = it >> 9, tile = (it >> 4) & 31, c = (it & 15) * 128 + ch; const float* LRUSUM = (const float*)(KWS + WS_LRUSUM);
        typedef float f32x2_ __attribute__((ext_vector_type(2))); f32x2_ sm[31]; float carry = 0.f;
#pragma unroll
        for (int tl = 0; tl < 31; ++tl) sm[tl] = *(const f32x2_*)(LRUSUM + (((size_t)b * 32 + tl) * 2048 + c) * 2);
#pragma unroll
        for (int tl = 0; tl < 31; ++tl) carry = (tl < tile) ? sm[tl][0] * carry + sm[tl][1] : carry;
        CL[tid] = carry; }
}
__device__ __forceinline__ void lru_apply_item(const kargp_t kp, int it, const float* CL, int wave) {
    const int b = it >> 9, tile = (it >> 4) & 31, g = it & 15; const int tid = make_tid(wave);
    bf16* YCAT = (bf16*)(KWS + WS_YCAT); const bf16* WB = (const bf16*)KOUT + (size_t)M * DM; const bf16* UB = (const bf16*)(KWS + WS_AN);
    const int t0 = tile * 128, c0 = g * 128; const size_t row0 = (size_t)b * SEQ + t0;
    v4u uw[4], ww[4];
#pragma unroll
    for (int i = 0; i < 4; ++i) { const int e = tid + NTHR * i, t = e >> 4, ch = e & 15; uw[i] = *(const v4u*)(UB + (row0 + t) * 2048 + c0 + ch * 8); ww[i] = *(const v4u*)(WB + (row0 + t) * 2048 + c0 + ch * 8); }
#pragma unroll
    for (int i = 0; i < 4; ++i) { const int e = tid + NTHR * i, t = e >> 4, ch = e & 15; const f32x4 c0v = *(const f32x4*)(CL + ch * 8), c1v = *(const f32x4*)(CL + ch * 8 + 4);
        const v4u u = uw[i], w = ww[i]; v4u o;
        o.x = pk2(bflo(u.x) + bflo(w.x) * c0v[0], bfhi(u.x) + bfhi(w.x) * c0v[1]); o.y = pk2(bflo(u.y) + bflo(w.y) * c0v[2], bfhi(u.y) + bfhi(w.y) * c0v[3]);
        o.z = pk2(bflo(u.z) + bflo(w.z) * c1v[0], bfhi(u.z) + bfhi(w.z) * c1v[1]); o.w = pk2(bflo(u.w) + bflo(w.w) * c1v[2], bfhi(u.w) + bfhi(w.w) * c1v[3]);
        *(v4u*)(YCAT + (row0 + t) * 4096 + c0 + ch * 8) = o; }
}

__device__ __forceinline__ void knorm_item(const kargp_t kp, int j, int it, int wave, int lane) {
    const bf16* PROJ = (const bf16*)(KWS + WS_PROJ); bf16* KN = (bf16*)(KWS + WS_KN); const float* kg = KIN(13) + (size_t)j * 128;
    const float g0 = kg[lane * 2], g1 = kg[lane * 2 + 1];
    unsigned w[8];
#pragma unroll
    for (int p = 0; p < 8; ++p) { const int pr = it * 64 + wave * 8 + p, row = pr >> 2, g = pr & 3; w[p] = *(const unsigned*)(PROJ + (size_t)row * PROJ_LD + COL_K + g * 128 + lane * 2); }
    asm volatile("" ::: "memory");
#pragma unroll
    for (int p = 0; p < 8; ++p) { const int pr = it * 64 + wave * 8 + p, row = pr >> 2, g = pr & 3;
        const float x0 = bflo(w[p]), x1 = bfhi(w[p]); const float ss = wave_sum(x0 * x0 + x1 * x1, lane);
        const float rstd = frsq(ss * (1.0f / 128.0f) + 1e-6f);
        *(unsigned*)(KN + (size_t)row * 512 + g * 128 + lane * 2) = pk2(x0 * rstd * g0, x1 * rstd * g1); }
}

__device__ __forceinline__ void score_item(const kargp_t kp, int b, int c, int kt, unsigned char* lds, int wave, bool check = false) {
    const int tid = make_tid(wave); const float* IDX = (const float*)(KWS + WS_IDX); float* SC = (float*)(KWS + WS_SC);
    float* IQs = (float*)lds; float* IKs = (float*)(lds + 32768);
    const int q = tid & 63, kg = tid >> 6; const size_t qrow0 = (size_t)b * SEQ + c * 64, krow0 = (size_t)b * SEQ + kt * 64;
    __syncthreads();
    for (int e = tid; e < 4096; e += NTHR) { const int k = e >> 6, d = e & 63; IKs[k * 65 + d] = IDX[(krow0 + k) * IDX_LD + 1024 + d]; }
    float acc[8];
#pragma unroll
    for (int kk = 0; kk < 8; ++kk) acc[kk] = 0.f;
#pragma unroll 1
    for (int h = 0; h < 16; ++h) {
        __syncthreads();
        for (int e = tid; e < 4096; e += NTHR) { const int qq = e >> 6, d = e & 63; IQs[qq * 65 + d] = IDX[(qrow0 + qq) * IDX_LD + h * 64 + d]; }
        __syncthreads();
        const float w = IDX[(qrow0 + q) * IDX_LD + 1088 + h];
        float qv[64];
#pragma unroll
        for (int d = 0; d < 64; ++d) qv[d] = IQs[q * 65 + d];
#pragma unroll
        for (int kk = 0; kk < 8; ++kk) { const float* kr = IKs + (kg * 8 + kk) * 65; float dot = 0.f;
#pragma unroll
            for (int d = 0; d < 64; ++d) dot += qv[d] * kr[d];
            acc[kk] += w * fmaxf(dot, 0.f); }
    }
    float* dst = SC + sc_off(b, c * 64 + q) + kt * 64 + kg * 8;
#pragma unroll
    for (int kk = 0; kk < 8; ++kk) { if (!check) dst[kk] = acc[kk]; else if (!(fabsf(dst[kk] - acc[kk]) <= 1.0f + 0.02f * fabsf(acc[kk]))) atomicOr((unsigned*)(KWS + WS_CTL) + 8, 1u); }
}

__device__ __forceinline__ void score_wave_unit(const kargp_t kp, int b, int c, int qg, int ks, int lane, unsigned char* lds, int wave) {
    const bf16* IDXB = (const bf16*)(KWS + WS_IDXB); const float* IDX = (const float*)(KWS + WS_IDX); float* SC = (float*)(KWS + WS_SC);
    const int fr = lane & 15, fq = lane >> 4; const size_t qrow = (size_t)b * SEQ + c * 64 + qg * 16 + fr;
    s_bf16x8 bq[16][2];
#pragma unroll
    for (int h = 0; h < 16; ++h)
#pragma unroll
        for (int s = 0; s < 2; ++s) bq[h][s] = *(const s_bf16x8*)(IDXB + qrow * IDX_LD + h * 64 + s * 32 + 8 * fq);
    float w[16];
#pragma unroll
    for (int h4 = 0; h4 < 4; ++h4) { const f32x4 t = *(const f32x4*)(IDX + qrow * IDX_LD + 1088 + 4 * h4); w[4 * h4] = t[0]; w[4 * h4 + 1] = t[1]; w[4 * h4 + 2] = t[2]; w[4 * h4 + 3] = t[3]; }
    float* dst = SC + sc_off(b, c * 64 + qg * 16 + fr) + fq * 4;
    const int ntile = 4 * (c + 1);
    const bf16* kbase = IDXB + ((size_t)b * SEQ + fr) * IDX_LD + 1024 + 8 * fq;
    unsigned char* ring = lds + wave * 8192;
#define SC_DMA(S, KT) do { const int kn_ = (KT) < ntile ? (KT) : ks; const bf16* src_ = kbase + (size_t)kn_ * 16 * IDX_LD; \
        __builtin_amdgcn_global_load_lds((const unsigned*)src_, (LAS unsigned*)(ring + (S) * 2048), 16, 0, 0); __builtin_amdgcn_global_load_lds((const unsigned*)(src_ + 32), (LAS unsigned*)(ring + (S) * 2048 + 1024), 16, 0, 0); } while (0)
#define SC_TILE(S, KT, NW) do { if ((KT) < ntile) { asm volatile("s_waitcnt vmcnt(" #NW ")" ::: "memory"); \
        const s_bf16x8 a0 = *(const LAS s_bf16x8*)((LAS unsigned char*)ring + (S) * 2048 + lane * 16), a1 = *(const LAS s_bf16x8*)((LAS unsigned char*)ring + (S) * 2048 + 1024 + lane * 16); \
        asm volatile("s_waitcnt lgkmcnt(0)" ::: "memory"); SC_DMA(S, (KT) + 32); f32x4 sc = {0.f, 0.f, 0.f, 0.f}; \
        _Pragma("unroll") for (int h = 0; h < 16; ++h) { f32x4 acc = {0.f, 0.f, 0.f, 0.f}; \
            acc = __builtin_amdgcn_mfma_f32_16x16x32_bf16(a0, bq[h][0], acc, 0, 0, 0); acc = __builtin_amdgcn_mfma_f32_16x16x32_bf16(a1, bq[h][1], acc, 0, 0, 0); \
            _Pragma("unroll") for (int r = 0; r < 4; ++r) { const int ri_ = __float_as_int(acc[r]); sc[r] += w[h] * __int_as_float(ri_ > 0 ? ri_ : 0); } } \
        *(f32x4*)(dst + (KT) * 16) = sc; asm volatile("" ::: "memory"); } } while (0)
    SC_DMA(0, ks); SC_DMA(1, ks + 8); SC_DMA(2, ks + 16); SC_DMA(3, ks + 24);
    asm volatile("s_waitcnt vmcnt(0)" ::: "memory");
#pragma unroll 1
    for (int kt = ks; kt < ntile; kt += 32) { SC_TILE(0, kt, 10); SC_TILE(1, kt + 8, 10); SC_TILE(2, kt + 16, 10); SC_TILE(3, kt + 24, 10); }
#undef SC_DMA
#undef SC_TILE
}

template <int NV> __device__ __forceinline__ void select_query_nv(const kargp_t kp, int qi, int lane) {
    const float* SC = (const float*)(KWS + WS_SC); unsigned* BMr = (unsigned*)(KWS + WS_BM) + (size_t)qi * 128;
    const int b = qi >> 12, t = qi & 4095, nv = (t >> 6) + 1;
    const float* row = SC + sc_off(b, t);
    unsigned key[NV];
#pragma unroll
    for (int v = 0; v < NV; ++v) { unsigned k = 0u;
        if (v < nv) { const float s = row[v * 64 + lane] + 0.0f; const unsigned u = __float_as_uint(s); k = (u & 0x80000000u) ? ~u : (u | 0x80000000u); }
        key[v] = k; }
    unsigned tau = 0u; int ctau = 64 * nv;
    bool done = false;
#ifndef SELECT_NO_PK16
    {
        typedef unsigned short us2 __attribute__((ext_vector_type(2)));
        us2 hp[NV / 2];
#pragma unroll
        for (int v = 0; v < NV / 2; ++v) { const unsigned w_ = (key[2 * v] >> 16) | (key[2 * v + 1] & 0xffff0000u); hp[v] = __builtin_bit_cast(us2, w_); }
        for (int bit = 31; bit >= 16; --bit) {
            const unsigned cand = tau | (1u << bit); const unsigned short c1 = (unsigned short)((cand >> 16) - 1u); const us2 c2 = {c1, c1}; const us2 one2 = {1, 1}; us2 acc = {0, 0};
#pragma unroll
            for (int v = 0; v < NV / 2; ++v) { unsigned d_; asm("v_pk_sub_u16 %0, %1, %2 clamp\n\tv_pk_min_u16 %0, %0, %3" : "=&v"(d_) : "v"(__builtin_bit_cast(unsigned, hp[v])), "v"(__builtin_bit_cast(unsigned, c2)), "v"(__builtin_bit_cast(unsigned, one2)));
                acc += __builtin_bit_cast(us2, d_); }
            int cnt = (int)acc[0] + (int)acc[1];
            cnt = wave_sum_i(cnt, lane);
            if (cnt >= TOPK) { tau = cand; ctau = cnt; }
            if (cnt == TOPK) { done = true; break; }
        }
    }
    for (int bit = 15; bit >= 0 && !done; --bit) {
#else
    for (int bit = 31; bit >= 0; --bit) {
#endif
        const unsigned cand = tau | (1u << bit); int cnt = 0;
#pragma unroll
        for (int v = 0; v < NV; ++v) cnt += (key[v] >= cand) ? 1 : 0;
        cnt = wave_sum_i(cnt, lane);
        if (cnt >= TOPK) { tau = cand; ctau = cnt; }
        if (cnt == TOPK) break;
    }
    unsigned mylo = 0u, myhi = 0u;
    if (ctau == TOPK) {
#pragma unroll
        for (int v = 0; v < NV; ++v) {
            const unsigned long long sm = __ballot(key[v] >= tau);
            { const unsigned slo = (unsigned)sm, shi = (unsigned)(sm >> 32); asm volatile("s_nop 1\n\tv_writelane_b32 %0, %2, %4\n\tv_writelane_b32 %1, %3, %4" : "+v"(mylo), "+v"(myhi) : "s"(slo), "s"(shi), "i"(v)); }
            __builtin_amdgcn_sched_barrier(0);
        }
    } else {
        int ngt = 0;
#pragma unroll
        for (int v = 0; v < NV; ++v) ngt += __popcll(__ballot(key[v] > tau));
        int need = TOPK - ngt;
#pragma unroll
        for (int v = 0; v < NV; ++v) {
            const bool eq = key[v] == tau; const unsigned long long em = __ballot(eq);
            const int below = __builtin_amdgcn_mbcnt_hi((unsigned)(em >> 32), __builtin_amdgcn_mbcnt_lo((unsigned)em, 0u));
            const bool sel = (key[v] > tau) || (eq && below < need);
            need -= __popcll(em); if (need < 0) need = 0;
            const unsigned long long sm = __ballot(sel);
            { const unsigned slo = (unsigned)sm, shi = (unsigned)(sm >> 32); asm volatile("s_nop 1\n\tv_writelane_b32 %0, %2, %4\n\tv_writelane_b32 %1, %3, %4" : "+v"(mylo), "+v"(myhi) : "s"(slo), "s"(shi), "i"(v)); }
            __builtin_amdgcn_sched_barrier(0);
        }
    }
    *(v2u*)(BMr + 2 * lane) = (v2u){mylo, myhi};
}

__device__ __forceinline__ void select_query(const kargp_t kp, int qi, int lane) {
    const int nv = ((qi & 4095) >> 6) + 1;
    if (nv <= 4) { unsigned* BMr = (unsigned*)(KWS + WS_BM) + (size_t)qi * 128; const unsigned w0 = (lane < nv) ? 0xffffffffu : 0u; *(v2u*)(BMr + 2 * lane) = (v2u){w0, w0}; }
#ifndef SELECT_NV64_ONLY
    else if (nv <= 16) select_query_nv<16>(kp, qi, lane);
    else if (nv <= 32) select_query_nv<32>(kp, qi, lane);
    else if (nv <= 48) select_query_nv<48>(kp, qi, lane);
#endif
    else select_query_nv<64>(kp, qi, lane);
}

__device__ __forceinline__ float rel_bias_at(const kargp_t kp, int rel, int h) {
    const int n = rel < 0 ? -rel : rel; int bk = n;
    if (n >= 8) { bk = 8;
#pragma unroll
        for (int k = 1; k < 8; ++k) bk += (n >= KTHR(k)) ? 1 : 0; }
    bk += (rel > 0 ? 16 : 0);
    return KIN(3)[bk * 16 + h];
}

__device__ __forceinline__ void attn_query(const kargp_t kp, int j, int qi, unsigned char* lds, int wave, bool check = false) {
    const int tid = make_tid(wave), b = qi >> 12, t = qi & 4095, limit = ((t >> 6) + 1) * 64;
    const bf16* PROJ = (const bf16*)(KWS + WS_PROJ); const bf16* KN = (const bf16*)(KWS + WS_KN); const unsigned* BM = (const unsigned*)(KWS + WS_BM); bf16* YCAT = (bf16*)(KWS + WS_YCAT);
    int* sel = (int*)lds; int* wcnt = (int*)(lds + 1024); int* nselp = (int*)(lds + 1536); float* qs = (float*)(lds + 2048); float* lg = (float*)(lds + 10240);
    __syncthreads();
    unsigned wbits = 0u;
    if (tid < 128) { wbits = BM[(size_t)qi * 128 + tid]; if (tid * 32 >= limit) wbits = 0u; wcnt[tid] = __popc(wbits); }
    {
        const int h = tid >> 5, d = (tid & 31) * 4; const v2u qw = *(const v2u*)(PROJ + (size_t)qi * PROJ_LD + COL_Q + h * 128 + d);
        const float x0 = bflo(qw.x), x1 = bfhi(qw.x), x2 = bflo(qw.y), x3 = bfhi(qw.y); float ss = x0 * x0 + x1 * x1 + x2 * x2 + x3 * x3;
#pragma unroll
        for (int o = 1; o < 32; o <<= 1) ss += shx(ss, o, tid & 63);
        const float rstd = frsq(ss * (1.0f / 128.0f) + 1e-6f) * 0.08838834764831845f; const float* qg = KIN(12) + (size_t)j * 128 + d;
        qs[h * 128 + d] = x0 * rstd * qg[0]; qs[h * 128 + d + 1] = x1 * rstd * qg[1]; qs[h * 128 + d + 2] = x2 * rstd * qg[2]; qs[h * 128 + d + 3] = x3 * rstd * qg[3]; }
    __syncthreads();
    if (tid < 128) { int off = 0; for (int i = 0; i < tid; ++i) off += wcnt[i];
        unsigned w = wbits; while (w) { const int bp = __ffs(w) - 1; w &= w - 1; if (off < 256) sel[off] = tid * 32 + bp; ++off; }
        if (tid == 127) *nselp = off < 256 ? off : 256; }
    __syncthreads();
    const int n = *nselp;
    {
        const int k = tid & 255, hh = tid >> 8;
        if (k < n) { const int s = sel[k]; const bf16* krow = KN + ((size_t)b * SEQ + s) * 512;
#pragma unroll 1
            for (int gg = 0; gg < 2; ++gg) { const int g = hh * 2 + gg; float acc[4] = {0.f, 0.f, 0.f, 0.f};
#pragma unroll 1
                for (int d0 = 0; d0 < 128; d0 += 8) { const v4u kw = *(const v4u*)(krow + g * 128 + d0);
                    float kv[8] = {bflo(kw.x), bfhi(kw.x), bflo(kw.y), bfhi(kw.y), bflo(kw.z), bfhi(kw.z), bflo(kw.w), bfhi(kw.w)};
#pragma unroll
                    for (int r = 0; r < 4; ++r) { const float* qp = qs + (g * 4 + r) * 128 + d0;
#pragma unroll
                        for (int i = 0; i < 8; ++i) acc[r] += qp[i] * kv[i]; } }
#pragma unroll
                for (int r = 0; r < 4; ++r) { const int h = g * 4 + r; lg[h * 256 + k] = acc[r] + rel_bias_at(kp, s - t, h); } }
        } else {
#pragma unroll
            for (int r = 0; r < 8; ++r) lg[(hh * 8 + r) * 256 + k] = -INFINITY; }
    }
    __syncthreads();
    {
        const int h = tid >> 5, l32 = tid & 31; float v[8]; float mx = -INFINITY;
#pragma unroll
        for (int i = 0; i < 8; ++i) { v[i] = lg[h * 256 + l32 + 32 * i]; mx = fmaxf(mx, v[i]); }
#pragma unroll
        for (int o = 1; o < 32; o <<= 1) mx = fmaxf(mx, shx(mx, o, tid & 63));
        float sm = 0.f;
#pragma unroll
        for (int i = 0; i < 8; ++i) { v[i] = fexp(v[i] - mx); sm += v[i]; }
#pragma unroll
        for (int o = 1; o < 32; o <<= 1) sm += shx(sm, o, tid & 63);
        const float inv = frcp(sm);
#pragma unroll
        for (int i = 0; i < 8; ++i) lg[h * 256 + l32 + 32 * i] = v[i] * inv; }
    __syncthreads();
    {
        const int d = tid & 127, g = tid >> 7; float o[4] = {0.f, 0.f, 0.f, 0.f};
#pragma unroll 2
        for (int k = 0; k < n; ++k) { const int s = sel[k]; const float v = bf2f(PROJ[((size_t)b * SEQ + s) * PROJ_LD + COL_V + g * 128 + d]);
#pragma unroll
            for (int r = 0; r < 4; ++r) o[r] += lg[(g * 4 + r) * 256 + k] * v; }
#pragma unroll
        for (int r = 0; r < 4; ++r) { const int h = g * 4 + r; const float gbv = bf2f(PROJ[(size_t)qi * PROJ_LD + COL_GB + h * 128 + d]);
            bf16* yp = YCAT + (size_t)qi * 4096 + 2048 + h * 128 + d; const float yv = o[r] * gbv;
            if (!check) *yp = (bf16)f2bf(yv); else if (!(fabsf(bf2f(*yp) - yv) <= 1e-4f + 0.012f * fabsf(gbv) + 0.03f * fabsf(yv))) atomicOr((unsigned*)(KWS + WS_CTL) + 8, 2u); } }
}

__device__ __forceinline__ void sgu_item(const kargp_t kp, int j, int b, int ch, int g, unsigned char* lds, int wave) {
    const int tid = make_tid(wave); float* V = (float*)lds; float* MU = (float*)(lds + 65536); float* RS = MU + 128;
    const bf16* PROJ = (const bf16*)(KWS + WS_PROJ); const float* SLN = (const float*)(KWS + WS_STATLN); bf16* Y = (bf16*)(KWS + WS_YCAT);
    const float* lng = KIN(16) + (size_t)j * 2048, *lnb = KIN(17) + (size_t)j * 2048; const float* ws = KIN(18) + ((size_t)j * 16 + g) * 16384; const float* bs = KIN(19) + ((size_t)j * 16 + g) * 128;
    const size_t row0 = (size_t)b * SEQ + ch * 128;
    __syncthreads();
    if (tid < 128) { const float* sp = SLN + (row0 + tid) * 64; float s1 = 0.f, s2 = 0.f;
        for (int i = 0; i < 32; ++i) { s1 += sp[2 * i]; s2 += sp[2 * i + 1]; }
        const float mean = s1 * (1.0f / 2048.0f); const float var = fmaxf(s2 * (1.0f / 2048.0f) - mean * mean, 0.f); MU[tid] = mean; RS[tid] = frsq(var + 1e-6f); }
    __syncthreads();
    for (int e = tid; e < 2048; e += NTHR) { const int s = e >> 4, dq = (e & 15) * 8; const v4u w = *(const v4u*)(PROJ + (row0 + s) * ODD_IN + 2048 + g * 128 + dq);
        const float x[8] = {bflo(w.x), bfhi(w.x), bflo(w.y), bfhi(w.y), bflo(w.z), bfhi(w.z), bflo(w.w), bfhi(w.w)}; const float mu = MU[s], rs = RS[s];
#pragma unroll
        for (int i = 0; i < 8; ++i) { const int c = g * 128 + dq + i; V[s * 128 + dq + i] = (x[i] - mu) * rs * lng[c] + lnb[c]; } }
    __syncthreads();
    const int t = tid >> 2, dseg = (tid & 3) * 32, smax = (t < 64) ? 64 : 128;
    float acc[32];
#pragma unroll
    for (int i = 0; i < 32; ++i) acc[i] = 0.f;
#pragma unroll 2
    for (int s = 0; s < smax; ++s) { const float w = ws[t * 128 + s];
#pragma unroll
        for (int i4 = 0; i4 < 8; ++i4) { const f32x4 v = *(const f32x4*)(V + s * 128 + dseg + i4 * 4);
#pragma unroll
            for (int i = 0; i < 4; ++i) acc[i4 * 4 + i] += w * v[i]; } }
    const float bias = bs[t];
#pragma unroll
    for (int i8 = 0; i8 < 4; ++i8) { const int col = g * 128 + dseg + i8 * 8; const v4u uw = *(const v4u*)(PROJ + (row0 + t) * ODD_IN + col), gw = *(const v4u*)(PROJ + (row0 + t) * ODD_IN + 4096 + col);
        const float uu[8] = {bflo(uw.x), bfhi(uw.x), bflo(uw.y), bfhi(uw.y), bflo(uw.z), bfhi(uw.z), bflo(uw.w), bfhi(uw.w)};
        const float gg[8] = {bflo(gw.x), bfhi(gw.x), bflo(gw.y), bfhi(gw.y), bflo(gw.z), bfhi(gw.z), bflo(gw.w), bfhi(gw.w)};
        float y[8];
#pragma unroll
        for (int i = 0; i < 8; ++i) y[i] = uu[i] * (acc[i8 * 8 + i] + bias) * gg[i];
        v4u o; o.x = pk2(y[0], y[1]); o.y = pk2(y[2], y[3]); o.z = pk2(y[4], y[5]); o.w = pk2(y[6], y[7]);
        *(v4u*)(Y + (row0 + t) * 2048 + col) = o; }
}

namespace att {
using bf16x8 = __attribute__((ext_vector_type(8))) short;
using s16x4  = __attribute__((ext_vector_type(4))) short;
using f32x16 = __attribute__((ext_vector_type(16))) float;
using u32x4  = __attribute__((ext_vector_type(4))) unsigned;
constexpr int D = 128, QBLK = 32, KVBLK = 64;
constexpr int LDKK = 512, LDKV = PROJ_LD;
constexpr float THRL = 11.5f;
#ifndef ATT_SDEPTH
#define ATT_SDEPTH 1
#endif
constexpr int SDEPTH = ATT_SDEPTH;
constexpr int SHM_V = KVBLK * D * 2, SHM_K = KVBLK * D * 2;
constexpr int LDS_WS = 2 * SHM_V + 2 * SHM_K, LDS_LUT = LDS_WS + 8 * 64 * 4, LUT_N = 320, LDS_Q = LDS_LUT + 4 * LUT_N * 4, LDS_MS = LDS_Q + 8 * 8192, LDS_END = LDS_MS + 2048;
#define KSWZ(row, colB) ((row) * 256 + ((colB) ^ (((row) & 7) << 4)))
#define SBAR() __builtin_amdgcn_sched_barrier(0)
__device__ __forceinline__ int crow(int r, int hi) { return (r & 3) + 8 * (r >> 2) + 4 * hi; }
__device__ __forceinline__ unsigned cvtpk(float lo, float hi) { unsigned r; asm volatile("v_cvt_pk_bf16_f32 %0, %1, %2" : "=v"(r) : "v"(lo), "v"(hi)); return r; }
__device__ __forceinline__ float psw_max(float x) { auto rr = __builtin_amdgcn_permlane32_swap(__float_as_uint(x), __float_as_uint(x), false, false); return fmaxf(__uint_as_float(rr[0]), __uint_as_float(rr[1])); }
__device__ __forceinline__ float psw_sum(float x) { auto rr = __builtin_amdgcn_permlane32_swap(__float_as_uint(x), __float_as_uint(x), false, false); return __uint_as_float(rr[0]) + __uint_as_float(rr[1]); }

__device__ __forceinline__ float max3f(float x, float y, float z) { float r; asm("v_max3_f32 %0, %1, %2, %3" : "=v"(r) : "v"(x), "v"(y), "v"(z)); return r; }
template <bool NEAR> __device__ __forceinline__ void maskbias(f32x16& p0, f32x16& p1, unsigned w0, unsigned w1, const float* lutp) {
#pragma unroll
    for (int r = 0; r < 16; ++r) { const int cb = (r & 3) + 8 * (r >> 2);
        float a = p0[r], b = p1[r];
        if (NEAR) { a += lutp[cb]; b += lutp[32 + cb]; }
        const unsigned m0 = (unsigned)(((int)(w0 << (31 - cb))) >> 31), m1 = (unsigned)(((int)(w1 << (31 - cb))) >> 31);
        p0[r] = __uint_as_float((__float_as_uint(a) & m0) | (~m0 & 0xff800000u)); p1[r] = __uint_as_float((__float_as_uint(b) & m1) | (~m1 & 0xff800000u)); }
}
template <int VAR = 0> __device__ __forceinline__ void partialSM(f32x16& p0, f32x16& p1, float& m_reg, float& alpha, float boff) {
    if (VAR == 5) { alpha = 1.f; asm volatile("" : "+v"(p0), "+v"(p1)); return; }
    float pa = max3f(p0[0], p0[1], p0[2]), pb = max3f(p1[0], p1[1], p1[2]);
#pragma unroll
    for (int r = 3; r < 15; r += 2) { pa = max3f(pa, p0[r], p0[r + 1]); pb = max3f(pb, p1[r], p1[r + 1]); }
    float pmax = max3f(pa, pb, p0[15]); pmax = max3f(pmax, p1[15], p1[15]);
    pmax = psw_max(pmax) + boff;
    float mn;
    if (__builtin_expect(__all(pmax - m_reg <= THRL), 1)) { mn = m_reg; alpha = 1.f; }
    else { mn = fmaxf(m_reg, pmax); alpha = __builtin_amdgcn_exp2f(m_reg - mn); m_reg = mn; }
    const float sub = mn - boff;
#pragma unroll
    for (int r = 0; r < 16; ++r) { p0[r] -= sub; p1[r] -= sub; }
#pragma unroll
    for (int r = 0; r < 16; ++r) p0[r] = __builtin_amdgcn_exp2f(p0[r]);
}
template <int VAR = 0> __device__ __forceinline__ void finishSM(f32x16& p0, f32x16& p1, float alpha, float& l_reg, bf16x8& pa0, bf16x8& pa1, bf16x8& pa2, bf16x8& pa3) {
    if (VAR != 5) {
#pragma unroll
    for (int r = 0; r < 16; ++r) p1[r] = __builtin_amdgcn_exp2f(p1[r]);
    float ps = 0.f;
#pragma unroll
    for (int r = 0; r < 16; ++r) ps += p0[r];
#pragma unroll
    for (int r = 0; r < 16; ++r) ps += p1[r];
    ps = psw_sum(ps);
    l_reg = l_reg * alpha + ps; } else l_reg = 1.f;
#define PK4(P, BASE, OUT) do { unsigned a0 = cvtpk(P[BASE + 0], P[BASE + 1]), a1 = cvtpk(P[BASE + 2], P[BASE + 3]);   \
    unsigned b0 = cvtpk(P[BASE + 4], P[BASE + 5]), b1 = cvtpk(P[BASE + 6], P[BASE + 7]);                              \
    auto r0 = __builtin_amdgcn_permlane32_swap(a0, b0, false, false); auto r1 = __builtin_amdgcn_permlane32_swap(a1, b1, false, false); \
    u32x4 w = {r0[0], r1[0], r0[1], r1[1]}; OUT = *reinterpret_cast<bf16x8*>(&w); } while (0)
    PK4(p0, 0, pa0); PK4(p0, 8, pa1); PK4(p1, 0, pa2); PK4(p1, 8, pa3);
#undef PK4
}
__device__ __forceinline__ void qkt(f32x16& p0, f32x16& p1, const char* Ks, const char* qs, int r32, int hi) {
    p0 = f32x16{}; p1 = f32x16{};
#pragma unroll
    for (int d0 = 0; d0 < 8; ++d0) { const int cb = (d0 * 16 + hi * 8) * 2;
        const bf16x8 b0 = *reinterpret_cast<const bf16x8*>(Ks + KSWZ(r32, cb));
        const bf16x8 b1 = *reinterpret_cast<const bf16x8*>(Ks + KSWZ(32 + r32, cb));
        const bf16x8 qf = *reinterpret_cast<const bf16x8*>(qs + d0 * 1024);
        p0 = __builtin_amdgcn_mfma_f32_32x32x16_bf16(b0, qf, p0, 0, 0, 0);
        p1 = __builtin_amdgcn_mfma_f32_32x32x16_bf16(b1, qf, p1, 0, 0, 0); }
}
#define PK4(P, BASE, OUT) do { unsigned a0 = cvtpk(P[BASE + 0], P[BASE + 1]), a1 = cvtpk(P[BASE + 2], P[BASE + 3]);   \
    unsigned b0 = cvtpk(P[BASE + 4], P[BASE + 5]), b1 = cvtpk(P[BASE + 6], P[BASE + 7]);                              \
    auto r0 = __builtin_amdgcn_permlane32_swap(a0, b0, false, false); auto r1 = __builtin_amdgcn_permlane32_swap(a1, b1, false, false); \
    u32x4 w = {r0[0], r1[0], r0[1], r1[1]}; OUT = *reinterpret_cast<bf16x8*>(&w); } while (0)
__device__ __forceinline__ void qkt_fsm(f32x16& p0, f32x16& p1, const char* Ks, const char* qs, int r32, int hi, f32x16& q0, f32x16& q1, float alpha, float& l_reg, bf16x8& pa0, bf16x8& pa1, bf16x8& pa2, bf16x8& pa3) {
    p0 = f32x16{}; p1 = f32x16{};
    bf16x8 fb0[3], fb1[3], fq[3];
#define QK_LD(S, D0) do { const int cb_ = ((D0) * 16 + hi * 8) * 2; fb0[S] = *reinterpret_cast<const bf16x8*>(Ks + KSWZ(r32, cb_)); fb1[S] = *reinterpret_cast<const bf16x8*>(Ks + KSWZ(32 + r32, cb_)); fq[S] = *reinterpret_cast<const bf16x8*>(qs + (D0) * 1024); } while (0)
    SBAR(); QK_LD(0, 0); QK_LD(1, 1);
    float ps = 0.f;
#pragma unroll
    for (int d0 = 0; d0 < 8; ++d0) {
        SBAR();
        if (d0 + 2 < 8) QK_LD((d0 + 2) % 3, d0 + 2);
        p0 = __builtin_amdgcn_mfma_f32_32x32x16_bf16(fb0[d0 % 3], fq[d0 % 3], p0, 0, 0, 0);
        p1 = __builtin_amdgcn_mfma_f32_32x32x16_bf16(fb1[d0 % 3], fq[d0 % 3], p1, 0, 0, 0);
        q1[2 * d0] = __builtin_amdgcn_exp2f(q1[2 * d0]); q1[2 * d0 + 1] = __builtin_amdgcn_exp2f(q1[2 * d0 + 1]);
        ps += (q0[2 * d0] + q0[2 * d0 + 1]) + (q1[2 * d0] + q1[2 * d0 + 1]);
        if (d0 == 1) PK4(q0, 0, pa0);
        if (d0 == 3) PK4(q0, 8, pa1);
        if (d0 == 5) PK4(q1, 0, pa2);
    }
    SBAR();
    PK4(q1, 8, pa3);
    ps = psw_sum(ps); l_reg = l_reg * alpha + ps;
#undef QK_LD
}
#undef PK4
__device__ __forceinline__ int v_st(int k, int c) { const int kk = (k & ~0xC) | ((k & 4) << 1) | ((k & 8) >> 1); return ((kk >> 3) * 4 + (c >> 5)) * 512 + ((kk & 7) * 32 + (c & 31)) * 2; }
__device__ __forceinline__ int v_rd_base(int lane) { return ((lane & 3) << 3) | (((lane >> 2) & 3) << 6) | (((lane >> 4) & 1) << 5) | (((lane >> 5) & 1) << 8); }
constexpr int v_rd_off(int d0, int ks, int half) { return d0 * 512 + ks * 4096 + half * 2048; }
template <int OFF> __device__ __forceinline__ s16x4 tr_read(int vb) { s16x4 r; asm volatile("ds_read_b64_tr_b16 %0, %1 offset:%2" : "=&v"(r) : "v"(vb), "i"(OFF) : "memory"); return r; }
#define PV_PK(L, H) (bf16x8){L[0], L[1], L[2], L[3], H[0], H[1], H[2], H[3]}
#define PV_READ(S, D0) do { S[0] = tr_read<v_rd_off(D0, 0, 0)>(vb); S[1] = tr_read<v_rd_off(D0, 0, 1)>(vb); S[2] = tr_read<v_rd_off(D0, 1, 0)>(vb); S[3] = tr_read<v_rd_off(D0, 1, 1)>(vb); \
    S[4] = tr_read<v_rd_off(D0, 2, 0)>(vb); S[5] = tr_read<v_rd_off(D0, 2, 1)>(vb); S[6] = tr_read<v_rd_off(D0, 3, 0)>(vb); S[7] = tr_read<v_rd_off(D0, 3, 1)>(vb); } while (0)
#define PV_MMA(S, OD) do { OD = __builtin_amdgcn_mfma_f32_32x32x16_bf16(pa0, PV_PK(S[0], S[1]), OD, 0, 0, 0); OD = __builtin_amdgcn_mfma_f32_32x32x16_bf16(pa1, PV_PK(S[2], S[3]), OD, 0, 0, 0); \
    OD = __builtin_amdgcn_mfma_f32_32x32x16_bf16(pa2, PV_PK(S[4], S[5]), OD, 0, 0, 0); OD = __builtin_amdgcn_mfma_f32_32x32x16_bf16(pa3, PV_PK(S[6], S[7]), OD, 0, 0, 0); } while (0)
template <int VAR = 0> __device__ __forceinline__ void pv_d0(f32x16* o, int vb, bf16x8 pa0, bf16x8 pa1, bf16x8 pa2, bf16x8 pa3) {
    if (VAR == 2) { asm volatile("" :: "v"(pa0), "v"(pa1), "v"(pa2), "v"(pa3)); return; }
    s16x4 sa[8], sb[8];
    SBAR(); asm volatile("s_waitcnt lgkmcnt(0)" ::: "memory");
    PV_READ(sa, 0); PV_READ(sb, 1);
    asm volatile("s_waitcnt lgkmcnt(8)" ::: "memory"); SBAR(); PV_MMA(sa, o[0]); SBAR();
    PV_READ(sa, 2);
    asm volatile("s_waitcnt lgkmcnt(8)" ::: "memory"); SBAR(); PV_MMA(sb, o[1]); SBAR();
    PV_READ(sb, 3);
    asm volatile("s_waitcnt lgkmcnt(8)" ::: "memory"); SBAR(); PV_MMA(sa, o[2]); SBAR();
    asm volatile("s_waitcnt lgkmcnt(0)" ::: "memory"); SBAR(); PV_MMA(sb, o[3]); SBAR();
}
#define SGB_MV(NM, NV) do { _Pragma("unroll") for (int q_ = 0; q_ < (NM); ++q_) { __builtin_amdgcn_sched_group_barrier(0x008, 1, 0); __builtin_amdgcn_sched_group_barrier(0x002, (NV), 0); } } while (0)
__device__ __forceinline__ void pv_psm(f32x16* o, int vb, bf16x8 pa0, bf16x8 pa1, bf16x8 pa2, bf16x8 pa3, f32x16& p0, f32x16& p1, float& m_reg, float& alpha, float boff) {
    s16x4 sa[8], sb[8];
    SBAR(); asm volatile("s_waitcnt lgkmcnt(0)" ::: "memory");
    PV_READ(sa, 0); PV_READ(sb, 1);
    asm volatile("s_waitcnt lgkmcnt(8)" ::: "memory"); SBAR(); PV_MMA(sa, o[0]);
    float pa = max3f(p0[0], p0[1], p0[2]), pb = max3f(p1[0], p1[1], p1[2]);
#pragma unroll
    for (int r = 3; r < 15; r += 2) { pa = max3f(pa, p0[r], p0[r + 1]); pb = max3f(pb, p1[r], p1[r + 1]); }
    float pmax = max3f(pa, pb, p0[15]); pmax = max3f(pmax, p1[15], p1[15]);
    pmax = psw_max(pmax) + boff;
    asm volatile("" : "+v"(pmax));
    SGB_MV(4, 4); SBAR();
    PV_READ(sa, 2);
    asm volatile("s_waitcnt lgkmcnt(8)" ::: "memory"); SBAR(); PV_MMA(sb, o[1]);
    const bool keep = __all(pmax - m_reg <= THRL);
    const float mn = keep ? m_reg : fmaxf(m_reg, pmax); alpha = __builtin_amdgcn_exp2f(m_reg - mn); m_reg = mn;
    const float sub = mn - boff;
#pragma unroll
    for (int r = 0; r < 16; ++r) p0[r] -= sub;
    asm volatile("" : "+v"(p0));
    SGB_MV(4, 5); SBAR();
    PV_READ(sb, 3);
    asm volatile("s_waitcnt lgkmcnt(8)" ::: "memory"); SBAR(); PV_MMA(sa, o[2]);
#pragma unroll
    for (int r = 0; r < 16; ++r) p1[r] -= sub;
#pragma unroll
    for (int r = 0; r < 6; ++r) p0[r] = __builtin_amdgcn_exp2f(p0[r]);
    asm volatile("" : "+v"(p0), "+v"(p1));
    SGB_MV(4, 6); SBAR();
    asm volatile("s_waitcnt lgkmcnt(0)" ::: "memory"); SBAR(); PV_MMA(sb, o[3]);
#pragma unroll
    for (int r = 6; r < 16; ++r) p0[r] = __builtin_amdgcn_exp2f(p0[r]);
    asm volatile("" : "+v"(p0));
    SGB_MV(4, 3); SBAR();
}
#undef PV_PK
#undef PV_READ
#undef PV_MMA

template <int VAR> __device__ __forceinline__ void attn_unit(const kargp_t kp, int j, int b, int g, int c, char* lds, int wave) {
    const int tid = make_tid(wave), wid = tid >> 6, lane = tid & 63, r32 = lane & 31, hi = lane >> 5;
    const bf16* PROJ = (const bf16*)(KWS + WS_PROJ); const unsigned* BM = (const unsigned*)(KWS + WS_BM); bf16* YCAT = (bf16*)(KWS + (VAR ? WS_SC : WS_YCAT));
    const int hr = wid >> 1, h = g * 4 + hr, qh = wid & 1;
    const int t = c * 64 + qh * 32 + r32; const size_t qrow = (size_t)b * SEQ + t;
    const bf16* Kh = (const bf16*)(KWS + WS_KN) + (size_t)b * SEQ * LDKK + g * 128; const bf16* Vh = PROJ + (size_t)b * SEQ * LDKV + COL_V + g * 128;
    char* V_lds = lds; char* K_lds = lds + 2 * SHM_V;
    float* wsf = (float*)(lds + LDS_WS) + wid * 64; float* li_l = wsf; float* al_l = wsf + 32; float* LUT = (float*)(lds + LDS_LUT);
    const int NT0 = c + 1, NT = NT0 + (NT0 & 1);
    __syncthreads();
    for (int e = tid; e < 4 * LUT_N; e += NTHR) { const int rr = e / LUT_N, i = e % LUT_N; LUT[e] = rel_bias_at(kp, i - 192, g * 4 + rr) * 1.4426950408889634f; }
    const float bfar = rel_bias_at(kp, -200, h) * 1.4426950408889634f;
    float m_reg = -1e30f, l_reg = 0.f; f32x16 o[4] = {}; char* qs = lds + LDS_Q + wid * 8192 + lane * 16;
    {   float qf[64]; float ss = 0.f; const bf16* qp = PROJ + qrow * PROJ_LD + COL_Q + h * 128 + hi * 8;
#pragma unroll
        for (int d0 = 0; d0 < 8; ++d0) { const u32x4 w = *(const u32x4*)(qp + d0 * 16);
            qf[d0 * 8 + 0] = bflo(w.x); qf[d0 * 8 + 1] = bfhi(w.x); qf[d0 * 8 + 2] = bflo(w.y); qf[d0 * 8 + 3] = bfhi(w.y); qf[d0 * 8 + 4] = bflo(w.z); qf[d0 * 8 + 5] = bfhi(w.z); qf[d0 * 8 + 6] = bflo(w.w); qf[d0 * 8 + 7] = bfhi(w.w); }
#pragma unroll
        for (int i = 0; i < 64; ++i) ss += qf[i] * qf[i];
        ss = psw_sum(ss);
        const float f = frsq(ss * (1.0f / 128.0f) + 1e-6f) * (0.08838834764831845f * 1.4426950408889634f); const float* qg = KIN(12) + (size_t)j * 128 + hi * 8;
#pragma unroll
        for (int d0 = 0; d0 < 8; ++d0) { const f32x4 g0 = *(const f32x4*)(qg + d0 * 16), g1 = *(const f32x4*)(qg + d0 * 16 + 4);
            u32x4 w; w.x = cvtpk(qf[d0 * 8 + 0] * f * g0[0], qf[d0 * 8 + 1] * f * g0[1]); w.y = cvtpk(qf[d0 * 8 + 2] * f * g0[2], qf[d0 * 8 + 3] * f * g0[3]);
            w.z = cvtpk(qf[d0 * 8 + 4] * f * g1[0], qf[d0 * 8 + 5] * f * g1[1]); w.w = cvtpk(qf[d0 * 8 + 6] * f * g1[2], qf[d0 * 8 + 7] * f * g1[3]); *reinterpret_cast<u32x4*>(qs + d0 * 1024) = w; }
    }
    const int vb0 = (int)(uintptr_t)V_lds + v_rd_base(lane);
    const int krow_ = 8 * wid + (lane >> 4), kch_ = lane & 15;
    const bf16* ksrc0 = Kh + (size_t)krow_ * LDKK + ((kch_ ^ (krow_ & 7)) * 8); const bf16* ksrc1 = Kh + (size_t)(krow_ + 4) * LDKK + ((kch_ ^ ((krow_ + 4) & 7)) * 8);
    const int vkk_ = 8 * wid + ((lane & 31) >> 2), vk_ = (vkk_ & ~0xC) | ((vkk_ & 4) << 1) | ((vkk_ & 8) >> 1);
    const bf16* vsrc0 = Vh + (size_t)vk_ * LDKV + (lane >> 5) * 32 + (lane & 3) * 8; const bf16* vsrc1 = vsrc0 + 64;
    const unsigned* msrc = BM + ((size_t)b * SEQ + c * 64 + lane) * 128;
    char* MS = lds + LDS_MS;
#define DMAK(bb, k0) do { LAS unsigned* d_ = (LAS unsigned*)(K_lds + (bb) * SHM_K + wave * 2048); \
    __builtin_amdgcn_global_load_lds((const unsigned*)(ksrc0 + (size_t)(k0) * LDKK), d_, 16, 0, 0); __builtin_amdgcn_global_load_lds((const unsigned*)(ksrc1 + (size_t)(k0) * LDKK), d_ + 256, 16, 0, 0); } while (0)
#define DMAV(bb, k0) do { LAS unsigned* d_ = (LAS unsigned*)(V_lds + (bb) * SHM_V + wave * 2048); \
    __builtin_amdgcn_global_load_lds((const unsigned*)(vsrc0 + (size_t)(k0) * LDKV), d_, 16, 0, 0); __builtin_amdgcn_global_load_lds((const unsigned*)(vsrc1 + (size_t)(k0) * LDKV), d_ + 256, 16, 0, 0); } while (0)
#define DMAM(pr) do { if (wave == 0) __builtin_amdgcn_global_load_lds(msrc + 4 * (pr), (LAS unsigned*)(MS + ((pr) & 1) * 1024), 16, 0, 0); } while (0)
#define RESC(a) do { if (__any((a) < 1.f)) { if (hi == 0) al_l[r32] = (a); asm volatile("s_waitcnt lgkmcnt(0)" ::: "memory"); \
    _Pragma("unroll") for (int d = 0; d < 4; ++d) _Pragma("unroll") for (int r = 0; r < 16; ++r) o[d][r] *= al_l[crow(r, hi)]; } } while (0)
#define SCORE(P0, P1, jt) do { const bool near_ = (jt) >= c - 2; const v2u mw_ = *(const v2u*)(MS + (((jt) >> 1) & 1) * 1024 + (qh * 32 + r32) * 16 + ((jt) & 1) * 8); \
    if (VAR == 3) { P0 = f32x16{}; P1 = f32x16{}; asm volatile("" : "+v"(P0), "+v"(P1)); } else qkt(P0, P1, K_lds + ((jt) & 1) * SHM_K, qs, r32, hi); const unsigned w0_ = mw_.x >> (4 * hi), w1_ = mw_.y >> (4 * hi); \
    if (near_) { const float* lutp_ = LUT + hr * LUT_N + (64 * (jt) - t + 192 + 4 * hi); maskbias<true>(P0, P1, w0_, w1_, lutp_); } else if (VAR != 1) maskbias<false>(P0, P1, w0_, w1_, nullptr); else asm volatile("" :: "v"(w0_), "v"(w1_)); } while (0)
#define WAITBAR() do { asm volatile("s_waitcnt vmcnt(0)" ::: "memory"); __syncthreads(); } while (0)
#define HALF(ORD, Pc0, Pc1, alc, Pp0, Pp1, alp, jt) do { SBAR(); if ((jt) + 1 < NT) DMAK(((jt) + 1) & 1, ((jt) + 1) * KVBLK);     \
    if (ORD == 0) { SCORE(Pc0, Pc1, jt); finishSM<VAR>(Pp0, Pp1, alp, l_reg, pa0, pa1, pa2, pa3); SBAR(); pv_d0<VAR>(o, vb0 + (((jt) - 1) & 1) * SHM_V, pa0, pa1, pa2, pa3); } \
    else { finishSM<VAR>(Pp0, Pp1, alp, l_reg, pa0, pa1, pa2, pa3); SBAR(); pv_d0<VAR>(o, vb0 + (((jt) - 1) & 1) * SHM_V, pa0, pa1, pa2, pa3); SBAR(); SCORE(Pc0, Pc1, jt); } \
    partialSM<VAR>(Pc0, Pc1, m_reg, alc, ((jt) >= c - 2) ? 0.f : bfar); \
    WAITBAR(); if ((jt) + 1 < NT) DMAV(((jt) + 1) & 1, ((jt) + 1) * KVBLK); if ((((jt) & 1) == 0) && (jt) + 2 < NT) DMAM(((jt) + 2) >> 1); \
    RESC(alc); } while (0)
#define SCORE_QK(P0, P1, jt) qkt(P0, P1, K_lds + ((jt) & 1) * SHM_K, qs, r32, hi)
#define MASKB(P0, P1, jt) do { const bool near_ = (jt) >= c - 2; const v2u mw_ = *(const v2u*)(MS + (((jt) >> 1) & 1) * 1024 + (qh * 32 + r32) * 16 + ((jt) & 1) * 8); const unsigned w0_ = mw_.x >> (4 * hi), w1_ = mw_.y >> (4 * hi); \
    if (near_) { const float* lutp_ = LUT + hr * LUT_N + (64 * (jt) - t + 192 + 4 * hi); maskbias<true>(P0, P1, w0_, w1_, lutp_); } else maskbias<false>(P0, P1, w0_, w1_, nullptr); } while (0)
#define HALF2(Pc0, Pc1, alc, Pp0, Pp1, alp, jt) do { SBAR(); if ((jt) + 1 < NT) DMAK(((jt) + 1) & 1, ((jt) + 1) * KVBLK); \
    qkt_fsm(Pc0, Pc1, K_lds + ((jt) & 1) * SHM_K, qs, r32, hi, Pp0, Pp1, alp, l_reg, pa0, pa1, pa2, pa3); \
    SBAR(); MASKB(Pc0, Pc1, jt); \
    pv_psm(o, vb0 + (((jt) - 1) & 1) * SHM_V, pa0, pa1, pa2, pa3, Pc0, Pc1, m_reg, alc, ((jt) >= c - 2) ? 0.f : bfar); \
    WAITBAR(); if ((jt) + 1 < NT) DMAV(((jt) + 1) & 1, ((jt) + 1) * KVBLK); if ((((jt) & 1) == 0) && (jt) + 2 < NT) DMAM(((jt) + 2) >> 1); \
    RESC(alc); } while (0)
#define TILE_LOOP2() do { for (int jt = 1; jt + 1 < NT; jt += 2) { HALF2(pB0, pB1, alB, pA0, pA1, alA, jt); HALF2(pA0, pA1, alA, pB0, pB1, alB, jt + 1); } } while (0)
#define TILE_LOOP(ORD) do { for (int jt = 1; jt + 1 < NT; jt += 2) { HALF(ORD, pB0, pB1, alB, pA0, pA1, alA, jt); HALF(ORD, pA0, pA1, alA, pB0, pB1, alB, jt + 1); } } while (0)
    f32x16 pA0, pA1, pB0, pB1; float alA, alB; bf16x8 pa0, pa1, pa2, pa3;
    DMAM(0); DMAK(0, 0); DMAV(0, 0); WAITBAR();
    SBAR(); DMAK(1, KVBLK); SCORE(pA0, pA1, 0); partialSM<VAR>(pA0, pA1, m_reg, alA, (0 >= c - 2) ? 0.f : bfar);
    WAITBAR(); DMAV(1, KVBLK); if (2 < NT) DMAM(1);
#ifdef ATT_OLD_LOOP
    if (wave < 4) TILE_LOOP(0); else TILE_LOOP(1);
#else
    TILE_LOOP2();
#endif
    SBAR(); SCORE(pB0, pB1, NT - 1);
    finishSM<VAR>(pA0, pA1, alA, l_reg, pa0, pa1, pa2, pa3); SBAR();
    pv_d0<VAR>(o, vb0, pa0, pa1, pa2, pa3); partialSM<VAR>(pB0, pB1, m_reg, alB, 0.f);
    WAITBAR(); RESC(alB);
    finishSM<VAR>(pB0, pB1, alB, l_reg, pa0, pa1, pa2, pa3); SBAR();
    pv_d0<VAR>(o, vb0 + SHM_V, pa0, pa1, pa2, pa3);
    if (hi == 0) li_l[r32] = l_reg; asm volatile("s_waitcnt lgkmcnt(0)" ::: "memory");
    const size_t row0 = (size_t)b * SEQ + c * 64 + qh * 32;
    const int erow = lane >> 4, ech = lane & 15;
    u32x4 gw[8];
#pragma unroll
    for (int i = 0; i < 8; ++i) gw[i] = *(const u32x4*)(PROJ + (row0 + 4 * i + erow) * PROJ_LD + COL_GB + h * 128 + ech * 8);
    char* stg = lds + LDS_Q + wid * 8192;
#pragma unroll
    for (int r = 0; r < 16; ++r) { const int orow = crow(r, hi); const float rl = frcp(li_l[orow]);
#pragma unroll
        for (int d0 = 0; d0 < 4; ++d0) *(unsigned short*)(stg + orow * 256 + (((d0 * 32 + r32) * 2) ^ (((orow >> 2) & 1) << 6))) = (unsigned short)f2bf(o[d0][r] * rl); }
    asm volatile("s_waitcnt lgkmcnt(0)" ::: "memory");
#pragma unroll
    for (int i = 0; i < 8; ++i) { const int row = 4 * i + erow; const u32x4 ov = *(const u32x4*)(stg + row * 256 + ((ech * 16) ^ (((row >> 2) & 1) << 6))); const u32x4 g = gw[i];
        u32x4 y; y.x = pk2(bflo(ov.x) * bflo(g.x), bfhi(ov.x) * bfhi(g.x)); y.y = pk2(bflo(ov.y) * bflo(g.y), bfhi(ov.y) * bfhi(g.y));
        y.z = pk2(bflo(ov.z) * bflo(g.z), bfhi(ov.z) * bfhi(g.z)); y.w = pk2(bflo(ov.w) * bflo(g.w), bfhi(ov.w) * bfhi(g.w));
        *(u32x4*)(YCAT + (row0 + row) * 4096 + 2048 + h * 128 + ech * 8) = y; }
#undef DMAK
#undef DMAV
#undef DMAM
#undef RESC
#undef SCORE
#undef WAITBAR
#undef HALF
#undef TILE_LOOP
#undef HALF2
#undef TILE_LOOP2
#undef SCORE_QK
#undef MASKB
}
#undef KSWZ
#undef SBAR
}

__device__ __forceinline__ void sgu_item_mfma(const kargp_t kp, int j, int b, int ch, int g, unsigned char* lds, int wave) {
    const int tid = make_tid(wave), lane = tid & 63, fr = lane & 15, q4 = lane >> 4, wid = tid >> 6;
    unsigned char* VT = lds; float* MU = (float*)(lds + 32768); float* RS = MU + 128; unsigned char* UT = lds + 40960; unsigned char* GT = lds + 73728;
    const bf16* PROJ = (const bf16*)(KWS + WS_PROJ); const float* SLN = (const float*)(KWS + WS_STATLN); bf16* Y = (bf16*)(KWS + WS_YCAT);
    const float* lng = KIN(16) + (size_t)j * 2048, *lnb = KIN(17) + (size_t)j * 2048; const float* bs = KIN(19) + ((size_t)j * 16 + g) * 128;
    const size_t row0 = (size_t)b * SEQ + ch * 128;
    __syncthreads();
    const int srow = tid >> 2, sq = tid & 3; const f32x4* sp = (const f32x4*)(SLN + (row0 + srow) * 64) + sq * 4;
    f32x4 sv[4];
#pragma unroll
    for (int i = 0; i < 4; ++i) sv[i] = sp[i];
    const bf16* wsb = (const bf16*)(KWS + WS_WSMALL) + (size_t)2 * 32 * 16384 + ((size_t)(j * 16 + g) * 128 + 16 * wid + fr) * 128 + 8 * q4;
    s_bf16x8 af[4];
#pragma unroll
    for (int ks = 0; ks < 4; ++ks) af[ks] = *(const s_bf16x8*)(wsb + ks * 32);
    float bias[4];
#pragma unroll
    for (int r = 0; r < 4; ++r) bias[r] = bs[16 * wid + 4 * q4 + r];
    const int dq = (tid & 15) * 8;
    v4u vw[4];
#pragma unroll
    for (int i = 0; i < 4; ++i) { const int s_ = (tid + NTHR * i) >> 4; vw[i] = *(const v4u*)(PROJ + (row0 + s_) * ODD_IN + 2048 + g * 128 + dq); }
    const f32x4 g0 = *(const f32x4*)(lng + g * 128 + dq), g1 = *(const f32x4*)(lng + g * 128 + dq + 4), b0 = *(const f32x4*)(lnb + g * 128 + dq), b1 = *(const f32x4*)(lnb + g * 128 + dq + 4);
    v4u uw[4], gw_[4];
#pragma unroll
    for (int i = 0; i < 4; ++i) { const int e = tid + NTHR * i, t = e >> 4, chk = e & 15; const bf16* pr = PROJ + (row0 + t) * ODD_IN + g * 128 + chk * 8; uw[i] = *(const v4u*)pr; gw_[i] = *(const v4u*)(pr + 4096); }
    {   float s1 = 0.f, s2 = 0.f;
#pragma unroll
        for (int i = 0; i < 4; ++i) { s1 += sv[i][0] + sv[i][2]; s2 += sv[i][1] + sv[i][3]; }
        s1 += __int_as_float(__builtin_amdgcn_mov_dpp(__float_as_int(s1), 0xB1, 0xF, 0xF, true)); s2 += __int_as_float(__builtin_amdgcn_mov_dpp(__float_as_int(s2), 0xB1, 0xF, 0xF, true));
        s1 += __int_as_float(__builtin_amdgcn_mov_dpp(__float_as_int(s1), 0x4E, 0xF, 0xF, true)); s2 += __int_as_float(__builtin_amdgcn_mov_dpp(__float_as_int(s2), 0x4E, 0xF, 0xF, true));
        const float mean = s1 * (1.0f / 2048.0f); const float var = fmaxf(s2 * (1.0f / 2048.0f) - mean * mean, 0.f); if (sq == 0) { MU[srow] = mean; RS[srow] = frsq(var + 1e-6f); } }
#pragma unroll
    for (int i = 0; i < 4; ++i) { const int e = tid + NTHR * i, t = e >> 4, chk = e & 15; *(v4u*)(UT + t * 256 + chk * 16) = uw[i]; *(v4u*)(GT + t * 256 + chk * 16) = gw_[i]; }
    __syncthreads();
#pragma unroll
    for (int i = 0; i < 4; ++i) { const int s = (tid + NTHR * i) >> 4; const v4u w = vw[i];
        const float x[8] = {bflo(w.x), bfhi(w.x), bflo(w.y), bfhi(w.y), bflo(w.z), bfhi(w.z), bflo(w.w), bfhi(w.w)}; const float mu = MU[s], rs = RS[s];
#pragma unroll
        for (int k = 0; k < 8; ++k) { const int d = dq + k; const float v = (x[k] - mu) * rs * (k < 4 ? g0[k & 3] : g1[k & 3]) + (k < 4 ? b0[k & 3] : b1[k & 3]);
            *(bf16*)(VT + d * 256 + ((s * 2) ^ (((d & 15) ^ ((d >> 4) & 7)) << 4))) = (bf16)f2bf(v); } }
    __syncthreads();
    f32x4 acc[8];
#pragma unroll
    for (int n = 0; n < 8; ++n) acc[n] = (f32x4){0.f, 0.f, 0.f, 0.f};
    {
        s_bf16x8 bv[2][4];
#define SGU_LD(S, N) do { _Pragma("unroll") for (int ks = 0; ks < 4; ++ks) bv[S][ks] = *(const s_bf16x8*)(VT + (16 * (N) + fr) * 256 + (((ks * 32 + 8 * q4) * 2) ^ ((fr ^ ((N) & 7)) << 4))); } while (0)
        SGU_LD(0, 0);
#pragma unroll
        for (int n = 0; n < 8; ++n) { __builtin_amdgcn_sched_barrier(0);
            if (n + 1 < 8) SGU_LD((n + 1) & 1, n + 1);
#pragma unroll
            for (int ks = 0; ks < 4; ++ks) acc[n] = __builtin_amdgcn_mfma_f32_16x16x32_bf16(af[ks], bv[n & 1][ks], acc[n], 0, 0, 0); }
        __builtin_amdgcn_sched_barrier(0);
#undef SGU_LD
    }
    unsigned short uq[4][8], gq[4][8];
#pragma unroll
    for (int r = 0; r < 4; ++r) { const int t = 16 * wid + 4 * q4 + r;
#pragma unroll
        for (int n = 0; n < 8; ++n) { uq[r][n] = *(const unsigned short*)(UT + t * 256 + (16 * n + fr) * 2); gq[r][n] = *(const unsigned short*)(GT + t * 256 + (16 * n + fr) * 2); } }
#pragma unroll
    for (int r = 0; r < 4; ++r) { const int t = 16 * wid + 4 * q4 + r;
#pragma unroll
        for (int n = 0; n < 8; ++n) *(bf16*)(UT + t * 256 + (16 * n + fr) * 2) = (bf16)f2bf(bf2f(uq[r][n]) * (acc[n][r] + bias[r]) * bf2f(gq[r][n])); }
    __syncthreads();
#pragma unroll
    for (int i = 0; i < 4; ++i) { const int e = tid + NTHR * i, t = e >> 4, chk = e & 15; *(v4u*)(Y + (row0 + t) * 2048 + g * 128 + chk * 8) = *(const v4u*)(UT + t * 256 + chk * 16); }
}

__global__ void __launch_bounds__(NTHR, 2) mega_fwd(Args args) {
    extern __shared__ __attribute__((aligned(16))) unsigned char lds[];
    const int wave = __builtin_amdgcn_readfirstlane((int)threadIdx.x >> 6);
    const int G = gridDim.x, bx = blockIdx.x;
#define LANE_ONLY() int lane_ = lane_id(); asm volatile("" : "+v"(lane_)); const int lane = lane_
#define LANE_OPAQUE() KARGS_OPEN(); int lane_ = lane_id(); asm volatile("" : "+v"(lane_)); const int lane = lane_

    volatile LAS unsigned* MISC = (volatile LAS unsigned*)((LAS unsigned char*)lds + MISC_OFF);
    if (threadIdx.x < 64) MISC[threadIdx.x] = 0u;
    __syncthreads();
    XcdBarrier bar; bar.bar = (unsigned*)(args.ws + WS_CTL) + CW_BAR; bar.x = 0; bar.st = nullptr;
    if (N_LAUNCHES == 1) bar = xcd_barrier_post((unsigned*)(args.ws + WS_CTL) + CW_BAR, MISC + 8);
#define GRID_BAR() do { if (N_LAUNCHES == 1) xcd_barrier(bar, wave == 0 && lane_id() == 0); } while (0)
    const int lo = args.ph_lo, hi = args.ph_hi;
#define IN(k) (lo <= (k) && (k) < hi)
#define SEAM(k) do { if (IN((k) + 1)) { GRID_BAR(); if (PROBE_REP == 9) { GRID_BAR(); GRID_BAR(); } } } while (0)
    const int gw = bx * NWAVES + wave, NGW = G * NWAVES;
#define ws KWS
#define HP ((bf16*)KOUT)
#define HQ ((bf16*)(ws + WS_AN))
#define PROJ ((bf16*)(ws + WS_PROJ))
#define YCAT ((bf16*)(ws + WS_YCAT))
#define IDX ((float*)(ws + WS_IDX))
#define EBL(l) ((bf16*)(ws + WS_H) + (size_t)((l) & 1) * M * DM)
#define EB EBL(layer)
#define STA ((float*)(ws + WS_STATA))
#define STB ((float*)(ws + WS_STATB))
#define SLN ((float*)(ws + WS_STATLN))
#define PBF ((bf16*)(ws + WS_PBF))
#define WPE ((bf16*)(ws + WS_WPE))
#define WGATE ((bf16*)(ws + WS_WGATE))
#define WEIN ((bf16*)(ws + WS_WEIN))
#define WEOUT ((bf16*)(ws + WS_WEOUT))
#define WOIN ((bf16*)(ws + WS_WOIN))
#define WOOUT ((bf16*)(ws + WS_WOOUT))
    LAS unsigned char* ldsl = (LAS unsigned char*)lds;

    if (IN(0)) { LANE_OPAQUE();
        float* scr = (float*)(lds + wave * 16640);
        for (int rep_ = 0; rep_ < NREP(8); ++rep_) {
        int base = 0, it = gw;
#define TRG(W, K, N, WT, GK) do { const int ni_ = ((K) / 64) * (((N) + 63) / 64); for (; it < base + ni_; it += NGW) p0_transpose_item((W), (K), (N), (WT), scr, it - base, lane, (GK)); base += ni_; } while (0)
#define TR(W, K, N, WT) TRG(W, K, N, WT, nullptr)
        TRG(KIN(4), 2048, EVEN_IN, WEIN, KIN(2));
        for (int j = 0; j < 2; ++j) TR(KIN(14) + (size_t)j * 4096 * 2048, 4096, 2048, WEOUT + (size_t)j * 2048 * 4096);
        TRG(KIN(15), 2048, ODD_IN, WOIN, KIN(2) + DM);
        TR(KIN(20), 2048, 2048, WOOUT);
        for (int l = 0; l < 4; ++l) TR(KIN(21) + (size_t)l * 256 * 2048, 256, 2048, WPE + (size_t)l * 2048 * 256);
        for (int l = 0; l < 3; ++l) TRG(KIN(23) + (size_t)l * 2048 * 2048, 2048, 2048, WGATE + (size_t)l * 2048 * 2048, KIN(22) + (size_t)l * DM);
        for (int jg = 0; jg < 32; ++jg) TR(KIN(7) + (size_t)jg * 16384, 128, 128, (bf16*)(ws + WS_WSMALL) + (size_t)jg * 16384);
        for (int jg = 0; jg < 32; ++jg) TR(KIN(9) + (size_t)jg * 16384, 128, 128, (bf16*)(ws + WS_WSMALL) + (size_t)(32 + jg) * 16384);
#undef TR
#undef TRG
        for (int j = 0; j < 2; ++j) { v4u* z = (v4u*)(WEIN + ((size_t)j * EVEN_INP + EVEN_IN) * 2048); const int n16 = (EVEN_INP - EVEN_IN) * 2048 / 8;
            for (int i = gw * 64 + lane; i < n16; i += NGW * 64) z[i] = (v4u){0u, 0u, 0u, 0u}; }
        for (int m = gw; m < M; m += NGW) { const f32x4* xr = (const f32x4*)(KIN(0) + (size_t)m * DM) + lane; float ss = 0.f;
            f32x4 xv[8];
#pragma unroll
            for (int jx = 0; jx < 8; ++jx) xv[jx] = __builtin_nontemporal_load(xr + 64 * jx);
            asm volatile("" ::: "memory");
#pragma unroll
            for (int jx = 0; jx < 8; ++jx) { const f32x4 v = xv[jx]; ss += (v[0] * v[0] + v[1] * v[1]) + (v[2] * v[2] + v[3] * v[3]);
                *(v2u*)(HP + (size_t)m * DM + (size_t)(lane + 64 * jx) * 4) = (v2u){pk2(v[0], v[1]), pk2(v[2], v[3])}; }
            ss = wave_sum(ss, lane); if (lane < 32) STA[(size_t)m * 32 + lane] = (lane == 0) ? ss : 0.f; }
        { const f32x4* w4 = (const f32x4*)KIN(18); bf16* wo = (bf16*)(ws + WS_WSMALL) + (size_t)2 * 32 * 16384; const int n4 = 2 * 16 * 128 * 128 / 4;
            for (int i = gw * 64 + lane; i < n4; i += NGW * 64) { f32x4 v = w4[i]; const int s = (i * 4) & 127, t = ((i * 4) >> 7) & 127; if (t < 64 && s >= 64) v = (f32x4){0.f, 0.f, 0.f, 0.f};
                *(v2u*)(wo + (size_t)i * 4) = (v2u){pk2(v[0], v[1]), pk2(v[2], v[3])}; } }
        { const f32x4* p4 = (const f32x4*)KIN(1); const int n4 = DEPTH * M * 256 / 4;
            for (int i = gw * 64 + lane; i < n4; i += 8 * NGW * 64) { f32x4 pv[8];
#pragma unroll
                for (int q = 0; q < 8; ++q) pv[q] = __builtin_nontemporal_load(p4 + ((i + q * NGW * 64 < n4) ? i + q * NGW * 64 : i));
                asm volatile("" ::: "memory");
#pragma unroll
                for (int q = 0; q < 8; ++q) if (i + q * NGW * 64 < n4) *(v2u*)(PBF + (size_t)(i + q * NGW * 64) * 4) = (v2u){pk2(pv[q][0], pv[q][1]), pk2(pv[q][2], pv[q][3])}; } }
        }
        SEAM(0);
    }

    int ph = 1;
#define PHASE_BEGIN() KARGS_OPEN(); int lyr_ = layer_it; asm volatile("" : "+s"(lyr_)); const int layer = lyr_, j = lyr_ >> 1; const bool last = (lyr_ == DEPTH - 1); (void)j; (void)last; (void)layer
    {
        constexpr int layer_it = 0;
        if ((layer_it & 1) == 0) {
            if (IN(ph)) { PHASE_BEGIN(); pg8::Gemm g{HP, WEIN + (size_t)j * EVEN_INP * 2048, M, EVEN_INP, 2048}; pg8::StaticOrder S; S.init(M, EVEN_INP, G, bx);
                pg8::EpiEvenIn E{PROJ, IDX, STA, (bf16*)(ws + WS_IDXB)}; for (int rep_ = 0; rep_ < NREP(1); ++rep_) pg8::gemm_phase<pg8::EpiEvenIn, pg8::StaticOrder, true, true>(ldsl, g, S, E, wave);
                if (bx >= 32 && G > 32) {
#pragma unroll 1
                    for (int l2 = 0; l2 < 2; ++l2) { const int ll = layer + l2; pg8::Gemm g2{PBF + (size_t)ll * M * 256, WPE + (size_t)ll * 2048 * 256, M, 2048, 256}; pg8::StaticOrder S2; S2.init(M, 2048, G - 32, bx - 32);
                        pg8::EpiPE E2{EBL(ll)}; pg8::gemm_phase<pg8::EpiPE, pg8::StaticOrder, true, true>(ldsl, g2, S2, E2, wave);  }
                    { LANE_ONLY(); float* scr = (float*)(lds + wave * 16640); const int gw2 = (bx - 32) * NWAVES + wave, NGW2 = (G - 32) * NWAVES; int base = 0, it = gw2;
#define TR2(W, K, N, WT, GK) do { const int ni_ = ((K) / 64) * (((N) + 63) / 64); for (; it < base + ni_; it += NGW2) p0_transpose_item((W), (K), (N), (WT), scr, it - base, lane, (GK)); base += ni_; } while (0)
                      if (layer == 0) { TR2(KIN(4) + (size_t)2048 * EVEN_IN, 2048, EVEN_IN, WEIN + (size_t)EVEN_INP * 2048, KIN(2) + 2 * DM); }
                      else { TR2(KIN(15) + (size_t)2048 * ODD_IN, 2048, ODD_IN, WOIN + (size_t)ODD_IN * 2048, KIN(2) + 3 * DM); TR2(KIN(20) + (size_t)2048 * 2048, 2048, 2048, WOOUT + (size_t)2048 * 2048, nullptr); TR2(KIN(23) + (size_t)3 * 2048 * 2048, 2048, 2048, WGATE + (size_t)3 * 2048 * 2048, KIN(22) + 3 * DM); }
#undef TR2
                    } }
#if PROBE_REP == 11 || PROBE_REP == 14
                __syncthreads();
                { pg8::EpiEvenInT<PROBE_REP == 11 ? 1 : 2> EN{PROJ, IDX, STA, (bf16*)(ws + WS_IDXB)}; for (int rep_ = 0; rep_ < 2; ++rep_) pg8::gemm_phase<pg8::EpiEvenInT<PROBE_REP == 11 ? 1 : 2>, pg8::StaticOrder, true, true>(ldsl, g, S, EN, wave); }
#endif
#if PROBE_REP == 10
                __syncthreads();
                { pg8::EpiNull EN; for (int rep_ = 0; rep_ < 2; ++rep_) pg8::gemm_phase<pg8::EpiNull, pg8::StaticOrder, true, true>(ldsl, g, S, EN, wave); }
#endif
                SEAM(ph); }
            ++ph;
            if (IN(ph)) { PHASE_BEGIN(); LANE_ONLY();
#ifdef NAIVE_LRU
                for (int it = bx; it < 1024; it += G) lru_tile(kp, j, it >> 9, (it >> 4) & 31, it & 15, false, lds, wave);
#else
                for (int rep_ = 0; rep_ < NREP(2); ++rep_)
                for (int it = bx; it < 1024; it += G) lru_tile_mfma(kp, j, it, it + G, it == bx, false, LRU_STREAM != 0, lds, wave);
#endif
#ifndef NO_KN
                for (int it = bx; it < 512; it += G) knorm_item(kp, j, it, wave, lane);
#endif
#ifdef NAIVE_SCORE
                for (int it = bx; it < 4160; it += G) { const int b = it / 2080; int r = it % 2080; int c = 0; while (r >= c + 1) { r -= c + 1; ++c; } score_item(kp, b, c, r, lds, wave); }
#else
                __syncthreads();
                for (int rep_ = 0; rep_ < NREP(3); ++rep_)
                for (int u = gw; u < 2048; u += NGW) { const int ks = u & 7, qg = (u >> 3) & 3, cp = (u >> 5) & 31, b = u >> 10;
                    score_wave_unit(kp, b, cp, qg, ks, lane, lds, wave); score_wave_unit(kp, b, 63 - cp, qg, ks, lane, lds, wave); }
#ifdef CHECK_SCORE
                GRID_BAR();
                for (int it = bx; it < 4160; it += G) { const int b = it / 2080; int r = it % 2080; int c = 0; while (r >= c + 1) { r -= c + 1; ++c; } score_item(kp, b, c, r, lds, wave, true); }
#endif
#endif
                SEAM(ph); }
            ++ph;
            if (IN(ph)) { PHASE_BEGIN(); LANE_ONLY();
#ifdef NAIVE_LRU
                for (int it = bx; it < 1024; it += G) lru_tile(kp, j, it >> 9, (it >> 4) & 31, it & 15, true, lds, wave);
#else
                for (int rep_ = 0; rep_ < NREP(2); ++rep_)
                for (int it = bx; it < 1024; it += (LRU_STREAM ? 4 : 1) * G) { if (LRU_STREAM) { __syncthreads(); lru_carry4(kp, it, G, (float*)lds, wave); __syncthreads();
#pragma unroll 1
                    for (int k4 = 0; k4 < 4; ++k4) if (it + k4 * G < 1024) lru_apply_item(kp, it + k4 * G, (const float*)lds + k4 * 128, wave); }
                  else lru_tile_mfma(kp, j, it, it + G, it == bx, true, false, lds, wave); }
#ifdef CHECK_LRU
                GRID_BAR();
                for (int it = bx; it < 1024; it += G) lru_tile(kp, j, it >> 9, (it >> 4) & 31, it & 15, true, lds, wave, true);
#endif
#endif
#ifndef NO_SEL
                for (int rep_ = 0; rep_ < NREP(4); ++rep_)
                for (int u = gw; u < M / 2; u += NGW) { const int b_ = u >> 11, t_ = u & 2047;
                    select_query(kp, b_ * SEQ + t_, lane); select_query(kp, b_ * SEQ + 4095 - t_, lane); }
#endif
                SEAM(ph); }
            ++ph;
            if (IN(ph)) { PHASE_BEGIN();
#ifdef NAIVE_ATTN
                for (int qi = bx; qi < M; qi += G) attn_query(kp, j, qi, lds, wave);
#else
                for (int rep_ = 0; rep_ < NREP(5); ++rep_)
                for (int u = bx; u < 256; u += G) { const int bg = u & 7, cp = u >> 3;

#pragma unroll 1
                    for (int k2 = 0; k2 < 2; ++k2) att::attn_unit<0>(kp, j, bg >> 2, bg & 3, k2 ? cp : 63 - cp, (char*)lds, wave); }
#if PROBE_REP >= 20 && PROBE_REP < 30
                for (int rep_ = 0; rep_ < 2; ++rep_) for (int u = bx; u < 256; u += G) { const int bg = u & 7, cp = u >> 3; att::attn_unit<PROBE_REP - 20>(kp, j, bg >> 2, bg & 3, 63 - cp, (char*)lds, wave); att::attn_unit<PROBE_REP - 20>(kp, j, bg >> 2, bg & 3, cp, (char*)lds, wave); }
#endif
#ifdef CHECK_ATTN
                GRID_BAR();
                for (int qi = bx; qi < M; qi += G) attn_query(kp, j, qi, lds, wave, true);
#endif
#endif
                SEAM(ph); }
            ++ph;
            if (IN(ph)) { PHASE_BEGIN();
                { pg8::Gemm g{YCAT, WEOUT + (size_t)j * 2048 * 4096, M, 2048, 4096}; pg8::StaticOrder S; S.init(M, 2048, G, bx);
                  pg8::EpiOut E{HP, HQ, STB}; pg8::gemm_phase<pg8::EpiOut, pg8::StaticOrder, true, true>(ldsl, g, S, E, wave);
#if PROBE_REP == 12
                  { pg8::EpiOut Ed{HP, (bf16*)(ws + WS_SC), (float*)(ws + WS_SC) + 16 * 1048576}; for (int rep_ = 0; rep_ < 2; ++rep_) pg8::gemm_phase<pg8::EpiOut, pg8::StaticOrder, true, true>(ldsl, g, S, Ed, wave); }
#endif
                }
                SEAM(ph); }
            ++ph;
        } else {
            if (IN(ph)) { PHASE_BEGIN(); pg8::Gemm g{HP, WOIN + (size_t)j * ODD_IN * 2048, M, ODD_IN, 2048}; pg8::StaticOrder S; S.init(M, ODD_IN, G, bx);
                pg8::EpiOddIn E{PROJ, STA, SLN}; for (int rep_ = 0; rep_ < NREP(6); ++rep_) pg8::gemm_phase<pg8::EpiOddIn, pg8::StaticOrder, true, true>(ldsl, g, S, E, wave); SEAM(ph); }
            ++ph;
            if (IN(ph)) { PHASE_BEGIN();
#ifndef NO_SGU
                for (int rep_ = 0; rep_ < NREP(7); ++rep_)
#ifdef NAIVE_SGU
                for (int it = bx; it < 1024; it += G) sgu_item(kp, j, it >> 9, (it >> 4) & 31, it & 15, lds, wave);
#else
                for (int it = bx; it < 1024; it += G) sgu_item_mfma(kp, j, it >> 9, (it >> 4) & 31, it & 15, lds, wave);
#endif
#endif
                SEAM(ph); }
            ++ph;
            if (IN(ph)) { PHASE_BEGIN();
                { pg8::Gemm g{YCAT, WOOUT + (size_t)j * 2048 * 2048, M, 2048, 2048}; pg8::StaticOrder S; S.init(M, 2048, G, bx);
                  pg8::EpiOut E{HP, HQ, STB}; pg8::gemm_phase<pg8::EpiOut, pg8::StaticOrder, true, true>(ldsl, g, S, E, wave);
#if PROBE_REP == 12
                  { pg8::EpiOut Ed{HP, (bf16*)(ws + WS_SC), (float*)(ws + WS_SC) + 16 * 1048576}; for (int rep_ = 0; rep_ < 2; ++rep_) pg8::gemm_phase<pg8::EpiOut, pg8::StaticOrder, true, true>(ldsl, g, S, Ed, wave); }
#endif
                }
                SEAM(ph); }
            ++ph;
        }
        if (IN(ph)) { PHASE_BEGIN(); pg8::Gemm g{HQ, WGATE + (size_t)layer * 2048 * 2048, M, 2048, 2048}; pg8::StaticOrder S; S.init(M, 2048, G, bx);
            typedef pg8::EpiGateT<layer_it == DEPTH - 1> EpiGate;
            EpiGate E{HQ, EB, STB, HP, STA, KOUT}; pg8::gemm_phase<EpiGate, pg8::StaticOrder, true, true>(ldsl, g, S, E, wave);
#if PROBE_REP == 13
            { pg8::EpiGateT<false> Ed{HQ, EB, STB, (bf16*)(ws + WS_SC), (float*)(ws + WS_SC) + 16 * 1048576, nullptr}; for (int rep_ = 0; rep_ < 2; ++rep_) pg8::gemm_phase<pg8::EpiGateT<false>, pg8::StaticOrder, true, true>(ldsl, g, S, Ed, wave); }
#endif

            if (layer_it != DEPTH - 1) SEAM(ph); }
        ++ph;
    }
    {
        constexpr int layer_it = 1;
        if ((layer_it & 1) == 0) {
            if (IN(ph)) { PHASE_BEGIN(); pg8::Gemm g{HP, WEIN + (size_t)j * EVEN_INP * 2048, M, EVEN_INP, 2048}; pg8::StaticOrder S; S.init(M, EVEN_INP, G, bx);
                pg8::EpiEvenIn E{PROJ, IDX, STA, (bf16*)(ws + WS_IDXB)}; for (int rep_ = 0; rep_ < NREP(1); ++rep_) pg8::gemm_phase<pg8::EpiEvenIn, pg8::StaticOrder, true, true>(ldsl, g, S, E, wave);
                if (bx >= 32 && G > 32) {
#pragma unroll 1
                    for (int l2 = 0; l2 < 2; ++l2) { const int ll = layer + l2; pg8::Gemm g2{PBF + (size_t)ll * M * 256, WPE + (size_t)ll * 2048 * 256, M, 2048, 256}; pg8::StaticOrder S2; S2.init(M, 2048, G - 32, bx - 32);
                        pg8::EpiPE E2{EBL(ll)}; pg8::gemm_phase<pg8::EpiPE, pg8::StaticOrder, true, true>(ldsl, g2, S2, E2, wave);  }
                    { LANE_ONLY(); float* scr = (float*)(lds + wave * 16640); const int gw2 = (bx - 32) * NWAVES + wave, NGW2 = (G - 32) * NWAVES; int base = 0, it = gw2;
#define TR2(W, K, N, WT, GK) do { const int ni_ = ((K) / 64) * (((N) + 63) / 64); for (; it < base + ni_; it += NGW2) p0_transpose_item((W), (K), (N), (WT), scr, it - base, lane, (GK)); base += ni_; } while (0)
                      if (layer == 0) { TR2(KIN(4) + (size_t)2048 * EVEN_IN, 2048, EVEN_IN, WEIN + (size_t)EVEN_INP * 2048, KIN(2) + 2 * DM); }
                      else { TR2(KIN(15) + (size_t)2048 * ODD_IN, 2048, ODD_IN, WOIN + (size_t)ODD_IN * 2048, KIN(2) + 3 * DM); TR2(KIN(20) + (size_t)2048 * 2048, 2048, 2048, WOOUT + (size_t)2048 * 2048, nullptr); TR2(KIN(23) + (size_t)3 * 2048 * 2048, 2048, 2048, WGATE + (size_t)3 * 2048 * 2048, KIN(22) + 3 * DM); }
#undef TR2
                    } }
#if PROBE_REP == 11 || PROBE_REP == 14
                __syncthreads();
                { pg8::EpiEvenInT<PROBE_REP == 11 ? 1 : 2> EN{PROJ, IDX, STA, (bf16*)(ws + WS_IDXB)}; for (int rep_ = 0; rep_ < 2; ++rep_) pg8::gemm_phase<pg8::EpiEvenInT<PROBE_REP == 11 ? 1 : 2>, pg8::StaticOrder, true, true>(ldsl, g, S, EN, wave); }
#endif
#if PROBE_REP == 10
                __syncthreads();
                { pg8::EpiNull EN; for (int rep_ = 0; rep_ < 2; ++rep_) pg8::gemm_phase<pg8::EpiNull, pg8::StaticOrder, true, true>(ldsl, g, S, EN, wave); }
#endif
                SEAM(ph); }
            ++ph;
            if (IN(ph)) { PHASE_BEGIN(); LANE_ONLY();
#ifdef NAIVE_LRU
                for (int it = bx; it < 1024; it += G) lru_tile(kp, j, it >> 9, (it >> 4) & 31, it & 15, false, lds, wave);
#else
                for (int rep_ = 0; rep_ < NREP(2); ++rep_)
                for (int it = bx; it < 1024; it += G) lru_tile_mfma(kp, j, it, it + G, it == bx, false, LRU_STREAM != 0, lds, wave);
#endif
#ifndef NO_KN
                for (int it = bx; it < 512; it += G) knorm_item(kp, j, it, wave, lane);
#endif
#ifdef NAIVE_SCORE
                for (int it = bx; it < 4160; it += G) { const int b = it / 2080; int r = it % 2080; int c = 0; while (r >= c + 1) { r -= c + 1; ++c; } score_item(kp, b, c, r, lds, wave); }
#else
                __syncthreads();
                for (int rep_ = 0; rep_ < NREP(3); ++rep_)
                for (int u = gw; u < 2048; u += NGW) { const int ks = u & 7, qg = (u >> 3) & 3, cp = (u >> 5) & 31, b = u >> 10;
                    score_wave_unit(kp, b, cp, qg, ks, lane, lds, wave); score_wave_unit(kp, b, 63 - cp, qg, ks, lane, lds, wave); }
#ifdef CHECK_SCORE
                GRID_BAR();
                for (int it = bx; it < 4160; it += G) { const int b = it / 2080; int r = it % 2080; int c = 0; while (r >= c + 1) { r -= c + 1; ++c; } score_item(kp, b, c, r, lds, wave, true); }
#endif
#endif
                SEAM(ph); }
            ++ph;
            if (IN(ph)) { PHASE_BEGIN(); LANE_ONLY();
#ifdef NAIVE_LRU
                for (int it = bx; it < 1024; it += G) lru_tile(kp, j, it >> 9, (it >> 4) & 31, it & 15, true, lds, wave);
#else
                for (int rep_ = 0; rep_ < NREP(2); ++rep_)
                for (int it = bx; it < 1024; it += (LRU_STREAM ? 4 : 1) * G) { if (LRU_STREAM) { __syncthreads(); lru_carry4(kp, it, G, (float*)lds, wave); __syncthreads();
#pragma unroll 1
                    for (int k4 = 0; k4 < 4; ++k4) if (it + k4 * G < 1024) lru_apply_item(kp, it + k4 * G, (const float*)lds + k4 * 128, wave); }
                  else lru_tile_mfma(kp, j, it, it + G, it == bx, true, false, lds, wave); }
#ifdef CHECK_LRU
                GRID_BAR();
                for (int it = bx; it < 1024; it += G) lru_tile(kp, j, it >> 9, (it >> 4) & 31, it & 15, true, lds, wave, true);
#endif
#endif
#ifndef NO_SEL
                for (int rep_ = 0; rep_ < NREP(4); ++rep_)
                for (int u = gw; u < M / 2; u += NGW) { const int b_ = u >> 11, t_ = u & 2047;
                    select_query(kp, b_ * SEQ + t_, lane); select_query(kp, b_ * SEQ + 4095 - t_, lane); }
#endif
                SEAM(ph); }
            ++ph;
            if (IN(ph)) { PHASE_BEGIN();
#ifdef NAIVE_ATTN
                for (int qi = bx; qi < M; qi += G) attn_query(kp, j, qi, lds, wave);
#else
                for (int rep_ = 0; rep_ < NREP(5); ++rep_)
                for (int u = bx; u < 256; u += G) { const int bg = u & 7, cp = u >> 3;

#pragma unroll 1
                    for (int k2 = 0; k2 < 2; ++k2) att::attn_unit<0>(kp, j, bg >> 2, bg & 3, k2 ? cp : 63 - cp, (char*)lds, wave); }
#if PROBE_REP >= 20 && PROBE_REP < 30
                for (int rep_ = 0; rep_ < 2; ++rep_) for (int u = bx; u < 256; u += G) { const int bg = u & 7, cp = u >> 3; att::attn_unit<PROBE_REP - 20>(kp, j, bg >> 2, bg & 3, 63 - cp, (char*)lds, wave); att::attn_unit<PROBE_REP - 20>(kp, j, bg >> 2, bg & 3, cp, (char*)lds, wave); }
#endif
#ifdef CHECK_ATTN
                GRID_BAR();
                for (int qi = bx; qi < M; qi += G) attn_query(kp, j, qi, lds, wave, true);
#endif
#endif
                SEAM(ph); }
            ++ph;
            if (IN(ph)) { PHASE_BEGIN();
                { pg8::Gemm g{YCAT, WEOUT + (size_t)j * 2048 * 4096, M, 2048, 4096}; pg8::StaticOrder S; S.init(M, 2048, G, bx);
                  pg8::EpiOut E{HP, HQ, STB}; pg8::gemm_phase<pg8::EpiOut, pg8::StaticOrder, true, true>(ldsl, g, S, E, wave);
#if PROBE_REP == 12
                  { pg8::EpiOut Ed{HP, (bf16*)(ws + WS_SC), (float*)(ws + WS_SC) + 16 * 1048576}; for (int rep_ = 0; rep_ < 2; ++rep_) pg8::gemm_phase<pg8::EpiOut, pg8::StaticOrder, true, true>(ldsl, g, S, Ed, wave); }
#endif
                }
                SEAM(ph); }
            ++ph;
        } else {
            if (IN(ph)) { PHASE_BEGIN(); pg8::Gemm g{HP, WOIN + (size_t)j * ODD_IN * 2048, M, ODD_IN, 2048}; pg8::StaticOrder S; S.init(M, ODD_IN, G, bx);
                pg8::EpiOddIn E{PROJ, STA, SLN}; for (int rep_ = 0; rep_ < NREP(6); ++rep_) pg8::gemm_phase<pg8::EpiOddIn, pg8::StaticOrder, true, true>(ldsl, g, S, E, wave); SEAM(ph); }
            ++ph;
            if (IN(ph)) { PHASE_BEGIN();
#ifndef NO_SGU
                for (int rep_ = 0; rep_ < NREP(7); ++rep_)
#ifdef NAIVE_SGU
                for (int it = bx; it < 1024; it += G) sgu_item(kp, j, it >> 9, (it >> 4) & 31, it & 15, lds, wave);
#else
                for (int it = bx; it < 1024; it += G) sgu_item_mfma(kp, j, it >> 9, (it >> 4) & 31, it & 15, lds, wave);
#endif
#endif
                SEAM(ph); }
            ++ph;
            if (IN(ph)) { PHASE_BEGIN();
                { pg8::Gemm g{YCAT, WOOUT + (size_t)j * 2048 * 2048, M, 2048, 2048}; pg8::StaticOrder S; S.init(M, 2048, G, bx);
                  pg8::EpiOut E{HP, HQ, STB}; pg8::gemm_phase<pg8::EpiOut, pg8::StaticOrder, true, true>(ldsl, g, S, E, wave);
#if PROBE_REP == 12
                  { pg8::EpiOut Ed{HP, (bf16*)(ws + WS_SC), (float*)(ws + WS_SC) + 16 * 1048576}; for (int rep_ = 0; rep_ < 2; ++rep_) pg8::gemm_phase<pg8::EpiOut, pg8::StaticOrder, true, true>(ldsl, g, S, Ed, wave); }
#endif
                }
                SEAM(ph); }
            ++ph;
        }
        if (IN(ph)) { PHASE_BEGIN(); pg8::Gemm g{HQ, WGATE + (size_t)layer * 2048 * 2048, M, 2048, 2048}; pg8::StaticOrder S; S.init(M, 2048, G, bx);
            typedef pg8::EpiGateT<layer_it == DEPTH - 1> EpiGate;
            EpiGate E{HQ, EB, STB, HP, STA, KOUT}; pg8::gemm_phase<EpiGate, pg8::StaticOrder, true, true>(ldsl, g, S, E, wave);
#if PROBE_REP == 13
            { pg8::EpiGateT<false> Ed{HQ, EB, STB, (bf16*)(ws + WS_SC), (float*)(ws + WS_SC) + 16 * 1048576, nullptr}; for (int rep_ = 0; rep_ < 2; ++rep_) pg8::gemm_phase<pg8::EpiGateT<false>, pg8::StaticOrder, true, true>(ldsl, g, S, Ed, wave); }
#endif

            if (layer_it != DEPTH - 1) SEAM(ph); }
        ++ph;
    }
    {
        constexpr int layer_it = 2;
        if ((layer_it & 1) == 0) {
            if (IN(ph)) { PHASE_BEGIN(); pg8::Gemm g{HP, WEIN + (size_t)j * EVEN_INP * 2048, M, EVEN_INP, 2048}; pg8::StaticOrder S; S.init(M, EVEN_INP, G, bx);
                pg8::EpiEvenIn E{PROJ, IDX, STA, (bf16*)(ws + WS_IDXB)}; for (int rep_ = 0; rep_ < NREP(1); ++rep_) pg8::gemm_phase<pg8::EpiEvenIn, pg8::StaticOrder, true, true>(ldsl, g, S, E, wave);
                if (bx >= 32 && G > 32) {
#pragma unroll 1
                    for (int l2 = 0; l2 < 2; ++l2) { const int ll = layer + l2; pg8::Gemm g2{PBF + (size_t)ll * M * 256, WPE + (size_t)ll * 2048 * 256, M, 2048, 256}; pg8::StaticOrder S2; S2.init(M, 2048, G - 32, bx - 32);
                        pg8::EpiPE E2{EBL(ll)}; pg8::gemm_phase<pg8::EpiPE, pg8::StaticOrder, true, true>(ldsl, g2, S2, E2, wave);  }
                    { LANE_ONLY(); float* scr = (float*)(lds + wave * 16640); const int gw2 = (bx - 32) * NWAVES + wave, NGW2 = (G - 32) * NWAVES; int base = 0, it = gw2;
#define TR2(W, K, N, WT, GK) do { const int ni_ = ((K) / 64) * (((N) + 63) / 64); for (; it < base + ni_; it += NGW2) p0_transpose_item((W), (K), (N), (WT), scr, it - base, lane, (GK)); base += ni_; } while (0)
                      if (layer == 0) { TR2(KIN(4) + (size_t)2048 * EVEN_IN, 2048, EVEN_IN, WEIN + (size_t)EVEN_INP * 2048, KIN(2) + 2 * DM); }
                      else { TR2(KIN(15) + (size_t)2048 * ODD_IN, 2048, ODD_IN, WOIN + (size_t)ODD_IN * 2048, KIN(2) + 3 * DM); TR2(KIN(20) + (size_t)2048 * 2048, 2048, 2048, WOOUT + (size_t)2048 * 2048, nullptr); TR2(KIN(23) + (size_t)3 * 2048 * 2048, 2048, 2048, WGATE + (size_t)3 * 2048 * 2048, KIN(22) + 3 * DM); }
#undef TR2
                    } }
#if PROBE_REP == 11 || PROBE_REP == 14
                __syncthreads();
                { pg8::EpiEvenInT<PROBE_REP == 11 ? 1 : 2> EN{PROJ, IDX, STA, (bf16*)(ws + WS_IDXB)}; for (int rep_ = 0; rep_ < 2; ++rep_) pg8::gemm_phase<pg8::EpiEvenInT<PROBE_REP == 11 ? 1 : 2>, pg8::StaticOrder, true, true>(ldsl, g, S, EN, wave); }
#endif
#if PROBE_REP == 10
                __syncthreads();
                { pg8::EpiNull EN; for (int rep_ = 0; rep_ < 2; ++rep_) pg8::gemm_phase<pg8::EpiNull, pg8::StaticOrder, true, true>(ldsl, g, S, EN, wave); }
#endif
                SEAM(ph); }
            ++ph;
            if (IN(ph)) { PHASE_BEGIN(); LANE_ONLY();
#ifdef NAIVE_LRU
                for (int it = bx; it < 1024; it += G) lru_tile(kp, j, it >> 9, (it >> 4) & 31, it & 15, false, lds, wave);
#else
                for (int rep_ = 0; rep_ < NREP(2); ++rep_)
                for (int it = bx; it < 1024; it += G) lru_tile_mfma(kp, j, it, it + G, it == bx, false, LRU_STREAM != 0, lds, wave);
#endif
#ifndef NO_KN
                for (int it = bx; it < 512; it += G) knorm_item(kp, j, it, wave, lane);
#endif
#ifdef NAIVE_SCORE
                for (int it = bx; it < 4160; it += G) { const int b = it / 2080; int r = it % 2080; int c = 0; while (r >= c + 1) { r -= c + 1; ++c; } score_item(kp, b, c, r, lds, wave); }
#else
                __syncthreads();
                for (int rep_ = 0; rep_ < NREP(3); ++rep_)
                for (int u = gw; u < 2048; u += NGW) { const int ks = u & 7, qg = (u >> 3) & 3, cp = (u >> 5) & 31, b = u >> 10;
                    score_wave_unit(kp, b, cp, qg, ks, lane, lds, wave); score_wave_unit(kp, b, 63 - cp, qg, ks, lane, lds, wave); }
#ifdef CHECK_SCORE
                GRID_BAR();
                for (int it = bx; it < 4160; it += G) { const int b = it / 2080; int r = it % 2080; int c = 0; while (r >= c + 1) { r -= c + 1; ++c; } score_item(kp, b, c, r, lds, wave, true); }
#endif
#endif
                SEAM(ph); }
            ++ph;
            if (IN(ph)) { PHASE_BEGIN(); LANE_ONLY();
#ifdef NAIVE_LRU
                for (int it = bx; it < 1024; it += G) lru_tile(kp, j, it >> 9, (it >> 4) & 31, it & 15, true, lds, wave);
#else
                for (int rep_ = 0; rep_ < NREP(2); ++rep_)
                for (int it = bx; it < 1024; it += (LRU_STREAM ? 4 : 1) * G) { if (LRU_STREAM) { __syncthreads(); lru_carry4(kp, it, G, (float*)lds, wave); __syncthreads();
#pragma unroll 1
                    for (int k4 = 0; k4 < 4; ++k4) if (it + k4 * G < 1024) lru_apply_item(kp, it + k4 * G, (const float*)lds + k4 * 128, wave); }
                  else lru_tile_mfma(kp, j, it, it + G, it == bx, true, false, lds, wave); }
#ifdef CHECK_LRU
                GRID_BAR();
                for (int it = bx; it < 1024; it += G) lru_tile(kp, j, it >> 9, (it >> 4) & 31, it & 15, true, lds, wave, true);
#endif
#endif
#ifndef NO_SEL
                for (int rep_ = 0; rep_ < NREP(4); ++rep_)
                for (int u = gw; u < M / 2; u += NGW) { const int b_ = u >> 11, t_ = u & 2047;
                    select_query(kp, b_ * SEQ + t_, lane); select_query(kp, b_ * SEQ + 4095 - t_, lane); }
#endif
                SEAM(ph); }
            ++ph;
            if (IN(ph)) { PHASE_BEGIN();
#ifdef NAIVE_ATTN
                for (int qi = bx; qi < M; qi += G) attn_query(kp, j, qi, lds, wave);
#else
                for (int rep_ = 0; rep_ < NREP(5); ++rep_)
                for (int u = bx; u < 256; u += G) { const int bg = u & 7, cp = u >> 3;

#pragma unroll 1
                    for (int k2 = 0; k2 < 2; ++k2) att::attn_unit<0>(kp, j, bg >> 2, bg & 3, k2 ? cp : 63 - cp, (char*)lds, wave); }
#if PROBE_REP >= 20 && PROBE_REP < 30
                for (int rep_ = 0; rep_ < 2; ++rep_) for (int u = bx; u < 256; u += G) { const int bg = u & 7, cp = u >> 3; att::attn_unit<PROBE_REP - 20>(kp, j, bg >> 2, bg & 3, 63 - cp, (char*)lds, wave); att::attn_unit<PROBE_REP - 20>(kp, j, bg >> 2, bg & 3, cp, (char*)lds, wave); }
#endif
#ifdef CHECK_ATTN
                GRID_BAR();
                for (int qi = bx; qi < M; qi += G) attn_query(kp, j, qi, lds, wave, true);
#endif
#endif
                SEAM(ph); }
            ++ph;
            if (IN(ph)) { PHASE_BEGIN();
                { pg8::Gemm g{YCAT, WEOUT + (size_t)j * 2048 * 4096, M, 2048, 4096}; pg8::StaticOrder S; S.init(M, 2048, G, bx);
                  pg8::EpiOut E{HP, HQ, STB}; pg8::gemm_phase<pg8::EpiOut, pg8::StaticOrder, true, true>(ldsl, g, S, E, wave);
#if PROBE_REP == 12
                  { pg8::EpiOut Ed{HP, (bf16*)(ws + WS_SC), (float*)(ws + WS_SC) + 16 * 1048576}; for (int rep_ = 0; rep_ < 2; ++rep_) pg8::gemm_phase<pg8::EpiOut, pg8::StaticOrder, true, true>(ldsl, g, S, Ed, wave); }
#endif
                }
                SEAM(ph); }
            ++ph;
        } else {
            if (IN(ph)) { PHASE_BEGIN(); pg8::Gemm g{HP, WOIN + (size_t)j * ODD_IN * 2048, M, ODD_IN, 2048}; pg8::StaticOrder S; S.init(M, ODD_IN, G, bx);
                pg8::EpiOddIn E{PROJ, STA, SLN}; for (int rep_ = 0; rep_ < NREP(6); ++rep_) pg8::gemm_phase<pg8::EpiOddIn, pg8::StaticOrder, true, true>(ldsl, g, S, E, wave); SEAM(ph); }
            ++ph;
            if (IN(ph)) { PHASE_BEGIN();
#ifndef NO_SGU
                for (int rep_ = 0; rep_ < NREP(7); ++rep_)
#ifdef NAIVE_SGU
                for (int it = bx; it < 1024; it += G) sgu_item(kp, j, it >> 9, (it >> 4) & 31, it & 15, lds, wave);
#else
                for (int it = bx; it < 1024; it += G) sgu_item_mfma(kp, j, it >> 9, (it >> 4) & 31, it & 15, lds, wave);
#endif
#endif
                SEAM(ph); }
            ++ph;
            if (IN(ph)) { PHASE_BEGIN();
                { pg8::Gemm g{YCAT, WOOUT + (size_t)j * 2048 * 2048, M, 2048, 2048}; pg8::StaticOrder S; S.init(M, 2048, G, bx);
                  pg8::EpiOut E{HP, HQ, STB}; pg8::gemm_phase<pg8::EpiOut, pg8::StaticOrder, true, true>(ldsl, g, S, E, wave);
#if PROBE_REP == 12
                  { pg8::EpiOut Ed{HP, (bf16*)(ws + WS_SC), (float*)(ws + WS_SC) + 16 * 1048576}; for (int rep_ = 0; rep_ < 2; ++rep_) pg8::gemm_phase<pg8::EpiOut, pg8::StaticOrder, true, true>(ldsl, g, S, Ed, wave); }
#endif
                }
                SEAM(ph); }
            ++ph;
        }
        if (IN(ph)) { PHASE_BEGIN(); pg8::Gemm g{HQ, WGATE + (size_t)layer * 2048 * 2048, M, 2048, 2048}; pg8::StaticOrder S; S.init(M, 2048, G, bx);
            typedef pg8::EpiGateT<layer_it == DEPTH - 1> EpiGate;
            EpiGate E{HQ, EB, STB, HP, STA, KOUT}; pg8::gemm_phase<EpiGate, pg8::StaticOrder, true, true>(ldsl, g, S, E, wave);
#if PROBE_REP == 13
            { pg8::EpiGateT<false> Ed{HQ, EB, STB, (bf16*)(ws + WS_SC), (float*)(ws + WS_SC) + 16 * 1048576, nullptr}; for (int rep_ = 0; rep_ < 2; ++rep_) pg8::gemm_phase<pg8::EpiGateT<false>, pg8::StaticOrder, true, true>(ldsl, g, S, Ed, wave); }
#endif

            if (layer_it != DEPTH - 1) SEAM(ph); }
        ++ph;
    }
    {
        constexpr int layer_it = 3;
        if ((layer_it & 1) == 0) {
            if (IN(ph)) { PHASE_BEGIN(); pg8::Gemm g{HP, WEIN + (size_t)j * EVEN_INP * 2048, M, EVEN_INP, 2048}; pg8::StaticOrder S; S.init(M, EVEN_INP, G, bx);
                pg8::EpiEvenIn E{PROJ, IDX, STA, (bf16*)(ws + WS_IDXB)}; for (int rep_ = 0; rep_ < NREP(1); ++rep_) pg8::gemm_phase<pg8::EpiEvenIn, pg8::StaticOrder, true, true>(ldsl, g, S, E, wave);
                if (bx >= 32 && G > 32) {
#pragma unroll 1
                    for (int l2 = 0; l2 < 2; ++l2) { const int ll = layer + l2; pg8::Gemm g2{PBF + (size_t)ll * M * 256, WPE + (size_t)ll * 2048 * 256, M, 2048, 256}; pg8::StaticOrder S2; S2.init(M, 2048, G - 32, bx - 32);
                        pg8::EpiPE E2{EBL(ll)}; pg8::gemm_phase<pg8::EpiPE, pg8::StaticOrder, true, true>(ldsl, g2, S2, E2, wave);  }
                    { LANE_ONLY(); float* scr = (float*)(lds + wave * 16640); const int gw2 = (bx - 32) * NWAVES + wave, NGW2 = (G - 32) * NWAVES; int base = 0, it = gw2;
#define TR2(W, K, N, WT, GK) do { const int ni_ = ((K) / 64) * (((N) + 63) / 64); for (; it < base + ni_; it += NGW2) p0_transpose_item((W), (K), (N), (WT), scr, it - base, lane, (GK)); base += ni_; } while (0)
                      if (layer == 0) { TR2(KIN(4) + (size_t)2048 * EVEN_IN, 2048, EVEN_IN, WEIN + (size_t)EVEN_INP * 2048, KIN(2) + 2 * DM); }
                      else { TR2(KIN(15) + (size_t)2048 * ODD_IN, 2048, ODD_IN, WOIN + (size_t)ODD_IN * 2048, KIN(2) + 3 * DM); TR2(KIN(20) + (size_t)2048 * 2048, 2048, 2048, WOOUT + (size_t)2048 * 2048, nullptr); TR2(KIN(23) + (size_t)3 * 2048 * 2048, 2048, 2048, WGATE + (size_t)3 * 2048 * 2048, KIN(22) + 3 * DM); }
#undef TR2
                    } }
#if PROBE_REP == 11 || PROBE_REP == 14
                __syncthreads();
                { pg8::EpiEvenInT<PROBE_REP == 11 ? 1 : 2> EN{PROJ, IDX, STA, (bf16*)(ws + WS_IDXB)}; for (int rep_ = 0; rep_ < 2; ++rep_) pg8::gemm_phase<pg8::EpiEvenInT<PROBE_REP == 11 ? 1 : 2>, pg8::StaticOrder, true, true>(ldsl, g, S, EN, wave); }
#endif
#if PROBE_REP == 10
                __syncthreads();
                { pg8::EpiNull EN; for (int rep_ = 0; rep_ < 2; ++rep_) pg8::gemm_phase<pg8::EpiNull, pg8::StaticOrder, true, true>(ldsl, g, S, EN, wave); }
#endif
                SEAM(ph); }
            ++ph;
            if (IN(ph)) { PHASE_BEGIN(); LANE_ONLY();
#ifdef NAIVE_LRU
                for (int it = bx; it < 1024; it += G) lru_tile(kp, j, it >> 9, (it >> 4) & 31, it & 15, false, lds, wave);
#else
                for (int rep_ = 0; rep_ < NREP(2); ++rep_)
                for (int it = bx; it < 1024; it += G) lru_tile_mfma(kp, j, it, it + G, it == bx, false, LRU_STREAM != 0, lds, wave);
#endif
#ifndef NO_KN
                for (int it = bx; it < 512; it += G) knorm_item(kp, j, it, wave, lane);
#endif
#ifdef NAIVE_SCORE
                for (int it = bx; it < 4160; it += G) { const int b = it / 2080; int r = it % 2080; int c = 0; while (r >= c + 1) { r -= c + 1; ++c; } score_item(kp, b, c, r, lds, wave); }
#else
                __syncthreads();
                for (int rep_ = 0; rep_ < NREP(3); ++rep_)
                for (int u = gw; u < 2048; u += NGW) { const int ks = u & 7, qg = (u >> 3) & 3, cp = (u >> 5) & 31, b = u >> 10;
                    score_wave_unit(kp, b, cp, qg, ks, lane, lds, wave); score_wave_unit(kp, b, 63 - cp, qg, ks, lane, lds, wave); }
#ifdef CHECK_SCORE
                GRID_BAR();
                for (int it = bx; it < 4160; it += G) { const int b = it / 2080; int r = it % 2080; int c = 0; while (r >= c + 1) { r -= c + 1; ++c; } score_item(kp, b, c, r, lds, wave, true); }
#endif
#endif
                SEAM(ph); }
            ++ph;
            if (IN(ph)) { PHASE_BEGIN(); LANE_ONLY();
#ifdef NAIVE_LRU
                for (int it = bx; it < 1024; it += G) lru_tile(kp, j, it >> 9, (it >> 4) & 31, it & 15, true, lds, wave);
#else
                for (int rep_ = 0; rep_ < NREP(2); ++rep_)
                for (int it = bx; it < 1024; it += (LRU_STREAM ? 4 : 1) * G) { if (LRU_STREAM) { __syncthreads(); lru_carry4(kp, it, G, (float*)lds, wave); __syncthreads();
#pragma unroll 1
                    for (int k4 = 0; k4 < 4; ++k4) if (it + k4 * G < 1024) lru_apply_item(kp, it + k4 * G, (const float*)lds + k4 * 128, wave); }
                  else lru_tile_mfma(kp, j, it, it + G, it == bx, true, false, lds, wave); }
#ifdef CHECK_LRU
                GRID_BAR();
                for (int it = bx; it < 1024; it += G) lru_tile(kp, j, it >> 9, (it >> 4) & 31, it & 15, true, lds, wave, true);
#endif
#endif
#ifndef NO_SEL
                for (int rep_ = 0; rep_ < NREP(4); ++rep_)
                for (int u = gw; u < M / 2; u += NGW) { const int b_ = u >> 11, t_ = u & 2047;
                    select_query(kp, b_ * SEQ + t_, lane); select_query(kp, b_ * SEQ + 4095 - t_, lane); }
#endif
                SEAM(ph); }
            ++ph;
            if (IN(ph)) { PHASE_BEGIN();
#ifdef NAIVE_ATTN
                for (int qi = bx; qi < M; qi += G) attn_query(kp, j, qi, lds, wave);
#else
                for (int rep_ = 0; rep_ < NREP(5); ++rep_)
                for (int u = bx; u < 256; u += G) { const int bg = u & 7, cp = u >> 3;

#pragma unroll 1
                    for (int k2 = 0; k2 < 2; ++k2) att::attn_unit<0>(kp, j, bg >> 2, bg & 3, k2 ? cp : 63 - cp, (char*)lds, wave); }
#if PROBE_REP >= 20 && PROBE_REP < 30
                for (int rep_ = 0; rep_ < 2; ++rep_) for (int u = bx; u < 256; u += G) { const int bg = u & 7, cp = u >> 3; att::attn_unit<PROBE_REP - 20>(kp, j, bg >> 2, bg & 3, 63 - cp, (char*)lds, wave); att::attn_unit<PROBE_REP - 20>(kp, j, bg >> 2, bg & 3, cp, (char*)lds, wave); }
#endif
#ifdef CHECK_ATTN
                GRID_BAR();
                for (int qi = bx; qi < M; qi += G) attn_query(kp, j, qi, lds, wave, true);
#endif
#endif
                SEAM(ph); }
            ++ph;
            if (IN(ph)) { PHASE_BEGIN();
                { pg8::Gemm g{YCAT, WEOUT + (size_t)j * 2048 * 4096, M, 2048, 4096}; pg8::StaticOrder S; S.init(M, 2048, G, bx);
                  pg8::EpiOut E{HP, HQ, STB}; pg8::gemm_phase<pg8::EpiOut, pg8::StaticOrder, true, true>(ldsl, g, S, E, wave);
#if PROBE_REP == 12
                  { pg8::EpiOut Ed{HP, (bf16*)(ws + WS_SC), (float*)(ws + WS_SC) + 16 * 1048576}; for (int rep_ = 0; rep_ < 2; ++rep_) pg8::gemm_phase<pg8::EpiOut, pg8::StaticOrder, true, true>(ldsl, g, S, Ed, wave); }
#endif
                }
                SEAM(ph); }
            ++ph;
        } else {
            if (IN(ph)) { PHASE_BEGIN(); pg8::Gemm g{HP, WOIN + (size_t)j * ODD_IN * 2048, M, ODD_IN, 2048}; pg8::StaticOrder S; S.init(M, ODD_IN, G, bx);
                pg8::EpiOddIn E{PROJ, STA, SLN}; for (int rep_ = 0; rep_ < NREP(6); ++rep_) pg8::gemm_phase<pg8::EpiOddIn, pg8::StaticOrder, true, true>(ldsl, g, S, E, wave); SEAM(ph); }
            ++ph;
            if (IN(ph)) { PHASE_BEGIN();
#ifndef NO_SGU
                for (int rep_ = 0; rep_ < NREP(7); ++rep_)
#ifdef NAIVE_SGU
                for (int it = bx; it < 1024; it += G) sgu_item(kp, j, it >> 9, (it >> 4) & 31, it & 15, lds, wave);
#else
                for (int it = bx; it < 1024; it += G) sgu_item_mfma(kp, j, it >> 9, (it >> 4) & 31, it & 15, lds, wave);
#endif
#endif
                SEAM(ph); }
            ++ph;
            if (IN(ph)) { PHASE_BEGIN();
                { pg8::Gemm g{YCAT, WOOUT + (size_t)j * 2048 * 2048, M, 2048, 2048}; pg8::StaticOrder S; S.init(M, 2048, G, bx);
                  pg8::EpiOut E{HP, HQ, STB}; pg8::gemm_phase<pg8::EpiOut, pg8::StaticOrder, true, true>(ldsl, g, S, E, wave);
#if PROBE_REP == 12
                  { pg8::EpiOut Ed{HP, (bf16*)(ws + WS_SC), (float*)(ws + WS_SC) + 16 * 1048576}; for (int rep_ = 0; rep_ < 2; ++rep_) pg8::gemm_phase<pg8::EpiOut, pg8::StaticOrder, true, true>(ldsl, g, S, Ed, wave); }
#endif
                }
                SEAM(ph); }
            ++ph;
        }
        if (IN(ph)) { PHASE_BEGIN(); pg8::Gemm g{HQ, WGATE + (size_t)layer * 2048 * 2048, M, 2048, 2048}; pg8::StaticOrder S; S.init(M, 2048, G, bx);
            typedef pg8::EpiGateT<layer_it == DEPTH - 1> EpiGate;
            EpiGate E{HQ, EB, STB, HP, STA, KOUT}; pg8::gemm_phase<EpiGate, pg8::StaticOrder, true, true>(ldsl, g, S, E, wave);
#if PROBE_REP == 13
            { pg8::EpiGateT<false> Ed{HQ, EB, STB, (bf16*)(ws + WS_SC), (float*)(ws + WS_SC) + 16 * 1048576, nullptr}; for (int rep_ = 0; rep_ < 2; ++rep_) pg8::gemm_phase<pg8::EpiGateT<false>, pg8::StaticOrder, true, true>(ldsl, g, S, Ed, wave); }
#endif

            if (layer_it != DEPTH - 1) SEAM(ph); }
        ++ph;
    }
#if defined(CHECK_SCORE) || defined(CHECK_ATTN) || defined(CHECK_LRU)
    if (IN(NPHASE - 1)) { KARGS_OPEN(); GRID_BAR(); if (bx == 0 && wave == 0 && lane_id() == 0 && __hip_atomic_load((unsigned*)(KWS + WS_CTL) + 8, __ATOMIC_RELAXED, __HIP_MEMORY_SCOPE_AGENT) != 0u) KOUT[0] = __builtin_nanf(""); }
#endif
#undef IN
#undef SEAM
#undef GRID_BAR
#undef HP
#undef HQ
#undef PROJ
#undef YCAT
#undef IDX
#undef EB
#undef STA
#undef STB
#undef SLN
#undef PBF
#undef WPE
#undef WGATE
#undef WEIN
#undef WEOUT
#undef WOIN
#undef WOOUT
#undef ws
}

extern "C" void kernel_launch(void* const* d_in, const int* in_sizes, int n_in, void* d_out, int out_size, void* d_ws, size_t ws_size, hipStream_t stream) {
    static int grid = 0;
    if (grid == 0) {
        if (n_in != 24 || out_size != M * DM || ws_size < WS_END) { fprintf(stderr, "kernel_launch: unexpected shapes (n_in %d out %d ws %zu)\n", n_in, out_size, ws_size); grid = -1; return; }
        int dev = 0, cus = 0, per_cu = 0;
        if (hipGetDevice(&dev) != hipSuccess || hipDeviceGetAttribute(&cus, hipDeviceAttributeMultiprocessorCount, dev) != hipSuccess) { grid = -1; return; }
        if (hipFuncSetAttribute((const void*)mega_fwd, hipFuncAttributeMaxDynamicSharedMemorySize, LDS_BYTES) != hipSuccess) { fprintf(stderr, "kernel_launch: hipFuncSetAttribute failed\n"); grid = -1; return; }
        if (hipOccupancyMaxActiveBlocksPerMultiprocessor(&per_cu, (const void*)mega_fwd, NTHR, LDS_BYTES) != hipSuccess || per_cu < 1) { fprintf(stderr, "kernel_launch: occupancy query says %d\n", per_cu); }
        (void)hipGetLastError();
        grid = cus;
        if (grid != 256) fprintf(stderr, "kernel_launch: %d CUs (built for 256)\n", grid);
    }
    if (grid < 0) return;
    (void)hipMemsetAsync((char*)d_ws + WS_CTL, 0, CTL_ZERO_BYTES, stream);
    Args a{};
    for (int i = 0; i < 24; ++i) a.in[i] = (const float*)d_in[i];
    a.out = (float*)d_out; a.ws = (unsigned char*)d_ws;
    for (int k = 0; k < 8; ++k) a.thr[k] = 1 << 30;
    for (int n = 8; n < 4096; ++n) { const float nf = (float)n; const float l = (float)log((double)(nf / 8.0f)); const float tt = (l / (float)log(16.0)) * 8.0f; int large = 8 + (int)tt; if (large > 15) large = 15;
        const int k = large - 8; for (int kk = 1; kk <= k; ++kk) if (n < a.thr[kk]) a.thr[kk] = n; }
    if (N_LAUNCHES == 1) { a.ph_lo = 0; a.ph_hi = NPHASE; hipLaunchKernelGGL(mega_fwd, dim3(grid), dim3(NTHR), LDS_BYTES, stream, a); }
    else { for (int p = 0; p < NPHASE; ++p) { a.ph_lo = p; a.ph_hi = p + 1; hipLaunchKernelGGL(mega_fwd, dim3(grid), dim3(NTHR), LDS_BYTES, stream, a); } }
}
```

```cpp
#include <hip/hip_runtime.h>
#include <cstdio>
#include <cstdint>
#include <cmath>
namespace pg8 {
#define PG8_LAS __attribute__((address_space(3)))
typedef unsigned short bf16_t;
typedef short bf16x8 __attribute__((ext_vector_type(8)));
typedef float f32x4 __attribute__((ext_vector_type(4)));
typedef unsigned u32x4 __attribute__((ext_vector_type(4)));
constexpr int BM = 256, BK = 64, HALF = 128, HTB = HALF * BK * 2  , STAGE_BYTES = 8 * HTB, NXCD = 8, WGM = 8;

__host__ __device__ __forceinline__ int lds_byte(int r, int c) { const int st = (r >> 4) * 2 + (c >> 5), rr = r & 15, cc = c & 31, ob = rr * 64 + cc * 2; return st * 1024 + (ob ^ (((ob >> 9) & 1) << 5)); }
__host__ __device__ __forceinline__ void stage_rc(int b, int& R, int& C) { const int st = b / 1024, sb = b % 1024, swz = sb ^ (((sb >> 9) & 1) << 5); R = (st >> 1) * 16 + swz / 64; C = (st & 1) * 32 + (swz % 64) / 2; }
__host__ __device__ __forceinline__ int perm32(int rho) { const int n = rho >> 4, i = rho & 15; return 8 * (i >> 2) + 4 * n + (i & 3); }

struct Unit { int pm, pn; };
struct Gemm { const bf16_t* A; const bf16_t* Bt; int M, N, K; };

struct StaticOrder {
    int nM, nN, nwg, G, c;
    __host__ __device__ void init(int M, int N, int G_, int c_) { nM = M / BM; nN = N / BM; nwg = nM * nN; G = G_; c = c_; }
    __host__ __device__ bool next(int i, Unit& u) const {
        const long L = (long)i * G + c; if (L >= nwg) return false;
        int wgid = (int)L; { const int q = nwg / NXCD, r = nwg % NXCD, xcd = wgid % NXCD, off = wgid / NXCD; wgid = (xcd < r ? xcd * (q + 1) : r * (q + 1) + (xcd - r) * q) + off; }
        const int nig = WGM * nN, gid = wgid / nig, fm = gid * WGM, gsz = (nM - fm) < WGM ? (nM - fm) : WGM;
        u.pm = fm + ((wgid % nig) % gsz); u.pn = (wgid % nig) / gsz; return true;
    }
    __device__ __forceinline__ void a_ready(const Unit&) const {}
    __device__ __forceinline__ void done(const Unit&) const {}
};

__device__ __forceinline__ unsigned cvt_pk_bf16(float lo, float hi) { unsigned r; asm volatile("v_cvt_pk_bf16_f32 %0, %1, %2" : "=v"(r) : "v"(lo), "v"(hi)); return r; }
typedef float f32x2 __attribute__((ext_vector_type(2)));
#ifdef EPI_NT
#define ST16(p, v) __builtin_nontemporal_store((v), (p))
#else
#define ST16(p, v) (*(p) = (v))
#endif
__device__ __forceinline__ float fast_sigmoid(float x) { return __builtin_amdgcn_rcpf(1.0f + __builtin_amdgcn_exp2f(x * -1.4426950408889634f)); }
__device__ __forceinline__ float silu_f(float x) { return x * fast_sigmoid(x); }
__device__ __forceinline__ float gelu_tanh_f(float x) { const float z = 1.5957691216057308f * (x + 0.044715f * x * x * x); return x * fast_sigmoid(z); }
__device__ __forceinline__ float xrow16_sum(float x) {
    auto s = __builtin_amdgcn_permlane16_swap(__float_as_uint(x), __float_as_uint(x), false, false);
    x = __uint_as_float(s[0]) + __uint_as_float(s[1]);
    auto t = __builtin_amdgcn_permlane32_swap(__float_as_uint(x), __float_as_uint(x), false, false);
    return __uint_as_float(t[0]) + __uint_as_float(t[1]);
}
__device__ __forceinline__ float bf2f(unsigned short v) { return __uint_as_float(((unsigned)v) << 16); }
__device__ __forceinline__ float row_rstd32(const float* part, int fq) {
    const f32x4 a = *(const f32x4*)(part + fq * 8), b = *(const f32x4*)(part + fq * 8 + 4);
    float s = ((a[0] + a[1]) + (a[2] + a[3])) + ((b[0] + b[1]) + (b[2] + b[3]));
    s = xrow16_sum(s);
    return __builtin_amdgcn_rsqf(s * (1.0f / 2048.0f) + 1e-6f);
}
__device__ __forceinline__ u32x4 pack8(const f32x4 v0, const f32x4 v1) { u32x4 w; w.x = cvt_pk_bf16(v0[0], v0[1]); w.y = cvt_pk_bf16(v0[2], v0[3]); w.z = cvt_pk_bf16(v1[0], v1[1]); w.w = cvt_pk_bf16(v1[2], v1[3]); return w; }

template <int NOSTORE> struct EpiEvenInT {
    static constexpr bool PERM = true, AFTER_DRAIN = false, PRE_STATS = true;
    bf16_t* PROJ; float* IDX; const float* stats; bf16_t* IDXB;
    __device__ __forceinline__ void operator()(const f32x4 (&acc)[2][2][4][2], const Unit& u, int wr, int wc, int fr, int fq, const float (&rs)[2][4]) const {
        const int rowb = u.pm * BM + wr * 64 + fr, pn = u.pn;
        if (pn < 36) {
            const bool act = __builtin_amdgcn_readfirstlane((int)((pn >= 8 && pn < 16) || (pn >= 28))) != 0;
            if (act) {
#pragma unroll
                for (int ai = 0; ai < 2; ++ai)
#pragma unroll
                    for (int m = 0; m < 4; ++m) { bf16_t* rowp = PROJ + (size_t)(rowb + ai * HALF + m * 16) * 9216 + pn * BM + wc * 32 + fq * 8; const float r = rs[ai][m];
#pragma unroll
                        for (int bj = 0; bj < 2; ++bj) { f32x4 v0 = acc[ai][bj][m][0] * r, v1 = acc[ai][bj][m][1] * r;
#pragma unroll
                            for (int i = 0; i < 4; ++i) { v0[i] = silu_f(v0[i]); v1[i] = silu_f(v1[i]); }
                            const u32x4 pk_ = pack8(v0, v1); if (NOSTORE) asm volatile("" :: "v"(pk_)); else ST16((u32x4*)(rowp + bj * HALF), pk_); } }
            } else {
#pragma unroll
                for (int ai = 0; ai < 2; ++ai)
#pragma unroll
                    for (int m = 0; m < 4; ++m) { bf16_t* rowp = PROJ + (size_t)(rowb + ai * HALF + m * 16) * 9216 + pn * BM + wc * 32 + fq * 8; const float r = rs[ai][m];
#pragma unroll
                        for (int bj = 0; bj < 2; ++bj) { const f32x4 v0 = acc[ai][bj][m][0] * r, v1 = acc[ai][bj][m][1] * r;
                            const u32x4 pk_ = pack8(v0, v1); if (NOSTORE) asm volatile("" :: "v"(pk_)); else ST16((u32x4*)(rowp + bj * HALF), pk_); } }
            }
        } else {
#ifdef CHECK_SCORE
            const bool f32too = true;
#else
            const bool f32too = __builtin_amdgcn_readfirstlane((int)(pn == 40)) != 0;
#endif
#pragma unroll
            for (int ai = 0; ai < 2; ++ai)
#pragma unroll
                for (int m = 0; m < 4; ++m) { float* rowp = IDX + (size_t)(rowb + ai * HALF + m * 16) * 1280 + (pn - 36) * BM + wc * 32 + fq * 8; const float r = rs[ai][m];
                    bf16_t* rowb16 = IDXB + (size_t)(rowb + ai * HALF + m * 16) * 1280 + (pn - 36) * BM + wc * 32 + fq * 8;
#pragma unroll
                    for (int bj = 0; bj < 2; ++bj) { const f32x4 v0 = acc[ai][bj][m][0] * r, v1 = acc[ai][bj][m][1] * r; if (f32too) { ST16((f32x4*)(rowp + bj * HALF), v0); ST16((f32x4*)(rowp + bj * HALF + 4), v1); } ST16((u32x4*)(rowb16 + bj * HALF), pack8(v0, v1)); } }
        }
    }
};
typedef EpiEvenInT<0> EpiEvenIn;
struct EpiOddIn {
    static constexpr bool PERM = true, AFTER_DRAIN = false, PRE_STATS = true;
    bf16_t* PROJ; const float* stats; float* statsLN;
    __device__ __forceinline__ void operator()(const f32x4 (&acc)[2][2][4][2], const Unit& u, int wr, int wc, int fr, int fq, const float (&rs)[2][4]) const {
        const int rowb = u.pm * BM + wr * 64 + fr, pn = u.pn;
#define EPO_BODY(ACTF) _Pragma("unroll") for (int ai = 0; ai < 2; ++ai) _Pragma("unroll") for (int m = 0; m < 4; ++m) { const int row = rowb + ai * HALF + m * 16; bf16_t* rowp = PROJ + (size_t)row * 6144 + pn * BM + wc * 32 + fq * 8; const float r = rs[ai][m]; \
                float s1 = 0.f, s2 = 0.f; \
                _Pragma("unroll") for (int bj = 0; bj < 2; ++bj) { f32x4 v0 = acc[ai][bj][m][0] * r, v1 = acc[ai][bj][m][1] * r; \
                    _Pragma("unroll") for (int i = 0; i < 4; ++i) { v0[i] = ACTF(v0[i]); v1[i] = ACTF(v1[i]); } \
                    _Pragma("unroll") for (int i = 0; i < 4; ++i) { s1 += v0[i] + v1[i]; s2 += v0[i] * v0[i] + v1[i] * v1[i]; } \
                    ST16((u32x4*)(rowp + bj * HALF), pack8(v0, v1)); } \
                if (stat) { s1 = xrow16_sum(s1); s2 = xrow16_sum(s2); if (fq == 0) { float* sp = statsLN + ((size_t)row * 32 + (pn - 8) * 4 + wc) * 2; sp[0] = s1; sp[1] = s2; } } }
        const bool isg = __builtin_amdgcn_readfirstlane((int)(pn < 16)) != 0, stat = __builtin_amdgcn_readfirstlane((int)(pn >= 8 && pn < 16)) != 0;
        if (isg) { EPO_BODY(gelu_tanh_f) } else { EPO_BODY(silu_f) }
#undef EPO_BODY
    }
};
__device__ __forceinline__ void unpack8(const u32x4 w, f32x4& a, f32x4& b) {
    a[0] = __uint_as_float(w.x << 16); a[1] = __uint_as_float(w.x & 0xffff0000u); a[2] = __uint_as_float(w.y << 16); a[3] = __uint_as_float(w.y & 0xffff0000u);
    b[0] = __uint_as_float(w.z << 16); b[1] = __uint_as_float(w.z & 0xffff0000u); b[2] = __uint_as_float(w.w << 16); b[3] = __uint_as_float(w.w & 0xffff0000u); }
struct EpiOut {
    static constexpr bool PERM = true, AFTER_DRAIN = false, PRE_STATS = false;
    const bf16_t* hin; bf16_t* hout; float* statsO;
    __device__ __forceinline__ void operator()(const f32x4 (&acc_)[2][2][4][2], const Unit& u, int wr, int wc, int fr, int fq) const {
        f32x4 (&acc)[2][2][4][2] = const_cast<f32x4 (&)[2][2][4][2]>(acc_);
        const int rowb = u.pm * BM + wr * 64 + fr, col0 = u.pn * BM + wc * 32 + fq * 8;
        float ssr[2][4];
#pragma unroll
        for (int ai = 0; ai < 2; ++ai)
#pragma unroll
            for (int m = 0; m < 4; ++m) { const int row = rowb + ai * HALF + m * 16; float ss = 0.f;
#pragma unroll
                for (int bj = 0; bj < 2; ++bj) { const size_t off = (size_t)row * 2048 + col0 + bj * HALF;
                    f32x4 h0, h1; unpack8(*(const u32x4*)(hin + off), h0, h1); h0 += acc[ai][bj][m][0]; h1 += acc[ai][bj][m][1];
                    acc[ai][bj][m][0] = h0; acc[ai][bj][m][1] = h1;
#pragma unroll
                    for (int i = 0; i < 4; ++i) ss += h0[i] * h0[i] + h1[i] * h1[i]; }
                ssr[ai][m] = xrow16_sum(ss); if (m == 3) asm volatile("" ::: "memory"); }
        asm volatile("" ::: "memory");
#pragma unroll
        for (int ai = 0; ai < 2; ++ai)
#pragma unroll
            for (int m = 0; m < 4; ++m) { const int row = rowb + ai * HALF + m * 16;
#pragma unroll
                for (int bj = 0; bj < 2; ++bj) { const size_t off = (size_t)row * 2048 + col0 + bj * HALF; ST16((u32x4*)(hout + off), pack8(acc[ai][bj][m][0], acc[ai][bj][m][1])); }
                if (fq == 0) statsO[(size_t)row * 32 + u.pn * 4 + wc] = ssr[ai][m]; }
    }
};
struct EpiPE {
    static constexpr bool PERM = true, AFTER_DRAIN = false, PRE_STATS = false;
    bf16_t* E;
    __device__ __forceinline__ void operator()(const f32x4 (&acc)[2][2][4][2], const Unit& u, int wr, int wc, int fr, int fq) const {
        const int rowb = u.pm * BM + wr * 64 + fr, col0 = u.pn * BM + wc * 32 + fq * 8;
#pragma unroll
        for (int ai = 0; ai < 2; ++ai)
#pragma unroll
            for (int m = 0; m < 4; ++m)
#pragma unroll
                for (int bj = 0; bj < 2; ++bj) ST16((u32x4*)(E + (size_t)(rowb + ai * HALF + m * 16) * 2048 + col0 + bj * HALF), pack8(acc[ai][bj][m][0], acc[ai][bj][m][1]));
    }
};
template <bool LAST> struct EpiGateT {
    static constexpr bool PERM = true, AFTER_DRAIN = false, PRE_STATS = true;
    const bf16_t* hin; const bf16_t* E; const float* stats; bf16_t* hout; float* statsO; float* fout;
    __device__ __forceinline__ void operator()(const f32x4 (&acc_)[2][2][4][2], const Unit& u, int wr, int wc, int fr, int fq, const float (&rs_)[2][4]) const {
        f32x4 (&acc)[2][2][4][2] = const_cast<f32x4 (&)[2][2][4][2]>(acc_);
        const int rowb = u.pm * BM + wr * 64 + fr, col0 = u.pn * BM + wc * 32 + fq * 8;
        float rs[2][4];
#pragma unroll
        for (int ai = 0; ai < 2; ++ai)
#pragma unroll
            for (int m = 0; m < 4; ++m) rs[ai][m] = rs_[ai][m];
#pragma unroll
        for (int ai = 0; ai < 2; ++ai)
#pragma unroll
            for (int m = 0; m < 4; ++m) { const int row = rowb + ai * HALF + m * 16; const float r = rs[ai][m]; float ss = 0.f;
#pragma unroll
                for (int bj = 0; bj < 2; ++bj) { const size_t off = (size_t)row * 2048 + col0 + bj * HALF;
                    f32x4 e0, e1, h0, h1; unpack8(*(const u32x4*)(E + off), e0, e1); unpack8(*(const u32x4*)(hin + off), h0, h1);
                    f32x4 g0 = acc[ai][bj][m][0] * r, g1 = acc[ai][bj][m][1] * r;
#pragma unroll
                    for (int i = 0; i < 4; ++i) { g0[i] = fast_sigmoid(g0[i]); g1[i] = fast_sigmoid(g1[i]); }
                    h0 += g0 * e0; h1 += g1 * e1;
                    acc[ai][bj][m][0] = h0; acc[ai][bj][m][1] = h1;
#pragma unroll
                    for (int i = 0; i < 4; ++i) ss += h0[i] * h0[i] + h1[i] * h1[i]; }
                if (!LAST) rs[ai][m] = xrow16_sum(ss);
                if (m == 3) asm volatile("" ::: "memory"); }
        asm volatile("" ::: "memory");
#pragma unroll
        for (int ai = 0; ai < 2; ++ai)
#pragma unroll
            for (int m = 0; m < 4; ++m) { const int row = rowb + ai * HALF + m * 16;
#pragma unroll
                for (int bj = 0; bj < 2; ++bj) { const size_t off = (size_t)row * 2048 + col0 + bj * HALF; const f32x4 h0 = acc[ai][bj][m][0], h1 = acc[ai][bj][m][1];
                    if (LAST) { ST16((f32x4*)(fout + off), h0); ST16((f32x4*)(fout + off + 4), h1); } else ST16((u32x4*)(hout + off), pack8(h0, h1)); }
                if (!LAST) { if (fq == 0) statsO[(size_t)row * 32 + u.pn * 4 + wc] = rs[ai][m]; } }
    }
};

struct EpiNull {
    static constexpr bool PERM = true, AFTER_DRAIN = false, PRE_STATS = false;
    __device__ __forceinline__ void operator()(const f32x4 (&acc)[2][2][4][2], const Unit& u, int wr, int wc, int fr, int fq) const {
#pragma unroll
        for (int ai = 0; ai < 2; ++ai)
#pragma unroll
            for (int bj = 0; bj < 2; ++bj) asm volatile("" :: "v"(acc[ai][bj][0][0]), "v"(acc[ai][bj][0][1]), "v"(acc[ai][bj][1][0]), "v"(acc[ai][bj][1][1]), "v"(acc[ai][bj][2][0]), "v"(acc[ai][bj][2][1]), "v"(acc[ai][bj][3][0]), "v"(acc[ai][bj][3][1])); }
};
template <class Epi, class Sched, bool ALIGN_EPI = false, bool SP2 = false>
__device__ __forceinline__ void gemm_phase(PG8_LAS unsigned char* lds, const Gemm g, const Sched& S, const Epi& E, const int wid_in) {
    int tid_; asm volatile("v_mbcnt_lo_u32_b32 %0, -1, 0\n\tv_mbcnt_hi_u32_b32 %0, -1, %0" : "=v"(tid_)); int wid = wid_in; asm volatile("" : "+s"(wid)); tid_ += wid * 64; asm volatile("" : "+v"(tid_));
    const int tid = tid_, lane = tid & 63, wr = wid >> 2, wc = wid & 3, fr = lane & 15, fq = lane >> 4;
    const int K = g.K, nt = K / BK;
    unsigned voffA[2], voffB[2];
#pragma unroll
    for (int i = 0; i < 2; ++i) { int R, C; stage_rc(tid * 16 + i * 8192, R, C); const int Rb = Epi::PERM ? ((R & ~31) + perm32(R & 31)) : R;
        voffA[i] = (unsigned)(R * K + C) * 2u; voffB[i] = (unsigned)(Rb * K + C) * 2u; }
    const size_t kstep = (size_t)(BK * 2);
    const size_t hstep = (size_t)HALF * K * 2;
    const size_t tstep = 2 * hstep;
    const unsigned ldsw = (unsigned)wid * 1024u;
    const int aoff = lds_byte(wr * 64 + fr, fq * 8), boff = lds_byte(wc * 32 + fr, fq * 8);
#define PG8_SA(b, h) (((b) * 2 + (h)) * HTB)
#define PG8_SB(b, h) ((4 + (b) * 2 + (h)) * HTB)
#define PG8_STAGE(bufoff, gbase, voff) do { _Pragma("unroll") for (int _i = 0; _i < 2; ++_i) \
        __builtin_amdgcn_global_load_lds((const unsigned*)((const char*)(gbase) + (voff)[_i]), (PG8_LAS unsigned*)(lds + (bufoff) + ldsw + _i * 8192), 16, 0, 0); } while (0)
#define PG8_LDA(dst, b, h) do { _Pragma("unroll") for (int m = 0; m < 4; ++m) _Pragma("unroll") for (int k = 0; k < 2; ++k) dst[m][k] = *(const PG8_LAS bf16x8*)(lds + PG8_SA(b, h) + aoff + m * 2048 + k * 1024); } while (0)
#define PG8_LDB(dst, b, h) do { _Pragma("unroll") for (int n = 0; n < 2; ++n) _Pragma("unroll") for (int k = 0; k < 2; ++k) dst[n][k] = *(const PG8_LAS bf16x8*)(lds + PG8_SB(b, h) + boff + n * 2048 + k * 1024); } while (0)
#define PG8_MMA(ai, bj, At, Bt) do { __builtin_amdgcn_s_setprio(1); _Pragma("unroll") for (int m = 0; m < 4; ++m) _Pragma("unroll") for (int n = 0; n < 2; ++n) _Pragma("unroll") for (int k = 0; k < 2; ++k) \
        acc[ai][bj][m][n] = __builtin_amdgcn_mfma_f32_16x16x32_bf16(Bt[n][k], At[m][k], acc[ai][bj][m][n], 0, 0, 0); __builtin_amdgcn_s_setprio(0); } while (0)
#define PG8_WAIT_V(n) asm volatile("s_waitcnt vmcnt(" #n ")" ::: "memory")
#define PG8_WAIT_L(n) asm volatile("s_waitcnt lgkmcnt(" #n ")" ::: "memory")
#define PG8_BAR __builtin_amdgcn_s_barrier()
#define PG8_SCHED __builtin_amdgcn_sched_barrier(0)
    Unit cur, nxt; int ui = 0;
    if (!S.next(0, cur)) return;
    f32x4 acc[2][2][4][2];
#pragma unroll
    for (int a = 0; a < 2; ++a)
#pragma unroll
        for (int b = 0; b < 2; ++b)
#pragma unroll
            for (int m = 0; m < 4; ++m)
#pragma unroll
                for (int n = 0; n < 2; ++n) acc[a][b][m][n] = (f32x4){0.f, 0.f, 0.f, 0.f};
    bf16x8 At[4][2], B0[2][2], B1[2][2];
    const char* cA = (const char*)g.A + (size_t)cur.pm * tstep; const char* cB = (const char*)g.Bt + (size_t)cur.pn * tstep;
    S.a_ready(cur);
    if constexpr (SP2) {
        PG8_STAGE(PG8_SB(0, 0), cB, voffB); PG8_STAGE(PG8_SB(0, 1), cB + hstep, voffB); PG8_STAGE(PG8_SA(0, 0), cA, voffA); PG8_STAGE(PG8_SA(0, 1), cA + hstep, voffA);
        if constexpr (Epi::PRE_STATS) {
            const int prow = tid >> 1, phalf = tid & 1;
#pragma unroll 1
            for (int i0 = 0; ; i0 += 3) { Unit uu[3]; bool hv[3];
#pragma unroll
                for (int q = 0; q < 3; ++q) { hv[q] = S.next(i0 + q, uu[q]); if (!hv[q]) uu[q] = cur; }
                if (!hv[0]) break;
                f32x4 pv[3][4];
#pragma unroll
                for (int q = 0; q < 3; ++q) { const float* sp = E.stats + ((size_t)(uu[q].pm * BM + prow) * 32 + phalf * 16);
#pragma unroll
                    for (int x = 0; x < 4; ++x) pv[q][x] = *(const f32x4*)(sp + 4 * x); }
#pragma unroll
                for (int q = 0; q < 3; ++q) { const f32x4 t4 = (pv[q][0] + pv[q][1]) + (pv[q][2] + pv[q][3]); float sq = (t4[0] + t4[1]) + (t4[2] + t4[3]);
                    sq += __int_as_float(__builtin_amdgcn_mov_dpp(__float_as_int(sq), 0xB1, 0xF, 0xF, true));
                    if (hv[q]) *(PG8_LAS float*)(lds + STAGE_BYTES + ((i0 + q) * 256 + prow) * 4) = __builtin_amdgcn_rsqf(sq * (1.0f / 2048.0f) + 1e-6f); }
                if (!hv[2]) break; }
        }
        if (wr == 1) PG8_BAR;
        PG8_WAIT_V(2); PG8_BAR;
        PG8_STAGE(PG8_SB(1, 0), cB + kstep, voffB); PG8_STAGE(PG8_SA(1, 0), cA + kstep, voffA); PG8_STAGE(PG8_SB(1, 1), cB + hstep + kstep, voffB);
        PG8_WAIT_V(6); PG8_BAR;
    } else {
        PG8_STAGE(PG8_SB(0, 0), cB, voffB); PG8_STAGE(PG8_SA(0, 0), cA, voffA); PG8_STAGE(PG8_SB(0, 1), cB + hstep, voffB); PG8_STAGE(PG8_SA(0, 1), cA + hstep, voffA);
        if (wr == 1) PG8_BAR;
        PG8_WAIT_V(4); PG8_BAR;
        PG8_STAGE(PG8_SB(1, 0), cB + kstep, voffB); PG8_STAGE(PG8_SA(1, 0), cA + kstep, voffA); PG8_STAGE(PG8_SB(1, 1), cB + hstep + kstep, voffB);
        PG8_WAIT_V(6); PG8_BAR;
    }
    for (;;) {
        const bool has_next = S.next(ui + 1, nxt);
        const char* nA = has_next ? (const char*)g.A + (size_t)nxt.pm * tstep : cA; const char* nB = has_next ? (const char*)g.Bt + (size_t)nxt.pn * tstep : cB;
        for (int t = 0; t < nt; t += 2) {
            const bool last = (t == nt - 2);
            const char* a1 = cA + (size_t)(t + 1) * kstep;
            const char* a2 = last ? nA : cA + (size_t)(t + 2) * kstep; const char* b2 = last ? nB : cB + (size_t)(t + 2) * kstep;
            const char* a3 = a2 + kstep; const char* b3 = b2 + kstep;
            if (last && has_next) S.a_ready(nxt);
            if constexpr (SP2) {
            PG8_LDB(B0, 0, 0); PG8_LDB(B1, 0, 1); PG8_SCHED; PG8_LDA(At, 0, 0); PG8_STAGE(PG8_SA(1, 1), a1 + hstep, voffA);
            PG8_WAIT_V(8); PG8_WAIT_L(0); PG8_BAR; PG8_MMA(0, 0, At, B0); PG8_MMA(0, 1, At, B1); PG8_BAR; PG8_SCHED;
            PG8_LDA(At, 0, 1); PG8_STAGE(PG8_SB(0, 0), b2, voffB); PG8_STAGE(PG8_SB(0, 1), b2 + hstep, voffB); PG8_STAGE(PG8_SA(0, 0), a2, voffA);
            PG8_WAIT_V(8); PG8_WAIT_L(0); PG8_BAR; PG8_MMA(1, 0, At, B0); PG8_MMA(1, 1, At, B1); PG8_BAR; PG8_SCHED;
            PG8_LDB(B0, 1, 0); PG8_LDB(B1, 1, 1); PG8_SCHED; PG8_LDA(At, 1, 0); PG8_STAGE(PG8_SA(0, 1), a2 + hstep, voffA);
            PG8_WAIT_V(8); PG8_WAIT_L(0); PG8_BAR; PG8_MMA(0, 0, At, B0); PG8_MMA(0, 1, At, B1); PG8_BAR; PG8_SCHED;
            PG8_LDA(At, 1, 1); PG8_STAGE(PG8_SB(1, 0), b3, voffB); PG8_STAGE(PG8_SB(1, 1), b3 + hstep, voffB); PG8_STAGE(PG8_SA(1, 0), a3, voffA);
            PG8_WAIT_V(8); PG8_WAIT_L(0); PG8_BAR; PG8_MMA(1, 0, At, B0); PG8_MMA(1, 1, At, B1); PG8_BAR; PG8_SCHED;
            } else {
            PG8_LDB(B0, 0, 0); PG8_SCHED; PG8_LDA(At, 0, 0); PG8_STAGE(PG8_SA(1, 1), a1 + hstep, voffA);
            PG8_WAIT_L(8); PG8_BAR; PG8_WAIT_L(0); PG8_MMA(0, 0, At, B0); PG8_BAR; PG8_SCHED;
            PG8_LDB(B1, 0, 1); PG8_STAGE(PG8_SB(0, 0), b2, voffB);
            PG8_BAR; PG8_WAIT_L(0); PG8_MMA(0, 1, At, B1); PG8_BAR;
            PG8_LDA(At, 0, 1); PG8_STAGE(PG8_SA(0, 0), a2, voffA);
            PG8_BAR; PG8_WAIT_L(0); PG8_MMA(1, 0, At, B0); PG8_BAR; PG8_SCHED;
            PG8_STAGE(PG8_SB(0, 1), b2 + hstep, voffB);
            PG8_WAIT_V(6); PG8_BAR; PG8_MMA(1, 1, At, B1); PG8_BAR;
            PG8_LDB(B0, 1, 0); PG8_SCHED; PG8_LDA(At, 1, 0); PG8_STAGE(PG8_SA(0, 1), a2 + hstep, voffA);
            PG8_WAIT_L(8); PG8_BAR; PG8_WAIT_L(0); PG8_MMA(0, 0, At, B0); PG8_BAR; PG8_SCHED;
            PG8_LDB(B1, 1, 1); PG8_STAGE(PG8_SB(1, 0), b3, voffB);
            PG8_BAR; PG8_WAIT_L(0); PG8_MMA(0, 1, At, B1); PG8_BAR;
            PG8_LDA(At, 1, 1); PG8_STAGE(PG8_SA(1, 0), a3, voffA);
            PG8_BAR; PG8_WAIT_L(0); PG8_MMA(1, 0, At, B0); PG8_BAR; PG8_SCHED;
            PG8_STAGE(PG8_SB(1, 1), b3 + hstep, voffB);
            PG8_WAIT_V(6); PG8_BAR; PG8_MMA(1, 1, At, B1); PG8_BAR;
            }
        }
        if constexpr (ALIGN_EPI) { if (wr == 0) PG8_BAR; }
        if constexpr (Epi::PRE_STATS) { float rs[2][4];
#pragma unroll
            for (int ai = 0; ai < 2; ++ai)
#pragma unroll
                for (int m = 0; m < 4; ++m) rs[ai][m] = *(const PG8_LAS float*)(lds + STAGE_BYTES + (ui * 256 + ai * HALF + wr * 64 + m * 16 + fr) * 4);
            E(acc, cur, wr, wc, fr, fq, rs); S.done(cur); }
        else if constexpr (!Epi::AFTER_DRAIN) { E(acc, cur, wr, wc, fr, fq); S.done(cur); }
        if (!has_next) break;
#pragma unroll
        for (int a = 0; a < 2; ++a)
#pragma unroll
            for (int b = 0; b < 2; ++b)
#pragma unroll
                for (int m = 0; m < 4; ++m)
#pragma unroll
                    for (int n = 0; n < 2; ++n) acc[a][b][m][n] = (f32x4){0.f, 0.f, 0.f, 0.f};
        cur = nxt; cA = nA; cB = nB; ++ui;
        if constexpr (ALIGN_EPI) { if (wr == 1) PG8_BAR; }
    }
    PG8_WAIT_V(0);
    if constexpr (!ALIGN_EPI) { if (wr == 0) PG8_BAR; }
    PG8_BAR;
    if constexpr (Epi::AFTER_DRAIN) { E.fused(acc, cur, wr, wc, fr, fq, lds, wid, lane); S.done(cur); }
#undef PG8_SA
#undef PG8_SB
#undef PG8_STAGE
#undef PG8_LDA
#undef PG8_LDB
#undef PG8_MMA
#undef PG8_WAIT_V
#undef PG8_WAIT_L
#undef PG8_BAR
#undef PG8_SCHED
}
}

#ifndef LRU_STREAM
#define LRU_STREAM 1
#endif
constexpr int NWAVES = 8, NTHR = 512;
constexpr int BATCH = 2, SEQ = 4096, DM = 2048, M = BATCH * SEQ, DEPTH = 4;
constexpr int EVEN_IN = 10320, EVEN_INP = 10496, PROJ_LD = 9216, ODD_IN = 6144, IDX_LD = 1280;
constexpr int COL_GA = 2048, COL_Q = 4096, COL_K = 6144, COL_V = 6656, COL_GB = 7168;
constexpr int TOPK = 256;
#ifndef N_LAUNCHES
#define N_LAUNCHES 1
#endif
constexpr int NPHASE = 1 + 2 * 6 + 2 * 4;
#ifndef PROBE_REP
#define PROBE_REP 0
#endif
#define NREP(n) ((PROBE_REP == (n)) ? 3 : 1)

constexpr size_t MiB = 1u << 20;
constexpr size_t WS_CTL = 0, CTL_ZERO_BYTES = 32768;
constexpr size_t WS_STATA = 1 * MiB, WS_STATB = 2 * MiB, WS_STATLN = 3 * MiB, WS_LRUSUM = 5 * MiB, WS_BM = 6 * MiB, WS_KN = 10 * MiB, WS_PBF = 18 * MiB;
constexpr size_t WS_WSMALL = 34 * MiB, WS_WPE = 38 * MiB, WS_WGATE = 42 * MiB, WS_WEIN = 74 * MiB, WS_WEOUT = 156 * MiB, WS_WOIN = 188 * MiB, WS_WOOUT = 236 * MiB;
constexpr size_t WS_H = 252 * MiB, WS_AN = 316 * MiB, WS_PROJ = 348 * MiB, WS_YCAT = 492 * MiB, WS_IDX = WS_YCAT, WS_IDXB = WS_YCAT + 40 * MiB, WS_SC = 556 * MiB, WS_E = WS_SC, WS_END = 622 * MiB;
constexpr size_t SCB = (size_t)4096 * 64 * 65 / 2;
static_assert(WS_IDXB + (size_t)M * IDX_LD * 2 <= WS_SC && WS_SC + 2 * SCB * 4 <= WS_END && WS_IDX + (size_t)M * IDX_LD * 4 <= WS_SC && WS_PROJ + (size_t)M * PROJ_LD * 2 <= WS_YCAT, "ws map");
constexpr int CW_BAR = 4096;
static_assert((CW_BAR + 3456) * 4 <= (int)CTL_ZERO_BYTES, "control words inside the memset");

constexpr int RING_BYTES = 131072, LDS_BYTES = 147456, MISC_OFF = LDS_BYTES - 256, XTRA_OFF = RING_BYTES;

#define GAS __attribute__((address_space(1)))
#define LAS __attribute__((address_space(3)))
typedef unsigned short bf16;
typedef unsigned v4u __attribute__((ext_vector_type(4)));
typedef unsigned v2u __attribute__((ext_vector_type(2)));
typedef float f32x4 __attribute__((ext_vector_type(4)));
typedef GAS unsigned gu32;
#define RLX_AGENT __ATOMIC_RELAXED, __HIP_MEMORY_SCOPE_AGENT
#define LDS_WAIT() asm volatile("s_waitcnt lgkmcnt(0)" ::: "memory")
__device__ __forceinline__ unsigned f2bf(float f) { unsigned u = __builtin_bit_cast(unsigned, f); return (u + 0x7fffu + ((u >> 16) & 1u)) >> 16; }
__device__ __forceinline__ unsigned pk2(float lo, float hi) { return f2bf(lo) | (f2bf(hi) << 16); }
__device__ __forceinline__ float bflo(unsigned w) { return __uint_as_float(w << 16); }
__device__ __forceinline__ float bfhi(unsigned w) { return __uint_as_float(w & 0xffff0000u); }
__device__ __forceinline__ float bf2f(bf16 v) { return __uint_as_float(((unsigned)v) << 16); }
__device__ __forceinline__ float shx(float v, int o, int lane) { return __int_as_float(__builtin_amdgcn_ds_bpermute((lane ^ o) << 2, __float_as_int(v))); }
__device__ __forceinline__ int shx_i(int v, int o, int lane) { return __builtin_amdgcn_ds_bpermute((lane ^ o) << 2, v); }
__device__ __forceinline__ int wave_sum_i(int v, int lane) {
    v += __builtin_amdgcn_update_dpp(0, v, 0x111, 0xF, 0xF, true); v += __builtin_amdgcn_update_dpp(0, v, 0x112, 0xF, 0xF, true);
    v += __builtin_amdgcn_update_dpp(0, v, 0x114, 0xF, 0xF, true); v += __builtin_amdgcn_update_dpp(0, v, 0x118, 0xF, 0xF, true);
    v += __builtin_amdgcn_update_dpp(0, v, 0x142, 0xA, 0xF, true); v += __builtin_amdgcn_update_dpp(0, v, 0x143, 0xC, 0xF, true);
    return __builtin_amdgcn_readlane(v, 63);
}
__device__ __forceinline__ float wave_sum(float v, int lane) {
    v += __int_as_float(__builtin_amdgcn_update_dpp(0, __float_as_int(v), 0x111, 0xF, 0xF, true)); v += __int_as_float(__builtin_amdgcn_update_dpp(0, __float_as_int(v), 0x112, 0xF, 0xF, true));
    v += __int_as_float(__builtin_amdgcn_update_dpp(0, __float_as_int(v), 0x114, 0xF, 0xF, true)); v += __int_as_float(__builtin_amdgcn_update_dpp(0, __float_as_int(v), 0x118, 0xF, 0xF, true));
    v += __int_as_float(__builtin_amdgcn_update_dpp(0, __float_as_int(v), 0x142, 0xA, 0xF, true)); v += __int_as_float(__builtin_amdgcn_update_dpp(0, __float_as_int(v), 0x143, 0xC, 0xF, true));
    return __int_as_float(__builtin_amdgcn_readlane(__float_as_int(v), 63));
}
__device__ __forceinline__ int lane_id() { int l; asm volatile("v_mbcnt_lo_u32_b32 %0, -1, 0\n\tv_mbcnt_hi_u32_b32 %0, -1, %0" : "=v"(l)); return l; }
__device__ __forceinline__ int make_tid(int wave) { asm volatile("" : "+s"(wave)); int t = wave * 64 + lane_id(); asm volatile("" : "+v"(t)); return t; }
__device__ __forceinline__ float fexp(float x) { return __builtin_amdgcn_exp2f(x * 1.4426950408889634f); }
__device__ __forceinline__ float frcp(float x) { return __builtin_amdgcn_rcpf(x); }
__device__ __forceinline__ float frsq(float x) { return __builtin_amdgcn_rsqf(x); }
__device__ __forceinline__ float sigmoid_acc(float x) { return frcp(1.0f + fexp(-x)); }

#define XB_TMO      128
#define XB_XCNT(j)  (256  + 64 * (j))
#define XB_XSUB(j)  (1280 + 64 * (j))
#define XB_XGEN(j)  (2304 + 64 * (j))
#define XB_TOP      3328
#define XB_TOPGEN   3392
#define XCD_BAR_WORDS 3456
#define XB_SPIN_CAP (1u << 18)

__device__ __forceinline__ unsigned xb_ld(unsigned* p)              { return __hip_atomic_load(p, __ATOMIC_RELAXED, __HIP_MEMORY_SCOPE_AGENT); }
__device__ __forceinline__ unsigned xb_add(unsigned* p, unsigned v) { return __hip_atomic_fetch_add(p, v, __ATOMIC_RELAXED, __HIP_MEMORY_SCOPE_AGENT); }
__device__ __forceinline__ unsigned xb_xcc_id() { return (unsigned)__builtin_amdgcn_s_getreg((3 << 11) | 20) & 0xFu; }
#define XB_SPIN(cond, bar) do { unsigned _sp = 0; while (cond) { __builtin_amdgcn_s_sleep(1); \
    if ((++_sp & 255u) == 0u) { if (xb_ld(&(bar)[XB_TMO])) break; if (_sp > XB_SPIN_CAP) { atomicAdd(&(bar)[XB_TMO], 1u); break; } } } } while (0)

struct XcdBarrier {
    unsigned* bar; unsigned x;
    volatile LAS unsigned* st;
};

__device__ __forceinline__ XcdBarrier xcd_barrier_post(unsigned* bar, volatile LAS unsigned* st) {
    XcdBarrier b; b.bar = bar; b.x = xb_xcc_id(); b.st = st;
    if (threadIdx.x == 0) (void)xb_add(&bar[XB_XCNT(b.x)], 1u);
    return b;
}
__device__ __forceinline__ void xcd_barrier_complete(unsigned* bar, unsigned x, unsigned& nloc, unsigned& nx) {
    const unsigned G = gridDim.x * gridDim.y * gridDim.z;
    unsigned sum, cnt, mine, sp = 0u;
    for (;;) {
        sum = 0u; cnt = 0u; mine = 0u;
#pragma unroll
        for (unsigned j = 0; j < 16; ++j) { const unsigned c = xb_ld(&bar[XB_XCNT(j)]); sum += c; cnt += (c > 0u) ? 1u : 0u; mine = (j == x) ? c : mine; }
        if (sum == G) break;
        __builtin_amdgcn_s_sleep(1);
        if ((++sp & 255u) == 0u) { if (xb_ld(&bar[XB_TMO])) break; if (sp > XB_SPIN_CAP) { atomicAdd(&bar[XB_TMO], 1u); break; } }
    }
    nloc = mine > 0u ? mine : 1u; nx = cnt > 0u ? cnt : 1u;
}

__device__ __forceinline__ void xcd_barrier(const XcdBarrier& b, const bool thread0) {
    asm volatile("s_waitcnt vmcnt(0)" ::: "memory");
    __syncthreads();
    if (thread0) {
        unsigned* bar = b.bar;
        __builtin_amdgcn_s_waitcnt(0);
        unsigned nloc = b.st[0], nx = b.st[1];
        if (nloc == 0u) { xcd_barrier_complete(bar, b.x, nloc, nx); b.st[0] = nloc; b.st[1] = nx; }
        const unsigned old = xb_add(&bar[XB_XSUB(b.x)], 1u);
        const unsigned gen = old / nloc;
        if (old + 1u == (gen + 1u) * nloc) {
            __builtin_amdgcn_fence(__ATOMIC_RELEASE, "agent");
            asm volatile("s_waitcnt vmcnt(0)" ::: "memory");
            const unsigned og = xb_add(&bar[XB_TOP], 1u);
            const unsigned tg = og / nx;
            if (og + 1u == (tg + 1u) * nx) xb_add(&bar[XB_TOPGEN], 1u);
            else XB_SPIN(xb_ld(&bar[XB_TOPGEN]) == tg, bar);
            __builtin_amdgcn_fence(__ATOMIC_ACQUIRE, "agent");
            xb_add(&bar[XB_XGEN(b.x)], 1u);
            asm volatile("s_waitcnt vmcnt(0)" ::: "memory");
        } else {
            XB_SPIN(xb_ld(&bar[XB_XGEN(b.x)]) == gen, bar);
            __builtin_amdgcn_fence(__ATOMIC_ACQUIRE, "agent");
            asm volatile("s_waitcnt vmcnt(0)" ::: "memory");
        }
    }
    __syncthreads();
}


typedef const char __attribute__((address_space(4)))* kargp_t;
#define KARGS_OPEN() int koff_ = 0; asm volatile("" : "+s"(koff_)); const kargp_t kp = (kargp_t)__builtin_amdgcn_kernarg_segment_ptr() + koff_
#define KIN(i) ((const float*)(const __attribute__((address_space(1))) float*)(*(const float* const __attribute__((address_space(4)))*)(kp + 8 * (i))))
#define KOUT ((float*)(__attribute__((address_space(1))) float*)(*(float* const __attribute__((address_space(4)))*)(kp + 192)))
#define KWS ((unsigned char*)(__attribute__((address_space(1))) unsigned char*)(*(unsigned char* const __attribute__((address_space(4)))*)(kp + 200)))
#define KTHR(k) (*(const int __attribute__((address_space(4)))*)(kp + 216 + 4 * (k)))
struct Args { const float* in[24]; float* out; unsigned char* ws; int ph_lo, ph_hi; int thr[8]; };

__device__ __forceinline__ void p0_transpose_item(const float* W, int K, int N, bf16* WT, float* scr, int item, int lane, const float* gk = nullptr) {
    const int nblk = (N + 63) / 64, kb = item / nblk, nb = item % nblk, k0 = 64 * kb, n0 = 64 * nb;
    const int nc = n0 + lane; const float* src = W + (size_t)k0 * N + (nc < N ? nc : 0);
    float v[64];
#pragma unroll
    for (int i = 0; i < 64; ++i) v[i] = __builtin_nontemporal_load(src + (size_t)i * N);
#pragma unroll
    for (int i = 0; i < 64; ++i) scr[i * 65 + lane] = (nc < N) ? v[i] : 0.f;
    LDS_WAIT(); asm volatile("" ::: "memory");
    const int c = lane & 7;
    f32x4 ga = (f32x4){1.f, 1.f, 1.f, 1.f}, gb = ga; if (gk) { ga = *(const f32x4*)(gk + k0 + 8 * c); gb = *(const f32x4*)(gk + k0 + 8 * c + 4); }
#pragma unroll
    for (int jn = 0; jn < 8; ++jn) { const int n = (lane >> 3) + 8 * jn; const float* s = scr + (8 * c) * 65 + n;
        v4u o; o.x = pk2(s[0 * 65] * ga[0], s[1 * 65] * ga[1]); o.y = pk2(s[2 * 65] * ga[2], s[3 * 65] * ga[3]); o.z = pk2(s[4 * 65] * gb[0], s[5 * 65] * gb[1]); o.w = pk2(s[6 * 65] * gb[2], s[7 * 65] * gb[3]);
        if (n0 + n < N) *(v4u*)(WT + (size_t)(n0 + n) * K + k0 + 8 * c) = o; }
    LDS_WAIT(); asm volatile("" ::: "memory");
}

__device__ __forceinline__ size_t sc_off(int b, int t) { const int c = t >> 6; return (size_t)b * SCB + (size_t)2048 * c * (c + 1) + (size_t)(t & 63) * 64 * (c + 1); }

__device__ __forceinline__ void lru_tile(const kargp_t kp, int j, int b, int tile, int g, bool final_pass, unsigned char* lds, int wave, bool check = false) {
    const int tid = make_tid(wave);
    float* XC = (float*)lds; float* AA = (float*)(lds + 65536); float* QS = (float*)(lds + XTRA_OFF);
    const bf16* PROJ = (const bf16*)(KWS + WS_PROJ); float* LRUSUM = (float*)(KWS + WS_LRUSUM); bf16* YCAT = (bf16*)(KWS + WS_YCAT);
    const float* conv_w = KIN(5) + (size_t)j * 4 * 2048; const float* conv_b = KIN(6) + (size_t)j * 2048;
    const float* w_r = KIN(7) + ((size_t)j * 16 + g) * 16384; const float* b_r = KIN(8) + ((size_t)j * 16 + g) * 128;
    const float* w_i = KIN(9) + ((size_t)j * 16 + g) * 16384; const float* b_i = KIN(10) + ((size_t)j * 16 + g) * 128;
    const float* lam = KIN(11) + (size_t)j * 2048;
    const int t0 = tile * 128, c0 = g * 128; const size_t row0 = (size_t)b * SEQ + t0;
    __syncthreads();
    for (int e = tid; e < 4096; e += NTHR) { const int t = e >> 5, cq = (e & 31) * 4;
        f32x4 acc = *(const f32x4*)(conv_b + c0 + cq);
#pragma unroll
        for (int k = 0; k < 4; ++k) { const int tt = t0 + t + k - 3;
            if (tt >= 0) { const v2u xw = *(const v2u*)(PROJ + ((size_t)b * SEQ + tt) * PROJ_LD + c0 + cq); const f32x4 w = *(const f32x4*)(conv_w + (size_t)k * 2048 + c0 + cq);
                acc[0] += bflo(xw.x) * w[0]; acc[1] += bfhi(xw.x) * w[1]; acc[2] += bflo(xw.y) * w[2]; acc[3] += bfhi(xw.y) * w[3]; } }
        *(f32x4*)(XC + t * 128 + cq) = acc; }
    __syncthreads();
    const int jj = tid & 127, q = tid >> 7;
    float R[32], I[32];
#pragma unroll
    for (int tt = 0; tt < 32; ++tt) { R[tt] = 0.f; I[tt] = 0.f; }
#pragma unroll 1
    for (int i = 0; i < 128; i += 4) {
        float wr4[4], wi4[4];
#pragma unroll
        for (int ii = 0; ii < 4; ++ii) { wr4[ii] = w_r[(size_t)(i + ii) * 128 + jj]; wi4[ii] = w_i[(size_t)(i + ii) * 128 + jj]; }
#pragma unroll
        for (int tt = 0; tt < 32; ++tt) { const f32x4 x = *(const f32x4*)(XC + (32 * q + tt) * 128 + i);
#pragma unroll
            for (int ii = 0; ii < 4; ++ii) { R[tt] += x[ii] * wr4[ii]; I[tt] += x[ii] * wi4[ii]; } }
    }
    __syncthreads();
    const int c = c0 + jj;
    const float el = fexp(-lam[c]); const float sp = el * (1.0f - el * (0.5f - el * (0.33333333f - el * 0.25f))), br = b_r[jj], bi = b_i[jj];
    float h = 0.f, A = 1.f;
#pragma unroll
    for (int tt = 0; tt < 32; ++tt) { const int t = 32 * q + tt;
        const float r = sigmoid_acc(R[tt] + br), ig = sigmoid_acc(I[tt] + bi), la = -8.0f * r * sp, aa = fexp(la), mult = __builtin_amdgcn_sqrtf(fmaxf(1.0f - fexp(2.0f * la), 0.f));
        const float bx = mult * ig * XC[t * 128 + jj];
        h = aa * h + bx; A *= aa; XC[t * 128 + jj] = h; AA[t * 128 + jj] = A; }
    QS[(q * 128 + jj) * 2] = A; QS[(q * 128 + jj) * 2 + 1] = h;
    __syncthreads();
    if (!final_pass) {
        if (q == 3) { float At = 1.f, ht = 0.f;
#pragma unroll
            for (int qq = 0; qq < 4; ++qq) { const float Aq = QS[(qq * 128 + jj) * 2], hq = QS[(qq * 128 + jj) * 2 + 1]; ht = Aq * ht + hq; At *= Aq; }
            float* sp2 = LRUSUM + (((size_t)b * 32 + tile) * 2048 + c) * 2; sp2[0] = At; sp2[1] = ht; }
    } else {
        float carry = 0.f;
        for (int tl = 0; tl < tile; ++tl) { const float* sp2 = LRUSUM + (((size_t)b * 32 + tl) * 2048 + c) * 2; carry = sp2[0] * carry + sp2[1]; }
        for (int qq = 0; qq < q; ++qq) carry = QS[(qq * 128 + jj) * 2] * carry + QS[(qq * 128 + jj) * 2 + 1];
#pragma unroll 4
        for (int tt = 0; tt < 32; ++tt) { const int t = 32 * q + tt; const float hv = XC[t * 128 + jj] + AA[t * 128 + jj] * carry;
            const float ga = bf2f(PROJ[(row0 + t) * PROJ_LD + COL_GA + c]);
            bf16* yp = YCAT + (row0 + t) * 4096 + c; const float yv = hv * ga;
            if (!check) *yp = (bf16)f2bf(yv); else if (!(fabsf(bf2f(*yp) - yv) <= 1e-4f + 0.03f * fabsf(ga) + 0.03f * fabsf(yv))) atomicOr((unsigned*)(KWS + WS_CTL) + 8, 4u); }
    }
}

typedef short s_bf16x8 __attribute__((ext_vector_type(8)));
__device__ __forceinline__ void lru_raw_dma(const kargp_t kp, int it, unsigned char* lds, int wave, int lane) {
    const bf16* PROJ = (const bf16*)(KWS + WS_PROJ); const int b = it >> 9, t0 = ((it >> 4) & 31) * 128, c0 = (it & 15) * 128;
#pragma unroll 1
    for (int q = wave; q < 33; q += 8) { const int row = q * 4 + (lane >> 4), tt = t0 - 3 + row;
        __builtin_amdgcn_global_load_lds((const unsigned*)(PROJ + ((size_t)b * SEQ + (tt >= 0 ? tt : 0)) * PROJ_LD + c0 + (lane & 15) * 8), (LAS unsigned*)(lds + 98304 + q * 1024), 16, 0, 0); }
}
__device__ __forceinline__ void lru_tile_mfma(const kargp_t kp, int j, int it, int it_next, bool first, bool final_pass, bool stream, unsigned char* lds, int wave) {
    const bool gates = final_pass || stream;
    const int b = it >> 9, tile = (it >> 4) & 31, g = it & 15;
    const int tid = make_tid(wave), lane = tid & 63, fr = lane & 15, q4 = lane >> 4, wid = tid >> 6;
    float* XF = (float*)lds; unsigned char* XB = lds + 65536; const unsigned char* RAW = lds + 98304;
    const bf16* PROJ = (const bf16*)(KWS + WS_PROJ); float* LRUSUM = (float*)(KWS + WS_LRUSUM); bf16* YCAT = (bf16*)(KWS + WS_YCAT);
    const float* conv_w = KIN(5) + (size_t)j * 4 * 2048; const float* conv_b = KIN(6) + (size_t)j * 2048;
    const int t0 = tile * 128, c0 = g * 128; const size_t row0 = (size_t)b * SEQ + t0;
    if (first) { __syncthreads(); lru_raw_dma(kp, it, lds, wave, lane); }
    asm volatile("s_waitcnt vmcnt(0)" ::: "memory"); __syncthreads();
    const int jl = 16 * wid + fr, c = c0 + jl;
    const bf16* wtr = (const bf16*)(KWS + WS_WSMALL) + ((size_t)(j * 16 + g) * 128 + jl) * 128 + 8 * q4; const bf16* wti = wtr + (size_t)2 * 16 * 128 * 128;
    s_bf16x8 wr[4], wi[4];
#pragma unroll
    for (int ks = 0; ks < 4; ++ks) { wr[ks] = *(const s_bf16x8*)(wtr + ks * 32); wi[ks] = *(const s_bf16x8*)(wti + ks * 32); }
    const float el = fexp(-KIN(11)[(size_t)j * 2048 + c]); const float sp8 = -8.0f * 1.4426950408889634f * (el * (1.0f - el * (0.5f - el * (0.33333333f - el * 0.25f))));
    const float br = KIN(8)[(size_t)(j * 16 + g) * 128 + jl], bi = KIN(10)[(size_t)(j * 16 + g) * 128 + jl];
    v4u gav[4];
    if (gates) {
#pragma unroll
        for (int i = 0; i < 4; ++i) { const int e = tid + NTHR * i, t = e >> 4, ch = e & 15; gav[i] = *(const v4u*)(PROJ + (row0 + t) * PROJ_LD + COL_GA + c0 + ch * 8); } }
    {
        const int tb = tid >> 5, cq = (tid & 31) * 4; const f32x4 bias = *(const f32x4*)(conv_b + c0 + cq);
        f32x4 cw[4];
#pragma unroll
        for (int k = 0; k < 4; ++k) cw[k] = *(const f32x4*)(conv_w + (size_t)k * 2048 + c0 + cq);
        v2u xw[8][4];
#pragma unroll
        for (int i = 0; i < 8; ++i)
#pragma unroll
            for (int k = 0; k < 4; ++k) xw[i][k] = *(const v2u*)(RAW + (tb + 16 * i + k) * 256 + cq * 2);
#pragma unroll
        for (int i = 0; i < 8; ++i) { const int t = tb + 16 * i; f32x4 acc = bias;
#pragma unroll
            for (int k = 0; k < 4; ++k) { const float on = (t0 + t + k - 3) >= 0 ? 1.f : 0.f; const f32x4 w = cw[k] * on;
                acc[0] += bflo(xw[i][k].x) * w[0]; acc[1] += bfhi(xw[i][k].x) * w[1]; acc[2] += bflo(xw[i][k].y) * w[2]; acc[3] += bfhi(xw[i][k].y) * w[3]; }
            *(f32x4*)(XF + t * 128 + (cq ^ (((t >> 2) & 3) << 4))) = acc;
            *(v2u*)(XB + t * 256 + ((cq * 2) ^ ((t & 15) << 4))) = (v2u){pk2(acc[0], acc[1]), pk2(acc[2], acc[3])}; }
    }
    __syncthreads();
    if (it_next < 1024) lru_raw_dma(kp, it_next, lds, wave, lane);
    typedef float f32x2_ __attribute__((ext_vector_type(2))); f32x2_ sm[31];
    if (final_pass) {
#pragma unroll
        for (int tl = 0; tl < 31; ++tl) sm[tl] = *(const f32x2_*)(LRUSUM + (((size_t)b * 32 + tl) * 2048 + c) * 2); }
    f32x4 aR[8], aI[8];
#pragma unroll
    for (int m = 0; m < 8; ++m) { aR[m] = (f32x4){0.f, 0.f, 0.f, 0.f}; aI[m] = aR[m]; }
#pragma unroll
    for (int m = 0; m < 8; ++m)
#pragma unroll
        for (int ks = 0; ks < 4; ++ks) { const s_bf16x8 a = *(const s_bf16x8*)(XB + (16 * m + fr) * 256 + (((ks * 32 + 8 * q4) * 2) ^ (fr << 4)));
            aR[m] = __builtin_amdgcn_mfma_f32_16x16x32_bf16(a, wr[ks], aR[m], 0, 0, 0); aI[m] = __builtin_amdgcn_mfma_f32_16x16x32_bf16(a, wi[ks], aI[m], 0, 0, 0); }
    if (gates) { __syncthreads();
#pragma unroll
        for (int i = 0; i < 4; ++i) { const int e = tid + NTHR * i, t = e >> 4, ch = e & 15; *(v4u*)(XB + t * 256 + ((ch * 16) ^ (((t >> 2) & 3) << 5))) = gav[i]; }
        __syncthreads(); }
    float carry = 0.f, Atot = 1.f;
    if (final_pass) {
#pragma unroll
        for (int tl = 0; tl < 31; ++tl) carry = (tl < tile) ? sm[tl][0] * carry + sm[tl][1] : carry; }
    unsigned short gq[8][4];
    if (gates) {
#pragma unroll
        for (int m = 0; m < 8; ++m)
#pragma unroll
            for (int r = 0; r < 4; ++r) gq[m][r] = *(const unsigned short*)(XB + (16 * m + 4 * q4 + r) * 256 + ((jl * 2) ^ (q4 << 5))); }
#pragma unroll
    for (int m = 0; m < 8; ++m) {
        float hl[4], Al[4]; float h = 0.f, A = 1.f;
#pragma unroll
        for (int r = 0; r < 4; ++r) { const int t = 16 * m + 4 * q4 + r; const float x = XF[t * 128 + (jl ^ (q4 << 4))];
            const float rg = frcp(1.0f + fexp(-(aR[m][r] + br))), ig = frcp(1.0f + fexp(-(aI[m][r] + bi)));
            const float la2 = rg * sp8, aa = __builtin_amdgcn_exp2f(la2), mult = __builtin_amdgcn_sqrtf(fmaxf(1.0f - aa * aa, 0.f));
            h = aa * h + mult * ig * x; A *= aa; hl[r] = h; Al[r] = A; }
        float cin = carry, cq = carry, Ain = Atot;
        float Arow[4], hrow[4];
        {   const auto sA = __builtin_amdgcn_permlane16_swap(__float_as_uint(A), __float_as_uint(A), false, false); const auto sH = __builtin_amdgcn_permlane16_swap(__float_as_uint(h), __float_as_uint(h), false, false);
            const auto a02 = __builtin_amdgcn_permlane32_swap(sA[0], sA[0], false, false), a13 = __builtin_amdgcn_permlane32_swap(sA[1], sA[1], false, false);
            const auto h02 = __builtin_amdgcn_permlane32_swap(sH[0], sH[0], false, false), h13 = __builtin_amdgcn_permlane32_swap(sH[1], sH[1], false, false);
            Arow[0] = __uint_as_float(a02[0]); Arow[2] = __uint_as_float(a02[1]); Arow[1] = __uint_as_float(a13[0]); Arow[3] = __uint_as_float(a13[1]);
            hrow[0] = __uint_as_float(h02[0]); hrow[2] = __uint_as_float(h02[1]); hrow[1] = __uint_as_float(h13[0]); hrow[3] = __uint_as_float(h13[1]); }
#pragma unroll
        for (int qq = 0; qq < 4; ++qq) { const float Aq = Arow[qq], hq = hrow[qq];
            if (qq == q4) { cin = cq; Ain = Atot; }
            cq = Aq * cq + hq; Atot *= Aq; }
        carry = cq;
        if (final_pass) {
#pragma unroll
            for (int r = 0; r < 4; ++r) { const int t = 16 * m + 4 * q4 + r; const float hv = hl[r] + Al[r] * cin;
                bf16* gp = (bf16*)(XB + t * 256 + ((jl * 2) ^ (q4 << 5))); *gp = (bf16)f2bf(hv * bf2f(gq[m][r])); } }
        if (stream) {
#pragma unroll
            for (int r = 0; r < 4; ++r) { const int t = 16 * m + 4 * q4 + r; const float sg = bf2f(gq[m][r]); const float hv = hl[r] + Al[r] * cin, ac = Al[r] * Ain;
                *(bf16*)(XB + t * 256 + ((jl * 2) ^ (q4 << 5))) = (bf16)f2bf(hv * sg);
                *(unsigned*)(XF + t * 128 + (jl ^ (q4 << 4))) = (unsigned)f2bf(ac * sg); } }
    }
    if (gates) { __syncthreads();
        bf16* dstb = stream ? (bf16*)(KWS + WS_AN) + row0 * 2048 + c0 : YCAT + row0 * 4096 + c0; const int dld = stream ? 2048 : 4096;
#pragma unroll
        for (int i = 0; i < 4; ++i) { const int e = tid + NTHR * i, t = e >> 4, ch = e & 15; *(v4u*)(dstb + (size_t)t * dld + ch * 8) = *(const v4u*)(XB + t * 256 + ((ch * 16) ^ (((t >> 2) & 3) << 5))); } }
    if (stream) { bf16* WB = (bf16*)KOUT + (size_t)M * DM;
#pragma unroll
        for (int i = 0; i < 4; ++i) { const int e = tid + NTHR * i, t = e >> 4, ch = e & 15; const int xc_ = (ch * 8) ^ (((t >> 2) & 3) << 4); const v4u a = *(const v4u*)(XF + t * 128 + xc_), b2 = *(const v4u*)(XF + t * 128 + xc_ + 4);
            *(v4u*)(WB + (row0 + t) * 2048 + c0 + ch * 8) = (v4u){(a.x & 0xffffu) | (a.y << 16), (a.z & 0xffffu) | (a.w << 16), (b2.x & 0xffffu) | (b2.y << 16), (b2.z & 0xffffu) | (b2.w << 16)}; } }
    if (!final_pass && q4 == 0) { float* s2 = LRUSUM + (((size_t)b * 32 + tile) * 2048 + c) * 2; s2[0] = Atot; s2[1] = carry; }
}
__device__ __forceinline__ void lru_carry4(const kargp_t kp, int it0, int Gs, float* CL, int wave) {
    const int tid = make_tid(wave), k = tid >> 7, ch = tid & 127, it = it0 + k * Gs;
    if (it < 1024) { const int b = it >> 9, tile = (it >> 4) & 31, c = (it & 15) * 128 + ch; const float* LRUSUM = (const float*)(KWS + WS_LRUSUM);
        typedef float f32x2_ __attribute__((ext_vector_type(2))); f32x2_ sm[31]; float carry = 0.f;
#pragma unroll
        for (int tl = 0; tl < 31; ++tl) sm[tl] = *(const f32x2_*)(LRUSUM + (((size_t)b * 32 + tl) * 2048 + c) * 2);
#pragma unroll
        for (int tl = 0; tl < 31; ++tl) carry = (tl < tile) ? sm[tl][0] * carry + sm[tl][1] : carry;
        CL[tid] = carry; }
}
__device__ __forceinline__ void lru_apply_item(const kargp_t kp, int it, const float* CL, int wave) {
    const int b = it >> 9, tile = (it >> 4) & 31, g = it & 15; const int tid = make_tid(wave);
    bf16* YCAT = (bf16*)(KWS + WS_YCAT); const bf16* WB = (const bf16*)KOUT + (size_t)M * DM; const bf16* UB = (const bf16*)(KWS + WS_AN);
    const int t0 = tile * 128, c0 = g * 128; const size_t row0 = (size_t)b * SEQ + t0;
    v4u uw[4], ww[4];
#pragma unroll
    for (int i = 0; i < 4; ++i) { const int e = tid + NTHR * i, t = e >> 4, ch = e & 15; uw[i] = *(const v4u*)(UB + (row0 + t) * 2048 + c0 + ch * 8); ww[i] = *(const v4u*)(WB + (row0 + t) * 2048 + c0 + ch * 8); }
#pragma unroll
    for (int i = 0; i < 4; ++i) { const int e = tid + NTHR * i, t = e >> 4, ch = e & 15; const f32x4 c0v = *(const f32x4*)(CL + ch * 8), c1v = *(const f32x4*)(CL + ch * 8 + 4);
        const v4u u = uw[i], w = ww[i]; v4u o;
        o.x = pk2(bflo(u.x) + bflo(w.x) * c0v[0], bfhi(u.x) + bfhi(w.x) * c0v[1]); o.y = pk2(bflo(u.y) + bflo(w.y) * c0v[2], bfhi(u.y) + bfhi(w.y) * c0v[3]);
        o.z = pk2(bflo(u.z) + bflo(w.z) * c1v[0], bfhi(u.z) + bfhi(w.z) * c1v[1]); o.w = pk2(bflo(u.w) + bflo(w.w) * c1v[2], bfhi(u.w) + bfhi(w.w) * c1v[3]);
        *(v4u*)(YCAT + (row0 + t) * 4096 + c0 + ch * 8) = o; }
}

__device__ __forceinline__ void knorm_item(const kargp_t kp, int j, int it, int wave, int lane) {
    const bf16* PROJ = (const bf16*)(KWS + WS_PROJ); bf16* KN = (bf16*)(KWS + WS_KN); const float* kg = KIN(13) + (size_t)j * 128;
    const float g0 = kg[lane * 2], g1 = kg[lane * 2 + 1];
    unsigned w[8];
#pragma unroll
    for (int p = 0; p < 8; ++p) { const int pr = it * 64 + wave * 8 + p, row = pr >> 2, g = pr & 3; w[p] = *(const unsigned*)(PROJ + (size_t)row * PROJ_LD + COL_K + g * 128 + lane * 2); }
    asm volatile("" ::: "memory");
#pragma unroll
    for (int p = 0; p < 8; ++p) { const int pr = it * 64 + wave * 8 + p, row = pr >> 2, g = pr & 3;
        const float x0 = bflo(w[p]), x1 = bfhi(w[p]); const float ss = wave_sum(x0 * x0 + x1 * x1, lane);
        const float rstd = frsq(ss * (1.0f / 128.0f) + 1e-6f);
        *(unsigned*)(KN + (size_t)row * 512 + g * 128 + lane * 2) = pk2(x0 * rstd * g0, x1 * rstd * g1); }
}

__device__ __forceinline__ void score_item(const kargp_t kp, int b, int c, int kt, unsigned char* lds, int wave, bool check = false) {
    const int tid = make_tid(wave); const float* IDX = (const float*)(KWS + WS_IDX); float* SC = (float*)(KWS + WS_SC);
    float* IQs = (float*)lds; float* IKs = (float*)(lds + 32768);
    const int q = tid & 63, kg = tid >> 6; const size_t qrow0 = (size_t)b * SEQ + c * 64, krow0 = (size_t)b * SEQ + kt * 64;
    __syncthreads();
    for (int e = tid; e < 4096; e += NTHR) { const int k = e >> 6, d = e & 63; IKs[k * 65 + d] = IDX[(krow0 + k) * IDX_LD + 1024 + d]; }
    float acc[8];
#pragma unroll
    for (int kk = 0; kk < 8; ++kk) acc[kk] = 0.f;
#pragma unroll 1
    for (int h = 0; h < 16; ++h) {
        __syncthreads();
        for (int e = tid; e < 4096; e += NTHR) { const int qq = e >> 6, d = e & 63; IQs[qq * 65 + d] = IDX[(qrow0 + qq) * IDX_LD + h * 64 + d]; }
        __syncthreads();
        const float w = IDX[(qrow0 + q) * IDX_LD + 1088 + h];
        float qv[64];
#pragma unroll
        for (int d = 0; d < 64; ++d) qv[d] = IQs[q * 65 + d];
#pragma unroll
        for (int kk = 0; kk < 8; ++kk) { const float* kr = IKs + (kg * 8 + kk) * 65; float dot = 0.f;
#pragma unroll
            for (int d = 0; d < 64; ++d) dot += qv[d] * kr[d];
            acc[kk] += w * fmaxf(dot, 0.f); }
    }
    float* dst = SC + sc_off(b, c * 64 + q) + kt * 64 + kg * 8;
#pragma unroll
    for (int kk = 0; kk < 8; ++kk) { if (!check) dst[kk] = acc[kk]; else if (!(fabsf(dst[kk] - acc[kk]) <= 1.0f + 0.02f * fabsf(acc[kk]))) atomicOr((unsigned*)(KWS + WS_CTL) + 8, 1u); }
}

__device__ __forceinline__ void score_wave_unit(const kargp_t kp, int b, int c, int qg, int ks, int lane, unsigned char* lds, int wave) {
    const bf16* IDXB = (const bf16*)(KWS + WS_IDXB); const float* IDX = (const float*)(KWS + WS_IDX); float* SC = (float*)(KWS + WS_SC);
    const int fr = lane & 15, fq = lane >> 4; const size_t qrow = (size_t)b * SEQ + c * 64 + qg * 16 + fr;
    s_bf16x8 bq[16][2];
#pragma unroll
    for (int h = 0; h < 16; ++h)
#pragma unroll
        for (int s = 0; s < 2; ++s) bq[h][s] = *(const s_bf16x8*)(IDXB + qrow * IDX_LD + h * 64 + s * 32 + 8 * fq);
    float w[16];
#pragma unroll
    for (int h4 = 0; h4 < 4; ++h4) { const f32x4 t = *(const f32x4*)(IDX + qrow * IDX_LD + 1088 + 4 * h4); w[4 * h4] = t[0]; w[4 * h4 + 1] = t[1]; w[4 * h4 + 2] = t[2]; w[4 * h4 + 3] = t[3]; }
    float* dst = SC + sc_off(b, c * 64 + qg * 16 + fr) + fq * 4;
    const int ntile = 4 * (c + 1);
    const bf16* kbase = IDXB + ((size_t)b * SEQ + fr) * IDX_LD + 1024 + 8 * fq;
    unsigned char* ring = lds + wave * 8192;
#define SC_DMA(S, KT) do { const int kn_ = (KT) < ntile ? (KT) : ks; const bf16* src_ = kbase + (size_t)kn_ * 16 * IDX_LD; \
        __builtin_amdgcn_global_load_lds((const unsigned*)src_, (LAS unsigned*)(ring + (S) * 2048), 16, 0, 0); __builtin_amdgcn_global_load_lds((const unsigned*)(src_ + 32), (LAS unsigned*)(ring + (S) * 2048 + 1024), 16, 0, 0); } while (0)
#define SC_TILE(S, KT, NW) do { if ((KT) < ntile) { asm volatile("s_waitcnt vmcnt(" #NW ")" ::: "memory"); \
        const s_bf16x8 a0 = *(const LAS s_bf16x8*)((LAS unsigned char*)ring + (S) * 2048 + lane * 16), a1 = *(const LAS s_bf16x8*)((LAS unsigned char*)ring + (S) * 2048 + 1024 + lane * 16); \
        asm volatile("s_waitcnt lgkmcnt(0)" ::: "memory"); SC_DMA(S, (KT) + 32); f32x4 sc = {0.f, 0.f, 0.f, 0.f}; \
        _Pragma("unroll") for (int h = 0; h < 16; ++h) { f32x4 acc = {0.f, 0.f, 0.f, 0.f}; \
            acc = __builtin_amdgcn_mfma_f32_16x16x32_bf16(a0, bq[h][0], acc, 0, 0, 0); acc = __builtin_amdgcn_mfma_f32_16x16x32_bf16(a1, bq[h][1], acc, 0, 0, 0); \
            _Pragma("unroll") for (int r = 0; r < 4; ++r) { const int ri_ = __float_as_int(acc[r]); sc[r] += w[h] * __int_as_float(ri_ > 0 ? ri_ : 0); } } \
        *(f32x4*)(dst + (KT) * 16) = sc; asm volatile("" ::: "memory"); } } while (0)
    SC_DMA(0, ks); SC_DMA(1, ks + 8); SC_DMA(2, ks + 16); SC_DMA(3, ks + 24);
    asm volatile("s_waitcnt vmcnt(0)" ::: "memory");
#pragma unroll 1
    for (int kt = ks; kt < ntile; kt += 32) { SC_TILE(0, kt, 10); SC_TILE(1, kt + 8, 10); SC_TILE(2, kt + 16, 10); SC_TILE(3, kt + 24, 10); }
#undef SC_DMA
#undef SC_TILE
}

template <int NV> __device__ __forceinline__ void select_query_nv(const kargp_t kp, int qi, int lane) {
    const float* SC = (const float*)(KWS + WS_SC); unsigned* BMr = (unsigned*)(KWS + WS_BM) + (size_t)qi * 128;
    const int b = qi >> 12, t = qi & 4095, nv = (t >> 6) + 1;
    const float* row = SC + sc_off(b, t);
    unsigned key[NV];
#pragma unroll
    for (int v = 0; v < NV; ++v) { unsigned k = 0u;
        if (v < nv) { const float s = row[v * 64 + lane] + 0.0f; const unsigned u = __float_as_uint(s); k = (u & 0x80000000u) ? ~u : (u | 0x80000000u); }
        key[v] = k; }
    unsigned tau = 0u; int ctau = 64 * nv;
    bool done = false;
#ifndef SELECT_NO_PK16
    {
        typedef unsigned short us2 __attribute__((ext_vector_type(2)));
        us2 hp[NV / 2];
#pragma unroll
        for (int v = 0; v < NV / 2; ++v) { const unsigned w_ = (key[2 * v] >> 16) | (key[2 * v + 1] & 0xffff0000u); hp[v] = __builtin_bit_cast(us2, w_); }
        for (int bit = 31; bit >= 16; --bit) {
            const unsigned cand = tau | (1u << bit); const unsigned short c1 = (unsigned short)((cand >> 16) - 1u); const us2 c2 = {c1, c1}; const us2 one2 = {1, 1}; us2 acc = {0, 0};
#pragma unroll
            for (int v = 0; v < NV / 2; ++v) { unsigned d_; asm("v_pk_sub_u16 %0, %1, %2 clamp\n\tv_pk_min_u16 %0, %0, %3" : "=&v"(d_) : "v"(__builtin_bit_cast(unsigned, hp[v])), "v"(__builtin_bit_cast(unsigned, c2)), "v"(__builtin_bit_cast(unsigned, one2)));
                acc += __builtin_bit_cast(us2, d_); }
            int cnt = (int)acc[0] + (int)acc[1];
            cnt = wave_sum_i(cnt, lane);
            if (cnt >= TOPK) { tau = cand; ctau = cnt; }
            if (cnt == TOPK) { done = true; break; }
        }
    }
    for (int bit = 15; bit >= 0 && !done; --bit) {
#else
    for (int bit = 31; bit >= 0; --bit) {
#endif
        const unsigned cand = tau | (1u << bit); int cnt = 0;
#pragma unroll
        for (int v = 0; v < NV; ++v) cnt += (key[v] >= cand) ? 1 : 0;
        cnt = wave_sum_i(cnt, lane);
        if (cnt >= TOPK) { tau = cand; ctau = cnt; }
        if (cnt == TOPK) break;
    }
    unsigned mylo = 0u, myhi = 0u;
    if (ctau == TOPK) {
#pragma unroll
        for (int v = 0; v < NV; ++v) {
            const unsigned long long sm = __ballot(key[v] >= tau);
            { const unsigned slo = (unsigned)sm, shi = (unsigned)(sm >> 32); asm volatile("s_nop 1\n\tv_writelane_b32 %0, %2, %4\n\tv_writelane_b32 %1, %3, %4" : "+v"(mylo), "+v"(myhi) : "s"(slo), "s"(shi), "i"(v)); }
            __builtin_amdgcn_sched_barrier(0);
        }
    } else {
        int ngt = 0;
#pragma unroll
        for (int v = 0; v < NV; ++v) ngt += __popcll(__ballot(key[v] > tau));
        int need = TOPK - ngt;
#pragma unroll
        for (int v = 0; v < NV; ++v) {
            const bool eq = key[v] == tau; const unsigned long long em = __ballot(eq);
            const int below = __builtin_amdgcn_mbcnt_hi((unsigned)(em >> 32), __builtin_amdgcn_mbcnt_lo((unsigned)em, 0u));
            const bool sel = (key[v] > tau) || (eq && below < need);
            need -= __popcll(em); if (need < 0) need = 0;
            const unsigned long long sm = __ballot(sel);
            { const unsigned slo = (unsigned)sm, shi = (unsigned)(sm >> 32); asm volatile("s_nop 1\n\tv_writelane_b32 %0, %2, %4\n\tv_writelane_b32 %1, %3, %4" : "+v"(mylo), "+v"(myhi) : "s"(slo), "s"(shi), "i"(v)); }
            __builtin_amdgcn_sched_barrier(0);
        }
    }
    *(v2u*)(BMr + 2 * lane) = (v2u){mylo, myhi};
}

__device__ __forceinline__ void select_query(const kargp_t kp, int qi, int lane) {
    const int nv = ((qi & 4095) >> 6) + 1;
    if (nv <= 4) { unsigned* BMr = (unsigned*)(KWS + WS_BM) + (size_t)qi * 128; const unsigned w0 = (lane < nv) ? 0xffffffffu : 0u; *(v2u*)(BMr + 2 * lane) = (v2u){w0, w0}; }
#ifndef SELECT_NV64_ONLY
    else if (nv <= 16) select_query_nv<16>(kp, qi, lane);
    else if (nv <= 32) select_query_nv<32>(kp, qi, lane);
    else if (nv <= 48) select_query_nv<48>(kp, qi, lane);
#endif
    else select_query_nv<64>(kp, qi, lane);
}

__device__ __forceinline__ float rel_bias_at(const kargp_t kp, int rel, int h) {
    const int n = rel < 0 ? -rel : rel; int bk = n;
    if (n >= 8) { bk = 8;
#pragma unroll
        for (int k = 1; k < 8; ++k) bk += (n >= KTHR(k)) ? 1 : 0; }
    bk += (rel > 0 ? 16 : 0);
    return KIN(3)[bk * 16 + h];
}

__device__ __forceinline__ void attn_query(const kargp_t kp, int j, int qi, unsigned char* lds, int wave, bool check = false) {
    const int tid = make_tid(wave), b = qi >> 12, t = qi & 4095, limit = ((t >> 6) + 1) * 64;
    const bf16* PROJ = (const bf16*)(KWS + WS_PROJ); const bf16* KN = (const bf16*)(KWS + WS_KN); const unsigned* BM = (const unsigned*)(KWS + WS_BM); bf16* YCAT = (bf16*)(KWS + WS_YCAT);
    int* sel = (int*)lds; int* wcnt = (int*)(lds + 1024); int* nselp = (int*)(lds + 1536); float* qs = (float*)(lds + 2048); float* lg = (float*)(lds + 10240);
    __syncthreads();
    unsigned wbits = 0u;
    if (tid < 128) { wbits = BM[(size_t)qi * 128 + tid]; if (tid * 32 >= limit) wbits = 0u; wcnt[tid] = __popc(wbits); }
    {
        const int h = tid >> 5, d = (tid & 31) * 4; const v2u qw = *(const v2u*)(PROJ + (size_t)qi * PROJ_LD + COL_Q + h * 128 + d);
        const float x0 = bflo(qw.x), x1 = bfhi(qw.x), x2 = bflo(qw.y), x3 = bfhi(qw.y); float ss = x0 * x0 + x1 * x1 + x2 * x2 + x3 * x3;
#pragma unroll
        for (int o = 1; o < 32; o <<= 1) ss += shx(ss, o, tid & 63);
        const float rstd = frsq(ss * (1.0f / 128.0f) + 1e-6f) * 0.08838834764831845f; const float* qg = KIN(12) + (size_t)j * 128 + d;
        qs[h * 128 + d] = x0 * rstd * qg[0]; qs[h * 128 + d + 1] = x1 * rstd * qg[1]; qs[h * 128 + d + 2] = x2 * rstd * qg[2]; qs[h * 128 + d + 3] = x3 * rstd * qg[3]; }
    __syncthreads();
    if (tid < 128) { int off = 0; for (int i = 0; i < tid; ++i) off += wcnt[i];
        unsigned w = wbits; while (w) { const int bp = __ffs(w) - 1; w &= w - 1; if (off < 256) sel[off] = tid * 32 + bp; ++off; }
        if (tid == 127) *nselp = off < 256 ? off : 256; }
    __syncthreads();
    const int n = *nselp;
    {
        const int k = tid & 255, hh = tid >> 8;
        if (k < n) { const int s = sel[k]; const bf16* krow = KN + ((size_t)b * SEQ + s) * 512;
#pragma unroll 1
            for (int gg = 0; gg < 2; ++gg) { const int g = hh * 2 + gg; float acc[4] = {0.f, 0.f, 0.f, 0.f};
#pragma unroll 1
                for (int d0 = 0; d0 < 128; d0 += 8) { const v4u kw = *(const v4u*)(krow + g * 128 + d0);
                    float kv[8] = {bflo(kw.x), bfhi(kw.x), bflo(kw.y), bfhi(kw.y), bflo(kw.z), bfhi(kw.z), bflo(kw.w), bfhi(kw.w)};
#pragma unroll
                    for (int r = 0; r < 4; ++r) { const float* qp = qs + (g * 4 + r) * 128 + d0;
#pragma unroll
                        for (int i = 0; i < 8; ++i) acc[r] += qp[i] * kv[i]; } }
#pragma unroll
                for (int r = 0; r < 4; ++r) { const int h = g * 4 + r; lg[h * 256 + k] = acc[r] + rel_bias_at(kp, s - t, h); } }
        } else {
#pragma unroll
            for (int r = 0; r < 8; ++r) lg[(hh * 8 + r) * 256 + k] = -INFINITY; }
    }
    __syncthreads();
    {
        const int h = tid >> 5, l32 = tid & 31; float v[8]; float mx = -INFINITY;
#pragma unroll
        for (int i = 0; i < 8; ++i) { v[i] = lg[h * 256 + l32 + 32 * i]; mx = fmaxf(mx, v[i]); }
#pragma unroll
        for (int o = 1; o < 32; o <<= 1) mx = fmaxf(mx, shx(mx, o, tid & 63));
        float sm = 0.f;
#pragma unroll
        for (int i = 0; i < 8; ++i) { v[i] = fexp(v[i] - mx); sm += v[i]; }
#pragma unroll
        for (int o = 1; o < 32; o <<= 1) sm += shx(sm, o, tid & 63);
        const float inv = frcp(sm);
#pragma unroll
        for (int i = 0; i < 8; ++i) lg[h * 256 + l32 + 32 * i] = v[i] * inv; }
    __syncthreads();
    {
        const int d = tid & 127, g = tid >> 7; float o[4] = {0.f, 0.f, 0.f, 0.f};
#pragma unroll 2
        for (int k = 0; k < n; ++k) { const int s = sel[k]; const float v = bf2f(PROJ[((size_t)b * SEQ + s) * PROJ_LD + COL_V + g * 128 + d]);
#pragma unroll
            for (int r = 0; r < 4; ++r) o[r] += lg[(g * 4 + r) * 256 + k] * v; }
#pragma unroll
        for (int r = 0; r < 4; ++r) { const int h = g * 4 + r; const float gbv = bf2f(PROJ[(size_t)qi * PROJ_LD + COL_GB + h * 128 + d]);
            bf16* yp = YCAT + (size_t)qi * 4096 + 2048 + h * 128 + d; const float yv = o[r] * gbv;
            if (!check) *yp = (bf16)f2bf(yv); else if (!(fabsf(bf2f(*yp) - yv) <= 1e-4f + 0.012f * fabsf(gbv) + 0.03f * fabsf(yv))) atomicOr((unsigned*)(KWS + WS_CTL) + 8, 2u); } }
}

__device__ __forceinline__ void sgu_item(const kargp_t kp, int j, int b, int ch, int g, unsigned char* lds, int wave) {
    const int tid = make_tid(wave); float* V = (float*)lds; float* MU = (float*)(lds + 65536); float* RS = MU + 128;
    const bf16* PROJ = (const bf16*)(KWS + WS_PROJ); const float* SLN = (const float*)(KWS + WS_STATLN); bf16* Y = (bf16*)(KWS + WS_YCAT);
    const float* lng = KIN(16) + (size_t)j * 2048, *lnb = KIN(17) + (size_t)j * 2048; const float* ws = KIN(18) + ((size_t)j * 16 + g) * 16384; const float* bs = KIN(19) + ((size_t)j * 16 + g) * 128;
    const size_t row0 = (size_t)b * SEQ + ch * 128;
    __syncthreads();
    if (tid < 128) { const float* sp = SLN + (row0 + tid) * 64; float s1 = 0.f, s2 = 0.f;
        for (int i = 0; i < 32; ++i) { s1 += sp[2 * i]; s2 += sp[2 * i + 1]; }
        const float mean = s1 * (1.0f / 2048.0f); const float var = fmaxf(s2 * (1.0f / 2048.0f) - mean * mean, 0.f); MU[tid] = mean; RS[tid] = frsq(var + 1e-6f); }
    __syncthreads();
    for (int e = tid; e < 2048; e += NTHR) { const int s = e >> 4, dq = (e & 15) * 8; const v4u w = *(const v4u*)(PROJ + (row0 + s) * ODD_IN + 2048 + g * 128 + dq);
        const float x[8] = {bflo(w.x), bfhi(w.x), bflo(w.y), bfhi(w.y), bflo(w.z), bfhi(w.z), bflo(w.w), bfhi(w.w)}; const float mu = MU[s], rs = RS[s];
#pragma unroll
        for (int i = 0; i < 8; ++i) { const int c = g * 128 + dq + i; V[s * 128 + dq + i] = (x[i] - mu) * rs * lng[c] + lnb[c]; } }
    __syncthreads();
    const int t = tid >> 2, dseg = (tid & 3) * 32, smax = (t < 64) ? 64 : 128;
    float acc[32];
#pragma unroll
    for (int i = 0; i < 32; ++i) acc[i] = 0.f;
#pragma unroll 2
    for (int s = 0; s < smax; ++s) { const float w = ws[t * 128 + s];
#pragma unroll
        for (int i4 = 0; i4 < 8; ++i4) { const f32x4 v = *(const f32x4*)(V + s * 128 + dseg + i4 * 4);
#pragma unroll
            for (int i = 0; i < 4; ++i) acc[i4 * 4 + i] += w * v[i]; } }
    const float bias = bs[t];
#pragma unroll
    for (int i8 = 0; i8 < 4; ++i8) { const int col = g * 128 + dseg + i8 * 8; const v4u uw = *(const v4u*)(PROJ + (row0 + t) * ODD_IN + col), gw = *(const v4u*)(PROJ + (row0 + t) * ODD_IN + 4096 + col);
        const float uu[8] = {bflo(uw.x), bfhi(uw.x), bflo(uw.y), bfhi(uw.y), bflo(uw.z), bfhi(uw.z), bflo(uw.w), bfhi(uw.w)};
        const float gg[8] = {bflo(gw.x), bfhi(gw.x), bflo(gw.y), bfhi(gw.y), bflo(gw.z), bfhi(gw.z), bflo(gw.w), bfhi(gw.w)};
        float y[8];
#pragma unroll
        for (int i = 0; i < 8; ++i) y[i] = uu[i] * (acc[i8 * 8 + i] + bias) * gg[i];
        v4u o; o.x = pk2(y[0], y[1]); o.y = pk2(y[2], y[3]); o.z = pk2(y[4], y[5]); o.w = pk2(y[6], y[7]);
        *(v4u*)(Y + (row0 + t) * 2048 + col) = o; }
}

namespace att {
using bf16x8 = __attribute__((ext_vector_type(8))) short;
using s16x4  = __attribute__((ext_vector_type(4))) short;
using f32x16 = __attribute__((ext_vector_type(16))) float;
using u32x4  = __attribute__((ext_vector_type(4))) unsigned;
constexpr int D = 128, QBLK = 32, KVBLK = 64;
constexpr int LDKK = 512, LDKV = PROJ_LD;
constexpr float THRL = 11.5f;
#ifndef ATT_SDEPTH
#define ATT_SDEPTH 1
#endif
constexpr int SDEPTH = ATT_SDEPTH;
constexpr int SHM_V = KVBLK * D * 2, SHM_K = KVBLK * D * 2;
constexpr int LDS_WS = 2 * SHM_V + 2 * SHM_K, LDS_LUT = LDS_WS + 8 * 64 * 4, LUT_N = 320, LDS_Q = LDS_LUT + 4 * LUT_N * 4, LDS_MS = LDS_Q + 8 * 8192, LDS_END = LDS_MS + 2048;
#define KSWZ(row, colB) ((row) * 256 + ((colB) ^ (((row) & 7) << 4)))
#define SBAR() __builtin_amdgcn_sched_barrier(0)
__device__ __forceinline__ int crow(int r, int hi) { return (r & 3) + 8 * (r >> 2) + 4 * hi; }
__device__ __forceinline__ unsigned cvtpk(float lo, float hi) { unsigned r; asm volatile("v_cvt_pk_bf16_f32 %0, %1, %2" : "=v"(r) : "v"(lo), "v"(hi)); return r; }
__device__ __forceinline__ float psw_max(float x) { auto rr = __builtin_amdgcn_permlane32_swap(__float_as_uint(x), __float_as_uint(x), false, false); return fmaxf(__uint_as_float(rr[0]), __uint_as_float(rr[1])); }
__device__ __forceinline__ float psw_sum(float x) { auto rr = __builtin_amdgcn_permlane32_swap(__float_as_uint(x), __float_as_uint(x), false, false); return __uint_as_float(rr[0]) + __uint_as_float(rr[1]); }

__device__ __forceinline__ float max3f(float x, float y, float z) { float r; asm("v_max3_f32 %0, %1, %2, %3" : "=v"(r) : "v"(x), "v"(y), "v"(z)); return r; }
template <bool NEAR> __device__ __forceinline__ void maskbias(f32x16& p0, f32x16& p1, unsigned w0, unsigned w1, const float* lutp) {
#pragma unroll
    for (int r = 0; r < 16; ++r) { const int cb = (r & 3) + 8 * (r >> 2);
        float a = p0[r], b = p1[r];
        if (NEAR) { a += lutp[cb]; b += lutp[32 + cb]; }
        const unsigned m0 = (unsigned)(((int)(w0 << (31 - cb))) >> 31), m1 = (unsigned)(((int)(w1 << (31 - cb))) >> 31);
        p0[r] = __uint_as_float((__float_as_uint(a) & m0) | (~m0 & 0xff800000u)); p1[r] = __uint_as_float((__float_as_uint(b) & m1) | (~m1 & 0xff800000u)); }
}
template <int VAR = 0> __device__ __forceinline__ void partialSM(f32x16& p0, f32x16& p1, float& m_reg, float& alpha, float boff) {
    if (VAR == 5) { alpha = 1.f; asm volatile("" : "+v"(p0), "+v"(p1)); return; }
    float pa = max3f(p0[0], p0[1], p0[2]), pb = max3f(p1[0], p1[1], p1[2]);
#pragma unroll
    for (int r = 3; r < 15; r += 2) { pa = max3f(pa, p0[r], p0[r + 1]); pb = max3f(pb, p1[r], p1[r + 1]); }
    float pmax = max3f(pa, pb, p0[15]); pmax = max3f(pmax, p1[15], p1[15]);
    pmax = psw_max(pmax) + boff;
    float mn;
    if (__builtin_expect(__all(pmax - m_reg <= THRL), 1)) { mn = m_reg; alpha = 1.f; }
    else { mn = fmaxf(m_reg, pmax); alpha = __builtin_amdgcn_exp2f(m_reg - mn); m_reg = mn; }
    const float sub = mn - boff;
#pragma unroll
    for (int r = 0; r < 16; ++r) { p0[r] -= sub; p1[r] -= sub; }
#pragma unroll
    for (int r = 0; r < 16; ++r) p0[r] = __builtin_amdgcn_exp2f(p0[r]);
}
template <int VAR = 0> __device__ __forceinline__ void finishSM(f32x16& p0, f32x16& p1, float alpha, float& l_reg, bf16x8& pa0, bf16x8& pa1, bf16x8& pa2, bf16x8& pa3) {
    if (VAR != 5) {
#pragma unroll
    for (int r = 0; r < 16; ++r) p1[r] = __builtin_amdgcn_exp2f(p1[r]);
    float ps = 0.f;
#pragma unroll
    for (int r = 0; r < 16; ++r) ps += p0[r];
#pragma unroll
    for (int r = 0; r < 16; ++r) ps += p1[r];
    ps = psw_sum(ps);
    l_reg = l_reg * alpha + ps; } else l_reg = 1.f;
#define PK4(P, BASE, OUT) do { unsigned a0 = cvtpk(P[BASE + 0], P[BASE + 1]), a1 = cvtpk(P[BASE + 2], P[BASE + 3]);   \
    unsigned b0 = cvtpk(P[BASE + 4], P[BASE + 5]), b1 = cvtpk(P[BASE + 6], P[BASE + 7]);                              \
    auto r0 = __builtin_amdgcn_permlane32_swap(a0, b0, false, false); auto r1 = __builtin_amdgcn_permlane32_swap(a1, b1, false, false); \
    u32x4 w = {r0[0], r1[0], r0[1], r1[1]}; OUT = *reinterpret_cast<bf16x8*>(&w); } while (0)
    PK4(p0, 0, pa0); PK4(p0, 8, pa1); PK4(p1, 0, pa2); PK4(p1, 8, pa3);
#undef PK4
}
__device__ __forceinline__ void qkt(f32x16& p0, f32x16& p1, const char* Ks, const char* qs, int r32, int hi) {
    p0 = f32x16{}; p1 = f32x16{};
#pragma unroll
    for (int d0 = 0; d0 < 8; ++d0) { const int cb = (d0 * 16 + hi * 8) * 2;
        const bf16x8 b0 = *reinterpret_cast<const bf16x8*>(Ks + KSWZ(r32, cb));
        const bf16x8 b1 = *reinterpret_cast<const bf16x8*>(Ks + KSWZ(32 + r32, cb));
        const bf16x8 qf = *reinterpret_cast<const bf16x8*>(qs + d0 * 1024);
        p0 = __builtin_amdgcn_mfma_f32_32x32x16_bf16(b0, qf, p0, 0, 0, 0);
        p1 = __builtin_amdgcn_mfma_f32_32x32x16_bf16(b1, qf, p1, 0, 0, 0); }
}
#define PK4(P, BASE, OUT) do { unsigned a0 = cvtpk(P[BASE + 0], P[BASE + 1]), a1 = cvtpk(P[BASE + 2], P[BASE + 3]);   \
    unsigned b0 = cvtpk(P[BASE + 4], P[BASE + 5]), b1 = cvtpk(P[BASE + 6], P[BASE + 7]);                              \
    auto r0 = __builtin_amdgcn_permlane32_swap(a0, b0, false, false); auto r1 = __builtin_amdgcn_permlane32_swap(a1, b1, false, false); \
    u32x4 w = {r0[0], r1[0], r0[1], r1[1]}; OUT = *reinterpret_cast<bf16x8*>(&w); } while (0)
__device__ __forceinline__ void qkt_fsm(f32x16& p0, f32x16& p1, const char* Ks, const char* qs, int r32, int hi, f32x16& q0, f32x16& q1, float alpha, float& l_reg, bf16x8& pa0, bf16x8& pa1, bf16x8& pa2, bf16x8& pa3) {
    p0 = f32x16{}; p1 = f32x16{};
    bf16x8 fb0[3], fb1[3], fq[3];
#define QK_LD(S, D0) do { const int cb_ = ((D0) * 16 + hi * 8) * 2; fb0[S] = *reinterpret_cast<const bf16x8*>(Ks + KSWZ(r32, cb_)); fb1[S] = *reinterpret_cast<const bf16x8*>(Ks + KSWZ(32 + r32, cb_)); fq[S] = *reinterpret_cast<const bf16x8*>(qs + (D0) * 1024); } while (0)
    SBAR(); QK_LD(0, 0); QK_LD(1, 1);
    float ps = 0.f;
#pragma unroll
    for (int d0 = 0; d0 < 8; ++d0) {
        SBAR();
        if (d0 + 2 < 8) QK_LD((d0 + 2) % 3, d0 + 2);
        p0 = __builtin_amdgcn_mfma_f32_32x32x16_bf16(fb0[d0 % 3], fq[d0 % 3], p0, 0, 0, 0);
        p1 = __builtin_amdgcn_mfma_f32_32x32x16_bf16(fb1[d0 % 3], fq[d0 % 3], p1, 0, 0, 0);
        q1[2 * d0] = __builtin_amdgcn_exp2f(q1[2 * d0]); q1[2 * d0 + 1] = __builtin_amdgcn_exp2f(q1[2 * d0 + 1]);
        ps += (q0[2 * d0] + q0[2 * d0 + 1]) + (q1[2 * d0] + q1[2 * d0 + 1]);
        if (d0 == 1) PK4(q0, 0, pa0);
        if (d0 == 3) PK4(q0, 8, pa1);
        if (d0 == 5) PK4(q1, 0, pa2);
    }
    SBAR();
    PK4(q1, 8, pa3);
    ps = psw_sum(ps); l_reg = l_reg * alpha + ps;
#undef QK_LD
}
#undef PK4
__device__ __forceinline__ int v_st(int k, int c) { const int kk = (k & ~0xC) | ((k & 4) << 1) | ((k & 8) >> 1); return ((kk >> 3) * 4 + (c >> 5)) * 512 + ((kk & 7) * 32 + (c & 31)) * 2; }
__device__ __forceinline__ int v_rd_base(int lane) { return ((lane & 3) << 3) | (((lane >> 2) & 3) << 6) | (((lane >> 4) & 1) << 5) | (((lane >> 5) & 1) << 8); }
constexpr int v_rd_off(int d0, int ks, int half) { return d0 * 512 + ks * 4096 + half * 2048; }
template <int OFF> __device__ __forceinline__ s16x4 tr_read(int vb) { s16x4 r; asm volatile("ds_read_b64_tr_b16 %0, %1 offset:%2" : "=&v"(r) : "v"(vb), "i"(OFF) : "memory"); return r; }
#define PV_PK(L, H) (bf16x8){L[0], L[1], L[2], L[3], H[0], H[1], H[2], H[3]}
#define PV_READ(S, D0) do { S[0] = tr_read<v_rd_off(D0, 0, 0)>(vb); S[1] = tr_read<v_rd_off(D0, 0, 1)>(vb); S[2] = tr_read<v_rd_off(D0, 1, 0)>(vb); S[3] = tr_read<v_rd_off(D0, 1, 1)>(vb); \
    S[4] = tr_read<v_rd_off(D0, 2, 0)>(vb); S[5] = tr_read<v_rd_off(D0, 2, 1)>(vb); S[6] = tr_read<v_rd_off(D0, 3, 0)>(vb); S[7] = tr_read<v_rd_off(D0, 3, 1)>(vb); } while (0)
#define PV_MMA(S, OD) do { OD = __builtin_amdgcn_mfma_f32_32x32x16_bf16(pa0, PV_PK(S[0], S[1]), OD, 0, 0, 0); OD = __builtin_amdgcn_mfma_f32_32x32x16_bf16(pa1, PV_PK(S[2], S[3]), OD, 0, 0, 0); \
    OD = __builtin_amdgcn_mfma_f32_32x32x16_bf16(pa2, PV_PK(S[4], S[5]), OD, 0, 0, 0); OD = __builtin_amdgcn_mfma_f32_32x32x16_bf16(pa3, PV_PK(S[6], S[7]), OD, 0, 0, 0); } while (0)
template <int VAR = 0> __device__ __forceinline__ void pv_d0(f32x16* o, int vb, bf16x8 pa0, bf16x8 pa1, bf16x8 pa2, bf16x8 pa3) {
    if (VAR == 2) { asm volatile("" :: "v"(pa0), "v"(pa1), "v"(pa2), "v"(pa3)); return; }
    s16x4 sa[8], sb[8];
    SBAR(); asm volatile("s_waitcnt lgkmcnt(0)" ::: "memory");
    PV_READ(sa, 0); PV_READ(sb, 1);
    asm volatile("s_waitcnt lgkmcnt(8)" ::: "memory"); SBAR(); PV_MMA(sa, o[0]); SBAR();
    PV_READ(sa, 2);
    asm volatile("s_waitcnt lgkmcnt(8)" ::: "memory"); SBAR(); PV_MMA(sb, o[1]); SBAR();
    PV_READ(sb, 3);
    asm volatile("s_waitcnt lgkmcnt(8)" ::: "memory"); SBAR(); PV_MMA(sa, o[2]); SBAR();
    asm volatile("s_waitcnt lgkmcnt(0)" ::: "memory"); SBAR(); PV_MMA(sb, o[3]); SBAR();
}
#define SGB_MV(NM, NV) do { _Pragma("unroll") for (int q_ = 0; q_ < (NM); ++q_) { __builtin_amdgcn_sched_group_barrier(0x008, 1, 0); __builtin_amdgcn_sched_group_barrier(0x002, (NV), 0); } } while (0)
__device__ __forceinline__ void pv_psm(f32x16* o, int vb, bf16x8 pa0, bf16x8 pa1, bf16x8 pa2, bf16x8 pa3, f32x16& p0, f32x16& p1, float& m_reg, float& alpha, float boff) {
    s16x4 sa[8], sb[8];
    SBAR(); asm volatile("s_waitcnt lgkmcnt(0)" ::: "memory");
    PV_READ(sa, 0); PV_READ(sb, 1);
    asm volatile("s_waitcnt lgkmcnt(8)" ::: "memory"); SBAR(); PV_MMA(sa, o[0]);
    float pa = max3f(p0[0], p0[1], p0[2]), pb = max3f(p1[0], p1[1], p1[2]);
#pragma unroll
    for (int r = 3; r < 15; r += 2) { pa = max3f(pa, p0[r], p0[r + 1]); pb = max3f(pb, p1[r], p1[r + 1]); }
    float pmax = max3f(pa, pb, p0[15]); pmax = max3f(pmax, p1[15], p1[15]);
    pmax = psw_max(pmax) + boff;
    asm volatile("" : "+v"(pmax));
    SGB_MV(4, 4); SBAR();
    PV_READ(sa, 2);
    asm volatile("s_waitcnt lgkmcnt(8)" ::: "memory"); SBAR(); PV_MMA(sb, o[1]);
    const bool keep = __all(pmax - m_reg <= THRL);
    const float mn = keep ? m_reg : fmaxf(m_reg, pmax); alpha = __builtin_amdgcn_exp2f(m_reg - mn); m_reg = mn;
    const float sub = mn - boff;
#pragma unroll
    for (int r = 0; r < 16; ++r) p0[r] -= sub;
    asm volatile("" : "+v"(p0));
    SGB_MV(4, 5); SBAR();
    PV_READ(sb, 3);
    asm volatile("s_waitcnt lgkmcnt(8)" ::: "memory"); SBAR(); PV_MMA(sa, o[2]);
#pragma unroll
    for (int r = 0; r < 16; ++r) p1[r] -= sub;
#pragma unroll
    for (int r = 0; r < 6; ++r) p0[r] = __builtin_amdgcn_exp2f(p0[r]);
    asm volatile("" : "+v"(p0), "+v"(p1));
    SGB_MV(4, 6); SBAR();
    asm volatile("s_waitcnt lgkmcnt(0)" ::: "memory"); SBAR(); PV_MMA(sb, o[3]);
#pragma unroll
    for (int r = 6; r < 16; ++r) p0[r] = __builtin_amdgcn_exp2f(p0[r]);
    asm volatile("" : "+v"(p0));
    SGB_MV(4, 3); SBAR();
}
#undef PV_PK
#undef PV_READ
#undef PV_MMA

template <int VAR> __device__ __forceinline__ void attn_unit(const kargp_t kp, int j, int b, int g, int c, char* lds, int wave) {
    const int tid = make_tid(wave), wid = tid >> 6, lane = tid & 63, r32 = lane & 31, hi = lane >> 5;
    const bf16* PROJ = (const bf16*)(KWS + WS_PROJ); const unsigned* BM = (const unsigned*)(KWS + WS_BM); bf16* YCAT = (bf16*)(KWS + (VAR ? WS_SC : WS_YCAT));
    const int hr = wid >> 1, h = g * 4 + hr, qh = wid & 1;
    const int t = c * 64 + qh * 32 + r32; const size_t qrow = (size_t)b * SEQ + t;
    const bf16* Kh = (const bf16*)(KWS + WS_KN) + (size_t)b * SEQ * LDKK + g * 128; const bf16* Vh = PROJ + (size_t)b * SEQ * LDKV + COL_V + g * 128;
    char* V_lds = lds; char* K_lds = lds + 2 * SHM_V;
    float* wsf = (float*)(lds + LDS_WS) + wid * 64; float* li_l = wsf; float* al_l = wsf + 32; float* LUT = (float*)(lds + LDS_LUT);
    const int NT0 = c + 1, NT = NT0 + (NT0 & 1);
    __syncthreads();
    for (int e = tid; e < 4 * LUT_N; e += NTHR) { const int rr = e / LUT_N, i = e % LUT_N; LUT[e] = rel_bias_at(kp, i - 192, g * 4 + rr) * 1.4426950408889634f; }
    const float bfar = rel_bias_at(kp, -200, h) * 1.4426950408889634f;
    float m_reg = -1e30f, l_reg = 0.f; f32x16 o[4] = {}; char* qs = lds + LDS_Q + wid * 8192 + lane * 16;
    {   float qf[64]; float ss = 0.f; const bf16* qp = PROJ + qrow * PROJ_LD + COL_Q + h * 128 + hi * 8;
#pragma unroll
        for (int d0 = 0; d0 < 8; ++d0) { const u32x4 w = *(const u32x4*)(qp + d0 * 16);
            qf[d0 * 8 + 0] = bflo(w.x); qf[d0 * 8 + 1] = bfhi(w.x); qf[d0 * 8 + 2] = bflo(w.y); qf[d0 * 8 + 3] = bfhi(w.y); qf[d0 * 8 + 4] = bflo(w.z); qf[d0 * 8 + 5] = bfhi(w.z); qf[d0 * 8 + 6] = bflo(w.w); qf[d0 * 8 + 7] = bfhi(w.w); }
#pragma unroll
        for (int i = 0; i < 64; ++i) ss += qf[i] * qf[i];
        ss = psw_sum(ss);
        const float f = frsq(ss * (1.0f / 128.0f) + 1e-6f) * (0.08838834764831845f * 1.4426950408889634f); const float* qg = KIN(12) + (size_t)j * 128 + hi * 8;
#pragma unroll
        for (int d0 = 0; d0 < 8; ++d0) { const f32x4 g0 = *(const f32x4*)(qg + d0 * 16), g1 = *(const f32x4*)(qg + d0 * 16 + 4);
            u32x4 w; w.x = cvtpk(qf[d0 * 8 + 0] * f * g0[0], qf[d0 * 8 + 1] * f * g0[1]); w.y = cvtpk(qf[d0 * 8 + 2] * f * g0[2], qf[d0 * 8 + 3] * f * g0[3]);
            w.z = cvtpk(qf[d0 * 8 + 4] * f * g1[0], qf[d0 * 8 + 5] * f * g1[1]); w.w = cvtpk(qf[d0 * 8 + 6] * f * g1[2], qf[d0 * 8 + 7] * f * g1[3]); *reinterpret_cast<u32x4*>(qs + d0 * 1024) = w; }
    }
    const int vb0 = (int)(uintptr_t)V_lds + v_rd_base(lane);
    const int krow_ = 8 * wid + (lane >> 4), kch_ = lane & 15;
    const bf16* ksrc0 = Kh + (size_t)krow_ * LDKK + ((kch_ ^ (krow_ & 7)) * 8); const bf16* ksrc1 = Kh + (size_t)(krow_ + 4) * LDKK + ((kch_ ^ ((krow_ + 4) & 7)) * 8);
    const int vkk_ = 8 * wid + ((lane & 31) >> 2), vk_ = (vkk_ & ~0xC) | ((vkk_ & 4) << 1) | ((vkk_ & 8) >> 1);
    const bf16* vsrc0 = Vh + (size_t)vk_ * LDKV + (lane >> 5) * 32 + (lane & 3) * 8; const bf16* vsrc1 = vsrc0 + 64;
    const unsigned* msrc = BM + ((size_t)b * SEQ + c * 64 + lane) * 128;
    char* MS = lds + LDS_MS;
#define DMAK(bb, k0) do { LAS unsigned* d_ = (LAS unsigned*)(K_lds + (bb) * SHM_K + wave * 2048); \
    __builtin_amdgcn_global_load_lds((const unsigned*)(ksrc0 + (size_t)(k0) * LDKK), d_, 16, 0, 0); __builtin_amdgcn_global_load_lds((const unsigned*)(ksrc1 + (size_t)(k0) * LDKK), d_ + 256, 16, 0, 0); } while (0)
#define DMAV(bb, k0) do { LAS unsigned* d_ = (LAS unsigned*)(V_lds + (bb) * SHM_V + wave * 2048); \
    __builtin_amdgcn_global_load_lds((const unsigned*)(vsrc0 + (size_t)(k0) * LDKV), d_, 16, 0, 0); __builtin_amdgcn_global_load_lds((const unsigned*)(vsrc1 + (size_t)(k0) * LDKV), d_ + 256, 16, 0, 0); } while (0)
#define DMAM(pr) do { if (wave == 0) __builtin_amdgcn_global_load_lds(msrc + 4 * (pr), (LAS unsigned*)(MS + ((pr) & 1) * 1024), 16, 0, 0); } while (0)
#define RESC(a) do { if (__any((a) < 1.f)) { if (hi == 0) al_l[r32] = (a); asm volatile("s_waitcnt lgkmcnt(0)" ::: "memory"); \
    _Pragma("unroll") for (int d = 0; d < 4; ++d) _Pragma("unroll") for (int r = 0; r < 16; ++r) o[d][r] *= al_l[crow(r, hi)]; } } while (0)
#define SCORE(P0, P1, jt) do { const bool near_ = (jt) >= c - 2; const v2u mw_ = *(const v2u*)(MS + (((jt) >> 1) & 1) * 1024 + (qh * 32 + r32) * 16 + ((jt) & 1) * 8); \
    if (VAR == 3) { P0 = f32x16{}; P1 = f32x16{}; asm volatile("" : "+v"(P0), "+v"(P1)); } else qkt(P0, P1, K_lds + ((jt) & 1) * SHM_K, qs, r32, hi); const unsigned w0_ = mw_.x >> (4 * hi), w1_ = mw_.y >> (4 * hi); \
    if (near_) { const float* lutp_ = LUT + hr * LUT_N + (64 * (jt) - t + 192 + 4 * hi); maskbias<true>(P0, P1, w0_, w1_, lutp_); } else if (VAR != 1) maskbias<false>(P0, P1, w0_, w1_, nullptr); else asm volatile("" :: "v"(w0_), "v"(w1_)); } while (0)
#define WAITBAR() do { asm volatile("s_waitcnt vmcnt(0)" ::: "memory"); __syncthreads(); } while (0)
#define HALF(ORD, Pc0, Pc1, alc, Pp0, Pp1, alp, jt) do { SBAR(); if ((jt) + 1 < NT) DMAK(((jt) + 1) & 1, ((jt) + 1) * KVBLK);     \
    if (ORD == 0) { SCORE(Pc0, Pc1, jt); finishSM<VAR>(Pp0, Pp1, alp, l_reg, pa0, pa1, pa2, pa3); SBAR(); pv_d0<VAR>(o, vb0 + (((jt) - 1) & 1) * SHM_V, pa0, pa1, pa2, pa3); } \
    else { finishSM<VAR>(Pp0, Pp1, alp, l_reg, pa0, pa1, pa2, pa3); SBAR(); pv_d0<VAR>(o, vb0 + (((jt) - 1) & 1) * SHM_V, pa0, pa1, pa2, pa3); SBAR(); SCORE(Pc0, Pc1, jt); } \
    partialSM<VAR>(Pc0, Pc1, m_reg, alc, ((jt) >= c - 2) ? 0.f : bfar); \
    WAITBAR(); if ((jt) + 1 < NT) DMAV(((jt) + 1) & 1, ((jt) + 1) * KVBLK); if ((((jt) & 1) == 0) && (jt) + 2 < NT) DMAM(((jt) + 2) >> 1); \
    RESC(alc); } while (0)
#define SCORE_QK(P0, P1, jt) qkt(P0, P1, K_lds + ((jt) & 1) * SHM_K, qs, r32, hi)
#define MASKB(P0, P1, jt) do { const bool near_ = (jt) >= c - 2; const v2u mw_ = *(const v2u*)(MS + (((jt) >> 1) & 1) * 1024 + (qh * 32 + r32) * 16 + ((jt) & 1) * 8); const unsigned w0_ = mw_.x >> (4 * hi), w1_ = mw_.y >> (4 * hi); \
    if (near_) { const float* lutp_ = LUT + hr * LUT_N + (64 * (jt) - t + 192 + 4 * hi); maskbias<true>(P0, P1, w0_, w1_, lutp_); } else maskbias<false>(P0, P1, w0_, w1_, nullptr); } while (0)
#define HALF2(Pc0, Pc1, alc, Pp0, Pp1, alp, jt) do { SBAR(); if ((jt) + 1 < NT) DMAK(((jt) + 1) & 1, ((jt) + 1) * KVBLK); \
    qkt_fsm(Pc0, Pc1, K_lds + ((jt) & 1) * SHM_K, qs, r32, hi, Pp0, Pp1, alp, l_reg, pa0, pa1, pa2, pa3); \
    SBAR(); MASKB(Pc0, Pc1, jt); \
    pv_psm(o, vb0 + (((jt) - 1) & 1) * SHM_V, pa0, pa1, pa2, pa3, Pc0, Pc1, m_reg, alc, ((jt) >= c - 2) ? 0.f : bfar); \
    WAITBAR(); if ((jt) + 1 < NT) DMAV(((jt) + 1) & 1, ((jt) + 1) * KVBLK); if ((((jt) & 1) == 0) && (jt) + 2 < NT) DMAM(((jt) + 2) >> 1); \
    RESC(alc); } while (0)
#define TILE_LOOP2() do { for (int jt = 1; jt + 1 < NT; jt += 2) { HALF2(pB0, pB1, alB, pA0, pA1, alA, jt); HALF2(pA0, pA1, alA, pB0, pB1, alB, jt + 1); } } while (0)
#define TILE_LOOP(ORD) do { for (int jt = 1; jt + 1 < NT; jt += 2) { HALF(ORD, pB0, pB1, alB, pA0, pA1, alA, jt); HALF(ORD, pA0, pA1, alA, pB0, pB1, alB, jt + 1); } } while (0)
    f32x16 pA0, pA1, pB0, pB1; float alA, alB; bf16x8 pa0, pa1, pa2, pa3;
    DMAM(0); DMAK(0, 0); DMAV(0, 0); WAITBAR();
    SBAR(); DMAK(1, KVBLK); SCORE(pA0, pA1, 0); partialSM<VAR>(pA0, pA1, m_reg, alA, (0 >= c - 2) ? 0.f : bfar);
    WAITBAR(); DMAV(1, KVBLK); if (2 < NT) DMAM(1);
#ifdef ATT_OLD_LOOP
    if (wave < 4) TILE_LOOP(0); else TILE_LOOP(1);
#else
    TILE_LOOP2();
#endif
    SBAR(); SCORE(pB0, pB1, NT - 1);
    finishSM<VAR>(pA0, pA1, alA, l_reg, pa0, pa1, pa2, pa3); SBAR();
    pv_d0<VAR>(o, vb0, pa0, pa1, pa2, pa3); partialSM<VAR>(pB0, pB1, m_reg, alB, 0.f);
    WAITBAR(); RESC(alB);
    finishSM<VAR>(pB0, pB1, alB, l_reg, pa0, pa1, pa2, pa3); SBAR();
    pv_d0<VAR>(o, vb0 + SHM_V, pa0, pa1, pa2, pa3);
    if (hi == 0) li_l[r32] = l_reg; asm volatile("s_waitcnt lgkmcnt(0)" ::: "memory");
    const size_t row0 = (size_t)b * SEQ + c * 64 + qh * 32;
    const int erow = lane >> 4, ech = lane & 15;
    u32x4 gw[8];
#pragma unroll
    for (int i = 0; i < 8; ++i) gw[i] = *(const u32x4*)(PROJ + (row0 + 4 * i + erow) * PROJ_LD + COL_GB + h * 128 + ech * 8);
    char* stg = lds + LDS_Q + wid * 8192;
#pragma unroll
    for (int r = 0; r < 16; ++r) { const int orow = crow(r, hi); const float rl = frcp(li_l[orow]);
#pragma unroll
        for (int d0 = 0; d0 < 4; ++d0) *(unsigned short*)(stg + orow * 256 + (((d0 * 32 + r32) * 2) ^ (((orow >> 2) & 1) << 6))) = (unsigned short)f2bf(o[d0][r] * rl); }
    asm volatile("s_waitcnt lgkmcnt(0)" ::: "memory");
#pragma unroll
    for (int i = 0; i < 8; ++i) { const int row = 4 * i + erow; const u32x4 ov = *(const u32x4*)(stg + row * 256 + ((ech * 16) ^ (((row >> 2) & 1) << 6))); const u32x4 g = gw[i];
        u32x4 y; y.x = pk2(bflo(ov.x) * bflo(g.x), bfhi(ov.x) * bfhi(g.x)); y.y = pk2(bflo(ov.y) * bflo(g.y), bfhi(ov.y) * bfhi(g.y));
        y.z = pk2(bflo(ov.z) * bflo(g.z), bfhi(ov.z) * bfhi(g.z)); y.w = pk2(bflo(ov.w) * bflo(g.w), bfhi(ov.w) * bfhi(g.w));
        *(u32x4*)(YCAT + (row0 + row) * 4096 + 2048 + h * 128 + ech * 8) = y; }
#undef DMAK
#undef DMAV
#undef DMAM
#undef RESC
#undef SCORE
#undef WAITBAR
#undef HALF
#undef TILE_LOOP
#undef HALF2
#undef TILE_LOOP2
#undef SCORE_QK
#undef MASKB
}
#undef KSWZ
#undef SBAR
}

__device__ __forceinline__ void sgu_item_mfma(const kargp_t kp, int j, int b, int ch, int g, unsigned char* lds, int wave) {
    const int tid = make_tid(wave), lane = tid & 63, fr = lane & 15, q4 = lane >> 4, wid = tid >> 6;
    unsigned char* VT = lds; float* MU = (float*)(lds + 32768); float* RS = MU + 128; unsigned char* UT = lds + 40960; unsigned char* GT = lds + 73728;
    const bf16* PROJ = (const bf16*)(KWS + WS_PROJ); const float* SLN = (const float*)(KWS + WS_STATLN); bf16* Y = (bf16*)(KWS + WS_YCAT);
    const float* lng = KIN(16) + (size_t)j * 2048, *lnb = KIN(17) + (size_t)j * 2048; const float* bs = KIN(19) + ((size_t)j * 16 + g) * 128;
    const size_t row0 = (size_t)b * SEQ + ch * 128;
    __syncthreads();
    const int srow = tid >> 2, sq = tid & 3; const f32x4* sp = (const f32x4*)(SLN + (row0 + srow) * 64) + sq * 4;
    f32x4 sv[4];
#pragma unroll
    for (int i = 0; i < 4; ++i) sv[i] = sp[i];
    const bf16* wsb = (const bf16*)(KWS + WS_WSMALL) + (size_t)2 * 32 * 16384 + ((size_t)(j * 16 + g) * 128 + 16 * wid + fr) * 128 + 8 * q4;
    s_bf16x8 af[4];
#pragma unroll
    for (int ks = 0; ks < 4; ++ks) af[ks] = *(const s_bf16x8*)(wsb + ks * 32);
    float bias[4];
#pragma unroll
    for (int r = 0; r < 4; ++r) bias[r] = bs[16 * wid + 4 * q4 + r];
    const int dq = (tid & 15) * 8;
    v4u vw[4];
#pragma unroll
    for (int i = 0; i < 4; ++i) { const int s_ = (tid + NTHR * i) >> 4; vw[i] = *(const v4u*)(PROJ + (row0 + s_) * ODD_IN + 2048 + g * 128 + dq); }
    const f32x4 g0 = *(const f32x4*)(lng + g * 128 + dq), g1 = *(const f32x4*)(lng + g * 128 + dq + 4), b0 = *(const f32x4*)(lnb + g * 128 + dq), b1 = *(const f32x4*)(lnb + g * 128 + dq + 4);
    v4u uw[4], gw_[4];
#pragma unroll
    for (int i = 0; i < 4; ++i) { const int e = tid + NTHR * i, t = e >> 4, chk = e & 15; const bf16* pr = PROJ + (row0 + t) * ODD_IN + g * 128 + chk * 8; uw[i] = *(const v4u*)pr; gw_[i] = *(const v4u*)(pr + 4096); }
    {   float s1 = 0.f, s2 = 0.f;
#pragma unroll
        for (int i = 0; i < 4; ++i) { s1 += sv[i][0] + sv[i][2]; s2 += sv[i][1] + sv[i][3]; }
        s1 += __int_as_float(__builtin_amdgcn_mov_dpp(__float_as_int(s1), 0xB1, 0xF, 0xF, true)); s2 += __int_as_float(__builtin_amdgcn_mov_dpp(__float_as_int(s2), 0xB1, 0xF, 0xF, true));
        s1 += __int_as_float(__builtin_amdgcn_mov_dpp(__float_as_int(s1), 0x4E, 0xF, 0xF, true)); s2 += __int_as_float(__builtin_amdgcn_mov_dpp(__float_as_int(s2), 0x4E, 0xF, 0xF, true));
        const float mean = s1 * (1.0f / 2048.0f); const float var = fmaxf(s2 * (1.0f / 2048.0f) - mean * mean, 0.f); if (sq == 0) { MU[srow] = mean; RS[srow] = frsq(var + 1e-6f); } }
#pragma unroll
    for (int i = 0; i < 4; ++i) { const int e = tid + NTHR * i, t = e >> 4, chk = e & 15; const int sw_ = (chk * 16) ^ (((t >> 2) & 3) << 5); *(v4u*)(UT + t * 256 + sw_) = uw[i]; *(v4u*)(GT + t * 256 + sw_) = gw_[i]; }
    __syncthreads();
#pragma unroll
    for (int i = 0; i < 4; ++i) { const int s = (tid + NTHR * i) >> 4; const v4u w = vw[i];
        const float x[8] = {bflo(w.x), bfhi(w.x), bflo(w.y), bfhi(w.y), bflo(w.z), bfhi(w.z), bflo(w.w), bfhi(w.w)}; const float mu = MU[s], rs = RS[s];
#pragma unroll
        for (int k = 0; k < 8; ++k) { const int d = dq + k; const float v = (x[k] - mu) * rs * (k < 4 ? g0[k & 3] : g1[k & 3]) + (k < 4 ? b0[k & 3] : b1[k & 3]);
            *(bf16*)(VT + d * 256 + ((s * 2) ^ (((d & 15) ^ ((d >> 4) & 7)) << 4))) = (bf16)f2bf(v); } }
    __syncthreads();
    f32x4 acc[8];
#pragma unroll
    for (int n = 0; n < 8; ++n) acc[n] = (f32x4){0.f, 0.f, 0.f, 0.f};
    {
        s_bf16x8 bv[2][4];
#define SGU_LD(S, N) do { _Pragma("unroll") for (int ks = 0; ks < 4; ++ks) bv[S][ks] = *(const s_bf16x8*)(VT + (16 * (N) + fr) * 256 + (((ks * 32 + 8 * q4) * 2) ^ ((fr ^ ((N) & 7)) << 4))); } while (0)
        SGU_LD(0, 0);
#pragma unroll
        for (int n = 0; n < 8; ++n) { __builtin_amdgcn_sched_barrier(0);
            if (n + 1 < 8) SGU_LD((n + 1) & 1, n + 1);
#pragma unroll
            for (int ks = 0; ks < 4; ++ks) acc[n] = __builtin_amdgcn_mfma_f32_16x16x32_bf16(af[ks], bv[n & 1][ks], acc[n], 0, 0, 0); }
        __builtin_amdgcn_sched_barrier(0);
#undef SGU_LD
    }
    unsigned short uq[4][8], gq[4][8];
#pragma unroll
    for (int r = 0; r < 4; ++r) { const int t = 16 * wid + 4 * q4 + r;
#pragma unroll
        for (int n = 0; n < 8; ++n) { uq[r][n] = *(const unsigned short*)(UT + t * 256 + (((16 * n + fr) * 2) ^ (q4 << 5))); gq[r][n] = *(const unsigned short*)(GT + t * 256 + (((16 * n + fr) * 2) ^ (q4 << 5))); } }
#pragma unroll
    for (int r = 0; r < 4; ++r) { const int t = 16 * wid + 4 * q4 + r;
#pragma unroll
        for (int n = 0; n < 8; ++n) *(bf16*)(UT + t * 256 + (((16 * n + fr) * 2) ^ (q4 << 5))) = (bf16)f2bf(bf2f(uq[r][n]) * (acc[n][r] + bias[r]) * bf2f(gq[r][n])); }
    __syncthreads();
#pragma unroll
    for (int i = 0; i < 4; ++i) { const int e = tid + NTHR * i, t = e >> 4, chk = e & 15; *(v4u*)(Y + (row0 + t) * 2048 + g * 128 + chk * 8) = *(const v4u*)(UT + t * 256 + ((chk * 16) ^ (((t >> 2) & 3) << 5))); }
}

__global__ void __launch_bounds__(NTHR, 2) mega_fwd(Args args) {
    extern __shared__ __attribute__((aligned(16))) unsigned char lds[];
    const int wave = __builtin_amdgcn_readfirstlane((int)threadIdx.x >> 6);
    const int G = gridDim.x, bx = blockIdx.x;
#define LANE_ONLY() int lane_ = lane_id(); asm volatile("" : "+v"(lane_)); const int lane = lane_
#define LANE_OPAQUE() KARGS_OPEN(); int lane_ = lane_id(); asm volatile("" : "+v"(lane_)); const int lane = lane_

    volatile LAS unsigned* MISC = (volatile LAS unsigned*)((LAS unsigned char*)lds + MISC_OFF);
    if (threadIdx.x < 64) MISC[threadIdx.x] = 0u;
    __syncthreads();
    XcdBarrier bar; bar.bar = (unsigned*)(args.ws + WS_CTL) + CW_BAR; bar.x = 0; bar.st = nullptr;
    if (N_LAUNCHES == 1) bar = xcd_barrier_post((unsigned*)(args.ws + WS_CTL) + CW_BAR, MISC + 8);
#define GRID_BAR() do { if (N_LAUNCHES == 1) xcd_barrier(bar, wave == 0 && lane_id() == 0); } while (0)
    const int lo = args.ph_lo, hi = args.ph_hi;
#define IN(k) (lo <= (k) && (k) < hi)
#define SEAM(k) do { if (IN((k) + 1)) { GRID_BAR(); if (PROBE_REP == 9) { GRID_BAR(); GRID_BAR(); } } } while (0)
    const int gw = bx * NWAVES + wave, NGW = G * NWAVES;
#define ws KWS
#define HP ((bf16*)KOUT)
#define HQ ((bf16*)(ws + WS_AN))
#define PROJ ((bf16*)(ws + WS_PROJ))
#define YCAT ((bf16*)(ws + WS_YCAT))
#define IDX ((float*)(ws + WS_IDX))
#define EBL(l) ((bf16*)(ws + WS_H) + (size_t)((l) & 1) * M * DM)
#define EB EBL(layer)
#define STA ((float*)(ws + WS_STATA))
#define STB ((float*)(ws + WS_STATB))
#define SLN ((float*)(ws + WS_STATLN))
#define PBF ((bf16*)(ws + WS_PBF))
#define WPE ((bf16*)(ws + WS_WPE))
#define WGATE ((bf16*)(ws + WS_WGATE))
#define WEIN ((bf16*)(ws + WS_WEIN))
#define WEOUT ((bf16*)(ws + WS_WEOUT))
#define WOIN ((bf16*)(ws + WS_WOIN))
#define WOOUT ((bf16*)(ws + WS_WOOUT))
    LAS unsigned char* ldsl = (LAS unsigned char*)lds;

    if (IN(0)) { LANE_OPAQUE();
        float* scr = (float*)(lds + wave * 16640);
        for (int rep_ = 0; rep_ < NREP(8); ++rep_) {
        int base = 0, it = gw;
#define TRG(W, K, N, WT, GK) do { const int ni_ = ((K) / 64) * (((N) + 63) / 64); for (; it < base + ni_; it += NGW) p0_transpose_item((W), (K), (N), (WT), scr, it - base, lane, (GK)); base += ni_; } while (0)
#define TR(W, K, N, WT) TRG(W, K, N, WT, nullptr)
        TRG(KIN(4), 2048, EVEN_IN, WEIN, KIN(2));
        for (int j = 0; j < 2; ++j) TR(KIN(14) + (size_t)j * 4096 * 2048, 4096, 2048, WEOUT + (size_t)j * 2048 * 4096);
        TRG(KIN(15), 2048, ODD_IN, WOIN, KIN(2) + DM);
        TR(KIN(20), 2048, 2048, WOOUT);
        for (int l = 0; l < 4; ++l) TR(KIN(21) + (size_t)l * 256 * 2048, 256, 2048, WPE + (size_t)l * 2048 * 256);
        for (int l = 0; l < 3; ++l) TRG(KIN(23) + (size_t)l * 2048 * 2048, 2048, 2048, WGATE + (size_t)l * 2048 * 2048, KIN(22) + (size_t)l * DM);
        for (int jg = 0; jg < 32; ++jg) TR(KIN(7) + (size_t)jg * 16384, 128, 128, (bf16*)(ws + WS_WSMALL) + (size_t)jg * 16384);
        for (int jg = 0; jg < 32; ++jg) TR(KIN(9) + (size_t)jg * 16384, 128, 128, (bf16*)(ws + WS_WSMALL) + (size_t)(32 + jg) * 16384);
#undef TR
#undef TRG
        for (int j = 0; j < 2; ++j) { v4u* z = (v4u*)(WEIN + ((size_t)j * EVEN_INP + EVEN_IN) * 2048); const int n16 = (EVEN_INP - EVEN_IN) * 2048 / 8;
            for (int i = gw * 64 + lane; i < n16; i += NGW * 64) z[i] = (v4u){0u, 0u, 0u, 0u}; }
        for (int m = gw; m < M; m += NGW) { const f32x4* xr = (const f32x4*)(KIN(0) + (size_t)m * DM) + lane; float ss = 0.f;
            f32x4 xv[8];
#pragma unroll
            for (int jx = 0; jx < 8; ++jx) xv[jx] = __builtin_nontemporal_load(xr + 64 * jx);
            asm volatile("" ::: "memory");
#pragma unroll
            for (int jx = 0; jx < 8; ++jx) { const f32x4 v = xv[jx]; ss += (v[0] * v[0] + v[1] * v[1]) + (v[2] * v[2] + v[3] * v[3]);
                *(v2u*)(HP + (size_t)m * DM + (size_t)(lane + 64 * jx) * 4) = (v2u){pk2(v[0], v[1]), pk2(v[2], v[3])}; }
            ss = wave_sum(ss, lane); if (lane < 32) STA[(size_t)m * 32 + lane] = (lane == 0) ? ss : 0.f; }
        { const f32x4* w4 = (const f32x4*)KIN(18); bf16* wo = (bf16*)(ws + WS_WSMALL) + (size_t)2 * 32 * 16384; const int n4 = 2 * 16 * 128 * 128 / 4;
            for (int i = gw * 64 + lane; i < n4; i += NGW * 64) { f32x4 v = w4[i]; const int s = (i * 4) & 127, t = ((i * 4) >> 7) & 127; if (t < 64 && s >= 64) v = (f32x4){0.f, 0.f, 0.f, 0.f};
                *(v2u*)(wo + (size_t)i * 4) = (v2u){pk2(v[0], v[1]), pk2(v[2], v[3])}; } }
        { const f32x4* p4 = (const f32x4*)KIN(1); const int n4 = DEPTH * M * 256 / 4;
            for (int i = gw * 64 + lane; i < n4; i += 8 * NGW * 64) { f32x4 pv[8];
#pragma unroll
                for (int q = 0; q < 8; ++q) pv[q] = __builtin_nontemporal_load(p4 + ((i + q * NGW * 64 < n4) ? i + q * NGW * 64 : i));
                asm volatile("" ::: "memory");
#pragma unroll
                for (int q = 0; q < 8; ++q) if (i + q * NGW * 64 < n4) *(v2u*)(PBF + (size_t)(i + q * NGW * 64) * 4) = (v2u){pk2(pv[q][0], pv[q][1]), pk2(pv[q][2], pv[q][3])}; } }
        }
        SEAM(0);
    }

    int ph = 1;
#define PHASE_BEGIN() KARGS_OPEN(); int lyr_ = layer_it; asm volatile("" : "+s"(lyr_)); const int layer = lyr_, j = lyr_ >> 1; const bool last = (lyr_ == DEPTH - 1); (void)j; (void)last; (void)layer
    {
        constexpr int layer_it = 0;
        if ((layer_it & 1) == 0) {
            if (IN(ph)) { PHASE_BEGIN(); pg8::Gemm g{HP, WEIN + (size_t)j * EVEN_INP * 2048, M, EVEN_INP, 2048}; pg8::StaticOrder S; S.init(M, EVEN_INP, G, bx);
                pg8::EpiEvenIn E{PROJ, IDX, STA, (bf16*)(ws + WS_IDXB)}; for (int rep_ = 0; rep_ < NREP(1); ++rep_) pg8::gemm_phase<pg8::EpiEvenIn, pg8::StaticOrder, true, true>(ldsl, g, S, E, wave);
                if (bx >= 32 && G > 32) {
#pragma unroll 1
                    for (int l2 = 0; l2 < 2; ++l2) { const int ll = layer + l2; pg8::Gemm g2{PBF + (size_t)ll * M * 256, WPE + (size_t)ll * 2048 * 256, M, 2048, 256}; pg8::StaticOrder S2; S2.init(M, 2048, G - 32, bx - 32);
                        pg8::EpiPE E2{EBL(ll)}; pg8::gemm_phase<pg8::EpiPE, pg8::StaticOrder, true, true>(ldsl, g2, S2, E2, wave);  }
                    { LANE_ONLY(); float* scr = (float*)(lds + wave * 16640); const int gw2 = (bx - 32) * NWAVES + wave, NGW2 = (G - 32) * NWAVES; int base = 0, it = gw2;
#define TR2(W, K, N, WT, GK) do { const int ni_ = ((K) / 64) * (((N) + 63) / 64); for (; it < base + ni_; it += NGW2) p0_transpose_item((W), (K), (N), (WT), scr, it - base, lane, (GK)); base += ni_; } while (0)
                      if (layer == 0) { TR2(KIN(4) + (size_t)2048 * EVEN_IN, 2048, EVEN_IN, WEIN + (size_t)EVEN_INP * 2048, KIN(2) + 2 * DM); }
                      else { TR2(KIN(15) + (size_t)2048 * ODD_IN, 2048, ODD_IN, WOIN + (size_t)ODD_IN * 2048, KIN(2) + 3 * DM); TR2(KIN(20) + (size_t)2048 * 2048, 2048, 2048, WOOUT + (size_t)2048 * 2048, nullptr); TR2(KIN(23) + (size_t)3 * 2048 * 2048, 2048, 2048, WGATE + (size_t)3 * 2048 * 2048, KIN(22) + 3 * DM); }
#undef TR2
                    } }
#if PROBE_REP == 11 || PROBE_REP == 14
                __syncthreads();
                { pg8::EpiEvenInT<PROBE_REP == 11 ? 1 : 2> EN{PROJ, IDX, STA, (bf16*)(ws + WS_IDXB)}; for (int rep_ = 0; rep_ < 2; ++rep_) pg8::gemm_phase<pg8::EpiEvenInT<PROBE_REP == 11 ? 1 : 2>, pg8::StaticOrder, true, true>(ldsl, g, S, EN, wave); }
#endif
#if PROBE_REP == 10
                __syncthreads();
                { pg8::EpiNull EN; for (int rep_ = 0; rep_ < 2; ++rep_) pg8::gemm_phase<pg8::EpiNull, pg8::StaticOrder, true, true>(ldsl, g, S, EN, wave); }
#endif
                SEAM(ph); }
            ++ph;
            if (IN(ph)) { PHASE_BEGIN(); LANE_ONLY();
#ifdef NAIVE_LRU
                for (int it = bx; it < 1024; it += G) lru_tile(kp, j, it >> 9, (it >> 4) & 31, it & 15, false, lds, wave);
#else
                for (int rep_ = 0; rep_ < NREP(2); ++rep_)
                for (int it = bx; it < 1024; it += G) lru_tile_mfma(kp, j, it, it + G, it == bx, false, LRU_STREAM != 0, lds, wave);
#endif
#ifndef NO_KN
                for (int it = bx; it < 512; it += G) knorm_item(kp, j, it, wave, lane);
#endif
#ifdef NAIVE_SCORE
                for (int it = bx; it < 4160; it += G) { const int b = it / 2080; int r = it % 2080; int c = 0; while (r >= c + 1) { r -= c + 1; ++c; } score_item(kp, b, c, r, lds, wave); }
#else
                __syncthreads();
                for (int rep_ = 0; rep_ < NREP(3); ++rep_)
                for (int u = gw; u < 2048; u += NGW) { const int ks = u & 7, qg = (u >> 3) & 3, cp = (u >> 5) & 31, b = u >> 10;
                    score_wave_unit(kp, b, cp, qg, ks, lane, lds, wave); score_wave_unit(kp, b, 63 - cp, qg, ks, lane, lds, wave); }
#ifdef CHECK_SCORE
                GRID_BAR();
                for (int it = bx; it < 4160; it += G) { const int b = it / 2080; int r = it % 2080; int c = 0; while (r >= c + 1) { r -= c + 1; ++c; } score_item(kp, b, c, r, lds, wave, true); }
#endif
#endif
                SEAM(ph); }
            ++ph;
            if (IN(ph)) { PHASE_BEGIN(); LANE_ONLY();
#ifdef NAIVE_LRU
                for (int it = bx; it < 1024; it += G) lru_tile(kp, j, it >> 9, (it >> 4) & 31, it & 15, true, lds, wave);
#else
                for (int rep_ = 0; rep_ < NREP(2); ++rep_)
                for (int it = bx; it < 1024; it += (LRU_STREAM ? 4 : 1) * G) { if (LRU_STREAM) { __syncthreads(); lru_carry4(kp, it, G, (float*)lds, wave); __syncthreads();
#pragma unroll 1
                    for (int k4 = 0; k4 < 4; ++k4) if (it + k4 * G < 1024) lru_apply_item(kp, it + k4 * G, (const float*)lds + k4 * 128, wave); }
                  else lru_tile_mfma(kp, j, it, it + G, it == bx, true, false, lds, wave); }
#ifdef CHECK_LRU
                GRID_BAR();
                for (int it = bx; it < 1024; it += G) lru_tile(kp, j, it >> 9, (it >> 4) & 31, it & 15, true, lds, wave, true);
#endif
#endif
#ifndef NO_SEL
                for (int rep_ = 0; rep_ < NREP(4); ++rep_)
                for (int u = gw; u < M / 2; u += NGW) { const int b_ = u >> 11, t_ = u & 2047;
                    select_query(kp, b_ * SEQ + t_, lane); select_query(kp, b_ * SEQ + 4095 - t_, lane); }
#endif
                SEAM(ph); }
            ++ph;
            if (IN(ph)) { PHASE_BEGIN();
#ifdef NAIVE_ATTN
                for (int qi = bx; qi < M; qi += G) attn_query(kp, j, qi, lds, wave);
#else
                for (int rep_ = 0; rep_ < NREP(5); ++rep_)
                for (int u = bx; u < 256; u += G) { const int bg = u & 7, cp = u >> 3;

#pragma unroll 1
                    for (int k2 = 0; k2 < 2; ++k2) att::attn_unit<0>(kp, j, bg >> 2, bg & 3, k2 ? cp : 63 - cp, (char*)lds, wave); }
#if PROBE_REP >= 20 && PROBE_REP < 30
                for (int rep_ = 0; rep_ < 2; ++rep_) for (int u = bx; u < 256; u += G) { const int bg = u & 7, cp = u >> 3; att::attn_unit<PROBE_REP - 20>(kp, j, bg >> 2, bg & 3, 63 - cp, (char*)lds, wave); att::attn_unit<PROBE_REP - 20>(kp, j, bg >> 2, bg & 3, cp, (char*)lds, wave); }
#endif
#ifdef CHECK_ATTN
                GRID_BAR();
                for (int qi = bx; qi < M; qi += G) attn_query(kp, j, qi, lds, wave, true);
#endif
#endif
                SEAM(ph); }
            ++ph;
            if (IN(ph)) { PHASE_BEGIN();
                { pg8::Gemm g{YCAT, WEOUT + (size_t)j * 2048 * 4096, M, 2048, 4096}; pg8::StaticOrder S; S.init(M, 2048, G, bx);
                  pg8::EpiOut E{HP, HQ, STB}; pg8::gemm_phase<pg8::EpiOut, pg8::StaticOrder, true, true>(ldsl, g, S, E, wave);
#if PROBE_REP == 12
                  { pg8::EpiOut Ed{HP, (bf16*)(ws + WS_SC), (float*)(ws + WS_SC) + 16 * 1048576}; for (int rep_ = 0; rep_ < 2; ++rep_) pg8::gemm_phase<pg8::EpiOut, pg8::StaticOrder, true, true>(ldsl, g, S, Ed, wave); }
#endif
                }
                SEAM(ph); }
            ++ph;
        } else {
            if (IN(ph)) { PHASE_BEGIN(); pg8::Gemm g{HP, WOIN + (size_t)j * ODD_IN * 2048, M, ODD_IN, 2048}; pg8::StaticOrder S; S.init(M, ODD_IN, G, bx);
                pg8::EpiOddIn E{PROJ, STA, SLN}; for (int rep_ = 0; rep_ < NREP(6); ++rep_) pg8::gemm_phase<pg8::EpiOddIn, pg8::StaticOrder, true, true>(ldsl, g, S, E, wave); SEAM(ph); }
            ++ph;
            if (IN(ph)) { PHASE_BEGIN();
#ifndef NO_SGU
                for (int rep_ = 0; rep_ < NREP(7); ++rep_)
#ifdef NAIVE_SGU
                for (int it = bx; it < 1024; it += G) sgu_item(kp, j, it >> 9, (it >> 4) & 31, it & 15, lds, wave);
#else
                for (int it = bx; it < 1024; it += G) sgu_item_mfma(kp, j, it >> 9, (it >> 4) & 31, it & 15, lds, wave);
#endif
#endif
                SEAM(ph); }
            ++ph;
            if (IN(ph)) { PHASE_BEGIN();
                { pg8::Gemm g{YCAT, WOOUT + (size_t)j * 2048 * 2048, M, 2048, 2048}; pg8::StaticOrder S; S.init(M, 2048, G, bx);
                  pg8::EpiOut E{HP, HQ, STB}; pg8::gemm_phase<pg8::EpiOut, pg8::StaticOrder, true, true>(ldsl, g, S, E, wave);
#if PROBE_REP == 12
                  { pg8::EpiOut Ed{HP, (bf16*)(ws + WS_SC), (float*)(ws + WS_SC) + 16 * 1048576}; for (int rep_ = 0; rep_ < 2; ++rep_) pg8::gemm_phase<pg8::EpiOut, pg8::StaticOrder, true, true>(ldsl, g, S, Ed, wave); }
#endif
                }
                SEAM(ph); }
            ++ph;
        }
        if (IN(ph)) { PHASE_BEGIN(); pg8::Gemm g{HQ, WGATE + (size_t)layer * 2048 * 2048, M, 2048, 2048}; pg8::StaticOrder S; S.init(M, 2048, G, bx);
            typedef pg8::EpiGateT<layer_it == DEPTH - 1> EpiGate;
            EpiGate E{HQ, EB, STB, HP, STA, KOUT}; pg8::gemm_phase<EpiGate, pg8::StaticOrder, true, true>(ldsl, g, S, E, wave);
#if PROBE_REP == 13
            { pg8::EpiGateT<false> Ed{HQ, EB, STB, (bf16*)(ws + WS_SC), (float*)(ws + WS_SC) + 16 * 1048576, nullptr}; for (int rep_ = 0; rep_ < 2; ++rep_) pg8::gemm_phase<pg8::EpiGateT<false>, pg8::StaticOrder, true, true>(ldsl, g, S, Ed, wave); }
#endif

            if (layer_it != DEPTH - 1) SEAM(ph); }
        ++ph;
    }
    {
        constexpr int layer_it = 1;
        if ((layer_it & 1) == 0) {
            if (IN(ph)) { PHASE_BEGIN(); pg8::Gemm g{HP, WEIN + (size_t)j * EVEN_INP * 2048, M, EVEN_INP, 2048}; pg8::StaticOrder S; S.init(M, EVEN_INP, G, bx);
                pg8::EpiEvenIn E{PROJ, IDX, STA, (bf16*)(ws + WS_IDXB)}; for (int rep_ = 0; rep_ < NREP(1); ++rep_) pg8::gemm_phase<pg8::EpiEvenIn, pg8::StaticOrder, true, true>(ldsl, g, S, E, wave);
                if (bx >= 32 && G > 32) {
#pragma unroll 1
                    for (int l2 = 0; l2 < 2; ++l2) { const int ll = layer + l2; pg8::Gemm g2{PBF + (size_t)ll * M * 256, WPE + (size_t)ll * 2048 * 256, M, 2048, 256}; pg8::StaticOrder S2; S2.init(M, 2048, G - 32, bx - 32);
                        pg8::EpiPE E2{EBL(ll)}; pg8::gemm_phase<pg8::EpiPE, pg8::StaticOrder, true, true>(ldsl, g2, S2, E2, wave);  }
                    { LANE_ONLY(); float* scr = (float*)(lds + wave * 16640); const int gw2 = (bx - 32) * NWAVES + wave, NGW2 = (G - 32) * NWAVES; int base = 0, it = gw2;
#define TR2(W, K, N, WT, GK) do { const int ni_ = ((K) / 64) * (((N) + 63) / 64); for (; it < base + ni_; it += NGW2) p0_transpose_item((W), (K), (N), (WT), scr, it - base, lane, (GK)); base += ni_; } while (0)
                      if (layer == 0) { TR2(KIN(4) + (size_t)2048 * EVEN_IN, 2048, EVEN_IN, WEIN + (size_t)EVEN_INP * 2048, KIN(2) + 2 * DM); }
                      else { TR2(KIN(15) + (size_t)2048 * ODD_IN, 2048, ODD_IN, WOIN + (size_t)ODD_IN * 2048, KIN(2) + 3 * DM); TR2(KIN(20) + (size_t)2048 * 2048, 2048, 2048, WOOUT + (size_t)2048 * 2048, nullptr); TR2(KIN(23) + (size_t)3 * 2048 * 2048, 2048, 2048, WGATE + (size_t)3 * 2048 * 2048, KIN(22) + 3 * DM); }
#undef TR2
                    } }
#if PROBE_REP == 11 || PROBE_REP == 14
                __syncthreads();
                { pg8::EpiEvenInT<PROBE_REP == 11 ? 1 : 2> EN{PROJ, IDX, STA, (bf16*)(ws + WS_IDXB)}; for (int rep_ = 0; rep_ < 2; ++rep_) pg8::gemm_phase<pg8::EpiEvenInT<PROBE_REP == 11 ? 1 : 2>, pg8::StaticOrder, true, true>(ldsl, g, S, EN, wave); }
#endif
#if PROBE_REP == 10
                __syncthreads();
                { pg8::EpiNull EN; for (int rep_ = 0; rep_ < 2; ++rep_) pg8::gemm_phase<pg8::EpiNull, pg8::StaticOrder, true, true>(ldsl, g, S, EN, wave); }
#endif
                SEAM(ph); }
            ++ph;
            if (IN(ph)) { PHASE_BEGIN(); LANE_ONLY();
#ifdef NAIVE_LRU
                for (int it = bx; it < 1024; it += G) lru_tile(kp, j, it >> 9, (it >> 4) & 31, it & 15, false, lds, wave);
#else
                for (int rep_ = 0; rep_ < NREP(2); ++rep_)
                for (int it = bx; it < 1024; it += G) lru_tile_mfma(kp, j, it, it + G, it == bx, false, LRU_STREAM != 0, lds, wave);
#endif
#ifndef NO_KN
                for (int it = bx; it < 512; it += G) knorm_item(kp, j, it, wave, lane);
#endif
#ifdef NAIVE_SCORE
                for (int it = bx; it < 4160; it += G) { const int b = it / 2080; int r = it % 2080; int c = 0; while (r >= c + 1) { r -= c + 1; ++c; } score_item(kp, b, c, r, lds, wave); }
#else
                __syncthreads();
                for (int rep_ = 0; rep_ < NREP(3); ++rep_)
                for (int u = gw; u < 2048; u += NGW) { const int ks = u & 7, qg = (u >> 3) & 3, cp = (u >> 5) & 31, b = u >> 10;
                    score_wave_unit(kp, b, cp, qg, ks, lane, lds, wave); score_wave_unit(kp, b, 63 - cp, qg, ks, lane, lds, wave); }
#ifdef CHECK_SCORE
                GRID_BAR();
                for (int it = bx; it < 4160; it += G) { const int b = it / 2080; int r = it % 2080; int c = 0; while (r >= c + 1) { r -= c + 1; ++c; } score_item(kp, b, c, r, lds, wave, true); }
#endif
#endif
                SEAM(ph); }
            ++ph;
            if (IN(ph)) { PHASE_BEGIN(); LANE_ONLY();
#ifdef NAIVE_LRU
                for (int it = bx; it < 1024; it += G) lru_tile(kp, j, it >> 9, (it >> 4) & 31, it & 15, true, lds, wave);
#else
                for (int rep_ = 0; rep_ < NREP(2); ++rep_)
                for (int it = bx; it < 1024; it += (LRU_STREAM ? 4 : 1) * G) { if (LRU_STREAM) { __syncthreads(); lru_carry4(kp, it, G, (float*)lds, wave); __syncthreads();
#pragma unroll 1
                    for (int k4 = 0; k4 < 4; ++k4) if (it + k4 * G < 1024) lru_apply_item(kp, it + k4 * G, (const float*)lds + k4 * 128, wave); }
                  else lru_tile_mfma(kp, j, it, it + G, it == bx, true, false, lds, wave); }
#ifdef CHECK_LRU
                GRID_BAR();
                for (int it = bx; it < 1024; it += G) lru_tile(kp, j, it >> 9, (it >> 4) & 31, it & 15, true, lds, wave, true);
#endif
#endif
#ifndef NO_SEL
                for (int rep_ = 0; rep_ < NREP(4); ++rep_)
                for (int u = gw; u < M / 2; u += NGW) { const int b_ = u >> 11, t_ = u & 2047;
                    select_query(kp, b_ * SEQ + t_, lane); select_query(kp, b_ * SEQ + 4095 - t_, lane); }
#endif
                SEAM(ph); }
            ++ph;
            if (IN(ph)) { PHASE_BEGIN();
#ifdef NAIVE_ATTN
                for (int qi = bx; qi < M; qi += G) attn_query(kp, j, qi, lds, wave);
#else
                for (int rep_ = 0; rep_ < NREP(5); ++rep_)
                for (int u = bx; u < 256; u += G) { const int bg = u & 7, cp = u >> 3;

#pragma unroll 1
                    for (int k2 = 0; k2 < 2; ++k2) att::attn_unit<0>(kp, j, bg >> 2, bg & 3, k2 ? cp : 63 - cp, (char*)lds, wave); }
#if PROBE_REP >= 20 && PROBE_REP < 30
                for (int rep_ = 0; rep_ < 2; ++rep_) for (int u = bx; u < 256; u += G) { const int bg = u & 7, cp = u >> 3; att::attn_unit<PROBE_REP - 20>(kp, j, bg >> 2, bg & 3, 63 - cp, (char*)lds, wave); att::attn_unit<PROBE_REP - 20>(kp, j, bg >> 2, bg & 3, cp, (char*)lds, wave); }
#endif
#ifdef CHECK_ATTN
                GRID_BAR();
                for (int qi = bx; qi < M; qi += G) attn_query(kp, j, qi, lds, wave, true);
#endif
#endif
                SEAM(ph); }
            ++ph;
            if (IN(ph)) { PHASE_BEGIN();
                { pg8::Gemm g{YCAT, WEOUT + (size_t)j * 2048 * 4096, M, 2048, 4096}; pg8::StaticOrder S; S.init(M, 2048, G, bx);
                  pg8::EpiOut E{HP, HQ, STB}; pg8::gemm_phase<pg8::EpiOut, pg8::StaticOrder, true, true>(ldsl, g, S, E, wave);
#if PROBE_REP == 12
                  { pg8::EpiOut Ed{HP, (bf16*)(ws + WS_SC), (float*)(ws + WS_SC) + 16 * 1048576}; for (int rep_ = 0; rep_ < 2; ++rep_) pg8::gemm_phase<pg8::EpiOut, pg8::StaticOrder, true, true>(ldsl, g, S, Ed, wave); }
#endif
                }
                SEAM(ph); }
            ++ph;
        } else {
            if (IN(ph)) { PHASE_BEGIN(); pg8::Gemm g{HP, WOIN + (size_t)j * ODD_IN * 2048, M, ODD_IN, 2048}; pg8::StaticOrder S; S.init(M, ODD_IN, G, bx);
                pg8::EpiOddIn E{PROJ, STA, SLN}; for (int rep_ = 0; rep_ < NREP(6); ++rep_) pg8::gemm_phase<pg8::EpiOddIn, pg8::StaticOrder, true, true>(ldsl, g, S, E, wave); SEAM(ph); }
            ++ph;
            if (IN(ph)) { PHASE_BEGIN();
#ifndef NO_SGU
                for (int rep_ = 0; rep_ < NREP(7); ++rep_)
#ifdef NAIVE_SGU
                for (int it = bx; it < 1024; it += G) sgu_item(kp, j, it >> 9, (it >> 4) & 31, it & 15, lds, wave);
#else
                for (int it = bx; it < 1024; it += G) sgu_item_mfma(kp, j, it >> 9, (it >> 4) & 31, it & 15, lds, wave);
#endif
#endif
                SEAM(ph); }
            ++ph;
            if (IN(ph)) { PHASE_BEGIN();
                { pg8::Gemm g{YCAT, WOOUT + (size_t)j * 2048 * 2048, M, 2048, 2048}; pg8::StaticOrder S; S.init(M, 2048, G, bx);
                  pg8::EpiOut E{HP, HQ, STB}; pg8::gemm_phase<pg8::EpiOut, pg8::StaticOrder, true, true>(ldsl, g, S, E, wave);
#if PROBE_REP == 12
                  { pg8::EpiOut Ed{HP, (bf16*)(ws + WS_SC), (float*)(ws + WS_SC) + 16 * 1048576}; for (int rep_ = 0; rep_ < 2; ++rep_) pg8::gemm_phase<pg8::EpiOut, pg8::StaticOrder, true, true>(ldsl, g, S, Ed, wave); }
#endif
                }
                SEAM(ph); }
            ++ph;
        }
        if (IN(ph)) { PHASE_BEGIN(); pg8::Gemm g{HQ, WGATE + (size_t)layer * 2048 * 2048, M, 2048, 2048}; pg8::StaticOrder S; S.init(M, 2048, G, bx);
            typedef pg8::EpiGateT<layer_it == DEPTH - 1> EpiGate;
            EpiGate E{HQ, EB, STB, HP, STA, KOUT}; pg8::gemm_phase<EpiGate, pg8::StaticOrder, true, true>(ldsl, g, S, E, wave);
#if PROBE_REP == 13
            { pg8::EpiGateT<false> Ed{HQ, EB, STB, (bf16*)(ws + WS_SC), (float*)(ws + WS_SC) + 16 * 1048576, nullptr}; for (int rep_ = 0; rep_ < 2; ++rep_) pg8::gemm_phase<pg8::EpiGateT<false>, pg8::StaticOrder, true, true>(ldsl, g, S, Ed, wave); }
#endif

            if (layer_it != DEPTH - 1) SEAM(ph); }
        ++ph;
    }
    {
        constexpr int layer_it = 2;
        if ((layer_it & 1) == 0) {
            if (IN(ph)) { PHASE_BEGIN(); pg8::Gemm g{HP, WEIN + (size_t)j * EVEN_INP * 2048, M, EVEN_INP, 2048}; pg8::StaticOrder S; S.init(M, EVEN_INP, G, bx);
                pg8::EpiEvenIn E{PROJ, IDX, STA, (bf16*)(ws + WS_IDXB)}; for (int rep_ = 0; rep_ < NREP(1); ++rep_) pg8::gemm_phase<pg8::EpiEvenIn, pg8::StaticOrder, true, true>(ldsl, g, S, E, wave);
                if (bx >= 32 && G > 32) {
#pragma unroll 1
                    for (int l2 = 0; l2 < 2; ++l2) { const int ll = layer + l2; pg8::Gemm g2{PBF + (size_t)ll * M * 256, WPE + (size_t)ll * 2048 * 256, M, 2048, 256}; pg8::StaticOrder S2; S2.init(M, 2048, G - 32, bx - 32);
                        pg8::EpiPE E2{EBL(ll)}; pg8::gemm_phase<pg8::EpiPE, pg8::StaticOrder, true, true>(ldsl, g2, S2, E2, wave);  }
                    { LANE_ONLY(); float* scr = (float*)(lds + wave * 16640); const int gw2 = (bx - 32) * NWAVES + wave, NGW2 = (G - 32) * NWAVES; int base = 0, it = gw2;
#define TR2(W, K, N, WT, GK) do { const int ni_ = ((K) / 64) * (((N) + 63) / 64); for (; it < base + ni_; it += NGW2) p0_transpose_item((W), (K), (N), (WT), scr, it - base, lane, (GK)); base += ni_; } while (0)
                      if (layer == 0) { TR2(KIN(4) + (size_t)2048 * EVEN_IN, 2048, EVEN_IN, WEIN + (size_t)EVEN_INP * 2048, KIN(2) + 2 * DM); }
                      else { TR2(KIN(15) + (size_t)2048 * ODD_IN, 2048, ODD_IN, WOIN + (size_t)ODD_IN * 2048, KIN(2) + 3 * DM); TR2(KIN(20) + (size_t)2048 * 2048, 2048, 2048, WOOUT + (size_t)2048 * 2048, nullptr); TR2(KIN(23) + (size_t)3 * 2048 * 2048, 2048, 2048, WGATE + (size_t)3 * 2048 * 2048, KIN(22) + 3 * DM); }
#undef TR2
                    } }
#if PROBE_REP == 11 || PROBE_REP == 14
                __syncthreads();
                { pg8::EpiEvenInT<PROBE_REP == 11 ? 1 : 2> EN{PROJ, IDX, STA, (bf16*)(ws + WS_IDXB)}; for (int rep_ = 0; rep_ < 2; ++rep_) pg8::gemm_phase<pg8::EpiEvenInT<PROBE_REP == 11 ? 1 : 2>, pg8::StaticOrder, true, true>(ldsl, g, S, EN, wave); }
#endif
#if PROBE_REP == 10
                __syncthreads();
                { pg8::EpiNull EN; for (int rep_ = 0; rep_ < 2; ++rep_) pg8::gemm_phase<pg8::EpiNull, pg8::StaticOrder, true, true>(ldsl, g, S, EN, wave); }
#endif
                SEAM(ph); }
            ++ph;
            if (IN(ph)) { PHASE_BEGIN(); LANE_ONLY();
#ifdef NAIVE_LRU
                for (int it = bx; it < 1024; it += G) lru_tile(kp, j, it >> 9, (it >> 4) & 31, it & 15, false, lds, wave);
#else
                for (int rep_ = 0; rep_ < NREP(2); ++rep_)
                for (int it = bx; it < 1024; it += G) lru_tile_mfma(kp, j, it, it + G, it == bx, false, LRU_STREAM != 0, lds, wave);
#endif
#ifndef NO_KN
                for (int it = bx; it < 512; it += G) knorm_item(kp, j, it, wave, lane);
#endif
#ifdef NAIVE_SCORE
                for (int it = bx; it < 4160; it += G) { const int b = it / 2080; int r = it % 2080; int c = 0; while (r >= c + 1) { r -= c + 1; ++c; } score_item(kp, b, c, r, lds, wave); }
#else
                __syncthreads();
                for (int rep_ = 0; rep_ < NREP(3); ++rep_)
                for (int u = gw; u < 2048; u += NGW) { const int ks = u & 7, qg = (u >> 3) & 3, cp = (u >> 5) & 31, b = u >> 10;
                    score_wave_unit(kp, b, cp, qg, ks, lane, lds, wave); score_wave_unit(kp, b, 63 - cp, qg, ks, lane, lds, wave); }
#ifdef CHECK_SCORE
                GRID_BAR();
                for (int it = bx; it < 4160; it += G) { const int b = it / 2080; int r = it % 2080; int c = 0; while (r >= c + 1) { r -= c + 1; ++c; } score_item(kp, b, c, r, lds, wave, true); }
#endif
#endif
                SEAM(ph); }
            ++ph;
            if (IN(ph)) { PHASE_BEGIN(); LANE_ONLY();
#ifdef NAIVE_LRU
                for (int it = bx; it < 1024; it += G) lru_tile(kp, j, it >> 9, (it >> 4) & 31, it & 15, true, lds, wave);
#else
                for (int rep_ = 0; rep_ < NREP(2); ++rep_)
                for (int it = bx; it < 1024; it += (LRU_STREAM ? 4 : 1) * G) { if (LRU_STREAM) { __syncthreads(); lru_carry4(kp, it, G, (float*)lds, wave); __syncthreads();
#pragma unroll 1
                    for (int k4 = 0; k4 < 4; ++k4) if (it + k4 * G < 1024) lru_apply_item(kp, it + k4 * G, (const float*)lds + k4 * 128, wave); }
                  else lru_tile_mfma(kp, j, it, it + G, it == bx, true, false, lds, wave); }
#ifdef CHECK_LRU
                GRID_BAR();
                for (int it = bx; it < 1024; it += G) lru_tile(kp, j, it >> 9, (it >> 4) & 31, it & 15, true, lds, wave, true);
#endif
#endif
#ifndef NO_SEL
                for (int rep_ = 0; rep_ < NREP(4); ++rep_)
                for (int u = gw; u < M / 2; u += NGW) { const int b_ = u >> 11, t_ = u & 2047;
                    select_query(kp, b_ * SEQ + t_, lane); select_query(kp, b_ * SEQ + 4095 - t_, lane); }
#endif
                SEAM(ph); }
            ++ph;
            if (IN(ph)) { PHASE_BEGIN();
#ifdef NAIVE_ATTN
                for (int qi = bx; qi < M; qi += G) attn_query(kp, j, qi, lds, wave);
#else
                for (int rep_ = 0; rep_ < NREP(5); ++rep_)
                for (int u = bx; u < 256; u += G) { const int bg = u & 7, cp = u >> 3;

#pragma unroll 1
                    for (int k2 = 0; k2 < 2; ++k2) att::attn_unit<0>(kp, j, bg >> 2, bg & 3, k2 ? cp : 63 - cp, (char*)lds, wave); }
#if PROBE_REP >= 20 && PROBE_REP < 30
                for (int rep_ = 0; rep_ < 2; ++rep_) for (int u = bx; u < 256; u += G) { const int bg = u & 7, cp = u >> 3; att::attn_unit<PROBE_REP - 20>(kp, j, bg >> 2, bg & 3, 63 - cp, (char*)lds, wave); att::attn_unit<PROBE_REP - 20>(kp, j, bg >> 2, bg & 3, cp, (char*)lds, wave); }
#endif
#ifdef CHECK_ATTN
                GRID_BAR();
                for (int qi = bx; qi < M; qi += G) attn_query(kp, j, qi, lds, wave, true);
#endif
#endif
                SEAM(ph); }
            ++ph;
            if (IN(ph)) { PHASE_BEGIN();
                { pg8::Gemm g{YCAT, WEOUT + (size_t)j * 2048 * 4096, M, 2048, 4096}; pg8::StaticOrder S; S.init(M, 2048, G, bx);
                  pg8::EpiOut E{HP, HQ, STB}; pg8::gemm_phase<pg8::EpiOut, pg8::StaticOrder, true, true>(ldsl, g, S, E, wave);
#if PROBE_REP == 12
                  { pg8::EpiOut Ed{HP, (bf16*)(ws + WS_SC), (float*)(ws + WS_SC) + 16 * 1048576}; for (int rep_ = 0; rep_ < 2; ++rep_) pg8::gemm_phase<pg8::EpiOut, pg8::StaticOrder, true, true>(ldsl, g, S, Ed, wave); }
#endif
                }
                SEAM(ph); }
            ++ph;
        } else {
            if (IN(ph)) { PHASE_BEGIN(); pg8::Gemm g{HP, WOIN + (size_t)j * ODD_IN * 2048, M, ODD_IN, 2048}; pg8::StaticOrder S; S.init(M, ODD_IN, G, bx);
                pg8::EpiOddIn E{PROJ, STA, SLN}; for (int rep_ = 0; rep_ < NREP(6); ++rep_) pg8::gemm_phase<pg8::EpiOddIn, pg8::StaticOrder, true, true>(ldsl, g, S, E, wave); SEAM(ph); }
            ++ph;
            if (IN(ph)) { PHASE_BEGIN();
#ifndef NO_SGU
                for (int rep_ = 0; rep_ < NREP(7); ++rep_)
#ifdef NAIVE_SGU
                for (int it = bx; it < 1024; it += G) sgu_item(kp, j, it >> 9, (it >> 4) & 31, it & 15, lds, wave);
#else
                for (int it = bx; it < 1024; it += G) sgu_item_mfma(kp, j, it >> 9, (it >> 4) & 31, it & 15, lds, wave);
#endif
#endif
                SEAM(ph); }
            ++ph;
            if (IN(ph)) { PHASE_BEGIN();
                { pg8::Gemm g{YCAT, WOOUT + (size_t)j * 2048 * 2048, M, 2048, 2048}; pg8::StaticOrder S; S.init(M, 2048, G, bx);
                  pg8::EpiOut E{HP, HQ, STB}; pg8::gemm_phase<pg8::EpiOut, pg8::StaticOrder, true, true>(ldsl, g, S, E, wave);
#if PROBE_REP == 12
                  { pg8::EpiOut Ed{HP, (bf16*)(ws + WS_SC), (float*)(ws + WS_SC) + 16 * 1048576}; for (int rep_ = 0; rep_ < 2; ++rep_) pg8::gemm_phase<pg8::EpiOut, pg8::StaticOrder, true, true>(ldsl, g, S, Ed, wave); }
#endif
                }
                SEAM(ph); }
            ++ph;
        }
        if (IN(ph)) { PHASE_BEGIN(); pg8::Gemm g{HQ, WGATE + (size_t)layer * 2048 * 2048, M, 2048, 2048}; pg8::StaticOrder S; S.init(M, 2048, G, bx);
            typedef pg8::EpiGateT<layer_it == DEPTH - 1> EpiGate;
            EpiGate E{HQ, EB, STB, HP, STA, KOUT}; pg8::gemm_phase<EpiGate, pg8::StaticOrder, true, true>(ldsl, g, S, E, wave);
#if PROBE_REP == 13
            { pg8::EpiGateT<false> Ed{HQ, EB, STB, (bf16*)(ws + WS_SC), (float*)(ws + WS_SC) + 16 * 1048576, nullptr}; for (int rep_ = 0; rep_ < 2; ++rep_) pg8::gemm_phase<pg8::EpiGateT<false>, pg8::StaticOrder, true, true>(ldsl, g, S, Ed, wave); }
#endif

            if (layer_it != DEPTH - 1) SEAM(ph); }
        ++ph;
    }
    {
        constexpr int layer_it = 3;
        if ((layer_it & 1) == 0) {
            if (IN(ph)) { PHASE_BEGIN(); pg8::Gemm g{HP, WEIN + (size_t)j * EVEN_INP * 2048, M, EVEN_INP, 2048}; pg8::StaticOrder S; S.init(M, EVEN_INP, G, bx);
                pg8::EpiEvenIn E{PROJ, IDX, STA, (bf16*)(ws + WS_IDXB)}; for (int rep_ = 0; rep_ < NREP(1); ++rep_) pg8::gemm_phase<pg8::EpiEvenIn, pg8::StaticOrder, true, true>(ldsl, g, S, E, wave);
                if (bx >= 32 && G > 32) {
#pragma unroll 1
                    for (int l2 = 0; l2 < 2; ++l2) { const int ll = layer + l2; pg8::Gemm g2{PBF + (size_t)ll * M * 256, WPE + (size_t)ll * 2048 * 256, M, 2048, 256}; pg8::StaticOrder S2; S2.init(M, 2048, G - 32, bx - 32);
                        pg8::EpiPE E2{EBL(ll)}; pg8::gemm_phase<pg8::EpiPE, pg8::StaticOrder, true, true>(ldsl, g2, S2, E2, wave);  }
                    { LANE_ONLY(); float* scr = (float*)(lds + wave * 16640); const int gw2 = (bx - 32) * NWAVES + wave, NGW2 = (G - 32) * NWAVES; int base = 0, it = gw2;
#define TR2(W, K, N, WT, GK) do { const int ni_ = ((K) / 64) * (((N) + 63) / 64); for (; it < base + ni_; it += NGW2) p0_transpose_item((W), (K), (N), (WT), scr, it - base, lane, (GK)); base += ni_; } while (0)
                      if (layer == 0) { TR2(KIN(4) + (size_t)2048 * EVEN_IN, 2048, EVEN_IN, WEIN + (size_t)EVEN_INP * 2048, KIN(2) + 2 * DM); }
                      else { TR2(KIN(15) + (size_t)2048 * ODD_IN, 2048, ODD_IN, WOIN + (size_t)ODD_IN * 2048, KIN(2) + 3 * DM); TR2(KIN(20) + (size_t)2048 * 2048, 2048, 2048, WOOUT + (size_t)2048 * 2048, nullptr); TR2(KIN(23) + (size_t)3 * 2048 * 2048, 2048, 2048, WGATE + (size_t)3 * 2048 * 2048, KIN(22) + 3 * DM); }
#undef TR2
                    } }
#if PROBE_REP == 11 || PROBE_REP == 14
                __syncthreads();
                { pg8::EpiEvenInT<PROBE_REP == 11 ? 1 : 2> EN{PROJ, IDX, STA, (bf16*)(ws + WS_IDXB)}; for (int rep_ = 0; rep_ < 2; ++rep_) pg8::gemm_phase<pg8::EpiEvenInT<PROBE_REP == 11 ? 1 : 2>, pg8::StaticOrder, true, true>(ldsl, g, S, EN, wave); }
#endif
#if PROBE_REP == 10
                __syncthreads();
                { pg8::EpiNull EN; for (int rep_ = 0; rep_ < 2; ++rep_) pg8::gemm_phase<pg8::EpiNull, pg8::StaticOrder, true, true>(ldsl, g, S, EN, wave); }
#endif
                SEAM(ph); }
            ++ph;
            if (IN(ph)) { PHASE_BEGIN(); LANE_ONLY();
#ifdef NAIVE_LRU
                for (int it = bx; it < 1024; it += G) lru_tile(kp, j, it >> 9, (it >> 4) & 31, it & 15, false, lds, wave);
#else
                for (int rep_ = 0; rep_ < NREP(2); ++rep_)
                for (int it = bx; it < 1024; it += G) lru_tile_mfma(kp, j, it, it + G, it == bx, false, LRU_STREAM != 0, lds, wave);
#endif
#ifndef NO_KN
                for (int it = bx; it < 512; it += G) knorm_item(kp, j, it, wave, lane);
#endif
#ifdef NAIVE_SCORE
                for (int it = bx; it < 4160; it += G) { const int b = it / 2080; int r = it % 2080; int c = 0; while (r >= c + 1) { r -= c + 1; ++c; } score_item(kp, b, c, r, lds, wave); }
#else
                __syncthreads();
                for (int rep_ = 0; rep_ < NREP(3); ++rep_)
                for (int u = gw; u < 2048; u += NGW) { const int ks = u & 7, qg = (u >> 3) & 3, cp = (u >> 5) & 31, b = u >> 10;
                    score_wave_unit(kp, b, cp, qg, ks, lane, lds, wave); score_wave_unit(kp, b, 63 - cp, qg, ks, lane, lds, wave); }
#ifdef CHECK_SCORE
                GRID_BAR();
                for (int it = bx; it < 4160; it += G) { const int b = it / 2080; int r = it % 2080; int c = 0; while (r >= c + 1) { r -= c + 1; ++c; } score_item(kp, b, c, r, lds, wave, true); }
#endif
#endif
                SEAM(ph); }
            ++ph;
            if (IN(ph)) { PHASE_BEGIN(); LANE_ONLY();
#ifdef NAIVE_LRU
                for (int it = bx; it < 1024; it += G) lru_tile(kp, j, it >> 9, (it >> 4) & 31, it & 15, true, lds, wave);
#else
                for (int rep_ = 0; rep_ < NREP(2); ++rep_)
                for (int it = bx; it < 1024; it += (LRU_STREAM ? 4 : 1) * G) { if (LRU_STREAM) { __syncthreads(); lru_carry4(kp, it, G, (float*)lds, wave); __syncthreads();
#pragma unroll 1
                    for (int k4 = 0; k4 < 4; ++k4) if (it + k4 * G < 1024) lru_apply_item(kp, it + k4 * G, (const float*)lds + k4 * 128, wave); }
                  else lru_tile_mfma(kp, j, it, it + G, it == bx, true, false, lds, wave); }
#ifdef CHECK_LRU
                GRID_BAR();
                for (int it = bx; it < 1024; it += G) lru_tile(kp, j, it >> 9, (it >> 4) & 31, it & 15, true, lds, wave, true);
#endif
#endif
#ifndef NO_SEL
                for (int rep_ = 0; rep_ < NREP(4); ++rep_)
                for (int u = gw; u < M / 2; u += NGW) { const int b_ = u >> 11, t_ = u & 2047;
                    select_query(kp, b_ * SEQ + t_, lane); select_query(kp, b_ * SEQ + 4095 - t_, lane); }
#endif
                SEAM(ph); }
            ++ph;
            if (IN(ph)) { PHASE_BEGIN();
#ifdef NAIVE_ATTN
                for (int qi = bx; qi < M; qi += G) attn_query(kp, j, qi, lds, wave);
#else
                for (int rep_ = 0; rep_ < NREP(5); ++rep_)
                for (int u = bx; u < 256; u += G) { const int bg = u & 7, cp = u >> 3;

#pragma unroll 1
                    for (int k2 = 0; k2 < 2; ++k2) att::attn_unit<0>(kp, j, bg >> 2, bg & 3, k2 ? cp : 63 - cp, (char*)lds, wave); }
#if PROBE_REP >= 20 && PROBE_REP < 30
                for (int rep_ = 0; rep_ < 2; ++rep_) for (int u = bx; u < 256; u += G) { const int bg = u & 7, cp = u >> 3; att::attn_unit<PROBE_REP - 20>(kp, j, bg >> 2, bg & 3, 63 - cp, (char*)lds, wave); att::attn_unit<PROBE_REP - 20>(kp, j, bg >> 2, bg & 3, cp, (char*)lds, wave); }
#endif
#ifdef CHECK_ATTN
                GRID_BAR();
                for (int qi = bx; qi < M; qi += G) attn_query(kp, j, qi, lds, wave, true);
#endif
#endif
                SEAM(ph); }
            ++ph;
            if (IN(ph)) { PHASE_BEGIN();
                { pg8::Gemm g{YCAT, WEOUT + (size_t)j * 2048 * 4096, M, 2048, 4096}; pg8::StaticOrder S; S.init(M, 2048, G, bx);
                  pg8::EpiOut E{HP, HQ, STB}; pg8::gemm_phase<pg8::EpiOut, pg8::StaticOrder, true, true>(ldsl, g, S, E, wave);
#if PROBE_REP == 12
                  { pg8::EpiOut Ed{HP, (bf16*)(ws + WS_SC), (float*)(ws + WS_SC) + 16 * 1048576}; for (int rep_ = 0; rep_ < 2; ++rep_) pg8::gemm_phase<pg8::EpiOut, pg8::StaticOrder, true, true>(ldsl, g, S, Ed, wave); }
#endif
                }
                SEAM(ph); }
            ++ph;
        } else {
            if (IN(ph)) { PHASE_BEGIN(); pg8::Gemm g{HP, WOIN + (size_t)j * ODD_IN * 2048, M, ODD_IN, 2048}; pg8::StaticOrder S; S.init(M, ODD_IN, G, bx);
                pg8::EpiOddIn E{PROJ, STA, SLN}; for (int rep_ = 0; rep_ < NREP(6); ++rep_) pg8::gemm_phase<pg8::EpiOddIn, pg8::StaticOrder, true, true>(ldsl, g, S, E, wave); SEAM(ph); }
            ++ph;
            if (IN(ph)) { PHASE_BEGIN();
#ifndef NO_SGU
                for (int rep_ = 0; rep_ < NREP(7); ++rep_)
#ifdef NAIVE_SGU
                for (int it = bx; it < 1024; it += G) sgu_item(kp, j, it >> 9, (it >> 4) & 31, it & 15, lds, wave);
#else
                for (int it = bx; it < 1024; it += G) sgu_item_mfma(kp, j, it >> 9, (it >> 4) & 31, it & 15, lds, wave);
#endif
#endif
                SEAM(ph); }
            ++ph;
            if (IN(ph)) { PHASE_BEGIN();
                { pg8::Gemm g{YCAT, WOOUT + (size_t)j * 2048 * 2048, M, 2048, 2048}; pg8::StaticOrder S; S.init(M, 2048, G, bx);
                  pg8::EpiOut E{HP, HQ, STB}; pg8::gemm_phase<pg8::EpiOut, pg8::StaticOrder, true, true>(ldsl, g, S, E, wave);
#if PROBE_REP == 12
                  { pg8::EpiOut Ed{HP, (bf16*)(ws + WS_SC), (float*)(ws + WS_SC) + 16 * 1048576}; for (int rep_ = 0; rep_ < 2; ++rep_) pg8::gemm_phase<pg8::EpiOut, pg8::StaticOrder, true, true>(ldsl, g, S, Ed, wave); }
#endif
                }
                SEAM(ph); }
            ++ph;
        }
        if (IN(ph)) { PHASE_BEGIN(); pg8::Gemm g{HQ, WGATE + (size_t)layer * 2048 * 2048, M, 2048, 2048}; pg8::StaticOrder S; S.init(M, 2048, G, bx);
            typedef pg8::EpiGateT<layer_it == DEPTH - 1> EpiGate;
            EpiGate E{HQ, EB, STB, HP, STA, KOUT}; pg8::gemm_phase<EpiGate, pg8::StaticOrder, true, true>(ldsl, g, S, E, wave);
#if PROBE_REP == 13
            { pg8::EpiGateT<false> Ed{HQ, EB, STB, (bf16*)(ws + WS_SC), (float*)(ws + WS_SC) + 16 * 1048576, nullptr}; for (int rep_ = 0; rep_ < 2; ++rep_) pg8::gemm_phase<pg8::EpiGateT<false>, pg8::StaticOrder, true, true>(ldsl, g, S, Ed, wave); }
#endif

            if (layer_it != DEPTH - 1) SEAM(ph); }
        ++ph;
    }
#if defined(CHECK_SCORE) || defined(CHECK_ATTN) || defined(CHECK_LRU)
    if (IN(NPHASE - 1)) { KARGS_OPEN(); GRID_BAR(); if (bx == 0 && wave == 0 && lane_id() == 0 && __hip_atomic_load((unsigned*)(KWS + WS_CTL) + 8, __ATOMIC_RELAXED, __HIP_MEMORY_SCOPE_AGENT) != 0u) KOUT[0] = __builtin_nanf(""); }
#endif
#undef IN
#undef SEAM
#undef GRID_BAR
#undef HP
#undef HQ
#undef PROJ
#undef YCAT
#undef IDX
#undef EB
#undef STA
#undef STB
#undef SLN
#undef PBF
#undef WPE
#undef WGATE
#undef WEIN
#undef WEOUT
#undef WOIN
#undef WOOUT
#undef ws
}

extern "C" void kernel_launch(void* const* d_in, const int* in_sizes, int n_in, void* d_out, int out_size, void* d_ws, size_t ws_size, hipStream_t stream) {
    static int grid = 0;
    if (grid == 0) {
        if (n_in != 24 || out_size != M * DM || ws_size < WS_END) { fprintf(stderr, "kernel_launch: unexpected shapes (n_in %d out %d ws %zu)\n", n_in, out_size, ws_size); grid = -1; return; }
        int dev = 0, cus = 0, per_cu = 0;
        if (hipGetDevice(&dev) != hipSuccess || hipDeviceGetAttribute(&cus, hipDeviceAttributeMultiprocessorCount, dev) != hipSuccess) { grid = -1; return; }
        if (hipFuncSetAttribute((const void*)mega_fwd, hipFuncAttributeMaxDynamicSharedMemorySize, LDS_BYTES) != hipSuccess) { fprintf(stderr, "kernel_launch: hipFuncSetAttribute failed\n"); grid = -1; return; }
        if (hipOccupancyMaxActiveBlocksPerMultiprocessor(&per_cu, (const void*)mega_fwd, NTHR, LDS_BYTES) != hipSuccess || per_cu < 1) { fprintf(stderr, "kernel_launch: occupancy query says %d\n", per_cu); }
        (void)hipGetLastError();
        grid = cus;
        if (grid != 256) fprintf(stderr, "kernel_launch: %d CUs (built for 256)\n", grid);
    }
    if (grid < 0) return;
    (void)hipMemsetAsync((char*)d_ws + WS_CTL, 0, CTL_ZERO_BYTES, stream);
    Args a{};
    for (int i = 0; i < 24; ++i) a.in[i] = (const float*)d_in[i];
    a.out = (float*)d_out; a.ws = (unsigned char*)d_ws;
    for (int k = 0; k < 8; ++k) a.thr[k] = 1 << 30;
    for (int n = 8; n < 4096; ++n) { const float nf = (float)n; const float l = (float)log((double)(nf / 8.0f)); const float tt = (l / (float)log(16.0)) * 8.0f; int large = 8 + (int)tt; if (large > 15) large = 15;
        const int k = large - 8; for (int kk = 1; kk <= k; ++kk) if (n < a.thr[kk]) a.thr[kk] = n; }
    if (N_LAUNCHES == 1) { a.ph_lo = 0; a.ph_hi = NPHASE; hipLaunchKernelGGL(mega_fwd, dim3(grid), dim3(NTHR), LDS_BYTES, stream, a); }
    else { for (int p = 0; p < NPHASE; ++p) { a.ph_lo = p; a.ph_hi = p + 1; hipLaunchKernelGGL(mega_fwd, dim3(grid), dim3(NTHR), LDS_BYTES, stream, a); } }
}
```
